# Optimizing an MI355X kernel written in HIP

```python
import math
import jax
import jax.numpy as jnp
from jax import lax
import numpy as np

D_MODEL = 1024
BATCH = 4
SEQ = 8192
DEPTH = 2

CTX_LEN = 256
GRID_W = 64
HEAD_DIM = 64
N_MIXERS = 4
GROUP_WIDTH = D_MODEL // N_MIXERS
GROUP_HEADS = GROUP_WIDTH // HEAD_DIM
Q_BLOCK = 128
MLA_NOPE = HEAD_DIM
MLA_ROPE = HEAD_DIM // 2
MLA_V = HEAD_DIM
MLA_KV_RANK = D_MODEL // 8
SWA_KV_HEADS = GROUP_HEADS // 2
SWA_WINDOW = 128
SWA_BLOCK = 128
NA_KH = 8
NA_KW = 16
NA_QB_W = 16
NA_KB_W = NA_QB_W + NA_KW
RET_CHUNK = 128
PEER_HEADS = 8
PEER_NKEYS = 128
PEER_EXPERTS = PEER_NKEYS * PEER_NKEYS
PEER_TOPK = 16
PEER_DKEY = 256
PEER_TOKEN_BLOCK = 128
ADA_CHUNKS = 6
ROPE_BASE = 10000.0
EPS = 1e-6
NEG_INF = -1e30

IN_SPLITS = (
    GROUP_HEADS * (MLA_NOPE + MLA_ROPE),
    MLA_KV_RANK,
    MLA_ROPE,
    GROUP_HEADS * HEAD_DIM,
    SWA_KV_HEADS * HEAD_DIM,
    SWA_KV_HEADS * HEAD_DIM,
    GROUP_WIDTH,
    GROUP_WIDTH,
    GROUP_WIDTH,
    GROUP_WIDTH,
    GROUP_WIDTH,
    GROUP_WIDTH,
    GROUP_WIDTH,
    GROUP_WIDTH,
)
IN_WIDTH = sum(IN_SPLITS)

kernel_name = "hybrid_parallel_heads_peer_flow_block"


def rmsnorm(x, g):
    xf = x.astype(jnp.float32)
    y = xf * lax.rsqrt(jnp.mean(xf * xf, axis=-1, keepdims=True) + EPS)
    return (y * g.astype(jnp.float32)).astype(x.dtype)


def modulate(h, shift, scale):
    return h * (1.0 + scale[:, None, :]) + shift[:, None, :]


def split_heads(t, n):
    b, s, _ = t.shape
    return t.reshape(b, s, n, -1).transpose(0, 2, 1, 3)


def merge_heads(t):
    b, n, s, d = t.shape
    return t.transpose(0, 2, 1, 3).reshape(b, s, n * d)


def softmax_f32(logits):
    return jax.nn.softmax(logits.astype(jnp.float32), axis=-1)


def axial_rope_tables(n_tok, rot_dim):
    quarter = rot_dim // 4
    inv = ROPE_BASE ** (-jnp.arange(quarter, dtype=jnp.float32) / quarter)
    t = jnp.arange(n_tok, dtype=jnp.int32)
    pos = jnp.stack([t // GRID_W, t % GRID_W], axis=-1).astype(jnp.float32)
    ang = pos[:, :, None] * inv
    return jnp.cos(ang), jnp.sin(ang)


def apply_axial_rope(x, cos, sin):
    shp = x.shape
    quarter = shp[-1] // 4
    xf = x.astype(jnp.float32).reshape(shp[:-1] + (2, 2, quarter))
    x1, x2 = xf[..., 0, :], xf[..., 1, :]
    out = jnp.stack([x1 * cos - x2 * sin, x1 * sin + x2 * cos], axis=-2)
    return out.reshape(shp).astype(x.dtype)


def dense_ctx_attention(q, k, v, scale, sink=None):
    s = jnp.einsum("bhqd,bhkd->bhqk", q, k).astype(jnp.float32) * scale
    if sink is not None:
        sink_col = jnp.broadcast_to(sink.astype(jnp.float32)[None, :, None, None], s.shape[:-1] + (1,))
        p = softmax_f32(jnp.concatenate([s, sink_col], axis=-1))[..., :-1]
    else:
        p = softmax_f32(s)
    return jnp.einsum("bhqk,bhkd->bhqd", p.astype(v.dtype), v)


def mla_kv(ckv, kv_norm_g, w_ukv):
    kv = split_heads(rmsnorm(ckv, kv_norm_g) @ w_ukv, GROUP_HEADS)
    return kv[..., :MLA_NOPE], kv[..., MLA_NOPE:]


def mla_mixer(q_l, ckv_l, kr_l, q_c, ckv_c, kr_c, kv_norm_g, w_ukv, cos, sin, with_ctx):
    h = GROUP_HEADS
    scale = (MLA_NOPE + MLA_ROPE) ** -0.5
    kn_l, v_l = mla_kv(ckv_l, kv_norm_g, w_ukv)
    kn_c, v_c = mla_kv(ckv_c, kv_norm_g, w_ukv)
    kr_lr = apply_axial_rope(kr_l, cos, sin)
    q = split_heads(q_l, h)
    qn, qr = q[..., :MLA_NOPE], apply_axial_rope(q[..., MLA_NOPE:], cos, sin)
    kn = jnp.concatenate([kn_c, kn_l], axis=2)
    kr = jnp.concatenate([kr_c, kr_lr], axis=1)
    v = jnp.concatenate([v_c, v_l], axis=2)
    b, _, n, _ = qn.shape
    nb = n // Q_BLOCK

    def block(qs):
        qn_b, qr_b = qs
        s = (jnp.einsum("bhqd,bhkd->bhqk", qn_b, kn)
             + jnp.einsum("bhqd,bkd->bhqk", qr_b, kr)).astype(jnp.float32) * scale
        p = softmax_f32(s)
        return jnp.einsum("bhqk,bhkd->bhqd", p.astype(v.dtype), v)

    to_blocks = lambda t: t.reshape(b, h, nb, Q_BLOCK, t.shape[-1]).transpose(2, 0, 1, 3, 4)
    o = lax.map(block, (to_blocks(qn), to_blocks(qr)))
    y_l = merge_heads(o.transpose(1, 2, 0, 3, 4).reshape(b, h, n, MLA_V))
    y_c = None
    if with_ctx:
        qc = split_heads(q_c, h)
        kc = jnp.concatenate([kn_c, jnp.broadcast_to(kr_c[:, None], kn_c.shape[:3] + (MLA_ROPE,))], axis=-1)
        y_c = merge_heads(dense_ctx_attention(qc, kc, v_c, scale))
    return y_l, y_c


def swa_mixer(q_l, k_l, v_l, q_c, k_c, v_c, sink, cos, sin, with_ctx):
    h, g = GROUP_HEADS, SWA_KV_HEADS
    r = h // g
    d = HEAD_DIM
    scale = d ** -0.5
    q = apply_axial_rope(split_heads(q_l, h), cos, sin)
    k = apply_axial_rope(split_heads(k_l, g), cos, sin)
    v = split_heads(v_l, g)
    kc, vc = split_heads(k_c, g), split_heads(v_c, g)
    b, _, n, _ = q.shape
    nb = n // SWA_BLOCK
    qb = q.reshape(b, g, r, nb, SWA_BLOCK, d)

    def band(t):
        tb = t.reshape(b, g, nb, SWA_BLOCK, d)
        tp = jnp.pad(tb, ((0, 0), (0, 0), (1, 1), (0, 0), (0, 0)))
        return jnp.concatenate([tp[:, :, :-2], tp[:, :, 1:-1], tp[:, :, 2:]], axis=3)

    kband, vband = band(k), band(v)
    nk = 3 * SWA_BLOCK
    rel = np.arange(nk)[None, :] - SWA_BLOCK - np.arange(SWA_BLOCK)[:, None]
    kpos = (np.arange(nb)[:, None] - 1) * SWA_BLOCK + np.arange(nk)[None, :]
    mask = (np.abs(rel) <= SWA_WINDOW)[None] & ((kpos >= 0) & (kpos < n))[:, None, :]
    s_band = jnp.einsum("bgrnqd,bgnkd->bgrnqk", qb, kband).astype(jnp.float32) * scale
    s_band = jnp.where(mask, s_band, NEG_INF)
    s_ctx = jnp.einsum("bgrnqd,bgkd->bgrnqk", qb, kc).astype(jnp.float32) * scale
    sink_col = jnp.broadcast_to(sink.astype(jnp.float32).reshape(1, g, r, 1, 1, 1), s_ctx.shape[:-1] + (1,))
    p = softmax_f32(jnp.concatenate([s_band, s_ctx, sink_col], axis=-1))
    n_ctx = kc.shape[2]
    o = (jnp.einsum("bgrnqk,bgnkd->bgrnqd", p[..., :nk].astype(v.dtype), vband)
         + jnp.einsum("bgrnqk,bgkd->bgrnqd", p[..., nk:nk + n_ctx].astype(v.dtype), vc))
    y_l = merge_heads(o.reshape(b, h, n, d))
    y_c = None
    if with_ctx:
        y_c = merge_heads(dense_ctx_attention(split_heads(q_c, h), jnp.repeat(kc, r, axis=1),
                                              jnp.repeat(vc, r, axis=1), scale, sink))
    return y_l, y_c


def na_mixer(q_l, k_l, v_l, q_c, k_c, v_c, rpb, with_ctx):
    h, d = GROUP_HEADS, HEAD_DIM
    scale = d ** -0.5
    q, k, v = split_heads(q_l, h), split_heads(k_l, h), split_heads(v_l, h)
    kc, vc = split_heads(k_c, h), split_heads(v_c, h)
    b, _, n, _ = q.shape
    rows = n // GRID_W
    kh = min(NA_KH, rows)
    nj = GRID_W // NA_QB_W
    qcol = np.arange(GRID_W).reshape(nj, NA_QB_W)
    cs = np.clip(qcol - NA_KW // 2, 0, GRID_W - NA_KW)
    cb = np.minimum(cs[:, 0], GRID_W - NA_KB_W)
    kcol = cb[:, None] + np.arange(NA_KB_W)[None, :]
    col_mask = (kcol[:, None, :] >= cs[:, :, None]) & (kcol[:, None, :] < cs[:, :, None] + NA_KW)
    dc_idx = np.clip(kcol[:, None, :] - qcol[:, :, None] + NA_KW - 1, 0, 2 * NA_KW - 2).astype(np.int32)
    r_idx = np.arange(rows)
    rs = np.clip(r_idx - kh // 2, 0, rows - kh)
    dr_idx = (rs[:, None] + np.arange(kh)[None, :] - r_idx[:, None] + NA_KH - 1).astype(np.int32)
    kg = k.reshape(b, h, rows, GRID_W, d)
    vg = v.reshape(b, h, rows, GRID_W, d)
    qg = q.reshape(b, h, rows, GRID_W, d).transpose(2, 0, 1, 3, 4)
    rpb_f = rpb.astype(jnp.float32)
    nk = kh * NA_KB_W

    def row_block(inp):
        q_row, r0, dri = inp
        k_win = lax.dynamic_slice_in_dim(kg, r0, kh, axis=2)[:, :, :, kcol]
        v_win = lax.dynamic_slice_in_dim(vg, r0, kh, axis=2)[:, :, :, kcol]
        qb = q_row.reshape(b, h, nj, NA_QB_W, d)
        s = jnp.einsum("bhjqd,bhajkd->bhjqak", qb, k_win).astype(jnp.float32) * scale
        bias = rpb_f[:, dri][:, :, dc_idx].transpose(0, 2, 3, 1, 4)
        s = jnp.where(col_mask[:, :, None, :], s + bias, NEG_INF).reshape(b, h, nj, NA_QB_W, nk)
        s_ctx = jnp.einsum("bhjqd,bhkd->bhjqk", qb, kc).astype(jnp.float32) * scale
        p = softmax_f32(jnp.concatenate([s, s_ctx], axis=-1))
        p_win = p[..., :nk].reshape(b, h, nj, NA_QB_W, kh, NA_KB_W).astype(v.dtype)
        o = (jnp.einsum("bhjqak,bhajkd->bhjqd", p_win, v_win)
             + jnp.einsum("bhjqk,bhkd->bhjqd", p[..., nk:].astype(v.dtype), vc))
        return o.reshape(b, h, GRID_W, d)

    o = lax.map(row_block, (qg, jnp.asarray(rs, jnp.int32), jnp.asarray(dr_idx)))
    y_l = merge_heads(o.transpose(1, 2, 0, 3, 4).reshape(b, h, n, d))
    y_c = None
    if with_ctx:
        y_c = merge_heads(dense_ctx_attention(split_heads(q_c, h), kc, vc, scale))
    return y_l, y_c


def retention_scan(q, k, v, log_gamma, state0, emit):
    b, h, t, _ = q.shape
    c = RET_CHUNK
    nc = t // c
    idx = jnp.arange(c, dtype=jnp.float32)
    diff = idx[:, None] - idx[None, :]
    lg = log_gamma[:, None, None]
    decay_in = jnp.where(diff >= 0, jnp.exp(lg * jnp.maximum(diff, 0.0)), 0.0)
    q_dec = jnp.exp(log_gamma[:, None] * (idx + 1.0))[..., None]
    k_dec = jnp.exp(log_gamma[:, None] * (c - 1.0 - idx))[..., None]
    c_dec = jnp.exp(log_gamma * c)[:, None, None]
    chunks = lambda a: a.reshape(b, h, nc, c, a.shape[-1]).transpose(2, 0, 1, 3, 4)

    def step(s, inp):
        qb, kb, vb = inp
        s_new = s * c_dec + jnp.einsum("bhjd,bhje->bhde", kb * k_dec, vb)
        if emit:
            inner = jnp.einsum("bhid,bhjd->bhij", qb, kb) * decay_in
            o = jnp.einsum("bhij,bhjd->bhid", inner, vb) + jnp.einsum("bhid,bhde->bhie", qb * q_dec, s)
            return s_new, o
        return s_new, None

    s_fin, o = lax.scan(step, state0, (chunks(q), chunks(k), chunks(v)))
    if emit:
        o = o.transpose(1, 2, 0, 3, 4).reshape(b, h, t, -1)
    return o, s_fin


def head_groupnorm(o, g):
    mu = jnp.mean(o, axis=-1, keepdims=True)
    var = jnp.mean(jnp.square(o - mu), axis=-1, keepdims=True)
    return merge_heads((o - mu) * lax.rsqrt(var + EPS)) * g.astype(jnp.float32)


def retention_gate(o_f, o_b, g_f, g_b, gn_f, gn_b):
    y = (jax.nn.silu(g_f.astype(jnp.float32)) * head_groupnorm(o_f, gn_f)
         + jax.nn.silu(g_b.astype(jnp.float32)) * head_groupnorm(o_b, gn_b))
    return y.astype(g_f.dtype)


def retention_mixer(q_l, k_l, v_l, gf_l, gb_l, q_c, k_c, v_c, gf_c, gb_c,
                    decay_f, decay_b, gn_f, gn_b, with_ctx):
    prep = lambda t: split_heads(t, GROUP_HEADS).astype(jnp.float32)
    kscale = HEAD_DIM ** -0.5
    ql, kl, vl = prep(q_l), prep(k_l) * kscale, prep(v_l)
    qc, kc, vc = prep(q_c), prep(k_c) * kscale, prep(v_c)
    lg_f = jax.nn.log_sigmoid(decay_f.astype(jnp.float32))
    lg_b = jax.nn.log_sigmoid(decay_b.astype(jnp.float32))
    zero = jnp.zeros(kl.shape[:2] + (HEAD_DIM, HEAD_DIM), jnp.float32)
    flip = lambda t: t[:, :, ::-1]
    oc_f, s_f = retention_scan(qc, kc, vc, lg_f, zero, with_ctx)
    oc_b, s_b = retention_scan(flip(qc), flip(kc), flip(vc), lg_b, zero, with_ctx)
    ol_f, _ = retention_scan(ql, kl, vl, lg_f, s_f, True)
    ol_b, _ = retention_scan(flip(ql), flip(kl), flip(vl), lg_b, s_b, True)
    y_l = retention_gate(ol_f, flip(ol_b), gf_l, gb_l, gn_f, gn_b)
    y_c = None
    if with_ctx:
        y_c = retention_gate(oc_f, flip(oc_b), gf_c, gb_c, gn_f, gn_b)
    return y_l, y_c


def peer_ffn(hid, wq, sub_k1, sub_k2, expert_u, expert_v):
    b, t, d = hid.shape
    flat = hid.reshape(b * t, d)
    blk = math.gcd(b * t, PEER_TOKEN_BLOCK)
    half = PEER_DKEY // 2

    def block(xb):
        tb = xb.shape[0]
        q = (xb @ wq).reshape(tb, PEER_HEADS, 2, half).astype(jnp.float32)
        s1 = jnp.einsum("thd,nd->thn", q[:, :, 0], sub_k1.astype(jnp.float32))
        s2 = jnp.einsum("thd,nd->thn", q[:, :, 1], sub_k2.astype(jnp.float32))
        v1, i1 = lax.top_k(s1, PEER_TOPK)
        v2, i2 = lax.top_k(s2, PEER_TOPK)
        cand_s = (v1[..., :, None] + v2[..., None, :]).reshape(tb, PEER_HEADS, PEER_TOPK * PEER_TOPK)
        cand_i = (i1[..., :, None] * PEER_NKEYS + i2[..., None, :]).reshape(tb, PEER_HEADS, PEER_TOPK * PEER_TOPK)
        top_s, pos = lax.top_k(cand_s, PEER_TOPK)
        eid = jnp.take_along_axis(cand_i, pos, axis=-1).reshape(tb, PEER_HEADS * PEER_TOPK)
        gate = jax.nn.softmax(top_s, axis=-1).reshape(tb, PEER_HEADS * PEER_TOPK)
        a = jnp.einsum("td,tkd->tk", xb, expert_u[eid]).astype(jnp.float32)
        w = (jax.nn.gelu(a, approximate=False) * gate).astype(xb.dtype)
        return jnp.einsum("tk,tkd->td", w, expert_v[eid])

    out = lax.map(block, flat.reshape(-1, blk, d))
    return out.reshape(b, t, d)


def setup_inputs(seed: int = 0) -> dict:
    key = jax.random.key(seed)
    ks = jax.random.split(key, 26)
    f32 = jnp.float32
    L, D, H = DEPTH, D_MODEL, GROUP_HEADS
    nrm = lambda k, shape, s: jax.random.normal(k, shape, f32) * s
    gain = lambda k, shape: 1.0 + 0.02 * jax.random.normal(k, shape, f32)
    decay0 = jnp.asarray(np.log(2.0 ** (5 + np.arange(H)) - 1.0), f32)
    return {
        "x": nrm(ks[0], (BATCH, SEQ, D), 1.0),
        "c": nrm(ks[1], (BATCH, D), 1.0),
        "ctx": nrm(ks[2], (BATCH, CTX_LEN, D), 1.0),
        "c_ctx": nrm(ks[3], (D,), 1.0),
        "ada_w": nrm(ks[4], (L, D, ADA_CHUNKS * D), 0.5 * D ** -0.5),
        "ada_b": nrm(ks[5], (L, ADA_CHUNKS * D), 0.01),
        "norm_mix_g": gain(ks[6], (L, D)),
        "w_in": nrm(ks[7], (L, D, IN_WIDTH), D ** -0.5),
        "mla_kv_norm_g": gain(ks[8], (L, MLA_KV_RANK)),
        "mla_w_ukv": nrm(ks[9], (L, MLA_KV_RANK, H * (MLA_NOPE + MLA_V)), MLA_KV_RANK ** -0.5),
        "swa_sink": nrm(ks[10], (L, H), 0.5),
        "na_rpb": nrm(ks[11], (L, H, 2 * NA_KH - 1, 2 * NA_KW - 1), 0.1),
        "ret_decay_f": decay0 + nrm(ks[12], (L, H), 0.1),
        "ret_decay_b": decay0 + nrm(ks[13], (L, H), 0.1),
        "ret_gn_f": gain(ks[14], (L, GROUP_WIDTH)),
        "ret_gn_b": gain(ks[15], (L, GROUP_WIDTH)),
        "mix_beta": gain(ks[16], (L, D)),
        "w_out": nrm(ks[17], (L, D, D), D ** -0.5),
        "norm_ffn_g": gain(ks[18], (L, D)),
        "peer_wq": nrm(ks[19], (L, D, PEER_HEADS * PEER_DKEY), D ** -0.5),
        "peer_k1": nrm(ks[20], (L, PEER_NKEYS, PEER_DKEY // 2), (PEER_DKEY // 2) ** -0.5),
        "peer_k2": nrm(ks[21], (L, PEER_NKEYS, PEER_DKEY // 2), (PEER_DKEY // 2) ** -0.5),
        "peer_u": nrm(ks[22], (L, PEER_EXPERTS, D), D ** -0.5),
        "peer_v": nrm(ks[23], (L, PEER_EXPERTS, D), 0.5),
        "final_norm_g": gain(ks[24], (D,)),
    }


def reference(x, c, ctx, c_ctx, ada_w, ada_b, norm_mix_g, w_in, mla_kv_norm_g, mla_w_ukv, swa_sink, na_rpb,
              ret_decay_f, ret_decay_b, ret_gn_f, ret_gn_b, mix_beta, w_out, norm_ffn_g, peer_wq, peer_k1,
              peer_k2, peer_u, peer_v, final_norm_g):
    n = x.shape[1]
    cos_r, sin_r = axial_rope_tables(n, MLA_ROPE)
    cos_h, sin_h = axial_rope_tables(n, HEAD_DIM)
    cuts = np.cumsum(IN_SPLITS)[:-1].tolist()
    xc = ctx
    for layer in range(DEPTH):
        with_ctx = layer < DEPTH - 1
        mod_l = jnp.split(jax.nn.silu(c) @ ada_w[layer] + ada_b[layer], ADA_CHUNKS, axis=-1)
        mod_c = jnp.split(jax.nn.silu(c_ctx)[None, :] @ ada_w[layer] + ada_b[layer], ADA_CHUNKS, axis=-1)
        p_l = jnp.split(modulate(rmsnorm(x, norm_mix_g[layer]), mod_l[0], mod_l[1]) @ w_in[layer], cuts, axis=-1)
        p_c = jnp.split(modulate(rmsnorm(xc, norm_mix_g[layer]), mod_c[0], mod_c[1]) @ w_in[layer], cuts, axis=-1)
        ya_l, ya_c = mla_mixer(*p_l[0:3], *p_c[0:3], mla_kv_norm_g[layer], mla_w_ukv[layer], cos_r, sin_r, with_ctx)
        yb_l, yb_c = swa_mixer(*p_l[3:6], *p_c[3:6], swa_sink[layer], cos_h, sin_h, with_ctx)
        yc_l, yc_c = na_mixer(*p_l[6:9], *p_c[6:9], na_rpb[layer], with_ctx)
        yd_l, yd_c = retention_mixer(*p_l[9:14], *p_c[9:14], ret_decay_f[layer], ret_decay_b[layer],
                                     ret_gn_f[layer], ret_gn_b[layer], with_ctx)
        y_l = jnp.concatenate([ya_l, yb_l, yc_l, yd_l], axis=-1) * mix_beta[layer]
        x = x + mod_l[2][:, None, :] * (y_l @ w_out[layer])
        h2 = modulate(rmsnorm(x, norm_ffn_g[layer]), mod_l[3], mod_l[4])
        x = x + mod_l[5][:, None, :] * peer_ffn(h2, peer_wq[layer], peer_k1[layer], peer_k2[layer],
                                                 peer_u[layer], peer_v[layer])
        if with_ctx:
            y_c = jnp.concatenate([ya_c, yb_c, yc_c, yd_c], axis=-1) * mix_beta[layer]
            xc = xc + mod_c[2][:, None, :] * (y_c @ w_out[layer])
            h2c = modulate(rmsnorm(xc, norm_ffn_g[layer]), mod_c[3], mod_c[4])
            xc = xc + mod_c[5][:, None, :] * peer_ffn(h2c, peer_wq[layer], peer_k1[layer], peer_k2[layer],
                                                       peer_u[layer], peer_v[layer])
    return rmsnorm(x, final_norm_g)
```

```cpp
#include <hip/hip_runtime.h>
#include <cstdio>
#include <cstdint>

#define GAS __attribute__((address_space(1)))
#define LAS __attribute__((address_space(3)))
typedef unsigned short bf16_t;
typedef short bf16x8 __attribute__((ext_vector_type(8)));
typedef float f32x4 __attribute__((ext_vector_type(4)));
typedef float f32x2 __attribute__((ext_vector_type(2)));
typedef float f32x16 __attribute__((ext_vector_type(16)));
typedef unsigned u32x4 __attribute__((ext_vector_type(4)));
typedef unsigned u32x2 __attribute__((ext_vector_type(2)));

constexpr int NBATCH = 4, SEQ = 8192, CTXL = 256, DM = 1024, NLAYER = 2;
constexpr int NB = SEQ + CTXL;
constexpr int NROW = NBATCH * NB;
constexpr int PW = 3328;
constexpr int INW = 3104;
constexpr int KVW = 512;
constexpr int C_MLAQ = 0, C_CKV = 384, C_KR = 512, C_SWAQ = 544, C_SWAK = 800, C_SWAV = 928, C_NAQ = 1056, C_NAK = 1312, C_NAV = 1568,
              C_RQ = 1824, C_RK = 2080, C_RV = 2336, C_RGF = 2592, C_RGB = 2848;
constexpr int NEXP = 16384, PEER_K = 128;
constexpr float LOG2E = 1.4426950408889634f;
constexpr float EPS = 1e-6f;

constexpr size_t MiB = 1u << 20;
constexpr size_t WS_CTL = 0, CTL_ZERO_BYTES = 1 * MiB;
constexpr size_t WS_MOD = 1 * MiB;
constexpr size_t WS_TAB = 2 * MiB;
constexpr size_t WS_WIN = 3 * MiB;
constexpr size_t WS_WOUT = 17 * MiB;
constexpr size_t WS_WSC = 21 * MiB;
constexpr size_t WS_WUKV = 29 * MiB;
constexpr size_t WS_SSQ = 30 * MiB;
constexpr size_t WS_XC = 31 * MiB;
constexpr size_t WS_UB = 35 * MiB;
constexpr size_t WS_VB = 67 * MiB;
constexpr size_t WS_XN = 99 * MiB;
constexpr size_t WS_P = 165 * MiB;
constexpr size_t WS_XQ = 300 * MiB;
constexpr size_t WS_XSC = 334 * MiB;
constexpr size_t WS_KV = 380 * MiB;
constexpr size_t WS_GATE = WS_KV + (size_t)NROW * 128 * 4;
constexpr size_t WS_RS = 413 * MiB;
constexpr size_t WS_XB = 446 * MiB;
constexpr size_t WS_END = 510 * MiB;
static_assert(WS_P + (size_t)NROW * 2048 * 2 <= WS_XQ && WS_XQ + (size_t)NROW * DM <= WS_XSC && WS_XSC + (size_t)NROW * 4 <= WS_KV, "ws map (ffn)");
static_assert(WS_WIN + (size_t)2 * PW * DM * 2 <= WS_WOUT && WS_XN + (size_t)NROW * DM * 2 <= WS_P && WS_P + (size_t)NROW * PW * 2 <= WS_KV &&
              WS_KV + (size_t)NROW * KVW * 2 <= WS_RS && WS_GATE + (size_t)NROW * 128 * 4 <= WS_RS && WS_RS + (size_t)32 * 66 * 4096 * 4 <= WS_XB && WS_XB + (size_t)NBATCH * SEQ * DM * 2 <= WS_END, "ws map");
constexpr int CW_TMO = 0, CW_BAR = 4096;

constexpr int RING_BYTES = 131072;
constexpr int LDSCTL_OFF = RING_BYTES, MISC_OFF = LDSCTL_OFF + 320;
constexpr int LDS_BYTES = 147456;
constexpr int NWAVES = 8, NTHR = 512;

__device__ __forceinline__ unsigned cvt_pk_bf16(float lo, float hi) { unsigned r; asm volatile("v_cvt_pk_bf16_f32 %0, %1, %2" : "=v"(r) : "v"(lo), "v"(hi)); return r; }
__device__ __forceinline__ float bf_lo(unsigned w) { return __uint_as_float(w << 16); }
__device__ __forceinline__ float bf_hi(unsigned w) { return __uint_as_float(w & 0xffff0000u); }
__device__ __forceinline__ float bf2f(bf16_t h) { return __uint_as_float((unsigned)h << 16); }
__device__ __forceinline__ int lane_id() { unsigned z = 0u; asm volatile("" : "+v"(z)); return (int)__builtin_amdgcn_mbcnt_hi(~0u, __builtin_amdgcn_mbcnt_lo(~0u, z)); }
template <int M> __device__ __forceinline__ float xshfl(float v) {
    if constexpr (M == 32) { auto rr = __builtin_amdgcn_permlane32_swap(__float_as_uint(v), __float_as_uint(v), false, false);
        return __uint_as_float((lane_id() & 32) ? rr[0] : rr[1]); }
    else return __uint_as_float((unsigned)__builtin_amdgcn_ds_swizzle((int)__float_as_uint(v), (M << 10) | 0x1F));
}
__device__ __forceinline__ float xsum32(float v) { auto rr = __builtin_amdgcn_permlane32_swap(__float_as_uint(v), __float_as_uint(v), false, false); return __uint_as_float(rr[0]) + __uint_as_float(rr[1]); }
__device__ __forceinline__ float xmax32(float v) { auto rr = __builtin_amdgcn_permlane32_swap(__float_as_uint(v), __float_as_uint(v), false, false); return fmaxf(__uint_as_float(rr[0]), __uint_as_float(rr[1])); }
__device__ __forceinline__ float wave_sum(float v) {
    v += xshfl<1>(v); v += xshfl<2>(v); v += xshfl<4>(v); v += xshfl<8>(v); v += xshfl<16>(v); return xsum32(v);
}
__device__ __forceinline__ float fexp2(float x) { return __builtin_amdgcn_exp2f(x); }
__device__ __forceinline__ float silu_f(float x) { return x / (1.f + __expf(-x)); }
template <class T> __device__ __forceinline__ T* as_global(T* p) { return (T*)(GAS T*)p; }
#define LDS_WAIT() asm volatile("s_waitcnt lgkmcnt(0)" ::: "memory")
#define VM_WAIT() asm volatile("s_waitcnt vmcnt(0)" ::: "memory")

#define XB_TMO      128
#define XB_XCNT(j)  (256  + 64 * (j))
#define XB_XSUB(j)  (1280 + 64 * (j))
#define XB_XGEN(j)  (2304 + 64 * (j))
#define XB_TOP      3328
#define XB_TOPGEN   3392
#define XCD_BAR_WORDS 3456
#define XB_SPIN_CAP (1u << 18)
__device__ __forceinline__ unsigned xb_ld(unsigned* p)              { return __hip_atomic_load(p, __ATOMIC_RELAXED, __HIP_MEMORY_SCOPE_AGENT); }
__device__ __forceinline__ unsigned xb_add(unsigned* p, unsigned v) { return __hip_atomic_fetch_add(p, v, __ATOMIC_RELAXED, __HIP_MEMORY_SCOPE_AGENT); }
__device__ __forceinline__ unsigned xb_xcc_id() { return (unsigned)__builtin_amdgcn_s_getreg((3 << 11) | 20) & 0xFu; }
#define XB_SPIN(cond, bar) do { unsigned _sp = 0; while (cond) { __builtin_amdgcn_s_sleep(1); \
    if ((++_sp & 255u) == 0u) { if (xb_ld(&(bar)[XB_TMO])) break; if (_sp > XB_SPIN_CAP) { atomicAdd(&(bar)[XB_TMO], 1u); break; } } } } while (0)
struct XcdBarrier { unsigned* bar; unsigned x; volatile LAS unsigned* st; };
__device__ __forceinline__ XcdBarrier xcd_barrier_post(unsigned* bar, volatile LAS unsigned* st) {
    XcdBarrier b; b.bar = bar; b.x = xb_xcc_id(); b.st = st;
    if (threadIdx.x == 0) (void)xb_add(&bar[XB_XCNT(b.x)], 1u);
    return b;
}
__device__ __forceinline__ void xcd_barrier_complete(unsigned* bar, unsigned x, unsigned& nloc, unsigned& nx) {
    const unsigned G = gridDim.x * gridDim.y * gridDim.z;
    unsigned sum, cnt, mine, sp = 0u;
    for (;;) {
        sum = 0u; cnt = 0u; mine = 0u;
#pragma unroll
        for (unsigned j = 0; j < 16; ++j) { const unsigned c = xb_ld(&bar[XB_XCNT(j)]); sum += c; cnt += (c > 0u) ? 1u : 0u; mine = (j == x) ? c : mine; }
        if (sum == G) break;
        __builtin_amdgcn_s_sleep(1);
        if ((++sp & 255u) == 0u) { if (xb_ld(&bar[XB_TMO])) break; if (sp > XB_SPIN_CAP) { atomicAdd(&bar[XB_TMO], 1u); break; } }
    }
    nloc = mine > 0u ? mine : 1u; nx = cnt > 0u ? cnt : 1u;
}
__device__ __forceinline__ void xcd_barrier(const XcdBarrier& b) {
    asm volatile("s_waitcnt vmcnt(0)" ::: "memory");
    __syncthreads();
    if (threadIdx.x == 0) {
        unsigned* bar = b.bar;
        __builtin_amdgcn_s_waitcnt(0);
        unsigned nloc = b.st[0], nx = b.st[1];
        if (nloc == 0u) { unsigned xo = b.x; asm volatile("" : "+s"(xo)); xcd_barrier_complete(bar, xo, nloc, nx); b.st[0] = nloc; b.st[1] = nx; }
        const unsigned old = xb_add(&bar[XB_XSUB(b.x)], 1u);
        const unsigned gen = old / nloc;
        if (old + 1u == (gen + 1u) * nloc) {
            __builtin_amdgcn_fence(__ATOMIC_RELEASE, "agent");
            asm volatile("s_waitcnt vmcnt(0)" ::: "memory");
            const unsigned og = xb_add(&bar[XB_TOP], 1u);
            const unsigned tg = og / nx;
            if (og + 1u == (tg + 1u) * nx) xb_add(&bar[XB_TOPGEN], 1u);
            else XB_SPIN(xb_ld(&bar[XB_TOPGEN]) == tg, bar);
            __builtin_amdgcn_fence(__ATOMIC_ACQUIRE, "agent");
            xb_add(&bar[XB_XGEN(b.x)], 1u);
            asm volatile("s_waitcnt vmcnt(0)" ::: "memory");
        } else {
            XB_SPIN(xb_ld(&bar[XB_XGEN(b.x)]) == gen, bar);
            __builtin_amdgcn_fence(__ATOMIC_ACQUIRE, "agent");
            asm volatile("s_waitcnt vmcnt(0)" ::: "memory");
        }
    }
    __syncthreads();
}
namespace pg8 {
constexpr int BM = 256, BK = 64, HALF = 128, HTB = HALF * BK * 2, STAGE_BYTES = 8 * HTB;
__host__ __device__ __forceinline__ int lds_byte(int r, int c) { const int st = (r >> 4) * 2 + (c >> 5), rr = r & 15, cc = c & 31, ob = rr * 64 + cc * 2; return st * 1024 + (ob ^ (((ob >> 9) & 1) << 5)); }
__host__ __device__ __forceinline__ void stage_rc(int b, int& R, int& C) { const int st = b / 1024, sb = b % 1024, swz = sb ^ (((sb >> 9) & 1) << 5); R = (st >> 1) * 16 + swz / 64; C = (st & 1) * 32 + (swz % 64) / 2; }
__host__ __device__ __forceinline__ int perm32(int rho) { const int n = rho >> 4, i = rho & 15; return 8 * (i >> 2) + 4 * n + (i & 3); }
struct Unit { int pm, pn; };
struct Gemm { const bf16_t* A; const bf16_t* Bt; };

struct LinOrder {
    int nN, nUnits, G, c, skipctx;
    __device__ __forceinline__ bool next(int i, Unit& u) const {
        const int L = i * G + c; if (L >= nUnits) return false;
        const int pmv = L / nN; u.pn = L - pmv * nN; u.pm = skipctx ? (pmv + pmv / 32 + 1) : pmv; return true;
    }
    __device__ __forceinline__ void a_ready(const Unit&) const {}
    __device__ __forceinline__ void done(const Unit&) const {}
};

template <class Epi, class Sched, int KDIM, int LDA, int LDB, bool ALIGN_EPI = false>
__device__ __forceinline__ void gemm_phase(LAS unsigned char* lds, int wave_sgpr, const Gemm g, const Sched& S, const Epi& E) {
    const int wid = __builtin_amdgcn_readfirstlane(wave_sgpr); int lane = lane_id(); asm volatile("" : "+v"(lane)); const int tid = wid * 64 + lane;
    const int wr = wid >> 2, wc = wid & 3, fr = lane & 15, fq = lane >> 4;
    int nt = KDIM / BK; asm volatile("" : "+s"(nt));
    unsigned voffA[2], voffB[2];
#pragma unroll
    for (int i = 0; i < 2; ++i) { int R, C; stage_rc(tid * 16 + i * 8192, R, C); const int Rb = Epi::PERM ? (64 * (R >> 5) + perm32(R & 31)) : R;
        voffA[i] = (unsigned)(R * LDA + C) * 2u; voffB[i] = (unsigned)(Rb * LDB + C) * 2u; }
    constexpr size_t kstep = (size_t)(BK * 2);
    constexpr size_t hstepA = (size_t)HALF * LDA * 2, hstepB = (size_t)(Epi::PERM ? 32 : HALF) * LDB * 2;
    constexpr size_t tstepA = (size_t)BM * LDA * 2, tstepB = (size_t)BM * LDB * 2;
    const unsigned ldsw = (unsigned)wid * 1024u;
    const int aoff = lds_byte(wr * 64 + fr, fq * 8), boff = lds_byte(wc * 32 + fr, fq * 8);
#define PG8_SA(b, h) (((b) * 2 + (h)) * HTB)
#define PG8_SB(b, h) ((4 + (b) * 2 + (h)) * HTB)
#define PG8_STAGE(bufoff, gbase, voff) do { _Pragma("unroll") for (int _i = 0; _i < 2; ++_i) \
        __builtin_amdgcn_global_load_lds((const unsigned*)((const char*)(gbase) + (voff)[_i]), (LAS unsigned*)(lds + (bufoff) + ldsw + _i * 8192), 16, 0, 0); } while (0)
#define PG8_LDA(dst, b, h) do { _Pragma("unroll") for (int m = 0; m < 4; ++m) _Pragma("unroll") for (int k = 0; k < 2; ++k) dst[m][k] = *(const LAS bf16x8*)(lds + PG8_SA(b, h) + aoff + m * 2048 + k * 1024); } while (0)
#define PG8_LDB(dst, b, h) do { _Pragma("unroll") for (int n = 0; n < 2; ++n) _Pragma("unroll") for (int k = 0; k < 2; ++k) dst[n][k] = *(const LAS bf16x8*)(lds + PG8_SB(b, h) + boff + n * 2048 + k * 1024); } while (0)
#define PG8_MMA(ai, bj, At, Bt) do { __builtin_amdgcn_s_setprio(1); _Pragma("unroll") for (int m = 0; m < 4; ++m) _Pragma("unroll") for (int n = 0; n < 2; ++n) _Pragma("unroll") for (int k = 0; k < 2; ++k) \
        acc[ai][bj][m][n] = __builtin_amdgcn_mfma_f32_16x16x32_bf16(Bt[n][k], At[m][k], acc[ai][bj][m][n], 0, 0, 0); __builtin_amdgcn_s_setprio(0); } while (0)
#define PG8_WAIT_V(n) asm volatile("s_waitcnt vmcnt(" #n ")" ::: "memory")
#define PG8_WAIT_L(n) asm volatile("s_waitcnt lgkmcnt(" #n ")" ::: "memory")
#define PG8_BAR __builtin_amdgcn_s_barrier()
#define PG8_SCHED __builtin_amdgcn_sched_barrier(0)
    Unit cur, nxt; int ui = 0;
    if (!S.next(0, cur)) return;
    f32x4 acc[2][2][4][2];
#pragma unroll
    for (int a = 0; a < 2; ++a)
#pragma unroll
        for (int b = 0; b < 2; ++b)
#pragma unroll
            for (int m = 0; m < 4; ++m)
#pragma unroll
                for (int n = 0; n < 2; ++n) acc[a][b][m][n] = (f32x4){0.f, 0.f, 0.f, 0.f};
    bf16x8 At[4][2], B0[2][2], B1[2][2];
    const char* cA = (const char*)g.A + (size_t)cur.pm * tstepA; const char* cB = (const char*)g.Bt + (size_t)cur.pn * tstepB;
    S.a_ready(cur);
    PG8_STAGE(PG8_SB(0, 0), cB, voffB); PG8_STAGE(PG8_SB(0, 1), cB + hstepB, voffB); PG8_STAGE(PG8_SA(0, 0), cA, voffA); PG8_STAGE(PG8_SA(0, 1), cA + hstepA, voffA);
    if (wr == 1) PG8_BAR;
    PG8_WAIT_V(2); PG8_BAR;
    PG8_STAGE(PG8_SB(1, 0), cB + kstep, voffB); PG8_STAGE(PG8_SA(1, 0), cA + kstep, voffA); PG8_STAGE(PG8_SB(1, 1), cB + hstepB + kstep, voffB);
    PG8_WAIT_V(6); PG8_BAR;
    for (;;) {
        const bool has_next = S.next(ui + 1, nxt);
        const char* nA = has_next ? (const char*)g.A + (size_t)nxt.pm * tstepA : cA; const char* nB = has_next ? (const char*)g.Bt + (size_t)nxt.pn * tstepB : cB;
        for (int t = 0; t < nt; t += 2) {
            const bool last = (t == nt - 2);
            const char* a1 = cA + (size_t)(t + 1) * kstep;
            const char* a2 = last ? nA : cA + (size_t)(t + 2) * kstep; const char* b2 = last ? nB : cB + (size_t)(t + 2) * kstep;
            const char* a3 = a2 + kstep; const char* b3 = b2 + kstep;
            if (last && has_next) S.a_ready(nxt);
            PG8_LDB(B0, 0, 0); PG8_LDB(B1, 0, 1); PG8_SCHED; PG8_LDA(At, 0, 0); PG8_STAGE(PG8_SA(1, 1), a1 + hstepA, voffA);
            PG8_WAIT_V(8); PG8_WAIT_L(0); PG8_BAR; PG8_MMA(0, 0, At, B0); PG8_MMA(0, 1, At, B1); PG8_BAR; PG8_SCHED;
            PG8_LDA(At, 0, 1); PG8_STAGE(PG8_SB(0, 0), b2, voffB); PG8_STAGE(PG8_SB(0, 1), b2 + hstepB, voffB); PG8_STAGE(PG8_SA(0, 0), a2, voffA);
            PG8_WAIT_V(8); PG8_WAIT_L(0); PG8_BAR; PG8_MMA(1, 0, At, B0); PG8_MMA(1, 1, At, B1); PG8_BAR; PG8_SCHED;
            PG8_LDB(B0, 1, 0); PG8_LDB(B1, 1, 1); PG8_SCHED; PG8_LDA(At, 1, 0); PG8_STAGE(PG8_SA(0, 1), a2 + hstepA, voffA);
            PG8_WAIT_V(8); PG8_WAIT_L(0); PG8_BAR; PG8_MMA(0, 0, At, B0); PG8_MMA(0, 1, At, B1); PG8_BAR; PG8_SCHED;
            PG8_LDA(At, 1, 1); PG8_STAGE(PG8_SB(1, 0), b3, voffB); PG8_STAGE(PG8_SB(1, 1), b3 + hstepB, voffB); PG8_STAGE(PG8_SA(1, 0), a3, voffA);
            PG8_WAIT_V(8); PG8_WAIT_L(0); PG8_BAR; PG8_MMA(1, 0, At, B0); PG8_MMA(1, 1, At, B1); PG8_BAR; PG8_SCHED;
        }
        if constexpr (ALIGN_EPI) { if (wr == 0) PG8_BAR; }
        E(acc, cur, wr, wc, fr, fq); S.done(cur);
        if (!has_next) break;
#pragma unroll
        for (int a = 0; a < 2; ++a)
#pragma unroll
            for (int b = 0; b < 2; ++b)
#pragma unroll
                for (int m = 0; m < 4; ++m)
#pragma unroll
                    for (int n = 0; n < 2; ++n) acc[a][b][m][n] = (f32x4){0.f, 0.f, 0.f, 0.f};
        cur = nxt; cA = nA; cB = nB; ++ui;
        if constexpr (ALIGN_EPI) { if (wr == 1) PG8_BAR; }
    }
    PG8_WAIT_V(0);
    if constexpr (!ALIGN_EPI) { if (wr == 0) PG8_BAR; }
    PG8_BAR;
#undef PG8_SA
#undef PG8_SB
#undef PG8_STAGE
#undef PG8_LDA
#undef PG8_LDB
#undef PG8_MMA
#undef PG8_WAIT_V
#undef PG8_WAIT_L
#undef PG8_BAR
#undef PG8_SCHED
}

__device__ __forceinline__ unsigned dpp_ror8(unsigned v) { return (unsigned)__builtin_amdgcn_mov_dpp((int)v, 0x128, 0xf, 0xf, false); }
__device__ __forceinline__ void epi_pair_exchange(const u32x4 c0, const u32x4 c1, int fr, u32x4& a, u32x4& b) {
    const bool lo = fr < 8;
    const u32x4 send = lo ? c1 : c0;
    u32x4 recv; recv.x = dpp_ror8(send.x); recv.y = dpp_ror8(send.y); recv.z = dpp_ror8(send.z); recv.w = dpp_ror8(send.w);
    a = lo ? c0 : recv;
    b = lo ? recv : c1;
}

struct EpiProj {
    static constexpr bool PERM = true;
    bf16_t* P; float* ssq; const f32x2* r64; const f32x2* r32;
    struct Cfg { float sc; int rope, pp, c0, cs; bool isckv, valid; };
    __device__ __forceinline__ Cfg cfg(int cs, int fq, bool isctx) const {
        Cfg C; C.cs = cs; C.c0 = cs + 8 * fq; C.sc = 1.f; C.rope = 0; C.pp = 0; C.valid = cs < INW;
        if (cs < C_CKV) { C.sc = 0.10206207261596577f * LOG2E; const int p = cs % 96; if (p >= 64) { C.rope = 32; C.pp = C.c0 % 96 - 64; } }
        else if (cs < C_KR) { }
        else if (cs < C_SWAQ) { C.rope = 32; C.pp = C.c0 - C_KR; }
        else if (cs < C_SWAK) { C.sc = 0.125f * LOG2E; C.rope = 64; C.pp = (C.c0 - C_SWAQ) & 63; }
        else if (cs < C_SWAV) { C.rope = 64; C.pp = (C.c0 - C_SWAK) & 63; }
        else if (cs < C_NAQ) { }
        else if (cs < C_NAK) { C.sc = 0.125f * LOG2E; }
        else if (cs < C_RK) { }
        else if (cs < C_RV) { C.sc = 0.125f; }
        C.isckv = (cs >= C_CKV && cs < C_KR);
        if (isctx) C.rope = 0;
        return C;
    }
    __device__ __forceinline__ u32x4 chunk(const f32x4 a0, const f32x4 a1, const Cfg& C, int t, int row, int fq) const {
        f32x4 v0 = a0 * C.sc, v1 = a1 * C.sc;
        if (C.rope) {
            f32x4 cs0, cs1;
            if (C.rope == 64) { const int pos = (C.pp >= 32) ? (t & 63) : (t >> 6); const GAS f32x4* tp = (const GAS f32x4*)(r64 + pos * 16 + ((C.pp & 31) >> 1)); cs0 = tp[0]; cs1 = tp[1]; }
            else              { const int pos = (C.pp >= 16) ? (t & 63) : (t >> 6); const GAS f32x4* tp = (const GAS f32x4*)(r32 + pos * 8 + ((C.pp & 15) >> 1)); cs0 = tp[0]; cs1 = tp[1]; }
            f32x4 w0, w1;
            w0[0] = v0[0] * cs0[0] - v0[1] * cs0[1]; w0[1] = v0[0] * cs0[1] + v0[1] * cs0[0];
            w0[2] = v0[2] * cs0[2] - v0[3] * cs0[3]; w0[3] = v0[2] * cs0[3] + v0[3] * cs0[2];
            w1[0] = v1[0] * cs1[0] - v1[1] * cs1[1]; w1[1] = v1[0] * cs1[1] + v1[1] * cs1[0];
            w1[2] = v1[2] * cs1[2] - v1[3] * cs1[3]; w1[3] = v1[2] * cs1[3] + v1[3] * cs1[2];
            v0 = w0; v1 = w1;
        }
        if (C.isckv) {
            float s = (v0[0] * v0[0] + v0[1] * v0[1]) + (v0[2] * v0[2] + v0[3] * v0[3]) + (v1[0] * v1[0] + v1[1] * v1[1]) + (v1[2] * v1[2] + v1[3] * v1[3]);
            s += xshfl<16>(s); s = xsum32(s);
            if (fq == 0) ((GAS float*)ssq)[(size_t)row * 4 + ((C.cs - C_CKV) >> 5)] = s;
        }
        u32x4 w; w.x = cvt_pk_bf16(v0[0], v0[1]); w.y = cvt_pk_bf16(v0[2], v0[3]); w.z = cvt_pk_bf16(v1[0], v1[1]); w.w = cvt_pk_bf16(v1[2], v1[3]);
        return w;
    }
    __device__ __forceinline__ void operator()(const f32x4 (&acc)[2][2][4][2], const Unit& u, int wr, int wc, int, int) const {
        int ln_ = lane_id(); asm volatile("" : "+v"(ln_)); const int fr = ln_ & 15, fq = ln_ >> 4;
        const bool isctx = (u.pm % 33) == 0;
        const int tb = (u.pm % 33 - 1) * 256;
        const int cw = u.pn * BM + wc * 64;
        const Cfg C0 = cfg(cw, fq, isctx), C1 = cfg(cw + 32, fq, isctx);
        if (!C0.valid) return;
        const bool vst = (fr < 8) ? true : C1.valid;
        const int cst = cw + ((fr >> 3) << 5) + 8 * fq;
#pragma unroll
        for (int ai = 0; ai < 2; ++ai)
#pragma unroll
            for (int m = 0; m < 4; ++m) {
                const int rg = u.pm * BM + ai * HALF + wr * 64 + m * 16;
                const int row = rg + fr, t = tb + ai * HALF + wr * 64 + m * 16 + fr;
                const u32x4 k0 = chunk(acc[ai][0][m][0], acc[ai][0][m][1], C0, t, row, fq);
                u32x4 k1 = {0u, 0u, 0u, 0u};
                if (C1.valid) k1 = chunk(acc[ai][1][m][0], acc[ai][1][m][1], C1, t, row, fq);
                u32x4 sa, sb; epi_pair_exchange(k0, k1, fr, sa, sb);
                if (vst) { *(GAS u32x4*)(P + (size_t)(rg + (fr & 7)) * PW + cst) = sa; *(GAS u32x4*)(P + (size_t)(rg + 8 + (fr & 7)) * PW + cst) = sb; }
            }
    }
};
struct EpiKV {
    static constexpr bool PERM = true;
    bf16_t* KV; const float* ssq;
    __device__ __forceinline__ void operator()(const f32x4 (&acc)[2][2][4][2], const Unit& u, int wr, int wc, int, int) const {
        int ln_ = lane_id(); asm volatile("" : "+v"(ln_)); const int fr = ln_ & 15, fq = ln_ >> 4;
        const int cst = u.pn * BM + wc * 64 + ((fr >> 3) << 5) + 8 * fq;
#pragma unroll
        for (int ai = 0; ai < 2; ++ai)
#pragma unroll
            for (int m = 0; m < 4; ++m) {
                const int rg = u.pm * BM + ai * HALF + wr * 64 + m * 16, row = rg + fr;
                const f32x4 q4 = *(const GAS f32x4*)(ssq + (size_t)row * 4); const float rs = 1.0f / sqrtf(((q4[0] + q4[1]) + (q4[2] + q4[3])) * (1.f / 128.f) + EPS);
                u32x4 k[2];
#pragma unroll
                for (int bj = 0; bj < 2; ++bj) { const f32x4 v0 = acc[ai][bj][m][0] * rs, v1 = acc[ai][bj][m][1] * rs;
                    k[bj].x = cvt_pk_bf16(v0[0], v0[1]); k[bj].y = cvt_pk_bf16(v0[2], v0[3]); k[bj].z = cvt_pk_bf16(v1[0], v1[1]); k[bj].w = cvt_pk_bf16(v1[2], v1[3]); }
                u32x4 sa, sb; epi_pair_exchange(k[0], k[1], fr, sa, sb);
                *(GAS u32x4*)(KV + (size_t)(rg + (fr & 7)) * KVW + cst) = sa; *(GAS u32x4*)(KV + (size_t)(rg + 8 + (fr & 7)) * KVW + cst) = sb;
            }
    }
};
struct EpiResid {
    static constexpr bool PERM = true;
    const float* xl_in; bf16_t* xb; const float* xc_in; float* xc_out; const float* mod;
    __device__ __forceinline__ void operator()(const f32x4 (&acc)[2][2][4][2], const Unit& u, int wr, int wc, int, int) const {
        int ln_ = lane_id(); asm volatile("" : "+v"(ln_)); const int fr = ln_ & 15, fq = ln_ >> 4;
        const int b = u.pm / 33, jt = u.pm % 33;
        const int cw = u.pn * BM + wc * 64 + 8 * fq;
        const float* gate = mod + ((jt == 0) ? 4 : b) * 6144 + 2 * DM;
        if (jt == 0) {
#pragma unroll
            for (int bj = 0; bj < 2; ++bj) { const int c = cw + 32 * bj; const f32x4 g0 = *(const GAS f32x4*)(gate + c), g1 = *(const GAS f32x4*)(gate + c + 4);
#pragma unroll
                for (int ai = 0; ai < 2; ++ai)
#pragma unroll
                    for (int m = 0; m < 4; ++m) { const size_t off = ((size_t)b * CTXL + ai * HALF + wr * 64 + m * 16 + fr) * DM + c;
                        const f32x4 b0 = *(const GAS f32x4*)(xc_in + off), b1 = *(const GAS f32x4*)(xc_in + off + 4);
                        *(GAS f32x4*)(xc_out + off) = b0 + g0 * acc[ai][bj][m][0]; *(GAS f32x4*)(xc_out + off + 4) = b1 + g1 * acc[ai][bj][m][1]; } }
            return;
        }
        const f32x4 ga0 = *(const GAS f32x4*)(gate + cw), ga1 = *(const GAS f32x4*)(gate + cw + 4), gb0 = *(const GAS f32x4*)(gate + cw + 32), gb1 = *(const GAS f32x4*)(gate + cw + 36);
        const int cst = cw + ((fr >> 3) << 5);
        const size_t rbase = (size_t)b * SEQ + (size_t)(jt - 1) * 256;
#pragma unroll
        for (int ai = 0; ai < 2; ++ai)
#pragma unroll
            for (int m = 0; m < 4; ++m) {
                const size_t rg = rbase + ai * HALF + wr * 64 + m * 16;
                const f32x4 d00 = ga0 * acc[ai][0][m][0], d01 = ga1 * acc[ai][0][m][1], d10 = gb0 * acc[ai][1][m][0], d11 = gb1 * acc[ai][1][m][1];
                u32x4 a0, b0, a1, b1;
                epi_pair_exchange(__builtin_bit_cast(u32x4, d00), __builtin_bit_cast(u32x4, d10), fr, a0, b0);
                epi_pair_exchange(__builtin_bit_cast(u32x4, d01), __builtin_bit_cast(u32x4, d11), fr, a1, b1);
#pragma unroll
                for (int hb = 0; hb < 2; ++hb) {
                    const size_t off = (rg + 8 * hb + (fr & 7)) * DM + cst;
                    const f32x4 e0 = __builtin_bit_cast(f32x4, hb ? b0 : a0), e1 = __builtin_bit_cast(f32x4, hb ? b1 : a1);
                    f32x4 x0, x1;
                    if (xl_in) { x0 = *(const GAS f32x4*)(xl_in + off); x1 = *(const GAS f32x4*)(xl_in + off + 4); }
                    else { const u32x4 w = *(const GAS u32x4*)(xb + off); x0 = (f32x4){bf_lo(w.x), bf_hi(w.x), bf_lo(w.y), bf_hi(w.y)}; x1 = (f32x4){bf_lo(w.z), bf_hi(w.z), bf_lo(w.w), bf_hi(w.w)}; }
                    const f32x4 r0 = x0 + e0, r1 = x1 + e1;
                    u32x4 w2; w2.x = cvt_pk_bf16(r0[0], r0[1]); w2.y = cvt_pk_bf16(r0[2], r0[3]); w2.z = cvt_pk_bf16(r1[0], r1[1]); w2.w = cvt_pk_bf16(r1[2], r1[3]);
                    *(GAS u32x4*)(xb + off) = w2;
                }
            }
    }
};
struct EpiScore {
    static constexpr bool PERM = true;
    _Float16* S;
    __device__ __forceinline__ void operator()(const f32x4 (&acc)[2][2][4][2], const Unit& u, int wr, int wc, int, int) const {
        int ln_ = lane_id(); asm volatile("" : "+v"(ln_)); const int fr = ln_ & 15, fq = ln_ >> 4;
        typedef _Float16 h2 __attribute__((ext_vector_type(2)));
        const int cst = u.pn * BM + wc * 64 + ((fr >> 3) << 5) + 8 * fq;
#pragma unroll
        for (int ai = 0; ai < 2; ++ai)
#pragma unroll
            for (int m = 0; m < 4; ++m) {
                const int rg = u.pm * BM + ai * HALF + wr * 64 + m * 16;
                u32x4 k[2];
#pragma unroll
                for (int bj = 0; bj < 2; ++bj) { const f32x4 v0 = acc[ai][bj][m][0], v1 = acc[ai][bj][m][1];
                    const h2 a = {(_Float16)v0[0], (_Float16)v0[1]}, b = {(_Float16)v0[2], (_Float16)v0[3]}, c = {(_Float16)v1[0], (_Float16)v1[1]}, d = {(_Float16)v1[2], (_Float16)v1[3]};
                    k[bj].x = __builtin_bit_cast(unsigned, a); k[bj].y = __builtin_bit_cast(unsigned, b); k[bj].z = __builtin_bit_cast(unsigned, c); k[bj].w = __builtin_bit_cast(unsigned, d); }
                u32x4 sa, sb; epi_pair_exchange(k[0], k[1], fr, sa, sb);
                *(GAS u32x4*)(S + (size_t)(rg + (fr & 7)) * 2048 + cst) = sa; *(GAS u32x4*)(S + (size_t)(rg + 8 + (fr & 7)) * 2048 + cst) = sb;
            }
    }
};
struct EpiNull {
    static constexpr bool PERM = true;
    float* sink;
    __device__ __forceinline__ void operator()(const f32x4 (&acc)[2][2][4][2], const Unit& u, int wr, int wc, int, int) const {
        float t = 0.f;
#pragma unroll
        for (int a = 0; a < 2; ++a)
#pragma unroll
            for (int b = 0; b < 2; ++b)
#pragma unroll
                for (int m = 0; m < 4; ++m) t += acc[a][b][m][0][0] + acc[a][b][m][1][3];
        if (t == 123.456f) sink[0] = t;
    }
};
}
struct Frame {
    LAS unsigned char* lds;
    int tid, lane, wave, vcu, G;
};
struct Inputs {
    const float *x, *c, *ctx, *c_ctx, *ada_w, *ada_b, *norm_mix_g, *w_in, *mla_kv_norm_g, *mla_w_ukv, *swa_sink, *na_rpb, *ret_decay_f, *ret_decay_b,
                *ret_gn_f, *ret_gn_b, *mix_beta, *w_out, *norm_ffn_g, *peer_wq, *peer_k1, *peer_k2, *peer_u, *peer_v, *final_norm_g;
};

__device__ __forceinline__ int orig_col(int c) {
    if (c < C_CKV) { const int h = c / 96, p = c % 96; if (p < 64) return c; const int pp = p - 64; return h * 96 + 64 + (pp >> 4) * 16 + (pp & 1) * 8 + ((pp & 15) >> 1); }
    if (c < C_KR) return c;
    if (c < C_SWAQ) { const int pp = c - C_KR; return C_KR + (pp >> 4) * 16 + (pp & 1) * 8 + ((pp & 15) >> 1); }
    if (c < C_SWAV) { const int q = c - C_SWAQ, hh = q >> 6, pp = q & 63; return C_SWAQ + hh * 64 + (pp >> 5) * 32 + (pp & 1) * 16 + ((pp & 31) >> 1); }
    return c;
}

template <int MAP  >
__device__ __forceinline__ void transpose_item(const float* W, int K, int Nsrc, int Nvalid, int Ndst, const float* kscale, bf16_t* WT, LAS float* scr, int item, int lane) {
    const int nblk = Ndst / 32, kb = item / nblk, nb = item % nblk, k0 = 64 * kb, n0 = 32 * nb;
    const int nd = n0 + (lane & 31);
    const int ns = (nd < Nvalid) ? (MAP ? orig_col(nd) : nd) : -1;
#pragma unroll 8
    for (int i = 0; i < 32; ++i) { const int kk = 2 * i + (lane >> 5); float v = 0.f; if (ns >= 0) { v = W[(size_t)(k0 + kk) * Nsrc + ns]; if (kscale) v *= kscale[k0 + kk]; } scr[kk * 33 + (lane & 31)] = v; }
    LDS_WAIT(); asm volatile("" ::: "memory");
    const int c = lane & 7;
#pragma unroll
    for (int j = 0; j < 4; ++j) { const int n = (lane >> 3) + 8 * j; const LAS float* s = scr + (8 * c) * 33 + n;
        u32x4 o; o.x = cvt_pk_bf16(s[0 * 33], s[1 * 33]); o.y = cvt_pk_bf16(s[2 * 33], s[3 * 33]); o.z = cvt_pk_bf16(s[4 * 33], s[5 * 33]); o.w = cvt_pk_bf16(s[6 * 33], s[7 * 33]);
        *(GAS u32x4*)(WT + (size_t)(n0 + n) * K + k0 + 8 * c) = o; }
    LDS_WAIT(); asm volatile("" ::: "memory");
}

__device__ __forceinline__ void sincos_small(float af, float& sn, float& cs) {
    const double a = (double)af; const double n = __builtin_rint(a * 0.63661977236758134308); const double r = (a - n * 1.57079632679489655800) - n * 6.123233995736766036e-17;
    const double r2 = r * r;
    const double s = r * (1.0 + r2 * (-1.0 / 6 + r2 * (1.0 / 120 + r2 * (-1.0 / 5040 + r2 * (1.0 / 362880 + r2 * (-1.0 / 39916800 + r2 * (1.0 / 6227020800.0)))))));
    const double c = 1.0 + r2 * (-0.5 + r2 * (1.0 / 24 + r2 * (-1.0 / 720 + r2 * (1.0 / 40320 + r2 * (-1.0 / 3628800 + r2 * (1.0 / 479001600 + r2 * (-1.0 / 87178291200.0)))))));
    const int q = ((int)n) & 3;
    const double ss = (q == 0) ? s : (q == 1) ? c : (q == 2) ? -s : -c;
    const double cc = (q == 0) ? c : (q == 1) ? -s : (q == 2) ? -c : s;
    sn = (float)ss; cs = (float)cc;
}

__device__ __forceinline__ void phase_prologue(Frame& F, const Inputs& I, unsigned char* ws) {
    float* MOD = (float*)(ws + WS_MOD);
    {
        LAS float* sc = (LAS float*)F.lds;
        LAS float* red = (LAS float*)(F.lds + 20480);
        for (int i = F.tid; i < 5 * DM; i += NTHR) { const float v = (i < 4 * DM) ? I.c[i] : I.c_ctx[i - 4 * DM]; sc[i] = silu_f(v); }
        __syncthreads();
        for (int task = blockIdx.x; task < NLAYER * 96; task += F.G) {
            const int l = task / 96, n = (task % 96) * 64 + F.lane;
            const float* w = I.ada_w + (size_t)l * DM * 6144 + n;
            float a0 = 0.f, a1 = 0.f, a2 = 0.f, a3 = 0.f, a4 = 0.f;
            const int kb = F.wave * 128;
            for (int k0 = kb; k0 < kb + 128; k0 += 16) {
                float wv[16];
#pragma unroll
                for (int i = 0; i < 16; ++i) wv[i] = ((const GAS float*)w)[(size_t)(k0 + i) * 6144];
#pragma unroll
                for (int i = 0; i < 16; ++i) { const int k = k0 + i; a0 += sc[k] * wv[i]; a1 += sc[DM + k] * wv[i]; a2 += sc[2 * DM + k] * wv[i]; a3 += sc[3 * DM + k] * wv[i]; a4 += sc[4 * DM + k] * wv[i]; }
            }
            LAS float* rw = red + F.wave * 320 + F.lane;
            rw[0] = a0; rw[64] = a1; rw[128] = a2; rw[192] = a3; rw[256] = a4;
            __syncthreads();
            if (F.tid < 320) { const int r = F.tid >> 6, ln = F.tid & 63; float s = 0.f;
#pragma unroll
                for (int wv = 0; wv < 8; ++wv) s += red[wv * 320 + r * 64 + ln];
                const int nn = (task % 96) * 64 + ln; MOD[(size_t)(l * 5 + r) * 6144 + nn] = s + I.ada_b[l * 6144 + nn]; }
            __syncthreads();
        }
    }
    {
        LAS float* scr = (LAS float*)(F.lds + F.wave * 16384);
        const int gw = F.vcu * NWAVES + F.wave, NGW = F.G * NWAVES;
        constexpr int I_IN = (DM / 64) * (PW / 32), I_OUT = (DM / 64) * (DM / 32), I_UKV = (128 / 64) * (KVW / 32);
        constexpr int PER_L = I_IN + I_OUT + I_UKV;
        for (int it = gw; it < NLAYER * PER_L; it += NGW) {
            const int l = it / PER_L; int r = it % PER_L;
            if (r < I_IN) { transpose_item<1>(I.w_in + (size_t)l * DM * INW, DM, INW, INW, PW, nullptr, (bf16_t*)(ws + WS_WIN) + (size_t)l * PW * DM, scr, r, F.lane); continue; } r -= I_IN;
            if (r < I_OUT) { transpose_item<0>(I.w_out + (size_t)l * DM * DM, DM, DM, DM, DM, I.mix_beta + l * DM, (bf16_t*)(ws + WS_WOUT) + (size_t)l * DM * DM, scr, r, F.lane); continue; } r -= I_OUT;
            transpose_item<0>(I.mla_w_ukv + (size_t)l * 128 * KVW, 128, KVW, KVW, KVW, I.mla_kv_norm_g + l * 128, (bf16_t*)(ws + WS_WUKV) + (size_t)l * KVW * 128, scr, r, F.lane);
        }
    }
    __syncthreads();
    {
        LAS float* wqs = (LAS float*)F.lds;
        LAS float* kps = (LAS float*)(F.lds + 32768);
        for (int task = blockIdx.x; task < NLAYER * 16 * 16; task += F.G) {
            const int l = task >> 8, hp = (task >> 4) & 15, k0 = (task & 15) * 64;
            const float* kp = ((hp & 1) ? I.peer_k2 : I.peer_k1) + (size_t)l * 128 * 128;
            for (int i = F.tid; i < 64 * 128; i += NTHR) wqs[i] = I.peer_wq[(size_t)l * DM * 2048 + (size_t)(k0 + (i >> 7)) * 2048 + hp * 128 + (i & 127)];
            for (int i = F.tid; i < 128 * 128; i += NTHR) kps[(i >> 7) * 129 + (i & 127)] = kp[i];
            __syncthreads();
            const int n = F.tid & 127, kq = F.tid >> 7;
            float a[16];
#pragma unroll
            for (int i = 0; i < 16; ++i) a[i] = 0.f;
            for (int d = 0; d < 128; ++d) { const float kv = kps[n * 129 + d];
#pragma unroll
                for (int i = 0; i < 16; ++i) a[i] += wqs[(kq * 16 + i) * 128 + d] * kv; }
            bf16_t* o = (bf16_t*)(ws + WS_WSC) + (size_t)l * 2048 * DM + (size_t)(hp * 128 + n) * DM + k0 + kq * 16;
            u32x4 w0, w1; w0.x = cvt_pk_bf16(a[0], a[1]); w0.y = cvt_pk_bf16(a[2], a[3]); w0.z = cvt_pk_bf16(a[4], a[5]); w0.w = cvt_pk_bf16(a[6], a[7]);
            w1.x = cvt_pk_bf16(a[8], a[9]); w1.y = cvt_pk_bf16(a[10], a[11]); w1.z = cvt_pk_bf16(a[12], a[13]); w1.w = cvt_pk_bf16(a[14], a[15]);
            *(GAS u32x4*)o = w0; *(GAS u32x4*)(o + 8) = w1;
            __syncthreads();
        }
    }
    {
        const int gt = blockIdx.x * NTHR + F.tid;
        if (gt < 128 * 16 + 128 * 8) {
            const bool big = gt < 2048; const int e = big ? gt : gt - 2048; const int q = big ? 16 : 8; const int pos = e / q, j = e % q;
            const float inv = (float)exp2(-(double)j / (double)q * 13.287712379549449);
            const float ang = (float)pos * inv; float sn, cs; sincos_small(ang, sn, cs);
            f32x2* tab = (f32x2*)(ws + WS_TAB + (big ? 0 : 16384));
            tab[e] = (f32x2){cs, sn};
        }
    }
}

__device__ __forceinline__ unsigned pack_i8(const f32x4 y) {
    const int q0 = __float2int_rn(fminf(fmaxf(y[0], -127.f), 127.f)), q1 = __float2int_rn(fminf(fmaxf(y[1], -127.f), 127.f)), q2 = __float2int_rn(fminf(fmaxf(y[2], -127.f), 127.f)), q3 = __float2int_rn(fminf(fmaxf(y[3], -127.f), 127.f));
    return ((unsigned)q0 & 0xFFu) | (((unsigned)q1 & 0xFFu) << 8) | (((unsigned)q2 & 0xFFu) << 16) | ((unsigned)q3 << 24);
}
__device__ __forceinline__ void phase_convert_uv(Frame& F, const float* u, const float* v, unsigned char* ws) {
    const size_t nblk = (size_t)NEXP * DM / 1024;
    const int gw = F.vcu * NWAVES + F.wave, NGW = F.G * NWAVES, lane = F.lane;
    for (size_t i = gw; i < 2 * nblk; i += NGW) {
        const bool second = i >= nblk; const size_t j = second ? i - nblk : i; const float sc = second ? 4.0f : 896.0f;
        const GAS f32x4* s = (const GAS f32x4*)(second ? v : u) + j * 256 + lane;
        GAS unsigned* d = (GAS unsigned*)(ws + (second ? WS_VB : WS_UB)) + j * 256 + lane;
        f32x4 a[4];
#pragma unroll
        for (int q = 0; q < 4; ++q) a[q] = s[64 * q] * sc;
#pragma unroll
        for (int q = 0; q < 4; ++q) d[64 * q] = second ? (unsigned)__builtin_amdgcn_cvt_pk_fp8_f32(a[q][2], a[q][3], __builtin_amdgcn_cvt_pk_fp8_f32(a[q][0], a[q][1], 0, false), true) : pack_i8(a[q]);
    }
}

template <bool Q8 = false>
__device__ __forceinline__ void phase_norm_mod(Frame& F, const float* xl, const bf16_t* xb, const float* xc, const float* gain, const float* mod  , int chunk, bf16_t* XN, bool skipctx, float* ssq_zero, unsigned char* XQ = nullptr, float* XSC = nullptr) {
    const int gw = F.vcu * NWAVES + F.wave, NGW = F.G * NWAVES;
    (void)ssq_zero;
    for (int gi = gw; gi < NROW / 4; gi += NGW) {
        const int r0 = 4 * gi, b = r0 / NB, j0 = r0 % NB;
        const bool isctx = j0 < CTXL;
        if (skipctx && isctx) continue;
        const float* mv = mod + (isctx ? 4 : b) * 6144 + chunk * DM;
        f32x4 v[4][4]; float s[4];
        if (!isctx && xl == nullptr) {
            const GAS u32x2* x2 = (const GAS u32x2*)(xb + ((size_t)b * SEQ + (j0 - CTXL)) * DM) + F.lane;
            u32x2 w[4][4];
#pragma unroll
            for (int i = 0; i < 4; ++i)
#pragma unroll
                for (int q = 0; q < 4; ++q) w[i][q] = x2[i * (DM / 4) + 64 * q];
#pragma unroll
            for (int i = 0; i < 4; ++i)
#pragma unroll
                for (int q = 0; q < 4; ++q) v[i][q] = (f32x4){bf_lo(w[i][q].x), bf_hi(w[i][q].x), bf_lo(w[i][q].y), bf_hi(w[i][q].y)};
        } else {
            const float* xr = isctx ? xc + ((size_t)b * CTXL + j0) * DM : xl + ((size_t)b * SEQ + (j0 - CTXL)) * DM;
            const GAS f32x4* x4 = (const GAS f32x4*)xr + F.lane;
#pragma unroll
            for (int i = 0; i < 4; ++i)
#pragma unroll
                for (int q = 0; q < 4; ++q) v[i][q] = x4[i * (DM / 4) + 64 * q];
        }
#pragma unroll
        for (int i = 0; i < 4; ++i) { float a = 0.f;
#pragma unroll
            for (int q = 0; q < 4; ++q) a += (v[i][q][0] * v[i][q][0] + v[i][q][1] * v[i][q][1]) + (v[i][q][2] * v[i][q][2] + v[i][q][3] * v[i][q][3]);
            s[i] = a; }
#pragma unroll
        for (int i = 0; i < 4; ++i) s[i] = 1.0f / sqrtf(wave_sum(s[i]) * (1.f / DM) + EPS);
#pragma unroll
        for (int q = 0; q < 4; ++q) {
            const int c = 4 * F.lane + 256 * q;
            const f32x4 g = *(const GAS f32x4*)(gain + c), sh = *(const GAS f32x4*)(mv + c), sc = *(const GAS f32x4*)(mv + DM + c);
            const f32x4 gs = g * (sc + 1.0f);
#pragma unroll
            for (int i = 0; i < 4; ++i) {
                const f32x4 y = (v[i][q] * s[i]) * gs + sh;
                u32x2 w; w.x = cvt_pk_bf16(y[0], y[1]); w.y = cvt_pk_bf16(y[2], y[3]);
                ((GAS u32x2*)(XN + (size_t)(r0 + i) * DM) + F.lane)[64 * q] = w;
                if (Q8) v[i][q] = y;
            }
        }
        if (Q8) {
#pragma unroll
            for (int i = 0; i < 4; ++i) { float m = 0.f;
#pragma unroll
                for (int q = 0; q < 4; ++q) m = fmaxf(fmaxf(m, fmaxf(fabsf(v[i][q][0]), fabsf(v[i][q][1]))), fmaxf(fabsf(v[i][q][2]), fabsf(v[i][q][3])));
                m = fmaxf(m, xshfl<1>(m)); m = fmaxf(m, xshfl<2>(m)); m = fmaxf(m, xshfl<4>(m)); m = fmaxf(m, xshfl<8>(m)); m = fmaxf(m, xshfl<16>(m)); m = fmaxf(xmax32(m), 1e-20f);
                const float qs = 127.0f / m;
#pragma unroll
                for (int q = 0; q < 4; ++q) ((GAS unsigned*)(XQ + (size_t)(r0 + i) * DM) + F.lane)[64 * q] = pack_i8(v[i][q] * qs);
                if (F.lane == 0) ((GAS float*)XSC)[r0 + i] = m * (1.0f / 127.0f);
            }
        }
    }
}

__device__ __forceinline__ void phase_final_norm(Frame& F, const bf16_t* xb, float* out, const float* gain, float dsc) {
    const int gw = F.vcu * NWAVES + F.wave, NGW = F.G * NWAVES;
    for (int gi = gw; gi < NBATCH * SEQ / 4; gi += NGW) {
        const int r0 = 4 * gi;
        const GAS u32x2* x2 = (const GAS u32x2*)(xb + (size_t)r0 * DM) + F.lane;
        u32x2 w[4][4];
#pragma unroll
        for (int i = 0; i < 4; ++i)
#pragma unroll
            for (int q = 0; q < 4; ++q) w[i][q] = x2[i * (DM / 4) + 64 * q];
        f32x4 v[4][4]; float s[4];
#pragma unroll
        for (int i = 0; i < 4; ++i) { float a = 0.f;
#pragma unroll
            for (int q = 0; q < 4; ++q) { v[i][q] = (f32x4){bf_lo(w[i][q].x), bf_hi(w[i][q].x), bf_lo(w[i][q].y), bf_hi(w[i][q].y)}; a += (v[i][q][0] * v[i][q][0] + v[i][q][1] * v[i][q][1]) + (v[i][q][2] * v[i][q][2] + v[i][q][3] * v[i][q][3]); }
            s[i] = a; }
#pragma unroll
        for (int i = 0; i < 4; ++i) s[i] = dsc / sqrtf(wave_sum(s[i]) * (1.f / DM) + EPS);
#pragma unroll
        for (int q = 0; q < 4; ++q) { const f32x4 g = *(const GAS f32x4*)(gain + 4 * F.lane + 256 * q);
#pragma unroll
            for (int i = 0; i < 4; ++i) ((GAS f32x4*)(out + (size_t)(r0 + i) * DM) + F.lane)[64 * q] = (v[i][q] * s[i]) * g; }
    }
}
__device__ __forceinline__ int crow(int r, int hi) { return (r & 3) + 8 * (r >> 2) + 4 * hi; }
constexpr int VS = 68;
enum { AT_MLA = 0, AT_SWA = 1, AT_NA = 2 };
#ifndef ATT_THR
#define ATT_THR 8.0f
#endif
#ifndef SC_MLA
#define SC_MLA 1.0f
#endif
#ifndef SC_SWA
#define SC_SWA 1.0f
#endif
#ifndef SC_NA
#define SC_NA 1.0f
#endif
#ifndef SKIP_ATT
#define SKIP_ATT 0
#endif
struct AttnArgs { const bf16_t* P; const bf16_t* KV; bf16_t* Y; const float* sink; const float* rpb; };

#ifndef ABL
#define ABL 0
#endif
template <int KIND, bool CTXQ, bool DUMMY = false>
__device__ __forceinline__ void attn_unit(Frame& F, const AttnArgs& A, int unit) {
    constexpr int AB = DUMMY ? ABL : 0;
    constexpr int DQK = (KIND == AT_MLA) ? 96 : 64, KS = DQK + 8, NP = DQK / 8, NS = DQK / 16;
    constexpr int KT_BYTES = 64 * KS * 2, VT_BYTES = 64 * VS * 2;
    LAS unsigned char* lds = F.lds;
    LAS unsigned char* Vt[2] = {lds + 3 * KT_BYTES, lds + 3 * KT_BYTES + VT_BYTES};
    LAS float* rpbl = (LAS float*)(lds + 3 * KT_BYTES + 2 * VT_BYTES);
    int lane = lane_id(); asm volatile("" : "+v"(lane));
    const int w = F.wave, tid = w * 64 + lane, r32 = lane & 31, hi = lane >> 5;

    int b, h = 0, g = 0, n = 0;
    if (KIND == AT_MLA) { if (CTXQ) { b = unit >> 2; h = unit & 3; } else { b = unit >> 7; h = (unit >> 5) & 3; n = unit & 31; } }
    else if (KIND == AT_SWA) { if (CTXQ) { b = unit >> 2; g = (unit >> 1) & 1; n = unit & 1; } else { b = unit >> 7; g = (unit >> 6) & 1; n = unit & 63; } }
    else { if (CTXQ) { b = unit >> 2; h = unit & 3; } else { b = unit >> 7; h = (unit >> 5) & 3; n = unit & 31; } }
    const size_t rb = (size_t)b * NB;

    int qj;
    int hq = h, qpos = 0, qrow = 0, qcol = 0;
    if (KIND == AT_MLA) qj = CTXQ ? (32 * w + r32) : (CTXL + 256 * n + 32 * w + r32);
    else if (KIND == AT_SWA) { hq = 2 * g + (w >> 2); qpos = 128 * n + 32 * (w & 3) + r32; qj = CTXQ ? qpos : CTXL + qpos; }
    else { if (CTXQ) qj = 32 * w + r32; else { qrow = 4 * n + (w >> 1); qcol = 32 * (w & 1) + r32; qj = CTXL + qrow * 64 + qcol; } }
    const int qcolbase = (KIND == AT_MLA) ? (C_MLAQ + hq * 96) : (KIND == AT_SWA) ? (C_SWAQ + hq * 64) : (C_NAQ + hq * 64);
    const bf16_t* qp = A.P + (rb + qj) * PW + qcolbase;
    bf16x8 qr[NS];
#pragma unroll
    for (int s = 0; s < NS; ++s) qr[s] = *(const GAS bf16x8*)(qp + 16 * s + 8 * hi);

    int nt = 4, band_lo = 0;
    if (!CTXQ) {
        if (KIND == AT_MLA) nt = 132;
        else if (KIND == AT_SWA) { band_lo = (n == 0) ? 2 : 0; const int band_hi = (n == 63) ? 4 : 6; nt = 4 + band_hi - band_lo; }
        else { int lo = 4 * n - 4; lo = lo < 0 ? 0 : (lo > 120 ? 120 : lo); int hi2 = 4 * n + 3 - 4; hi2 = hi2 < 0 ? 0 : (hi2 > 120 ? 120 : hi2); band_lo = lo; nt = 4 + (hi2 + 7 - lo + 1); }
    }
    auto tile_j0 = [&](int t) -> int {
        if (t < 4) return 64 * t;
        if (KIND == AT_MLA) return 64 * t;
        if (KIND == AT_SWA) return CTXL + 128 * (n - 1) + 64 * (band_lo + t - 4);
        return CTXL + 64 * (band_lo + t - 4);
    };
    int na_rs = 0, na_cs = 0;
    if (KIND == AT_NA && !CTXQ) { na_rs = qrow - 4; na_rs = na_rs < 0 ? 0 : (na_rs > 120 ? 120 : na_rs); na_cs = qcol - 8; na_cs = na_cs < 0 ? 0 : (na_cs > 48 ? 48 : na_cs); }

    const int vkey = (lane & 15) + 16 * (w & 3), vdp = 4 * (w >> 2) + (lane >> 4);
    const int kcolbase = (KIND == AT_SWA) ? (C_SWAK + g * 64) : (C_NAK + h * 64);
    const int vcolbase = (KIND == AT_SWA) ? (C_SWAV + g * 64) : (C_NAV + h * 64);
    constexpr int KPITCH0 = (KIND == AT_MLA) ? KVW : PW, VPITCH = (KIND == AT_MLA) ? KVW : PW;
    const GAS char* kbase0 = (KIND == AT_MLA) ? (const GAS char*)(A.KV + rb * KVW + h * 128) : (const GAS char*)(A.P + rb * PW + kcolbase);
    const GAS char* kbase1 = (const GAS char*)(A.P + rb * PW + C_KR);
    const GAS char* vbase = (KIND == AT_MLA) ? (const GAS char*)(A.KV + rb * KVW + h * 128 + 64) : (const GAS char*)(A.P + rb * PW + vcolbase);
    const unsigned koff0 = (unsigned)((tid >> 3) * KPITCH0 + (tid & 7) * 8) * 2u, koff1 = (unsigned)((tid >> 2) * PW + (tid & 3) * 8) * 2u, voff = (unsigned)(vkey * VPITCH + vdp * 8) * 2u;
    const bool has_k1 = (DQK == 96) && tid < 256;
    const unsigned kl0 = (unsigned)((tid >> 3) * (KS * 2) + (tid & 7) * 16), kl1 = (unsigned)((tid >> 2) * (KS * 2) + 128 + (tid & 3) * 16);
    struct Stage { u32x4 k0, k1, v; };
    auto gloadK = [&](Stage& R, int t) { const int j0 = tile_j0(t); R.k0 = *(const GAS u32x4*)(kbase0 + (size_t)j0 * (KPITCH0 * 2) + koff0); if (has_k1) R.k1 = *(const GAS u32x4*)(kbase1 + (size_t)j0 * (PW * 2) + koff1); };
    auto gloadV = [&](Stage& R, int t) { R.v = *(const GAS u32x4*)(vbase + (size_t)tile_j0(t) * (VPITCH * 2) + voff); };
    auto lstoreK = [&](const Stage& R, int kofs) { *(LAS u32x4*)(lds + kofs + kl0) = R.k0; if (has_k1) *(LAS u32x4*)(lds + kofs + kl1) = R.k1; };
    auto lstoreV = [&](const Stage& R, int buf) { const u32x4 vreg = R.v;
        LAS bf16_t* vt = (LAS bf16_t*)Vt[buf] + (8 * vdp) * VS + vkey;
        vt[0 * VS] = (bf16_t)(vreg.x & 0xffffu); vt[1 * VS] = (bf16_t)(vreg.x >> 16); vt[2 * VS] = (bf16_t)(vreg.y & 0xffffu); vt[3 * VS] = (bf16_t)(vreg.y >> 16);
        vt[4 * VS] = (bf16_t)(vreg.z & 0xffffu); vt[5 * VS] = (bf16_t)(vreg.z >> 16); vt[6 * VS] = (bf16_t)(vreg.w & 0xffffu); vt[7 * VS] = (bf16_t)(vreg.w >> 16);
    };
    struct KF { bf16x8 f[NS]; };
    auto kread = [&](KF& K, int kofs, int hf) {
        const LAS unsigned char* kb = lds + kofs + (32 * hf + r32) * (KS * 2) + hi * 16;
#pragma unroll
        for (int q = 0; q < NS; ++q) K.f[q] = *(const LAS bf16x8*)(kb + q * 32);
    };
    auto qkh = [&](const KF& K, const f32x16& negm, f32x16& p) {
        p = __builtin_amdgcn_mfma_f32_32x32x16_bf16(K.f[0], qr[0], negm, 0, 0, 0);
#pragma unroll
        for (int q = 1; q < NS; ++q) p = __builtin_amdgcn_mfma_f32_32x32x16_bf16(K.f[q], qr[q], p, 0, 0, 0);
    };
    struct VF { u32x2 l0[2], h0[2], l1[2], h1[2]; };
    auto vread = [&](VF& V, int buf, int hf) {
        const LAS unsigned char* vb = Vt[buf] + r32 * (VS * 2) + hi * 8 + hf * 64;
#pragma unroll
        for (int q = 0; q < 2; ++q) { V.l0[q] = *(const LAS u32x2*)(vb + q * 32); V.h0[q] = *(const LAS u32x2*)(vb + q * 32 + 16);
            V.l1[q] = *(const LAS u32x2*)(vb + 32 * (VS * 2) + q * 32); V.h1[q] = *(const LAS u32x2*)(vb + 32 * (VS * 2) + q * 32 + 16); }
    };
    auto mask_half = [&](int t, int hf, f32x16& p) {
        if (CTXQ) return;
        if (KIND == AT_SWA) {
            const bool band = t >= 4;
            int db = band ? (128 * (n - 1) + 64 * (band_lo + t - 4) + 32 * hf + 4 * hi - qpos) : 0;
            asm volatile("" : "+v"(db));
#pragma unroll
            for (int r = 0; r < 16; ++r) { const int c = (r & 3) + 8 * (r >> 2); if (band && (db > 128 - c || db < -128 - c)) p[r] = -1.0e30f; }
        } else if (KIND == AT_NA) {
            const bool band = t >= 4;
            const int krow = band_lo + t - 4;
            const bool rowok = !band || (krow >= na_rs && krow < na_rs + 8);
            const int dr = band ? (krow - qrow + 7) : 0;
            int e = 4 * hi + 32 * hf - na_cs;
            const LAS float* brow = rpbl + (dr < 0 ? 0 : (dr > 14 ? 14 : dr)) * 32 + (15 - qcol + 4 * hi + 32 * hf);
            asm volatile("" : "+v"(e));
#pragma unroll
            for (int r = 0; r < 16; ++r) { const int c = (r & 3) + 8 * (r >> 2);
                const bool v0 = rowok && (!band || (unsigned)(e + c) < 16u);
                const float b0 = (band && v0) ? brow[c] : 0.f;
                p[r] = v0 ? p[r] + b0 : -1.0e30f; }
        }
    };

    if (KIND == AT_NA && !CTXQ) { for (int i = tid; i < 15 * 32; i += NTHR) { const int dr = i >> 5, dc = i & 31; rpbl[i] = (dc < 31) ? ((const GAS float*)A.rpb)[(h * 15 + dr) * 31 + dc] * LOG2E : 0.f; } }

    nt = __builtin_amdgcn_readfirstlane(nt); asm volatile("" : "+s"(nt));
    Stage RA, RB;
    RA.k1 = (u32x4){0u, 0u, 0u, 0u}; RB.k1 = RA.k1;
    gloadK(RA, 0); gloadV(RA, 0); gloadK(RB, nt > 1 ? 1 : 0);
    lstoreK(RA, 0); lstoreV(RA, 0); lstoreK(RB, KT_BYTES);
    int kA = 0, kB = KT_BYTES, kC = 2 * KT_BYTES;
    gloadK(RB, nt > 2 ? 2 : nt - 1); gloadV(RB, nt > 1 ? 1 : nt - 1);
    __syncthreads();
    float m_ref, l_run = 0.f;
    f32x16 o0, o1, pa, pb, negm;
#pragma unroll
    for (int r = 0; r < 16; ++r) { o0[r] = 0.f; o1[r] = 0.f; negm[r] = 0.f; }
    { f32x16& pc = pa; KF K0; kread(K0, 0, 0); qkh(K0, negm, pc); mask_half(0, 0, pc);
      float mx = pc[0];
#pragma unroll
      for (int r = 1; r < 16; ++r) mx = fmaxf(mx, pc[r]);
      mx = xmax32(mx); m_ref = mx;
#pragma unroll
      for (int r = 0; r < 16; ++r) { pc[r] -= mx; negm[r] = -mx; } }
#define ATT_HALF(t, hf, tn, hn, kbuf, pc, pn) do { \
        KF Kn; VF Vc; \
        kread(Kn, (kbuf), (hn)); vread(Vc, (t) & 1, (hf)); \
        qkh(Kn, negm, pn); \
        float rsum = 0.f; \
        _Pragma("unroll") for (int r = 0; r < 16; ++r) { if (!(AB & 1)) pc[r] = fexp2(pc[r]); rsum += pc[r]; } \
        l_run += rsum; \
        mask_half((tn), (hn), pn); \
        float mx = fmaxf(pn[0], pn[1]); \
        _Pragma("unroll") for (int r = 2; r < 16; ++r) mx = fmaxf(mx, pn[r]); \
        mx = xmax32(mx); \
        if (__builtin_expect(((tn) < nt) && __any(mx > ATT_THR), 0)) { \
            const float d = fmaxf(mx, 0.f), al = fexp2(-d); \
            m_ref += d; l_run *= al; \
            _Pragma("unroll") for (int r = 0; r < 16; ++r) { pn[r] -= d; o0[r] *= al; o1[r] *= al; pc[r] *= al; negm[r] = -m_ref; } \
        } \
        const bf16x8 pf0 = __builtin_bit_cast(bf16x8, (u32x4){cvt_pk_bf16(pc[0], pc[1]), cvt_pk_bf16(pc[2], pc[3]), cvt_pk_bf16(pc[4], pc[5]), cvt_pk_bf16(pc[6], pc[7])}); \
        const bf16x8 pf1 = __builtin_bit_cast(bf16x8, (u32x4){cvt_pk_bf16(pc[8], pc[9]), cvt_pk_bf16(pc[10], pc[11]), cvt_pk_bf16(pc[12], pc[13]), cvt_pk_bf16(pc[14], pc[15])}); \
        o0 = __builtin_amdgcn_mfma_f32_32x32x16_bf16(__builtin_bit_cast(bf16x8, (u32x4){Vc.l0[0].x, Vc.l0[0].y, Vc.h0[0].x, Vc.h0[0].y}), pf0, o0, 0, 0, 0); \
        o1 = __builtin_amdgcn_mfma_f32_32x32x16_bf16(__builtin_bit_cast(bf16x8, (u32x4){Vc.l1[0].x, Vc.l1[0].y, Vc.h1[0].x, Vc.h1[0].y}), pf0, o1, 0, 0, 0); \
        o0 = __builtin_amdgcn_mfma_f32_32x32x16_bf16(__builtin_bit_cast(bf16x8, (u32x4){Vc.l0[1].x, Vc.l0[1].y, Vc.h0[1].x, Vc.h0[1].y}), pf1, o0, 0, 0, 0); \
        o1 = __builtin_amdgcn_mfma_f32_32x32x16_bf16(__builtin_bit_cast(bf16x8, (u32x4){Vc.l1[1].x, Vc.l1[1].y, Vc.h1[1].x, Vc.h1[1].y}), pf1, o1, 0, 0, 0); \
    } while (0)
#define ATT_STEP(t, RL, RS) do { \
        if (!(AB & 32)) { const int tk_ = ((t) + 3 < nt) ? (t) + 3 : nt - 1, tv_ = ((t) + 2 < nt) ? (t) + 2 : nt - 1; gloadK(RL, tk_); gloadV(RL, tv_); } \
        ATT_HALF(t, 0, t, 1, kA, pa, pb); \
        ATT_HALF(t, 1, (t) + 1, 0, kB, pb, pa); \
        if (!(AB & 64)) lstoreK(RS, kC); if (!(AB & 8)) lstoreV(RS, ((t) + 1) & 1); \
        { const int k_ = kA; kA = kB; kB = kC; kC = k_; } \
        if (!(AB & 16)) __syncthreads(); \
    } while (0)
#pragma nounroll
    for (int t = 0; t < nt; t += 2) {
        ATT_STEP(t, RA, RB);
        if (t + 1 < nt) ATT_STEP(t + 1, RB, RA);
    }
#undef ATT_STEP
#undef ATT_HALF
    const float m_run = m_ref;
    float l_tot = xsum32(l_run);
    if (KIND == AT_SWA) l_tot += fexp2(((const GAS float*)A.sink)[hq] * LOG2E - m_run);
    const float rl = ((KIND == AT_MLA) ? SC_MLA : (KIND == AT_SWA) ? SC_SWA : SC_NA) / l_tot;
    const int ycol = (KIND == AT_MLA) ? (hq * 64) : (KIND == AT_SWA) ? (256 + hq * 64) : (512 + hq * 64);
    LAS unsigned char* ost = lds + 3 * KT_BYTES + 2 * VT_BYTES + 2048 + w * 4608;
#pragma unroll
    for (int q4 = 0; q4 < 4; ++q4) {
        u32x2 w0, w1;
        w0.x = cvt_pk_bf16(o0[4 * q4] * rl, o0[4 * q4 + 1] * rl); w0.y = cvt_pk_bf16(o0[4 * q4 + 2] * rl, o0[4 * q4 + 3] * rl);
        w1.x = cvt_pk_bf16(o1[4 * q4] * rl, o1[4 * q4 + 1] * rl); w1.y = cvt_pk_bf16(o1[4 * q4 + 2] * rl, o1[4 * q4 + 3] * rl);
        *(LAS u32x2*)(ost + r32 * 144 + (4 * hi + 8 * q4) * 2) = w0; *(LAS u32x2*)(ost + r32 * 144 + (32 + 4 * hi + 8 * q4) * 2) = w1;
    }
    LDS_WAIT(); asm volatile("" ::: "memory");
    const int qj0 = __builtin_amdgcn_readfirstlane(qj);
#pragma unroll
    for (int i = 0; i < 4; ++i) { const int rr = 8 * i + (lane >> 3), ch = lane & 7;
        *(GAS u32x4*)(A.Y + (rb + qj0 + rr) * DM + ycol + 8 * ch) = *(const LAS u32x4*)(ost + rr * 144 + 16 * ch); }
    LDS_WAIT(); asm volatile("" ::: "memory");
}
constexpr int RVS = 132;
struct RetArgs { const bf16_t* P; bf16_t* Y; float* RS; const float* decay_f; const float* decay_b; const float* gn_f; const float* gn_b; };
__device__ __forceinline__ float log2_sigmoid(float d) { return -log2f(1.0f + expf(-d)); }

struct RStage { u32x4 k[2], v[2]; };
__device__ __forceinline__ void ret_stage_load(RStage& S, const bf16_t* P, int unit, int tid) {
    const int c = unit % 66, bh = unit / 66, b = bh >> 2, h = bh & 3;
    const size_t row0 = (size_t)b * NB + 128 * c;
#pragma unroll
    for (int j = 0; j < 2; ++j) {
        const int q = tid + 512 * j, tok = (q & 31) + 32 * ((q >> 5) & 3), dp = q >> 7;
        const bf16_t* pr = P + (row0 + tok) * PW + h * 64 + dp * 8;
        S.k[j] = *(const GAS u32x4*)(pr + C_RK); S.v[j] = *(const GAS u32x4*)(pr + C_RV);
    }
}
__device__ __forceinline__ void ret_local_loop(Frame& F, const RetArgs& A, int u0, int ustep, int nunits) {
    int lane = lane_id(); asm volatile("" : "+v"(lane));
    const int w = F.wave, tid = w * 64 + lane, r32 = lane & 31, hi = lane >> 5;
    LAS bf16_t* Ktt = (LAS bf16_t*)F.lds;
    LAS bf16_t* Vtf = Ktt + 64 * RVS;
    LAS bf16_t* Vtb = Vtf + 64 * RVS;
    RStage S;
    int unit = u0;
    if (unit < nunits) ret_stage_load(S, A.P, unit, tid);
    while (unit < nunits) {
        const int c = unit % 66, bh = unit / 66, h = bh & 3;
        const float lgf = log2_sigmoid(((const GAS float*)A.decay_f)[h]), lgb = log2_sigmoid(((const GAS float*)A.decay_b)[h]);
#pragma unroll
        for (int j = 0; j < 2; ++j) {
            const int q = tid + 512 * j, tok = (q & 31) + 32 * ((q >> 5) & 3), dp = q >> 7;
            const float wf = fexp2(lgf * (float)(127 - tok)), wb = fexp2(lgb * (float)tok);
            LAS bf16_t* kt = Ktt + (8 * dp) * RVS + tok; LAS bf16_t* vf = Vtf + (8 * dp) * RVS + tok; LAS bf16_t* vb = Vtb + (8 * dp) * RVS + tok;
            const unsigned kw[4] = {S.k[j].x, S.k[j].y, S.k[j].z, S.k[j].w}, vw[4] = {S.v[j].x, S.v[j].y, S.v[j].z, S.v[j].w};
#pragma unroll
            for (int e = 0; e < 4; ++e) {
                kt[(2 * e) * RVS] = (bf16_t)(kw[e] & 0xffffu); kt[(2 * e + 1) * RVS] = (bf16_t)(kw[e] >> 16);
                const float v0 = bf_lo(vw[e]), v1 = bf_hi(vw[e]);
                const unsigned pf = cvt_pk_bf16(v0 * wf, v1 * wf), pb = cvt_pk_bf16(v0 * wb, v1 * wb);
                vf[(2 * e) * RVS] = (bf16_t)(pf & 0xffffu); vf[(2 * e + 1) * RVS] = (bf16_t)(pf >> 16);
                vb[(2 * e) * RVS] = (bf16_t)(pb & 0xffffu); vb[(2 * e + 1) * RVS] = (bf16_t)(pb >> 16);
            }
        }
        const int unext = unit + ustep;
        if (unext < nunits) ret_stage_load(S, A.P, unext, tid);
        __syncthreads();
        const int dir = w >> 2, dvb = (w >> 1) & 1, dkb = w & 1;
        const LAS bf16_t* va = (dir ? Vtb : Vtf) + (32 * dvb + r32) * RVS + 8 * hi;
        const LAS bf16_t* kb = Ktt + (32 * dkb + r32) * RVS + 8 * hi;
        f32x16 acc;
#pragma unroll
        for (int r = 0; r < 16; ++r) acc[r] = 0.f;
#pragma unroll
        for (int s = 0; s < 8; ++s) {
            const u32x2 a0 = *(const LAS u32x2*)(va + 16 * s), a1 = *(const LAS u32x2*)(va + 16 * s + 4);
            const u32x2 b0 = *(const LAS u32x2*)(kb + 16 * s), b1 = *(const LAS u32x2*)(kb + 16 * s + 4);
            acc = __builtin_amdgcn_mfma_f32_32x32x16_bf16(__builtin_bit_cast(bf16x8, (u32x4){a0.x, a0.y, a1.x, a1.y}), __builtin_bit_cast(bf16x8, (u32x4){b0.x, b0.y, b1.x, b1.y}), acc, 0, 0, 0);
        }
        GAS float* out = (GAS float*)A.RS + ((size_t)(bh * 2 + dir) * 66 + c) * 4096 + 32 * dkb + r32;
#pragma unroll
        for (int r = 0; r < 16; ++r) out[(32 * dvb + crow(r, hi)) * 64] = acc[r];
        __syncthreads();
        unit = unext;
    }
}

__device__ __forceinline__ void ret_scan(Frame& F, const RetArgs& A) {
    for (int e = blockIdx.x * NTHR + F.tid; e < 32 * 4096; e += F.G * NTHR) {
        const int seq = e >> 12, el = e & 4095, dir = seq & 1, h = (seq >> 1) & 3;
        const float a = fexp2(128.0f * log2_sigmoid(dir ? ((const GAS float*)A.decay_b)[h] : ((const GAS float*)A.decay_f)[h]));
        GAS float* base = (GAS float*)A.RS + (size_t)seq * 66 * 4096 + el;
        float s = 0.f;
#pragma nounroll
        for (int n0 = 0; n0 < 66; n0 += 11) {
            int nb = n0; asm volatile("" : "+s"(nb));
            float u[11];
#pragma unroll
            for (int i = 0; i < 11; ++i) { const int n = nb + i; const int c = dir ? ((n < 2) ? 1 - n : 67 - n) : n; u[i] = base[(size_t)c * 4096]; }
#pragma unroll
            for (int i = 0; i < 11; ++i) { const int n = nb + i; const int c = dir ? ((n < 2) ? 1 - n : 67 - n) : n; base[(size_t)c * 4096] = s; s = a * s + u[i]; }
        }
    }
}

__device__ __forceinline__ void ret_out_loop(Frame& F, const RetArgs& A, int u0, int ustep, int nunits, bool skipctx) {
    int lane = lane_id(); asm volatile("" : "+v"(lane));
    const int w = F.wave, tid = w * 64 + lane, r32 = lane & 31, hi = lane >> 5;
    constexpr int KS = 72;
    LAS unsigned char* Kc = F.lds;
    LAS bf16_t* Vt = (LAS bf16_t*)(F.lds + 128 * KS * 2);
    LAS float* comb = (LAS float*)(F.lds + 128 * KS * 2 + 64 * RVS * 2);
    auto nextu = [&](int u) { u += ustep; while (skipctx && u < nunits && (u % 66) < 2) u += ustep; return u; };
    int unit = u0; while (skipctx && unit < nunits && (unit % 66) < 2) unit += ustep;
    RStage S;
    if (unit < nunits) ret_stage_load(S, A.P, unit, tid);
    while (unit < nunits) {
    const int c = unit % 66, bh = unit / 66, b = bh >> 2, h = bh & 3;
    const size_t row0 = (size_t)b * NB + 128 * c;
#pragma unroll
    for (int j = 0; j < 2; ++j) {
        const int q = tid + 512 * j, tok = (q & 31) + 32 * ((q >> 5) & 3), dp = q >> 7;
        *(LAS u32x4*)(Kc + tok * (KS * 2) + dp * 16) = S.k[j];
        const u32x4 vv = S.v[j];
        LAS bf16_t* vt = Vt + (8 * dp) * RVS + tok;
        vt[0 * RVS] = (bf16_t)(vv.x & 0xffffu); vt[1 * RVS] = (bf16_t)(vv.x >> 16); vt[2 * RVS] = (bf16_t)(vv.y & 0xffffu); vt[3 * RVS] = (bf16_t)(vv.y >> 16);
        vt[4 * RVS] = (bf16_t)(vv.z & 0xffffu); vt[5 * RVS] = (bf16_t)(vv.z >> 16); vt[6 * RVS] = (bf16_t)(vv.w & 0xffffu); vt[7 * RVS] = (bf16_t)(vv.w >> 16);
    }
    const int unext = nextu(unit);
    if (unext < nunits) ret_stage_load(S, A.P, unext, tid);
    const int dir = w >> 2, qg = w & 3, qi = 32 * qg + r32;
    const float lg = log2_sigmoid(dir ? ((const GAS float*)A.decay_b)[h] : ((const GAS float*)A.decay_f)[h]);
    const bf16_t* prow = A.P + (row0 + qi) * PW;
    bf16x8 qr[4];
#pragma unroll
    for (int s = 0; s < 4; ++s) qr[s] = *(const GAS bf16x8*)(prow + C_RQ + h * 64 + 16 * s + 8 * hi);
    f32x16 o0, o1;
#pragma unroll
    for (int r = 0; r < 16; ++r) { o0[r] = 0.f; o1[r] = 0.f; }
    f32x4 sa[4][2], sb[4][2];
    {
        const float* sp = A.RS + ((size_t)(bh * 2 + dir) * 66 + c) * 4096 + r32 * 64 + 8 * hi;
#pragma unroll
        for (int s = 0; s < 4; ++s) { sa[s][0] = *(const GAS f32x4*)(sp + 16 * s); sa[s][1] = *(const GAS f32x4*)(sp + 16 * s + 4);
            sb[s][0] = *(const GAS f32x4*)(sp + 32 * 64 + 16 * s); sb[s][1] = *(const GAS f32x4*)(sp + 32 * 64 + 16 * s + 4); }
    }
#pragma unroll
    for (int s = 0; s < 4; ++s) {
        const bf16x8 fa = __builtin_bit_cast(bf16x8, (u32x4){cvt_pk_bf16(sa[s][0][0], sa[s][0][1]), cvt_pk_bf16(sa[s][0][2], sa[s][0][3]), cvt_pk_bf16(sa[s][1][0], sa[s][1][1]), cvt_pk_bf16(sa[s][1][2], sa[s][1][3])});
        const bf16x8 fb = __builtin_bit_cast(bf16x8, (u32x4){cvt_pk_bf16(sb[s][0][0], sb[s][0][1]), cvt_pk_bf16(sb[s][0][2], sb[s][0][3]), cvt_pk_bf16(sb[s][1][0], sb[s][1][1]), cvt_pk_bf16(sb[s][1][2], sb[s][1][3])});
        o0 = __builtin_amdgcn_mfma_f32_32x32x16_bf16(fa, qr[s], o0, 0, 0, 0);
        o1 = __builtin_amdgcn_mfma_f32_32x32x16_bf16(fb, qr[s], o1, 0, 0, 0);
    }
    { const float qdec = fexp2(lg * (float)(dir ? (128 - qi) : (qi + 1)));
#pragma unroll
      for (int r = 0; r < 16; ++r) { o0[r] *= qdec; o1[r] *= qdec; } }
    __syncthreads();
#pragma unroll
    for (int kt = 0; kt < 2; ++kt) {
        const bool need = dir ? (64 * kt + 63 >= 32 * qg) : (64 * kt <= 32 * qg + 31);
        if (!need) continue;
        f32x16 p0, p1;
#pragma unroll
        for (int r = 0; r < 16; ++r) { p0[r] = 0.f; p1[r] = 0.f; }
        const LAS unsigned char* kb = Kc + (64 * kt + r32) * (KS * 2) + hi * 16;
#pragma unroll
        for (int s = 0; s < 4; ++s) {
            const bf16x8 a0 = *(const LAS bf16x8*)(kb + s * 32), a1 = *(const LAS bf16x8*)(kb + 32 * (KS * 2) + s * 32);
            p0 = __builtin_amdgcn_mfma_f32_32x32x16_bf16(a0, qr[s], p0, 0, 0, 0);
            p1 = __builtin_amdgcn_mfma_f32_32x32x16_bf16(a1, qr[s], p1, 0, 0, 0);
        }
#pragma unroll
        for (int r = 0; r < 16; ++r) {
            const int j0 = 64 * kt + crow(r, hi), j1 = j0 + 32;
            const int d0 = dir ? (j0 - qi) : (qi - j0), d1 = dir ? (j1 - qi) : (qi - j1);
            p0[r] = (d0 >= 0) ? p0[r] * fexp2(lg * (float)d0) : 0.f;
            p1[r] = (d1 >= 0) ? p1[r] * fexp2(lg * (float)d1) : 0.f;
        }
        u32x4 pw[4];
        pw[0] = (u32x4){cvt_pk_bf16(p0[0], p0[1]), cvt_pk_bf16(p0[2], p0[3]), cvt_pk_bf16(p0[4], p0[5]), cvt_pk_bf16(p0[6], p0[7])};
        pw[1] = (u32x4){cvt_pk_bf16(p0[8], p0[9]), cvt_pk_bf16(p0[10], p0[11]), cvt_pk_bf16(p0[12], p0[13]), cvt_pk_bf16(p0[14], p0[15])};
        pw[2] = (u32x4){cvt_pk_bf16(p1[0], p1[1]), cvt_pk_bf16(p1[2], p1[3]), cvt_pk_bf16(p1[4], p1[5]), cvt_pk_bf16(p1[6], p1[7])};
        pw[3] = (u32x4){cvt_pk_bf16(p1[8], p1[9]), cvt_pk_bf16(p1[10], p1[11]), cvt_pk_bf16(p1[12], p1[13]), cvt_pk_bf16(p1[14], p1[15])};
        const LAS bf16_t* vb = Vt + r32 * RVS + 64 * kt + 4 * hi;
#pragma unroll
        for (int s = 0; s < 4; ++s) {
            const u32x2 l0 = *(const LAS u32x2*)(vb + 16 * s), h0 = *(const LAS u32x2*)(vb + 16 * s + 8);
            const u32x2 l1 = *(const LAS u32x2*)(vb + 32 * RVS + 16 * s), h1 = *(const LAS u32x2*)(vb + 32 * RVS + 16 * s + 8);
            const bf16x8 pf = __builtin_bit_cast(bf16x8, pw[s]);
            o0 = __builtin_amdgcn_mfma_f32_32x32x16_bf16(__builtin_bit_cast(bf16x8, (u32x4){l0.x, l0.y, h0.x, h0.y}), pf, o0, 0, 0, 0);
            o1 = __builtin_amdgcn_mfma_f32_32x32x16_bf16(__builtin_bit_cast(bf16x8, (u32x4){l1.x, l1.y, h1.x, h1.y}), pf, o1, 0, 0, 0);
        }
    }
    float sum = 0.f;
#pragma unroll
    for (int r = 0; r < 16; ++r) sum += o0[r] + o1[r];
    sum = xsum32(sum);
    const float mu = sum * (1.f / 64.f);
    float var = 0.f;
#pragma unroll
    for (int r = 0; r < 16; ++r) { o0[r] -= mu; o1[r] -= mu; var += o0[r] * o0[r] + o1[r] * o1[r]; }
    var = xsum32(var);
    const float rstd = 1.0f / sqrtf(var * (1.f / 64.f) + EPS);
    const float* gn = (dir ? A.gn_b : A.gn_f) + h * 64 + 4 * hi;
    const bf16_t* gp = prow + (dir ? C_RGB : C_RGF) + h * 64 + 4 * hi;
    bf16_t* yp = A.Y + (row0 + qi) * DM + 768 + h * 64 + 4 * hi;
    LAS float* cb = comb + qi * 65 + 4 * hi;
    if (dir == 1) {
#pragma unroll
        for (int q4 = 0; q4 < 4; ++q4)
#pragma unroll
            for (int half = 0; half < 2; ++half) {
                const int d = 8 * q4 + 32 * half; const f32x4 g4 = *(const GAS f32x4*)(gn + d); const u32x2 gw = *(const GAS u32x2*)(gp + d);
                const float gt[4] = {bf_lo(gw.x), bf_hi(gw.x), bf_lo(gw.y), bf_hi(gw.y)};
#pragma unroll
                for (int e = 0; e < 4; ++e) { const float ov = half ? o1[4 * q4 + e] : o0[4 * q4 + e]; cb[d + e] = silu_f(gt[e]) * (ov * rstd) * g4[e]; }
            }
    }
    __syncthreads();
    if (dir == 0) {
#pragma unroll
        for (int q4 = 0; q4 < 4; ++q4)
#pragma unroll
            for (int half = 0; half < 2; ++half) {
                const int d = 8 * q4 + 32 * half; const f32x4 g4 = *(const GAS f32x4*)(gn + d); const u32x2 gw = *(const GAS u32x2*)(gp + d);
                const float gt[4] = {bf_lo(gw.x), bf_hi(gw.x), bf_lo(gw.y), bf_hi(gw.y)};
                float y[4];
#pragma unroll
                for (int e = 0; e < 4; ++e) { const float ov = half ? o1[4 * q4 + e] : o0[4 * q4 + e]; y[e] = silu_f(gt[e]) * (ov * rstd) * g4[e] + cb[d + e]; }
                u32x2 wv; wv.x = cvt_pk_bf16(y[0], y[1]); wv.y = cvt_pk_bf16(y[2], y[3]); *(GAS u32x2*)(yp + d) = wv;
            }
    }
    __syncthreads();
    unit = unext;
    }
}
#define CE(a, i, j) do { const float hi_ = fmaxf(a[i], a[j]), lo_ = fminf(a[i], a[j]); a[i] = hi_; a[j] = lo_; } while (0)
#define SORT16(a) do { CE(a,0,13); CE(a,1,12); CE(a,2,15); CE(a,3,14); CE(a,4,8); CE(a,5,6); CE(a,7,11); CE(a,9,10); CE(a,0,5); CE(a,1,7); CE(a,2,9); CE(a,3,4); CE(a,6,13); CE(a,8,14); CE(a,10,15); CE(a,11,12); CE(a,0,1); CE(a,2,3); CE(a,4,5); CE(a,6,8); CE(a,7,9); CE(a,10,11); CE(a,12,13); CE(a,14,15); CE(a,0,2); CE(a,1,3); CE(a,4,10); CE(a,5,11); CE(a,6,7); CE(a,8,9); CE(a,12,14); CE(a,13,15); CE(a,1,2); CE(a,3,12); CE(a,4,6); CE(a,5,7); CE(a,8,10); CE(a,9,11); CE(a,13,14); CE(a,1,4); CE(a,2,6); CE(a,5,8); CE(a,7,10); CE(a,9,13); CE(a,11,14); CE(a,2,4); CE(a,3,6); CE(a,9,12); CE(a,11,13); CE(a,3,5); CE(a,6,8); CE(a,7,9); CE(a,10,12); CE(a,3,4); CE(a,5,6); CE(a,7,8); CE(a,9,10); CE(a,11,12); CE(a,6,7); CE(a,8,9); } while (0)
#define MERGE16(T, C) do { T[0] = fmaxf(T[0], C[15]); T[1] = fmaxf(T[1], C[14]); T[2] = fmaxf(T[2], C[13]); T[3] = fmaxf(T[3], C[12]); T[4] = fmaxf(T[4], C[11]); T[5] = fmaxf(T[5], C[10]); T[6] = fmaxf(T[6], C[9]); T[7] = fmaxf(T[7], C[8]); T[8] = fmaxf(T[8], C[7]); T[9] = fmaxf(T[9], C[6]); T[10] = fmaxf(T[10], C[5]); T[11] = fmaxf(T[11], C[4]); T[12] = fmaxf(T[12], C[3]); T[13] = fmaxf(T[13], C[2]); T[14] = fmaxf(T[14], C[1]); T[15] = fmaxf(T[15], C[0]); CE(T,0,8); CE(T,1,9); CE(T,2,10); CE(T,3,11); CE(T,4,12); CE(T,5,13); CE(T,6,14); CE(T,7,15); CE(T,0,4); CE(T,1,5); CE(T,2,6); CE(T,3,7); CE(T,8,12); CE(T,9,13); CE(T,10,14); CE(T,11,15); CE(T,0,2); CE(T,1,3); CE(T,4,6); CE(T,5,7); CE(T,8,10); CE(T,9,11); CE(T,12,14); CE(T,13,15); CE(T,0,1); CE(T,2,3); CE(T,4,5); CE(T,6,7); CE(T,8,9); CE(T,10,11); CE(T,12,13); CE(T,14,15); } while (0)

__device__ __forceinline__ void phase_topk(Frame& F, const _Float16* S16, int* eid, float* gate, bool skipctx) {
    LAS unsigned char* timg = F.lds + F.wave * 11264;
    LAS unsigned char* ilds = F.lds + F.wave * 11264 + 9216 + F.lane;
    const int lane = F.lane, gwv = F.vcu * NWAVES + F.wave, NGW = F.G * NWAVES;
    for (int wt = gwv; wt < NROW / 8; wt += NGW) {
        const int row0 = 8 * wt;
        if (skipctx && (row0 % NB) < CTXL) continue;
        const int row = row0 + (lane >> 3), h = lane & 7;
        const GAS unsigned char* blk = (const GAS unsigned char*)(S16 + (size_t)row0 * 2048);
        float v1[16], v2[16];
#pragma unroll
        for (int hf = 0; hf < 2; ++hf) {
            float T[16];
#pragma unroll
            for (int i = 0; i < 16; ++i) T[i] = -3.0e38f;
#pragma unroll
            for (int qq = 0; qq < 2; ++qq) {
                const int q = 2 * hf + qq;
                u32x4 ld[8];
#pragma unroll
                for (int i = 0; i < 8; ++i) ld[i] = *(const GAS u32x4*)(blk + (size_t)(8 * i + (lane >> 3)) * 512 + 128 * q + 16 * (lane & 7));
#pragma unroll
                for (int i = 0; i < 8; ++i) *(LAS u32x4*)(timg + (8 * i + (lane >> 3)) * 144 + 16 * (lane & 7)) = ld[i];
                LDS_WAIT(); asm volatile("" ::: "memory");
#pragma unroll
                for (int ch = 0; ch < 4; ++ch) {
                    const u32x4 a = *(const LAS u32x4*)(timg + lane * 144 + 32 * ch), b = *(const LAS u32x4*)(timg + lane * 144 + 32 * ch + 16);
                    const unsigned wv[8] = {a.x, a.y, a.z, a.w, b.x, b.y, b.z, b.w};
                    const unsigned nb = 127u - 64u * (unsigned)qq - 16u * (unsigned)ch;
                    float c[16];
#pragma unroll
                    for (int e = 0; e < 8; ++e) {
                        typedef _Float16 h2 __attribute__((ext_vector_type(2)));
                        const h2 p = __builtin_bit_cast(h2, wv[e]);
                        c[2 * e] = __uint_as_float((__float_as_uint((float)p[0]) & ~0x7Fu) | (nb - 2 * e));
                        c[2 * e + 1] = __uint_as_float((__float_as_uint((float)p[1]) & ~0x7Fu) | (nb - 2 * e - 1));
                    }
                    SORT16(c); MERGE16(T, c);
                }
                LDS_WAIT(); asm volatile("" ::: "memory");
            }
#pragma unroll
            for (int i = 0; i < 16; ++i) { const unsigned bits = __float_as_uint(T[i]); ilds[(16 * hf + i) * 64] = (unsigned char)(127u - (bits & 0x7Fu)); (hf ? v2[i] : v1[i]) = __uint_as_float(bits & ~0x7Fu); }
        }
        float cs[16];
#pragma unroll
        for (int i = 0; i < 16; ++i) cs[i] = -3.0e38f;
        { float c[16];
        { c[0] = __uint_as_float((__float_as_uint(v1[0] + v2[0]) & ~0xFFu) | 255u); c[1] = __uint_as_float((__float_as_uint(v1[0] + v2[1]) & ~0xFFu) | 254u); c[2] = __uint_as_float((__float_as_uint(v1[0] + v2[2]) & ~0xFFu) | 253u); c[3] = __uint_as_float((__float_as_uint(v1[0] + v2[3]) & ~0xFFu) | 252u); c[4] = __uint_as_float((__float_as_uint(v1[0] + v2[4]) & ~0xFFu) | 251u); c[5] = __uint_as_float((__float_as_uint(v1[0] + v2[5]) & ~0xFFu) | 250u); c[6] = __uint_as_float((__float_as_uint(v1[0] + v2[6]) & ~0xFFu) | 249u); c[7] = __uint_as_float((__float_as_uint(v1[0] + v2[7]) & ~0xFFu) | 248u); c[8] = __uint_as_float((__float_as_uint(v1[0] + v2[8]) & ~0xFFu) | 247u); c[9] = __uint_as_float((__float_as_uint(v1[0] + v2[9]) & ~0xFFu) | 246u); c[10] = __uint_as_float((__float_as_uint(v1[0] + v2[10]) & ~0xFFu) | 245u); c[11] = __uint_as_float((__float_as_uint(v1[0] + v2[11]) & ~0xFFu) | 244u); c[12] = __uint_as_float((__float_as_uint(v1[0] + v2[12]) & ~0xFFu) | 243u); c[13] = __uint_as_float((__float_as_uint(v1[0] + v2[13]) & ~0xFFu) | 242u); c[14] = __uint_as_float((__float_as_uint(v1[0] + v2[14]) & ~0xFFu) | 241u); c[15] = __uint_as_float((__float_as_uint(v1[0] + v2[15]) & ~0xFFu) | 240u); SORT16(c); MERGE16(cs, c); }
        { c[0] = __uint_as_float((__float_as_uint(v1[1] + v2[0]) & ~0xFFu) | 239u); c[1] = __uint_as_float((__float_as_uint(v1[1] + v2[1]) & ~0xFFu) | 238u); c[2] = __uint_as_float((__float_as_uint(v1[1] + v2[2]) & ~0xFFu) | 237u); c[3] = __uint_as_float((__float_as_uint(v1[1] + v2[3]) & ~0xFFu) | 236u); c[4] = __uint_as_float((__float_as_uint(v1[1] + v2[4]) & ~0xFFu) | 235u); c[5] = __uint_as_float((__float_as_uint(v1[1] + v2[5]) & ~0xFFu) | 234u); c[6] = __uint_as_float((__float_as_uint(v1[1] + v2[6]) & ~0xFFu) | 233u); c[7] = __uint_as_float((__float_as_uint(v1[1] + v2[7]) & ~0xFFu) | 232u); c[8] = __uint_as_float((__float_as_uint(v1[2] + v2[0]) & ~0xFFu) | 223u); c[9] = __uint_as_float((__float_as_uint(v1[2] + v2[1]) & ~0xFFu) | 222u); c[10] = __uint_as_float((__float_as_uint(v1[2] + v2[2]) & ~0xFFu) | 221u); c[11] = __uint_as_float((__float_as_uint(v1[2] + v2[3]) & ~0xFFu) | 220u); c[12] = __uint_as_float((__float_as_uint(v1[2] + v2[4]) & ~0xFFu) | 219u); c[13] = __uint_as_float((__float_as_uint(v1[3] + v2[0]) & ~0xFFu) | 207u); c[14] = __uint_as_float((__float_as_uint(v1[3] + v2[1]) & ~0xFFu) | 206u); c[15] = __uint_as_float((__float_as_uint(v1[3] + v2[2]) & ~0xFFu) | 205u); SORT16(c); MERGE16(cs, c); }
        { c[0] = __uint_as_float((__float_as_uint(v1[3] + v2[3]) & ~0xFFu) | 204u); c[1] = __uint_as_float((__float_as_uint(v1[4] + v2[0]) & ~0xFFu) | 191u); c[2] = __uint_as_float((__float_as_uint(v1[4] + v2[1]) & ~0xFFu) | 190u); c[3] = __uint_as_float((__float_as_uint(v1[4] + v2[2]) & ~0xFFu) | 189u); c[4] = __uint_as_float((__float_as_uint(v1[5] + v2[0]) & ~0xFFu) | 175u); c[5] = __uint_as_float((__float_as_uint(v1[5] + v2[1]) & ~0xFFu) | 174u); c[6] = __uint_as_float((__float_as_uint(v1[6] + v2[0]) & ~0xFFu) | 159u); c[7] = __uint_as_float((__float_as_uint(v1[6] + v2[1]) & ~0xFFu) | 158u); c[8] = __uint_as_float((__float_as_uint(v1[7] + v2[0]) & ~0xFFu) | 143u); c[9] = __uint_as_float((__float_as_uint(v1[7] + v2[1]) & ~0xFFu) | 142u); c[10] = __uint_as_float((__float_as_uint(v1[8] + v2[0]) & ~0xFFu) | 127u); c[11] = __uint_as_float((__float_as_uint(v1[9] + v2[0]) & ~0xFFu) | 111u); c[12] = __uint_as_float((__float_as_uint(v1[10] + v2[0]) & ~0xFFu) | 95u); c[13] = __uint_as_float((__float_as_uint(v1[11] + v2[0]) & ~0xFFu) | 79u); c[14] = __uint_as_float((__float_as_uint(v1[12] + v2[0]) & ~0xFFu) | 63u); c[15] = __uint_as_float((__float_as_uint(v1[13] + v2[0]) & ~0xFFu) | 47u); SORT16(c); MERGE16(cs, c); }
        { c[0] = __uint_as_float((__float_as_uint(v1[14] + v2[0]) & ~0xFFu) | 31u); c[1] = __uint_as_float((__float_as_uint(v1[15] + v2[0]) & ~0xFFu) | 15u); c[2] = -3.0e38f; c[3] = -3.0e38f; c[4] = -3.0e38f; c[5] = -3.0e38f; c[6] = -3.0e38f; c[7] = -3.0e38f; c[8] = -3.0e38f; c[9] = -3.0e38f; c[10] = -3.0e38f; c[11] = -3.0e38f; c[12] = -3.0e38f; c[13] = -3.0e38f; c[14] = -3.0e38f; c[15] = -3.0e38f; SORT16(c); MERGE16(cs, c); }
        }
        float ev[16]; float den = 0.f;
        const float top = __uint_as_float(__float_as_uint(cs[0]) & ~0xFFu);
#pragma unroll
        for (int k = 0; k < 16; ++k) { ev[k] = __expf(__uint_as_float(__float_as_uint(cs[k]) & ~0xFFu) - top); den += ev[k]; }
        const float rden = 1.0f / den;
        LDS_WAIT(); asm volatile("" ::: "memory");
        int eo[16]; float go[16];
#pragma unroll
        for (int k = 0; k < 16; ++k) { const int pos = 255 - (int)(__float_as_uint(cs[k]) & 0xFFu); eo[k] = ((int)ilds[(pos >> 4) * 64] * 128 + (int)ilds[(16 + (pos & 15)) * 64]) * DM; go[k] = ev[k] * rden; }
        LAS u32x4* img = (LAS u32x4*)timg;
#pragma unroll
        for (int q = 0; q < 4; ++q) { img[lane * 4 + q] = (u32x4){(unsigned)eo[4 * q], (unsigned)eo[4 * q + 1], (unsigned)eo[4 * q + 2], (unsigned)eo[4 * q + 3]};
            img[256 + lane * 4 + q] = (u32x4){__float_as_uint(go[4 * q]), __float_as_uint(go[4 * q + 1]), __float_as_uint(go[4 * q + 2]), __float_as_uint(go[4 * q + 3])}; }
        LDS_WAIT(); asm volatile("" ::: "memory");
        GAS u32x4* eg = (GAS u32x4*)((GAS int*)eid + (size_t)row0 * 128); GAS u32x4* gg = (GAS u32x4*)((GAS float*)gate + (size_t)row0 * 128);
#pragma unroll
        for (int q = 0; q < 4; ++q) { eg[64 * q + lane] = img[64 * q + lane]; gg[64 * q + lane] = img[256 + 64 * q + lane]; }
        LDS_WAIT(); asm volatile("" ::: "memory");
    }
}

constexpr float U8_SCALE = 896.0f, V8_SCALE = 4.0f;
struct PeerUMeta { u32x4 e[4]; u32x4 xq; float xs; };
template <bool DUMMY = false>
__device__ __forceinline__ void peer_u_meta(PeerUMeta& M, const unsigned* eoff, const unsigned char* XQ, const float* XSC, int r, int g, int c8, int cb) {
    const GAS u32x4* ep = (const GAS u32x4*)(eoff + (size_t)r * 128 + 16 * g);
#pragma unroll
    for (int i = 0; i < 4; ++i) { M.e[i] = ep[i]; if (DUMMY) { M.e[i].x &= 0x3C00u; M.e[i].y &= 0x3C00u; M.e[i].z &= 0x3C00u; M.e[i].w &= 0x3C00u; } }
    M.xq = *(const GAS u32x4*)(XQ + (size_t)r * DM + cb + 16 * c8); M.xs = ((const GAS float*)XSC)[r];
}
typedef _Float16 h2_t __attribute__((ext_vector_type(2)));
__device__ __forceinline__ h2_t fp8x2_to_h2(unsigned w, bool hi) { return hi ? __builtin_amdgcn_cvt_scalef32_pk_f16_fp8(w, 1.0f, true) : __builtin_amdgcn_cvt_scalef32_pk_f16_fp8(w, 1.0f, false); }
__device__ __forceinline__ int dot16_i8(const u32x4 t, const u32x4 x) {
    return __builtin_amdgcn_sdot4((int)t.x, (int)x.x, __builtin_amdgcn_sdot4((int)t.y, (int)x.y, __builtin_amdgcn_sdot4((int)t.z, (int)x.z, __builtin_amdgcn_sdot4((int)t.w, (int)x.w, 0, false), false), false), false);
}
__device__ __forceinline__ void peer_u_row(const PeerUMeta& M, const char* ub, float* PART, int xq, int r, int g, int c8, int lane) {
    u32x4 t[16];
#pragma unroll
    for (int i = 0; i < 4; ++i) { t[4 * i] = *(const GAS u32x4*)(ub + M.e[i].x); t[4 * i + 1] = *(const GAS u32x4*)(ub + M.e[i].y); t[4 * i + 2] = *(const GAS u32x4*)(ub + M.e[i].z); t[4 * i + 3] = *(const GAS u32x4*)(ub + M.e[i].w); }
    float part[16];
#pragma unroll
    for (int i = 0; i < 16; ++i) part[i] = (float)dot16_i8(t[i], M.xq);
    float p8[8], p4[4], p2[2];
    { const bool up = (lane & 4) != 0;
#pragma unroll
      for (int q = 0; q < 8; ++q) { const float keep = up ? part[q + 8] : part[q], send = up ? part[q] : part[q + 8]; p8[q] = keep + xshfl<4>(send); } }
    { const bool up = (lane & 2) != 0;
#pragma unroll
      for (int q = 0; q < 4; ++q) { const float keep = up ? p8[q + 4] : p8[q], send = up ? p8[q] : p8[q + 4]; p4[q] = keep + xshfl<2>(send); } }
    { const bool up = (lane & 1) != 0;
#pragma unroll
      for (int q = 0; q < 2; ++q) { const float keep = up ? p4[q + 2] : p4[q], send = up ? p4[q] : p4[q + 2]; p2[q] = keep + xshfl<1>(send); } }
    ((GAS unsigned*)PART)[((size_t)xq * NROW + r) * 64 + 8 * g + c8] = cvt_pk_bf16(p2[0] * M.xs, p2[1] * M.xs);
}
__device__ __forceinline__ int peer_next_row(int r, int step, bool skipctx) { r += step; if (skipctx && r < NROW && (r % NB) < CTXL) r += ((CTXL - (r % NB) + step - 1) / step) * step; return r; }
template <bool DUMMY = false>
__device__ __forceinline__ void phase_peer_u(Frame& F, const unsigned char* XQ, const float* XSC, const unsigned char* U8, const unsigned* eoff, float* PART, bool skipctx) {
    const int lane = F.lane, xq = blockIdx.x & 7, rank = blockIdx.x >> 3, nr = (F.G - xq + 7) >> 3, step = nr * NWAVES;
    const int g = lane >> 3, c8 = lane & 7, cb = xq * 128;
    const char* ub = (const char*)U8 + cb + c8 * 16;
    int r = peer_next_row(rank * NWAVES + F.wave - step, step, skipctx);
    PeerUMeta A, B;
    if (r < NROW) peer_u_meta<DUMMY>(A, eoff, XQ, XSC, r, g, c8, cb);
    while (r < NROW) {
        const int r1 = peer_next_row(r, step, skipctx);
        if (r1 < NROW) peer_u_meta<DUMMY>(B, eoff, XQ, XSC, r1, g, c8, cb);
        peer_u_row(A, ub, PART, xq, r, g, c8, lane);
        if (r1 >= NROW) break;
        const int r2 = peer_next_row(r1, step, skipctx);
        if (r2 < NROW) peer_u_meta<DUMMY>(A, eoff, XQ, XSC, r2, g, c8, cb);
        peer_u_row(B, ub, PART, xq, r1, g, c8, lane);
        r = r2;
    }
}

__device__ __forceinline__ float gelu_as(float v) {
    const float av = fabsf(v), t = __builtin_amdgcn_rcpf(av * 0.2316418882f + 1.0f);
    float q = t * 0.5307027145f + (-0.7265760135f); q = q * t + 0.7107068705f; q = q * t + (-0.142248368f); q = q * t + 0.127414796f; q = q * t;
    const float e = fexp2((v * v) * (-0.72134752044f)), m = v * (q * e);
    return v < 0.f ? m : v - m;
}
__device__ __forceinline__ void phase_peer_w(Frame& F, const float* PART, float* gw, bool skipctx) {
    const int gwv = F.vcu * NWAVES + F.wave, NGW = F.G * NWAVES, lane = F.lane;
    for (int r = gwv; r < NROW; r += NGW) {
        if (skipctx && (r % NB) < CTXL) continue;
        float a0 = 0.f, a1 = 0.f;
#pragma unroll
        for (int g = 0; g < 8; ++g) { const unsigned w = ((const GAS unsigned*)PART)[((size_t)g * NROW + r) * 64 + lane]; a0 += bf_lo(w); a1 += bf_hi(w); }
        GAS f32x2* gp = (GAS f32x2*)(gw + (size_t)r * 128) + lane;
        const f32x2 gt = *gp;
        *gp = (f32x2){gelu_as(a0 * (1.0f / U8_SCALE)) * gt[0] * (1.0f / V8_SCALE), gelu_as(a1 * (1.0f / U8_SCALE)) * gt[1] * (1.0f / V8_SCALE)};
    }
}

struct PeerVMeta { u32x4 e[4]; f32x4 w[4]; };
__device__ __forceinline__ void peer_v_meta(PeerVMeta& M, const unsigned* eoff, const float* gw, int r, int g) {
    const GAS u32x4* ep = (const GAS u32x4*)(eoff + (size_t)r * 128 + 16 * g); const GAS f32x4* wp = (const GAS f32x4*)(gw + (size_t)r * 128 + 16 * g);
#pragma unroll
    for (int i = 0; i < 4; ++i) { M.e[i] = ep[i]; M.w[i] = wp[i]; }
}
__device__ __forceinline__ void peer_v_row(const PeerVMeta& M, const char* vb, bf16_t* xb, float* xc, const float* mod, int r, int cb, int c8, int lane, float vscale) {
    const int b = r / NB, j = r % NB;
    const int col = cb + 16 * c8 + ((lane >> 3) & 1) * 8 + ((lane >> 4) & 1) * 4 + ((lane >> 5) & 1) * 2;
    const bool isctx = j < CTXL;
    float* xr = xc + ((size_t)b * CTXL + (isctx ? j : 0)) * DM + col;
    bf16_t* xq = xb + ((size_t)b * SEQ + (isctx ? 0 : (j - CTXL))) * DM + col;
    f32x2 xv; unsigned xw = 0u;
    if (isctx) xv = *(const GAS f32x2*)xr; else { xw = *(const GAS unsigned*)xq; xv = (f32x2){bf_lo(xw), bf_hi(xw)}; }
    const f32x2 gv = *(const GAS f32x2*)(mod + (isctx ? 4 : b) * 6144 + 5 * DM + col) * vscale;
    u32x4 t[16];
#pragma unroll
    for (int i = 0; i < 4; ++i) { t[4 * i] = *(const GAS u32x4*)(vb + M.e[i].x); t[4 * i + 1] = *(const GAS u32x4*)(vb + M.e[i].y); t[4 * i + 2] = *(const GAS u32x4*)(vb + M.e[i].z); t[4 * i + 3] = *(const GAS u32x4*)(vb + M.e[i].w); }
    h2_t acc[8];
#pragma unroll
    for (int c = 0; c < 8; ++c) acc[c] = (h2_t){(_Float16)0.f, (_Float16)0.f};
#pragma unroll
    for (int i = 0; i < 16; ++i) { const _Float16 wh = (_Float16)M.w[i >> 2][i & 3]; const h2_t w2 = {wh, wh}; const u32x4 d = t[i];
        acc[0] += w2 * fp8x2_to_h2(d.x, false); acc[1] += w2 * fp8x2_to_h2(d.x, true);
        acc[2] += w2 * fp8x2_to_h2(d.y, false); acc[3] += w2 * fp8x2_to_h2(d.y, true);
        acc[4] += w2 * fp8x2_to_h2(d.z, false); acc[5] += w2 * fp8x2_to_h2(d.z, true);
        acc[6] += w2 * fp8x2_to_h2(d.w, false); acc[7] += w2 * fp8x2_to_h2(d.w, true); }
    h2_t p4[4], p2[2], p1h;
#define H2X(v, M) __builtin_bit_cast(h2_t, __float_as_uint(xshfl<M>(__uint_as_float(__builtin_bit_cast(unsigned, (v))))))
    { const bool up = (lane & 8) != 0;
#pragma unroll
      for (int q = 0; q < 4; ++q) { const h2_t keep = up ? acc[q + 4] : acc[q], send = up ? acc[q] : acc[q + 4]; p4[q] = keep + H2X(send, 8); } }
    { const bool up = (lane & 16) != 0;
#pragma unroll
      for (int q = 0; q < 2; ++q) { const h2_t keep = up ? p4[q + 2] : p4[q], send = up ? p4[q] : p4[q + 2]; p2[q] = keep + H2X(send, 16); } }
    { const bool up = (lane & 32) != 0; const h2_t keep = up ? p2[1] : p2[0], send = up ? p2[0] : p2[1]; p1h = keep + H2X(send, 32); }
#undef H2X
    const f32x2 p1 = {(float)p1h[0], (float)p1h[1]};
    const f32x2 xn = {xv[0] + gv[0] * p1[0], xv[1] + gv[1] * p1[1]};
    if (isctx) *(GAS f32x2*)xr = xn; else *(GAS unsigned*)xq = cvt_pk_bf16(xn[0], xn[1]);
}
__device__ __forceinline__ void phase_peer_v(Frame& F, const unsigned char* V8, const unsigned* eoff, const float* gw, bf16_t* xb, float* xc, const float* mod, bool skipctx, float vscale) {
    const int lane = F.lane, xq = blockIdx.x & 7, rank = blockIdx.x >> 3, nr = (F.G - xq + 7) >> 3, step = nr * NWAVES;
    const int g = lane >> 3, c8 = lane & 7, cb = xq * 128;
    const char* vb = (const char*)V8 + cb + c8 * 16;
    int r = peer_next_row(rank * NWAVES + F.wave - step, step, skipctx);
    PeerVMeta A, B;
    if (r < NROW) peer_v_meta(A, eoff, gw, r, g);
    while (r < NROW) {
        const int r1 = peer_next_row(r, step, skipctx);
        if (r1 < NROW) peer_v_meta(B, eoff, gw, r1, g);
        peer_v_row(A, vb, xb, xc, mod, r, cb, c8, lane, vscale);
        if (r1 >= NROW) break;
        const int r2 = peer_next_row(r1, step, skipctx);
        if (r2 < NROW) peer_v_meta(A, eoff, gw, r2, g);
        peer_v_row(B, vb, xb, xc, mod, r1, cb, c8, lane, vscale);
        r = r2;
    }
}
#ifndef DIAG
#define DIAG 0
#endif
#if DIAG
#ifndef DIAG_TOL
#define DIAG_TOL 2.5e-3f
#endif
__device__ __forceinline__ float blk_max(LAS float* red, float v, int tid) {
    v = fmaxf(v, xshfl<1>(v)); v = fmaxf(v, xshfl<2>(v)); v = fmaxf(v, xshfl<4>(v)); v = fmaxf(v, xshfl<8>(v)); v = fmaxf(v, xshfl<16>(v)); v = xmax32(v);
    __syncthreads(); if ((tid & 63) == 0) red[tid >> 6] = v; __syncthreads();
    float r = red[0];
#pragma unroll
    for (int i = 1; i < 8; ++i) r = fmaxf(r, red[i]);
    __syncthreads(); return r;
}
__device__ __forceinline__ float blk_sum(LAS float* red, float v, int tid) {
    v = wave_sum(v);
    __syncthreads(); if ((tid & 63) == 0) red[tid >> 6] = v; __syncthreads();
    float r = 0.f;
#pragma unroll
    for (int i = 0; i < 8; ++i) r += red[i];
    __syncthreads(); return r;
}
template <int DQK, class KeyFn>
__device__ __forceinline__ float diag_attn(LAS float* sm, int tid, const bf16_t* qp, const bf16_t* kbase, int kpitch, int koff, const bf16_t* k2base, int k2pitch, int k2off,
                                           const bf16_t* vbase, int vpitch, int voff, int nkeys, KeyFn keyfn, float sink_l2, bool has_sink, const bf16_t* yp) {
    LAS float* mw = sm;
    LAS float* lw = sm + 8;
    LAS float* ow = sm + 16;
    LAS float* red = sm + 16 + 512;
    const int lane = tid & 63, w = tid >> 6;
    const float q0 = bf2f(qp[lane]); const float q1 = (DQK == 96 && lane < 32) ? bf2f(qp[64 + lane]) : 0.f;
    float m = -3.0e38f, l = 0.f, o = 0.f;
    for (int i = w; i < nkeys; i += 8) {
        size_t krow; float bias; bool valid; keyfn(i, krow, bias, valid);
        if (!valid) continue;
        float part = q0 * bf2f(kbase[krow * kpitch + koff + lane]);
        if (DQK == 96 && lane < 32) part += q1 * bf2f(k2base[krow * k2pitch + k2off + lane]);
        const float sc = wave_sum(part) + bias;
        const float mn = fmaxf(m, sc), al = fexp2(m - mn), pp = fexp2(sc - mn);
        m = mn; l = l * al + pp; o = o * al + pp * bf2f(vbase[krow * vpitch + voff + lane]);
    }
    __syncthreads();
    if (lane == 0) { mw[w] = m; lw[w] = l; }
    ow[w * 64 + lane] = o;
    __syncthreads();
    float M = mw[0];
#pragma unroll
    for (int i = 1; i < 8; ++i) M = fmaxf(M, mw[i]);
    if (has_sink) M = fmaxf(M, sink_l2);
    float lt = has_sink ? fexp2(sink_l2 - M) : 0.f, ot = 0.f;
#pragma unroll
    for (int i = 0; i < 8; ++i) { const float f = fexp2(mw[i] - M); lt += lw[i] * f; ot += ow[i * 64 + lane] * f; }
    float num = 0.f, den = 0.f;
    if (tid < 64) { const float r = ot / lt, y = bf2f(yp[tid]); num = (y - r) * (y - r); den = r * r; }
    num = blk_sum(red, num, tid); den = blk_sum(red, den, tid);
    return num / (den + 1e-20f);
}

__device__ __forceinline__ float diag_ret(LAS float* sm, int tid, const bf16_t* P, size_t rb0, int j, int h, float lgf, float lgb, const float* gnf, const float* gnb, const bf16_t* yp) {
    LAS float* ow = sm;
    LAS float* red = sm + 1024;
    const int lane = tid & 63, w = tid >> 6;
    const float q = bf2f(P[(rb0 + j) * PW + C_RQ + h * 64 + lane]);
    const int posj = (j < CTXL) ? (CTXL - 1 - j) : (CTXL + (NB - 1 - j));
    float of = 0.f, ob = 0.f;
    for (int s = w; s < NB; s += 8) {
        const int poss = (s < CTXL) ? (CTXL - 1 - s) : (CTXL + (NB - 1 - s));
        const bool inf = s <= j, inb = poss <= posj;
        if (!inf && !inb) continue;
        const bf16_t* pr = P + (rb0 + s) * PW + h * 64 + lane;
        const float qk = wave_sum(q * bf2f(pr[C_RK])); const float v = bf2f(pr[C_RV]);
        if (inf) of += fexp2(lgf * (float)(j - s)) * qk * v;
        if (inb) ob += fexp2(lgb * (float)(posj - poss)) * qk * v;
    }
    __syncthreads();
    ow[w * 64 + lane] = of; ow[512 + w * 64 + lane] = ob;
    __syncthreads();
    float tf = 0.f, tb = 0.f;
#pragma unroll
    for (int i = 0; i < 8; ++i) { tf += ow[i * 64 + lane]; tb += ow[512 + i * 64 + lane]; }
    const float muf = wave_sum(tf) * (1.f / 64.f), mub = wave_sum(tb) * (1.f / 64.f);
    const float vf = wave_sum((tf - muf) * (tf - muf)) * (1.f / 64.f), vb = wave_sum((tb - mub) * (tb - mub)) * (1.f / 64.f);
    const float gf = bf2f(P[(rb0 + j) * PW + C_RGF + h * 64 + lane]), gb = bf2f(P[(rb0 + j) * PW + C_RGB + h * 64 + lane]);
    const float r = silu_f(gf) * ((tf - muf) / sqrtf(vf + EPS)) * gnf[h * 64 + lane] + silu_f(gb) * ((tb - mub) / sqrtf(vb + EPS)) * gnb[h * 64 + lane];
    float num = 0.f, den = 0.f;
    if (tid < 64) { const float y = bf2f(yp[tid]); num = (y - r) * (y - r); den = r * r; }
    num = blk_sum(red, num, tid); den = blk_sum(red, den, tid);
    return num / (den + 1e-20f);
}

__device__ __forceinline__ void diag_check(Frame& F, const Inputs& I, unsigned char* ws, unsigned* code) {
    const int tid = F.tid;
    LAS float* sm = (LAS float*)F.lds;
    LAS float* raw = (LAS float*)(F.lds + 4096);
    LAS float* xn = (LAS float*)(F.lds + 4096 + 12544);
    LAS float* red = (LAS float*)(F.lds + 4096 + 12544 + 4096);
    const bf16_t* P = (const bf16_t*)(ws + WS_P); const bf16_t* KV = (const bf16_t*)(ws + WS_KV); const bf16_t* Y = (const bf16_t*)(ws + WS_XN);
    const float* MOD = (const float*)(ws + WS_MOD);
    const float tol = DIAG_TOL;
    for (int sidx = blockIdx.x; sidx < 256; sidx += F.G) {
        const int b = sidx & 3, si = sidx >> 2;
        static const int jl[16] = {0, 17, 128, 255, 256, 257, 256 + 63, 256 + 64, 256 + 127, 256 + 128, 256 + 129, 256 + 8191, 256 + 8064, 256 + 8063, 256 + 4095, 256 + 4160};
        int j; if (si < 16) { j = 0; for (int q = 0; q < 16; ++q) if (q == si) j = jl[q]; } else j = 256 + ((si * 2654435761u) >> 7) % 8192u;
        const int h = (si * 7 + 3) & 3;
        const size_t row = (size_t)b * NB + j;
        const bool isctx = j < CTXL; const int t = j - CTXL, prow = t >> 6, pcol = t & 63;
        {
            const float* xr = isctx ? I.ctx + ((size_t)b * CTXL + j) * DM : I.x + ((size_t)b * SEQ + t) * DM;
            const float* mv = MOD + (isctx ? 4 : b) * 6144;
            float ss = 0.f; for (int k = tid; k < DM; k += NTHR) ss += xr[k] * xr[k];
            ss = blk_sum(red, ss, tid);
            const float rs = 1.0f / sqrtf(ss / DM + EPS);
            for (int k = tid; k < DM; k += NTHR) { const float y = xr[k] * rs * I.norm_mix_g[k] * (1.f + mv[DM + k]) + mv[k]; xn[k] = bf_lo(cvt_pk_bf16(y, 0.f)); }
            __syncthreads();
            for (int c = tid; c < INW; c += NTHR) { float a = 0.f; for (int k = 0; k < DM; ++k) a += xn[k] * bf_lo(cvt_pk_bf16(I.w_in[(size_t)k * INW + c], 0.f)); raw[c] = a; }
            __syncthreads();
            float num = 0.f, den = 0.f;
            for (int c = tid; c < INW; c += NTHR) {
                const int oc = orig_col(c);
                float ref = raw[oc], sc = 1.f;
                int rb = -1, R = 0;
                if (oc < 384) { if (oc % 96 >= 64) { rb = oc - (oc % 96) + 64; R = 32; } sc = 0.10206207261596577f * LOG2E; }
                else if (oc >= C_KR && oc < C_SWAQ) { rb = C_KR; R = 32; }
                else if (oc >= C_SWAQ && oc < C_SWAK) { rb = C_SWAQ + ((oc - C_SWAQ) & ~63); R = 64; sc = 0.125f * LOG2E; }
                else if (oc >= C_SWAK && oc < C_SWAV) { rb = C_SWAK + ((oc - C_SWAK) & ~63); R = 64; }
                else if (oc >= C_NAQ && oc < C_NAK) sc = 0.125f * LOG2E;
                else if (oc >= C_RK && oc < C_RV) sc = 0.125f;
                if (rb >= 0 && !isctx) {
                    const int quarter = R / 4, p = oc - rb, part = p / (R / 2), which = (p % (R / 2)) / quarter, jj = p % quarter;
                    const float inv = __powf(10000.f, -(float)jj / (float)quarter);
                    const float ang = (float)(part ? pcol : prow) * inv;
                    const float rev = ang * 0.15915494309189535f; const float cs = __builtin_amdgcn_cosf(rev), sn = __builtin_amdgcn_sinf(rev);
                    const float x1 = raw[rb + part * (R / 2) + jj], x2 = raw[rb + part * (R / 2) + quarter + jj];
                    ref = which ? (x1 * sn + x2 * cs) : (x1 * cs - x2 * sn);
                }
                ref *= sc;
                const float got = bf2f(P[row * PW + c]);
                num += (got - ref) * (got - ref); den += ref * ref;
            }
            num = blk_sum(red, num, tid); den = blk_sum(red, den, tid);
            if (tid == 0 && num > tol * den) atomicOr(code, 1u);
        }
        {
            const float* g = I.mla_kv_norm_g; const float* wu = I.mla_w_ukv;
            float ss = 0.f; for (int k = tid; k < 128; k += NTHR) { const float v = bf2f(P[row * PW + C_CKV + k]); ss += v * v; }
            ss = blk_sum(red, ss, tid);
            const float rs = 1.0f / sqrtf(ss / 128.f + EPS);
            float num = 0.f, den = 0.f;
            { const int n = tid; float a = 0.f; for (int k = 0; k < 128; ++k) a += bf2f(P[row * PW + C_CKV + k]) * g[k] * wu[k * KVW + n]; a *= rs;
              const float got = bf2f(KV[row * KVW + n]); num = (got - a) * (got - a); den = a * a; }
            num = blk_sum(red, num, tid); den = blk_sum(red, den, tid);
            if (tid == 0 && num > tol * den) atomicOr(code, 16u);
        }
        const size_t rb0 = (size_t)b * NB;
        {
            auto keyfn = [&](int i, size_t& krow, float& bias, bool& valid) { krow = rb0 + i; bias = 0.f; valid = true; };
            const float e = diag_attn<96>(sm, tid, P + row * PW + h * 96, KV, KVW, h * 128, P, PW, C_KR, KV, KVW, h * 128 + 64, isctx ? CTXL : NB, keyfn, 0.f, false, Y + row * DM + h * 64);
            if (tid == 0 && e > tol) atomicOr(code, 2u);
        }
        {
            const int g = h >> 1;
            auto keyfn = [&](int i, size_t& krow, float& bias, bool& valid) { krow = rb0 + i; bias = 0.f;
                if (i < CTXL) valid = true; else { const int kp = i - CTXL; valid = (kp - t <= 128) && (t - kp <= 128); } };
            const float e = diag_attn<64>(sm, tid, P + row * PW + C_SWAQ + h * 64, P, PW, C_SWAK + g * 64, P, PW, 0, P, PW, C_SWAV + g * 64, isctx ? CTXL : NB, keyfn,
                                          I.swa_sink[h] * LOG2E, true, Y + row * DM + 256 + h * 64);
            if (tid == 0 && e > tol) atomicOr(code, 4u);
        }
        {
            int rs = prow - 4; rs = rs < 0 ? 0 : (rs > 120 ? 120 : rs); int cs = pcol - 8; cs = cs < 0 ? 0 : (cs > 48 ? 48 : cs);
            const float* rpb = I.na_rpb + h * 15 * 31;
            auto keyfn = [&](int i, size_t& krow, float& bias, bool& valid) { krow = rb0 + i; bias = 0.f;
                if (i < CTXL) valid = true; else { const int kp = i - CTXL, kr = kp >> 6, kc = kp & 63; valid = (kr >= rs && kr < rs + 8 && kc >= cs && kc < cs + 16);
                    if (valid) bias = rpb[(kr - prow + 7) * 31 + (kc - pcol + 15)] * LOG2E; } };
            const float e = diag_attn<64>(sm, tid, P + row * PW + C_NAQ + h * 64, P, PW, C_NAK + h * 64, P, PW, 0, P, PW, C_NAV + h * 64, isctx ? CTXL : NB, keyfn, 0.f, false, Y + row * DM + 512 + h * 64);
            if (tid == 0 && e > tol) atomicOr(code, 8u);
        }
        {
            const float e = diag_ret(sm, tid, P, rb0, j, h, log2_sigmoid(I.ret_decay_f[h]), log2_sigmoid(I.ret_decay_b[h]), I.ret_gn_f, I.ret_gn_b, Y + row * DM + 768 + h * 64);
            if (tid == 0 && e > tol) atomicOr(code, 32u);
        }
    }
}
#endif
constexpr int N_PHASES = 26;
#ifndef MK_SINGLE
#define MK_SINGLE 1
#endif
__device__ __forceinline__ Frame fresh(const Frame& F) { Frame f = F; int ln = lane_id(); asm volatile("" : "+v"(ln)); f.lane = ln; f.tid = F.wave * 64 + ln; return f; }
struct Args { Inputs in; float* out; unsigned char* ws; int ph_lo, ph_hi, li, pad; };

__global__ void __launch_bounds__(NTHR, 2) fwd_kernel(Args args) {
    extern __shared__ __attribute__((aligned(16))) unsigned char lds_raw[];
    Frame F;
    F.lds = (LAS unsigned char*)lds_raw;
    F.tid = threadIdx.x; F.lane = F.tid & 63; F.wave = __builtin_amdgcn_readfirstlane(F.tid >> 6);
    F.G = gridDim.x; { const int bx = blockIdx.x; F.vcu = (F.G % 8 == 0) ? (bx % 8) * (F.G / 8) + bx / 8 : bx; }
    typedef const __attribute__((address_space(4))) Args* KArgP;
    const KArgP kap = (KArgP)__builtin_amdgcn_kernarg_segment_ptr();
#define KARGV(f) ({ KArgP _p = kap; asm volatile("" : "+s"(_p)); _p->f; })
#define KARG(f) as_global(KARGV(f))
    unsigned char* ws = KARGV(ws);
    volatile LAS unsigned* MISC = (volatile LAS unsigned*)(F.lds + MISC_OFF);
    for (int u = F.tid; u < (LDS_BYTES - LDSCTL_OFF) / 4; u += NTHR) ((LAS unsigned*)(F.lds + LDSCTL_OFF))[u] = 0u;
    __syncthreads();
    unsigned* ctl = (unsigned*)(ws + WS_CTL);
    XcdBarrier bar = xcd_barrier_post(ctl + CW_BAR + KARGV(li) * XCD_BAR_WORDS, MISC + 8);
    const int lo = KARGV(ph_lo), hi = KARGV(ph_hi);
#ifndef PH_MASK
#define PH_MASK 0x3ff
#endif
#define PHM(j) ((PH_MASK >> (j)) & 1)
#ifndef UM
#define UM 0xff
#endif
#ifndef REP_J
#define REP_J -1
#define REP_N 1
#endif
#define REPS(j) for (int rep_ = 0; rep_ < ((REP_J == (j)) ? REP_N : 1); ++rep_)
#define IN(k) ({ int lo_ = lo, hi_ = hi; asm volatile("" : "+s"(lo_), "+s"(hi_)); lo_ <= (k) && (k) < hi_; })
#define SEAM(k) do { if (IN(k) && IN((k) + 1)) xcd_barrier(bar); } while (0)

#define WSQ() unsigned char* wsq_ = ws; asm volatile("" : "+s"(wsq_)); unsigned char* wsq = as_global(wsq_); \
    float* MOD = (float*)(wsq + WS_MOD); bf16_t* XN = (bf16_t*)(wsq + WS_XN); bf16_t* P = (bf16_t*)(wsq + WS_P); bf16_t* KV = (bf16_t*)(wsq + WS_KV); float* SSQ = (float*)(wsq + WS_SSQ); \
    float* XC = (float*)(wsq + WS_XC); float* RS = (float*)(wsq + WS_RS); unsigned char* UB = wsq + WS_UB; unsigned char* VB = wsq + WS_VB; _Float16* S16 = (_Float16*)(wsq + WS_P); \
    int* EID = (int*)(wsq + WS_KV); float* GATE = (float*)(wsq + WS_GATE); bf16_t* XB = (bf16_t*)(wsq + WS_XB); const float* mod = MOD + (size_t)l * 5 * 6144; \
    const float* xl_cur = (l == 0) ? KARG(in.x) : (const float*)nullptr; const float* xc_cur = (l == 0) ? KARG(in.ctx) : XC; \
    (void)XN; (void)P; (void)KV; (void)SSQ; (void)XC; (void)RS; (void)UB; (void)VB; (void)S16; (void)EID; (void)GATE; (void)XB; (void)mod; (void)xl_cur; (void)xc_cur;

    if (IN(0)) REPS(100) { { const Inputs Iv = args.in; phase_prologue(F, Iv, as_global(ws)); }; }
    SEAM(0);

#pragma nounroll
    for (int l0 = 0; l0 < NLAYER; ++l0) {
        int l = l0; asm volatile("" : "+s"(l));
        const int pb = 1 + 12 * l;
        const bool last = (l == NLAYER - 1);

        if (PHM(0) && IN(pb + 0)) REPS(0) { Frame Fq = fresh(F); WSQ();
            phase_norm_mod(Fq, xl_cur, XB, xc_cur, KARG(in.norm_mix_g) + l * DM, mod, 0, XN, false, SSQ);
            phase_convert_uv(Fq, KARG(in.peer_u) + (size_t)l * NEXP * DM, KARG(in.peer_v) + (size_t)l * NEXP * DM, wsq);
        }
        SEAM(pb + 0);

        if (PHM(1) && IN(pb + 1)) REPS(1) { Frame Fq = fresh(F); WSQ();
            pg8::Gemm g{XN, (const bf16_t*)(wsq + WS_WIN) + (size_t)l * PW * DM};
            pg8::LinOrder S{PW / 256, (NROW / 256) * (PW / 256), Fq.G, Fq.vcu, 0};
            pg8::EpiProj E{P, SSQ, (const f32x2*)(wsq + WS_TAB), (const f32x2*)(wsq + WS_TAB + 16384)};
            pg8::gemm_phase<pg8::EpiProj, pg8::LinOrder, DM, DM, DM, true>(Fq.lds, Fq.wave, g, S, E);
        }
        SEAM(pb + 1);

        if (PHM(2) && IN(pb + 2)) REPS(2) { Frame Fq = fresh(F); WSQ();
            {
                pg8::Gemm g{P + C_CKV, (const bf16_t*)(wsq + WS_WUKV) + (size_t)l * KVW * 128};
                pg8::LinOrder S{KVW / 256, (NROW / 256) * (KVW / 256), Fq.G, Fq.vcu, 0};
                pg8::EpiKV E{KV, SSQ};
                pg8::gemm_phase<pg8::EpiKV, pg8::LinOrder, 128, PW, 128, true>(Fq.lds, Fq.wave, g, S, E);
            }
            __syncthreads();
            const RetArgs RA{P, XN, RS, KARG(in.ret_decay_f) + l * 4, KARG(in.ret_decay_b) + l * 4, KARG(in.ret_gn_f) + l * 256, KARG(in.ret_gn_b) + l * 256};
            const AttnArgs AA{P, KV, XN, KARG(in.swa_sink) + l * 4, KARG(in.na_rpb) + (size_t)l * 4 * 15 * 31};
            const int n_ctx = last ? 0 : 16;
            if (UM & 1) REPS(21) for (int u = Fq.vcu; u < 512; u += Fq.G) attn_unit<AT_SWA, false>(Fq, AA, u);
            if (UM & 2) REPS(22) for (int u = Fq.vcu; u < 512; u += Fq.G) attn_unit<AT_NA, false>(Fq, AA, u);
            if (UM & 4) REPS(23) ret_local_loop(Fq, RA, (Fq.vcu + 128) % Fq.G, Fq.G, 16 * 66);
            if (UM & 8) for (int u = (Fq.vcu + 32) % Fq.G; u < n_ctx; u += Fq.G) attn_unit<AT_SWA, true>(Fq, AA, u);
            if (UM & 16) for (int u = (Fq.vcu + 48) % Fq.G; u < n_ctx; u += Fq.G) attn_unit<AT_NA, true>(Fq, AA, u);
        }
        SEAM(pb + 2);

        if (PHM(3) && IN(pb + 3)) { Frame Fq = fresh(F); WSQ();
            const RetArgs RA{P, XN, RS, KARG(in.ret_decay_f) + l * 4, KARG(in.ret_decay_b) + l * 4, KARG(in.ret_gn_f) + l * 256, KARG(in.ret_gn_b) + l * 256};
            ret_scan(Fq, RA);
        }
        SEAM(pb + 3);

        if (PHM(4) && IN(pb + 4)) REPS(4) { Frame Fq = fresh(F); WSQ();
            const RetArgs RA{P, XN, RS, KARG(in.ret_decay_f) + l * 4, KARG(in.ret_decay_b) + l * 4, KARG(in.ret_gn_f) + l * 256, KARG(in.ret_gn_b) + l * 256};
            const AttnArgs AA{P, KV, XN, KARG(in.swa_sink) + l * 4, KARG(in.na_rpb) + (size_t)l * 4 * 15 * 31};
            const int n_ctx = last ? 0 : 16;
#if REP_J == 40
            for (int rep_ = 0; rep_ < REP_N - 1; ++rep_) for (int u = Fq.vcu; u < 512; u += Fq.G) attn_unit<AT_MLA, false, true>(Fq, AA, u);
#endif
            if (UM & 32) for (int u = Fq.vcu; u < 512; u += Fq.G) attn_unit<AT_MLA, false>(Fq, AA, u);
            if (UM & 64) for (int u = Fq.vcu; u < n_ctx; u += Fq.G) attn_unit<AT_MLA, true>(Fq, AA, u);
            if (UM & 128) REPS(41) ret_out_loop(Fq, RA, (Fq.vcu + 16) % Fq.G, Fq.G, 16 * 66, last);
        }
        SEAM(pb + 4);

        if (PHM(5) && IN(pb + 5)) { Frame Fq = fresh(F); WSQ();
            pg8::Gemm g{XN, (const bf16_t*)(wsq + WS_WOUT) + (size_t)l * DM * DM};
            pg8::LinOrder S{DM / 256, (last ? 128 : 132) * (DM / 256), Fq.G, Fq.vcu, last ? 1 : 0};
            pg8::EpiResid E{xl_cur, XB, xc_cur, XC, mod};
            pg8::gemm_phase<pg8::EpiResid, pg8::LinOrder, DM, DM, DM, true>(Fq.lds, Fq.wave, g, S, E);
        }
        SEAM(pb + 5);

        if (PHM(6) && IN(pb + 6)) REPS(6) { Frame Fq = fresh(F); WSQ(); phase_norm_mod<true>(Fq, nullptr, XB, XC, KARG(in.norm_ffn_g) + l * DM, mod, 3, XN, last, nullptr, wsq + WS_XQ, (float*)(wsq + WS_XSC)); }
        SEAM(pb + 6);
#ifdef EXTRA_BAR
        if (IN(pb + 6) && IN(pb + 7)) for (int eb = 0; eb < EXTRA_BAR; ++eb) xcd_barrier(bar);
#endif

#if REP_J == 70
        if (PHM(7) && IN(pb + 7)) for (int rep_ = 0; rep_ < REP_N - 1; ++rep_) { Frame Fq = fresh(F); WSQ();
            pg8::Gemm g{XN, (const bf16_t*)(wsq + WS_WSC) + (size_t)l * 2048 * DM};
            pg8::LinOrder S{2048 / 256, (last ? 128 : 132) * (2048 / 256), Fq.G, Fq.vcu, last ? 1 : 0};
            pg8::EpiNull E{(float*)(wsq + WS_CTL + 4096)};
            pg8::gemm_phase<pg8::EpiNull, pg8::LinOrder, DM, DM, DM, true>(Fq.lds, Fq.wave, g, S, E); }
#endif
        if (PHM(7) && IN(pb + 7)) REPS(7) { Frame Fq = fresh(F); WSQ();
            pg8::Gemm g{XN, (const bf16_t*)(wsq + WS_WSC) + (size_t)l * 2048 * DM};
            pg8::LinOrder S{2048 / 256, (last ? 128 : 132) * (2048 / 256), Fq.G, Fq.vcu, last ? 1 : 0};
            pg8::EpiScore E{S16};
            pg8::gemm_phase<pg8::EpiScore, pg8::LinOrder, DM, DM, DM, true>(Fq.lds, Fq.wave, g, S, E);
        }
        SEAM(pb + 7);

        if (PHM(8) && IN(pb + 8)) REPS(8) { Frame Fq = fresh(F); WSQ(); phase_topk(Fq, S16, EID, GATE, last); }
        SEAM(pb + 8);

#if REP_J == 90
        if (PHM(9) && IN(pb + 9)) for (int rep_ = 0; rep_ < REP_N - 1; ++rep_) { Frame Fq = fresh(F); WSQ(); phase_peer_u<true>(Fq, wsq + WS_XQ, (const float*)(wsq + WS_XSC), UB, (const unsigned*)EID, (float*)(wsq + WS_P), last); }
#endif
        if (PHM(9) && IN(pb + 9)) REPS(9) { Frame Fq = fresh(F); WSQ(); phase_peer_u(Fq, wsq + WS_XQ, (const float*)(wsq + WS_XSC), UB, (const unsigned*)EID, (float*)(wsq + WS_P), last); }
        SEAM(pb + 9);

        if (PHM(9) && IN(pb + 10)) { Frame Fq = fresh(F); WSQ(); phase_peer_w(Fq, (const float*)(wsq + WS_P), GATE, last); }
        SEAM(pb + 10);

        if (PHM(9) && IN(pb + 11)) REPS(11) { Frame Fq = fresh(F); WSQ(); float vsc = 1.0f;
#ifdef PEER_SCALE
            vsc = PEER_SCALE;
#endif
            if (REP_J == 11) { vsc = (rep_ == REP_N - 1) ? 1.0f : 0.0f; asm volatile("" : "+v"(vsc)); }
            phase_peer_v(Fq, VB, (const unsigned*)EID, GATE, XB, XC, mod, last, vsc); }
        SEAM(pb + 11);
    }

#if DIAG
    if (IN(25)) { const float dsc = 1.0f + 0.05f * (float)__hip_atomic_load(ctl + 8, __ATOMIC_RELAXED, __HIP_MEMORY_SCOPE_AGENT); phase_final_norm(F, (const bf16_t*)as_global(ws + WS_XB), KARG(out), KARG(in.final_norm_g), dsc); }
#else
    if (IN(25)) { phase_final_norm(F, (const bf16_t*)as_global(ws + WS_XB), KARG(out), KARG(in.final_norm_g), 1.0f); }
#endif
#undef IN
#undef SEAM
}

#if DIAG
__global__ void __launch_bounds__(NTHR, 2) diag_kernel(Args args) {
    extern __shared__ __attribute__((aligned(16))) unsigned char lds_raw[];
    Frame F; F.lds = (LAS unsigned char*)lds_raw; F.tid = threadIdx.x; F.lane = F.tid & 63; F.wave = __builtin_amdgcn_readfirstlane(F.tid >> 6); F.G = gridDim.x; F.vcu = blockIdx.x;
    diag_check(F, args.in, args.ws, (unsigned*)(args.ws + WS_CTL) + 8);
}
#endif
extern "C" void kernel_launch(void* const* d_in, const int* in_sizes, int n_in, void* d_out, int out_size, void* d_ws, size_t ws_size, hipStream_t stream) {
    static int grid = 0;
    if (grid == 0) {
        if (n_in != 25 || in_sizes[0] != NBATCH * SEQ * DM || out_size != NBATCH * SEQ * DM || ws_size < WS_END) {
            fprintf(stderr, "kernel_launch: unexpected problem (n_in %d, in0 %d, out %d, ws %zu < %zu); nothing launched\n", n_in, n_in > 0 ? in_sizes[0] : -1, out_size, ws_size, (size_t)WS_END); grid = -1; return; }
        int dev = 0, cus = 0, per_cu = 0;
        if (hipGetDevice(&dev) != hipSuccess || hipDeviceGetAttribute(&cus, hipDeviceAttributeMultiprocessorCount, dev) != hipSuccess) { grid = -1; return; }
#if DIAG
        (void)hipFuncSetAttribute((const void*)diag_kernel, hipFuncAttributeMaxDynamicSharedMemorySize, LDS_BYTES);
#endif
        if (hipFuncSetAttribute((const void*)fwd_kernel, hipFuncAttributeMaxDynamicSharedMemorySize, LDS_BYTES) != hipSuccess) { fprintf(stderr, "kernel_launch: hipFuncSetAttribute failed\n"); grid = -1; return; }
        if (hipOccupancyMaxActiveBlocksPerMultiprocessor(&per_cu, (const void*)fwd_kernel, NTHR, LDS_BYTES) != hipSuccess || per_cu < 1) {
            fprintf(stderr, "kernel_launch: occupancy query reports %d workgroups per CU\n", per_cu); (void)hipGetLastError(); if (per_cu < 1) { grid = -1; return; } }
        grid = cus;
    }
    if (grid < 0) return;
    (void)hipMemsetAsync((char*)d_ws + WS_CTL, 0, CTL_ZERO_BYTES, stream);
    Args a{};
    const float** ip = (const float**)&a.in;
    for (int i = 0; i < 25; ++i) ip[i] = (const float*)d_in[i];
    a.out = (float*)d_out; a.ws = (unsigned char*)d_ws;
#if DIAG
    a.ph_lo = 0; a.ph_hi = 6; a.li = 0; hipLaunchKernelGGL(fwd_kernel, dim3(grid), dim3(NTHR), LDS_BYTES, stream, a);
    hipLaunchKernelGGL(diag_kernel, dim3(grid), dim3(NTHR), LDS_BYTES, stream, a);
    a.ph_lo = 6; a.ph_hi = N_PHASES; a.li = 1; hipLaunchKernelGGL(fwd_kernel, dim3(grid), dim3(NTHR), LDS_BYTES, stream, a);
#elif MK_SINGLE
    a.ph_lo = 0; a.ph_hi = N_PHASES;
    hipLaunchKernelGGL(fwd_kernel, dim3(grid), dim3(NTHR), LDS_BYTES, stream, a);
#else
    for (int p = 0; p < N_PHASES; ++p) { a.ph_lo = p; a.ph_hi = p + 1; hipLaunchKernelGGL(fwd_kernel, dim3(grid), dim3(NTHR), LDS_BYTES, stream, a); }
#endif
}
```

```cpp
#include <hip/hip_runtime.h>
#include <cstdio>
#include <cstdint>

#define GAS __attribute__((address_space(1)))
#define LAS __attribute__((address_space(3)))
typedef unsigned short bf16_t;
typedef short bf16x8 __attribute__((ext_vector_type(8)));
typedef float f32x4 __attribute__((ext_vector_type(4)));
typedef float f32x2 __attribute__((ext_vector_type(2)));
typedef float f32x16 __attribute__((ext_vector_type(16)));
typedef unsigned u32x4 __attribute__((ext_vector_type(4)));
typedef unsigned u32x2 __attribute__((ext_vector_type(2)));

constexpr int NBATCH = 4, SEQ = 8192, CTXL = 256, DM = 1024, NLAYER = 2;
constexpr int NB = SEQ + CTXL;
constexpr int NROW = NBATCH * NB;
constexpr int PW = 3328;
constexpr int INW = 3104;
constexpr int KVW = 512;
constexpr int C_MLAQ = 0, C_CKV = 384, C_KR = 512, C_SWAQ = 544, C_SWAK = 800, C_SWAV = 928, C_NAQ = 1056, C_NAK = 1312, C_NAV = 1568,
              C_RQ = 1824, C_RK = 2080, C_RV = 2336, C_RGF = 2592, C_RGB = 2848;
constexpr int NEXP = 16384, PEER_K = 128;
constexpr float LOG2E = 1.4426950408889634f;
constexpr float EPS = 1e-6f;

constexpr size_t MiB = 1u << 20;
constexpr size_t WS_CTL = 0, CTL_ZERO_BYTES = 1 * MiB;
constexpr size_t WS_MOD = 1 * MiB;
constexpr size_t WS_TAB = 2 * MiB;
constexpr size_t WS_WIN = 3 * MiB;
constexpr size_t WS_WOUT = 17 * MiB;
constexpr size_t WS_WSC = 21 * MiB;
constexpr size_t WS_WUKV = 29 * MiB;
constexpr size_t WS_SSQ = 30 * MiB;
constexpr size_t WS_XC = 31 * MiB;
constexpr size_t WS_UB = 35 * MiB;
constexpr size_t WS_VB = 67 * MiB;
constexpr size_t WS_XN = 99 * MiB;
constexpr size_t WS_P = 165 * MiB;
constexpr size_t WS_XQ = 300 * MiB;
constexpr size_t WS_XSC = 334 * MiB;
constexpr size_t WS_KV = 380 * MiB;
constexpr size_t WS_GATE = WS_KV + (size_t)NROW * 128 * 4;
constexpr size_t WS_RS = 413 * MiB;
constexpr size_t WS_XB = 446 * MiB;
constexpr size_t WS_END = 510 * MiB;
static_assert(WS_P + (size_t)NROW * 2048 * 2 <= WS_XQ && WS_XQ + (size_t)NROW * DM <= WS_XSC && WS_XSC + (size_t)NROW * 16 <= WS_KV, "ws map (ffn)");
static_assert(WS_WIN + (size_t)2 * PW * DM * 2 <= WS_WOUT && WS_XN + (size_t)NROW * DM * 2 <= WS_P && WS_P + (size_t)NROW * PW * 2 <= WS_KV &&
              WS_KV + (size_t)NROW * KVW * 2 <= WS_RS && WS_GATE + (size_t)NROW * 128 * 4 <= WS_RS && WS_RS + (size_t)32 * 66 * 4096 * 4 <= WS_XB && WS_XB + (size_t)NBATCH * SEQ * DM * 2 <= WS_END, "ws map");
constexpr int CW_TMO = 0, CW_BAR = 4096;

constexpr int RING_BYTES = 131072;
constexpr int LDSCTL_OFF = RING_BYTES, MISC_OFF = LDSCTL_OFF + 320;
constexpr int LDS_BYTES = 147456;
constexpr int NWAVES = 8, NTHR = 512;

__device__ __forceinline__ unsigned cvt_pk_bf16(float lo, float hi) { unsigned r; asm volatile("v_cvt_pk_bf16_f32 %0, %1, %2" : "=v"(r) : "v"(lo), "v"(hi)); return r; }
__device__ __forceinline__ float bf_lo(unsigned w) { return __uint_as_float(w << 16); }
__device__ __forceinline__ float bf_hi(unsigned w) { return __uint_as_float(w & 0xffff0000u); }
__device__ __forceinline__ float bf2f(bf16_t h) { return __uint_as_float((unsigned)h << 16); }
__device__ __forceinline__ int lane_id() { unsigned z = 0u; asm volatile("" : "+v"(z)); return (int)__builtin_amdgcn_mbcnt_hi(~0u, __builtin_amdgcn_mbcnt_lo(~0u, z)); }
template <int M> __device__ __forceinline__ float xshfl(float v) {
    if constexpr (M == 32) { auto rr = __builtin_amdgcn_permlane32_swap(__float_as_uint(v), __float_as_uint(v), false, false);
        return __uint_as_float((lane_id() & 32) ? rr[0] : rr[1]); }
    else return __uint_as_float((unsigned)__builtin_amdgcn_ds_swizzle((int)__float_as_uint(v), (M << 10) | 0x1F));
}
__device__ __forceinline__ float xsum32(float v) { auto rr = __builtin_amdgcn_permlane32_swap(__float_as_uint(v), __float_as_uint(v), false, false); return __uint_as_float(rr[0]) + __uint_as_float(rr[1]); }
__device__ __forceinline__ float xmax32(float v) { auto rr = __builtin_amdgcn_permlane32_swap(__float_as_uint(v), __float_as_uint(v), false, false); return fmaxf(__uint_as_float(rr[0]), __uint_as_float(rr[1])); }
__device__ __forceinline__ float wave_sum(float v) {
    v += xshfl<1>(v); v += xshfl<2>(v); v += xshfl<4>(v); v += xshfl<8>(v); v += xshfl<16>(v); return xsum32(v);
}
__device__ __forceinline__ float fexp2(float x) { return __builtin_amdgcn_exp2f(x); }
__device__ __forceinline__ float silu_f(float x) { return x / (1.f + __expf(-x)); }
template <class T> __device__ __forceinline__ T* as_global(T* p) { return (T*)(GAS T*)p; }
#define LDS_WAIT() asm volatile("s_waitcnt lgkmcnt(0)" ::: "memory")
#define VM_WAIT() asm volatile("s_waitcnt vmcnt(0)" ::: "memory")

#define XB_TMO      128
#define XB_XCNT(j)  (256  + 64 * (j))
#define XB_XSUB(j)  (1280 + 64 * (j))
#define XB_XGEN(j)  (2304 + 64 * (j))
#define XB_TOP      3328
#define XB_TOPGEN   3392
#define XCD_BAR_WORDS 3456
#define XB_SPIN_CAP (1u << 18)
__device__ __forceinline__ unsigned xb_ld(unsigned* p)              { return __hip_atomic_load(p, __ATOMIC_RELAXED, __HIP_MEMORY_SCOPE_AGENT); }
__device__ __forceinline__ unsigned xb_add(unsigned* p, unsigned v) { return __hip_atomic_fetch_add(p, v, __ATOMIC_RELAXED, __HIP_MEMORY_SCOPE_AGENT); }
__device__ __forceinline__ unsigned xb_xcc_id() { return (unsigned)__builtin_amdgcn_s_getreg((3 << 11) | 20) & 0xFu; }
#define XB_SPIN(cond, bar) do { unsigned _sp = 0; while (cond) { __builtin_amdgcn_s_sleep(1); \
    if ((++_sp & 255u) == 0u) { if (xb_ld(&(bar)[XB_TMO])) break; if (_sp > XB_SPIN_CAP) { atomicAdd(&(bar)[XB_TMO], 1u); break; } } } } while (0)
struct XcdBarrier { unsigned* bar; unsigned x; volatile LAS unsigned* st; };
__device__ __forceinline__ XcdBarrier xcd_barrier_post(unsigned* bar, volatile LAS unsigned* st) {
    XcdBarrier b; b.bar = bar; b.x = xb_xcc_id(); b.st = st;
    if (threadIdx.x == 0) (void)xb_add(&bar[XB_XCNT(b.x)], 1u);
    return b;
}
__device__ __forceinline__ void xcd_barrier_complete(unsigned* bar, unsigned x, unsigned& nloc, unsigned& nx) {
    const unsigned G = gridDim.x * gridDim.y * gridDim.z;
    unsigned sum, cnt, mine, sp = 0u;
    for (;;) {
        sum = 0u; cnt = 0u; mine = 0u;
#pragma unroll
        for (unsigned j = 0; j < 16; ++j) { const unsigned c = xb_ld(&bar[XB_XCNT(j)]); sum += c; cnt += (c > 0u) ? 1u : 0u; mine = (j == x) ? c : mine; }
        if (sum == G) break;
        __builtin_amdgcn_s_sleep(1);
        if ((++sp & 255u) == 0u) { if (xb_ld(&bar[XB_TMO])) break; if (sp > XB_SPIN_CAP) { atomicAdd(&bar[XB_TMO], 1u); break; } }
    }
    nloc = mine > 0u ? mine : 1u; nx = cnt > 0u ? cnt : 1u;
}
__device__ __forceinline__ void xcd_barrier(const XcdBarrier& b) {
    asm volatile("s_waitcnt vmcnt(0)" ::: "memory");
    __syncthreads();
    if (threadIdx.x == 0) {
        unsigned* bar = b.bar;
        __builtin_amdgcn_s_waitcnt(0);
        unsigned nloc = b.st[0], nx = b.st[1];
        if (nloc == 0u) { unsigned xo = b.x; asm volatile("" : "+s"(xo)); xcd_barrier_complete(bar, xo, nloc, nx); b.st[0] = nloc; b.st[1] = nx; }
        const unsigned old = xb_add(&bar[XB_XSUB(b.x)], 1u);
        const unsigned gen = old / nloc;
        if (old + 1u == (gen + 1u) * nloc) {
            __builtin_amdgcn_fence(__ATOMIC_RELEASE, "agent");
            asm volatile("s_waitcnt vmcnt(0)" ::: "memory");
            const unsigned og = xb_add(&bar[XB_TOP], 1u);
            const unsigned tg = og / nx;
            if (og + 1u == (tg + 1u) * nx) xb_add(&bar[XB_TOPGEN], 1u);
            else XB_SPIN(xb_ld(&bar[XB_TOPGEN]) == tg, bar);
            __builtin_amdgcn_fence(__ATOMIC_ACQUIRE, "agent");
            xb_add(&bar[XB_XGEN(b.x)], 1u);
            asm volatile("s_waitcnt vmcnt(0)" ::: "memory");
        } else {
            XB_SPIN(xb_ld(&bar[XB_XGEN(b.x)]) == gen, bar);
            __builtin_amdgcn_fence(__ATOMIC_ACQUIRE, "agent");
            asm volatile("s_waitcnt vmcnt(0)" ::: "memory");
        }
    }
    __syncthreads();
}
namespace pg8 {
constexpr int BM = 256, BK = 64, HALF = 128, HTB = HALF * BK * 2, STAGE_BYTES = 8 * HTB;
__host__ __device__ __forceinline__ int lds_byte(int r, int c) { const int st = (r >> 4) * 2 + (c >> 5), rr = r & 15, cc = c & 31, ob = rr * 64 + cc * 2; return st * 1024 + (ob ^ (((ob >> 9) & 1) << 5)); }
__host__ __device__ __forceinline__ void stage_rc(int b, int& R, int& C) { const int st = b / 1024, sb = b % 1024, swz = sb ^ (((sb >> 9) & 1) << 5); R = (st >> 1) * 16 + swz / 64; C = (st & 1) * 32 + (swz % 64) / 2; }
__host__ __device__ __forceinline__ int perm32(int rho) { const int n = rho >> 4, i = rho & 15; return 8 * (i >> 2) + 4 * n + (i & 3); }
struct Unit { int pm, pn; };
struct Gemm { const bf16_t* A; const bf16_t* Bt; };

struct LinOrder {
    int nN, nUnits, G, c, skipctx;
    __device__ __forceinline__ bool next(int i, Unit& u) const {
        const int L = i * G + c; if (L >= nUnits) return false;
        const int pmv = L / nN; u.pn = L - pmv * nN; u.pm = skipctx ? (pmv + pmv / 32 + 1) : pmv; return true;
    }
    __device__ __forceinline__ void a_ready(const Unit&) const {}
    __device__ __forceinline__ void done(const Unit&) const {}
};

template <class Epi, class Sched, int KDIM, int LDA, int LDB, bool ALIGN_EPI = false>
__device__ __forceinline__ void gemm_phase(LAS unsigned char* lds, int wave_sgpr, const Gemm g, const Sched& S, const Epi& E) {
    const int wid = __builtin_amdgcn_readfirstlane(wave_sgpr); int lane = lane_id(); asm volatile("" : "+v"(lane)); const int tid = wid * 64 + lane;
    const int wr = wid >> 2, wc = wid & 3, fr = lane & 15, fq = lane >> 4;
    int nt = KDIM / BK; asm volatile("" : "+s"(nt));
    unsigned voffA[2], voffB[2];
#pragma unroll
    for (int i = 0; i < 2; ++i) { int R, C; stage_rc(tid * 16 + i * 8192, R, C); const int Rb = Epi::PERM ? (64 * (R >> 5) + perm32(R & 31)) : R;
        voffA[i] = (unsigned)(R * LDA + C) * 2u; voffB[i] = (unsigned)(Rb * LDB + C) * 2u; }
    constexpr size_t kstep = (size_t)(BK * 2);
    constexpr size_t hstepA = (size_t)HALF * LDA * 2, hstepB = (size_t)(Epi::PERM ? 32 : HALF) * LDB * 2;
    constexpr size_t tstepA = (size_t)BM * LDA * 2, tstepB = (size_t)BM * LDB * 2;
    const unsigned ldsw = (unsigned)wid * 1024u;
    const int aoff = lds_byte(wr * 64 + fr, fq * 8), boff = lds_byte(wc * 32 + fr, fq * 8);
#define PG8_SA(b, h) (((b) * 2 + (h)) * HTB)
#define PG8_SB(b, h) ((4 + (b) * 2 + (h)) * HTB)
#define PG8_STAGE(bufoff, gbase, voff) do { _Pragma("unroll") for (int _i = 0; _i < 2; ++_i) \
        __builtin_amdgcn_global_load_lds((const unsigned*)((const char*)(gbase) + (voff)[_i]), (LAS unsigned*)(lds + (bufoff) + ldsw + _i * 8192), 16, 0, 0); } while (0)
#define PG8_LDA(dst, b, h) do { _Pragma("unroll") for (int m = 0; m < 4; ++m) _Pragma("unroll") for (int k = 0; k < 2; ++k) dst[m][k] = *(const LAS bf16x8*)(lds + PG8_SA(b, h) + aoff + m * 2048 + k * 1024); } while (0)
#define PG8_LDB(dst, b, h) do { _Pragma("unroll") for (int n = 0; n < 2; ++n) _Pragma("unroll") for (int k = 0; k < 2; ++k) dst[n][k] = *(const LAS bf16x8*)(lds + PG8_SB(b, h) + boff + n * 2048 + k * 1024); } while (0)
#define PG8_MMA(ai, bj, At, Bt) do { __builtin_amdgcn_s_setprio(1); _Pragma("unroll") for (int m = 0; m < 4; ++m) _Pragma("unroll") for (int n = 0; n < 2; ++n) _Pragma("unroll") for (int k = 0; k < 2; ++k) \
        acc[ai][bj][m][n] = __builtin_amdgcn_mfma_f32_16x16x32_bf16(Bt[n][k], At[m][k], acc[ai][bj][m][n], 0, 0, 0); __builtin_amdgcn_s_setprio(0); } while (0)
#define PG8_WAIT_V(n) asm volatile("s_waitcnt vmcnt(" #n ")" ::: "memory")
#define PG8_WAIT_L(n) asm volatile("s_waitcnt lgkmcnt(" #n ")" ::: "memory")
#define PG8_BAR __builtin_amdgcn_s_barrier()
#define PG8_SCHED __builtin_amdgcn_sched_barrier(0)
    Unit cur, nxt; int ui = 0;
    if (!S.next(0, cur)) return;
    f32x4 acc[2][2][4][2];
#pragma unroll
    for (int a = 0; a < 2; ++a)
#pragma unroll
        for (int b = 0; b < 2; ++b)
#pragma unroll
            for (int m = 0; m < 4; ++m)
#pragma unroll
                for (int n = 0; n < 2; ++n) acc[a][b][m][n] = (f32x4){0.f, 0.f, 0.f, 0.f};
    bf16x8 At[4][2], B0[2][2], B1[2][2];
    const char* cA = (const char*)g.A + (size_t)cur.pm * tstepA; const char* cB = (const char*)g.Bt + (size_t)cur.pn * tstepB;
    S.a_ready(cur);
    PG8_STAGE(PG8_SB(0, 0), cB, voffB); PG8_STAGE(PG8_SB(0, 1), cB + hstepB, voffB); PG8_STAGE(PG8_SA(0, 0), cA, voffA); PG8_STAGE(PG8_SA(0, 1), cA + hstepA, voffA);
    if (wr == 1) PG8_BAR;
    PG8_WAIT_V(2); PG8_BAR;
    PG8_STAGE(PG8_SB(1, 0), cB + kstep, voffB); PG8_STAGE(PG8_SA(1, 0), cA + kstep, voffA); PG8_STAGE(PG8_SB(1, 1), cB + hstepB + kstep, voffB);
    PG8_WAIT_V(6); PG8_BAR;
    for (;;) {
        const bool has_next = S.next(ui + 1, nxt);
        const char* nA = has_next ? (const char*)g.A + (size_t)nxt.pm * tstepA : cA; const char* nB = has_next ? (const char*)g.Bt + (size_t)nxt.pn * tstepB : cB;
        for (int t = 0; t < nt; t += 2) {
            const bool last = (t == nt - 2);
            const char* a1 = cA + (size_t)(t + 1) * kstep;
            const char* a2 = last ? nA : cA + (size_t)(t + 2) * kstep; const char* b2 = last ? nB : cB + (size_t)(t + 2) * kstep;
            const char* a3 = a2 + kstep; const char* b3 = b2 + kstep;
            if (last && has_next) S.a_ready(nxt);
            PG8_LDB(B0, 0, 0); PG8_LDB(B1, 0, 1); PG8_SCHED; PG8_LDA(At, 0, 0); PG8_STAGE(PG8_SA(1, 1), a1 + hstepA, voffA);
            PG8_WAIT_V(8); PG8_WAIT_L(0); PG8_BAR; PG8_MMA(0, 0, At, B0); PG8_MMA(0, 1, At, B1); PG8_BAR; PG8_SCHED;
            PG8_LDA(At, 0, 1); PG8_STAGE(PG8_SB(0, 0), b2, voffB); PG8_STAGE(PG8_SB(0, 1), b2 + hstepB, voffB); PG8_STAGE(PG8_SA(0, 0), a2, voffA);
            PG8_WAIT_V(8); PG8_WAIT_L(0); PG8_BAR; PG8_MMA(1, 0, At, B0); PG8_MMA(1, 1, At, B1); PG8_BAR; PG8_SCHED;
            PG8_LDB(B0, 1, 0); PG8_LDB(B1, 1, 1); PG8_SCHED; PG8_LDA(At, 1, 0); PG8_STAGE(PG8_SA(0, 1), a2 + hstepA, voffA);
            PG8_WAIT_V(8); PG8_WAIT_L(0); PG8_BAR; PG8_MMA(0, 0, At, B0); PG8_MMA(0, 1, At, B1); PG8_BAR; PG8_SCHED;
            PG8_LDA(At, 1, 1); PG8_STAGE(PG8_SB(1, 0), b3, voffB); PG8_STAGE(PG8_SB(1, 1), b3 + hstepB, voffB); PG8_STAGE(PG8_SA(1, 0), a3, voffA);
            PG8_WAIT_V(8); PG8_WAIT_L(0); PG8_BAR; PG8_MMA(1, 0, At, B0); PG8_MMA(1, 1, At, B1); PG8_BAR; PG8_SCHED;
        }
        if constexpr (ALIGN_EPI) { if (wr == 0) PG8_BAR; }
        E(acc, cur, wr, wc, fr, fq); S.done(cur);
        if (!has_next) break;
#pragma unroll
        for (int a = 0; a < 2; ++a)
#pragma unroll
            for (int b = 0; b < 2; ++b)
#pragma unroll
                for (int m = 0; m < 4; ++m)
#pragma unroll
                    for (int n = 0; n < 2; ++n) acc[a][b][m][n] = (f32x4){0.f, 0.f, 0.f, 0.f};
        cur = nxt; cA = nA; cB = nB; ++ui;
        if constexpr (ALIGN_EPI) { if (wr == 1) PG8_BAR; }
    }
    PG8_WAIT_V(0);
    if constexpr (!ALIGN_EPI) { if (wr == 0) PG8_BAR; }
    PG8_BAR;
#undef PG8_SA
#undef PG8_SB
#undef PG8_STAGE
#undef PG8_LDA
#undef PG8_LDB
#undef PG8_MMA
#undef PG8_WAIT_V
#undef PG8_WAIT_L
#undef PG8_BAR
#undef PG8_SCHED
}

__device__ __forceinline__ unsigned dpp_ror8(unsigned v) { return (unsigned)__builtin_amdgcn_mov_dpp((int)v, 0x128, 0xf, 0xf, false); }
__device__ __forceinline__ void epi_pair_exchange(const u32x4 c0, const u32x4 c1, int fr, u32x4& a, u32x4& b) {
    const bool lo = fr < 8;
    const u32x4 send = lo ? c1 : c0;
    u32x4 recv; recv.x = dpp_ror8(send.x); recv.y = dpp_ror8(send.y); recv.z = dpp_ror8(send.z); recv.w = dpp_ror8(send.w);
    a = lo ? c0 : recv;
    b = lo ? recv : c1;
}

struct EpiProj {
    static constexpr bool PERM = true;
    bf16_t* P; float* ssq; const f32x2* r64; const f32x2* r32;
    struct Cfg { float sc; int rope, pp, c0, cs; bool isckv, valid; };
    __device__ __forceinline__ Cfg cfg(int cs, int fq, bool isctx) const {
        Cfg C; C.cs = cs; C.c0 = cs + 8 * fq; C.sc = 1.f; C.rope = 0; C.pp = 0; C.valid = cs < INW;
        if (cs < C_CKV) { C.sc = 0.10206207261596577f * LOG2E; const int p = cs % 96; if (p >= 64) { C.rope = 32; C.pp = C.c0 % 96 - 64; } }
        else if (cs < C_KR) { }
        else if (cs < C_SWAQ) { C.rope = 32; C.pp = C.c0 - C_KR; }
        else if (cs < C_SWAK) { C.sc = 0.125f * LOG2E; C.rope = 64; C.pp = (C.c0 - C_SWAQ) & 63; }
        else if (cs < C_SWAV) { C.rope = 64; C.pp = (C.c0 - C_SWAK) & 63; }
        else if (cs < C_NAQ) { }
        else if (cs < C_NAK) { C.sc = 0.125f * LOG2E; }
        else if (cs < C_RK) { }
        else if (cs < C_RV) { C.sc = 0.125f; }
        C.isckv = (cs >= C_CKV && cs < C_KR);
        if (isctx) C.rope = 0;
        return C;
    }
    __device__ __forceinline__ u32x4 chunk(const f32x4 a0, const f32x4 a1, const Cfg& C, int t, int row, int fq) const {
        f32x4 v0 = a0 * C.sc, v1 = a1 * C.sc;
        if (C.rope) {
            f32x4 cs0, cs1;
            if (C.rope == 64) { const int pos = (C.pp >= 32) ? (t & 63) : (t >> 6); const GAS f32x4* tp = (const GAS f32x4*)(r64 + pos * 16 + ((C.pp & 31) >> 1)); cs0 = tp[0]; cs1 = tp[1]; }
            else              { const int pos = (C.pp >= 16) ? (t & 63) : (t >> 6); const GAS f32x4* tp = (const GAS f32x4*)(r32 + pos * 8 + ((C.pp & 15) >> 1)); cs0 = tp[0]; cs1 = tp[1]; }
            f32x4 w0, w1;
            w0[0] = v0[0] * cs0[0] - v0[1] * cs0[1]; w0[1] = v0[0] * cs0[1] + v0[1] * cs0[0];
            w0[2] = v0[2] * cs0[2] - v0[3] * cs0[3]; w0[3] = v0[2] * cs0[3] + v0[3] * cs0[2];
            w1[0] = v1[0] * cs1[0] - v1[1] * cs1[1]; w1[1] = v1[0] * cs1[1] + v1[1] * cs1[0];
            w1[2] = v1[2] * cs1[2] - v1[3] * cs1[3]; w1[3] = v1[2] * cs1[3] + v1[3] * cs1[2];
            v0 = w0; v1 = w1;
        }
        if (C.isckv) {
            float s = (v0[0] * v0[0] + v0[1] * v0[1]) + (v0[2] * v0[2] + v0[3] * v0[3]) + (v1[0] * v1[0] + v1[1] * v1[1]) + (v1[2] * v1[2] + v1[3] * v1[3]);
            s += xshfl<16>(s); s = xsum32(s);
            if (fq == 0) ((GAS float*)ssq)[(size_t)row * 4 + ((C.cs - C_CKV) >> 5)] = s;
        }
        u32x4 w; w.x = cvt_pk_bf16(v0[0], v0[1]); w.y = cvt_pk_bf16(v0[2], v0[3]); w.z = cvt_pk_bf16(v1[0], v1[1]); w.w = cvt_pk_bf16(v1[2], v1[3]);
        return w;
    }
    __device__ __forceinline__ void operator()(const f32x4 (&acc)[2][2][4][2], const Unit& u, int wr, int wc, int, int) const {
        int ln_ = lane_id(); asm volatile("" : "+v"(ln_)); const int fr = ln_ & 15, fq = ln_ >> 4;
        const bool isctx = (u.pm % 33) == 0;
        const int tb = (u.pm % 33 - 1) * 256;
        const int cw = u.pn * BM + wc * 64;
        const Cfg C0 = cfg(cw, fq, isctx), C1 = cfg(cw + 32, fq, isctx);
        if (!C0.valid) return;
        const bool vst = (fr < 8) ? true : C1.valid;
        const int cst = cw + ((fr >> 3) << 5) + 8 * fq;
#pragma unroll
        for (int ai = 0; ai < 2; ++ai)
#pragma unroll
            for (int m = 0; m < 4; ++m) {
                const int rg = u.pm * BM + ai * HALF + wr * 64 + m * 16;
                const int row = rg + fr, t = tb + ai * HALF + wr * 64 + m * 16 + fr;
                const u32x4 k0 = chunk(acc[ai][0][m][0], acc[ai][0][m][1], C0, t, row, fq);
                u32x4 k1 = {0u, 0u, 0u, 0u};
                if (C1.valid) k1 = chunk(acc[ai][1][m][0], acc[ai][1][m][1], C1, t, row, fq);
                u32x4 sa, sb; epi_pair_exchange(k0, k1, fr, sa, sb);
                if (vst) { *(GAS u32x4*)(P + (size_t)(rg + (fr & 7)) * PW + cst) = sa; *(GAS u32x4*)(P + (size_t)(rg + 8 + (fr & 7)) * PW + cst) = sb; }
            }
    }
};
struct EpiKV {
    static constexpr bool PERM = true;
    bf16_t* KV; const float* ssq;
    __device__ __forceinline__ void operator()(const f32x4 (&acc)[2][2][4][2], const Unit& u, int wr, int wc, int, int) const {
        int ln_ = lane_id(); asm volatile("" : "+v"(ln_)); const int fr = ln_ & 15, fq = ln_ >> 4;
        const int cst = u.pn * BM + wc * 64 + ((fr >> 3) << 5) + 8 * fq;
#pragma unroll
        for (int ai = 0; ai < 2; ++ai)
#pragma unroll
            for (int m = 0; m < 4; ++m) {
                const int rg = u.pm * BM + ai * HALF + wr * 64 + m * 16, row = rg + fr;
                const f32x4 q4 = *(const GAS f32x4*)(ssq + (size_t)row * 4); const float rs = 1.0f / sqrtf(((q4[0] + q4[1]) + (q4[2] + q4[3])) * (1.f / 128.f) + EPS);
                u32x4 k[2];
#pragma unroll
                for (int bj = 0; bj < 2; ++bj) { const f32x4 v0 = acc[ai][bj][m][0] * rs, v1 = acc[ai][bj][m][1] * rs;
                    k[bj].x = cvt_pk_bf16(v0[0], v0[1]); k[bj].y = cvt_pk_bf16(v0[2], v0[3]); k[bj].z = cvt_pk_bf16(v1[0], v1[1]); k[bj].w = cvt_pk_bf16(v1[2], v1[3]); }
                u32x4 sa, sb; epi_pair_exchange(k[0], k[1], fr, sa, sb);
                *(GAS u32x4*)(KV + (size_t)(rg + (fr & 7)) * KVW + cst) = sa; *(GAS u32x4*)(KV + (size_t)(rg + 8 + (fr & 7)) * KVW + cst) = sb;
            }
    }
};
struct EpiResid {
    static constexpr bool PERM = true;
    const float* xl_in; bf16_t* xb; const float* xc_in; float* xc_out; const float* mod;
    __device__ __forceinline__ void operator()(const f32x4 (&acc)[2][2][4][2], const Unit& u, int wr, int wc, int, int) const {
        int ln_ = lane_id(); asm volatile("" : "+v"(ln_)); const int fr = ln_ & 15, fq = ln_ >> 4;
        const int b = u.pm / 33, jt = u.pm % 33;
        const int cw = u.pn * BM + wc * 64 + 8 * fq;
        const float* gate = mod + ((jt == 0) ? 4 : b) * 6144 + 2 * DM;
        if (jt == 0) {
#pragma unroll
            for (int bj = 0; bj < 2; ++bj) { const int c = cw + 32 * bj; const f32x4 g0 = *(const GAS f32x4*)(gate + c), g1 = *(const GAS f32x4*)(gate + c + 4);
#pragma unroll
                for (int ai = 0; ai < 2; ++ai)
#pragma unroll
                    for (int m = 0; m < 4; ++m) { const size_t off = ((size_t)b * CTXL + ai * HALF + wr * 64 + m * 16 + fr) * DM + c;
                        const f32x4 b0 = *(const GAS f32x4*)(xc_in + off), b1 = *(const GAS f32x4*)(xc_in + off + 4);
                        *(GAS f32x4*)(xc_out + off) = b0 + g0 * acc[ai][bj][m][0]; *(GAS f32x4*)(xc_out + off + 4) = b1 + g1 * acc[ai][bj][m][1]; } }
            return;
        }
        const f32x4 ga0 = *(const GAS f32x4*)(gate + cw), ga1 = *(const GAS f32x4*)(gate + cw + 4), gb0 = *(const GAS f32x4*)(gate + cw + 32), gb1 = *(const GAS f32x4*)(gate + cw + 36);
        const int cst = cw + ((fr >> 3) << 5);
        const size_t rbase = (size_t)b * SEQ + (size_t)(jt - 1) * 256;
#pragma unroll
        for (int ai = 0; ai < 2; ++ai)
#pragma unroll
            for (int m = 0; m < 4; ++m) {
                const size_t rg = rbase + ai * HALF + wr * 64 + m * 16;
                const f32x4 d00 = ga0 * acc[ai][0][m][0], d01 = ga1 * acc[ai][0][m][1], d10 = gb0 * acc[ai][1][m][0], d11 = gb1 * acc[ai][1][m][1];
                u32x4 a0, b0, a1, b1;
                epi_pair_exchange(__builtin_bit_cast(u32x4, d00), __builtin_bit_cast(u32x4, d10), fr, a0, b0);
                epi_pair_exchange(__builtin_bit_cast(u32x4, d01), __builtin_bit_cast(u32x4, d11), fr, a1, b1);
#pragma unroll
                for (int hb = 0; hb < 2; ++hb) {
                    const size_t off = (rg + 8 * hb + (fr & 7)) * DM + cst;
                    const f32x4 e0 = __builtin_bit_cast(f32x4, hb ? b0 : a0), e1 = __builtin_bit_cast(f32x4, hb ? b1 : a1);
                    f32x4 x0, x1;
                    if (xl_in) { x0 = *(const GAS f32x4*)(xl_in + off); x1 = *(const GAS f32x4*)(xl_in + off + 4); }
                    else { const u32x4 w = *(const GAS u32x4*)(xb + off); x0 = (f32x4){bf_lo(w.x), bf_hi(w.x), bf_lo(w.y), bf_hi(w.y)}; x1 = (f32x4){bf_lo(w.z), bf_hi(w.z), bf_lo(w.w), bf_hi(w.w)}; }
                    const f32x4 r0 = x0 + e0, r1 = x1 + e1;
                    u32x4 w2; w2.x = cvt_pk_bf16(r0[0], r0[1]); w2.y = cvt_pk_bf16(r0[2], r0[3]); w2.z = cvt_pk_bf16(r1[0], r1[1]); w2.w = cvt_pk_bf16(r1[2], r1[3]);
                    *(GAS u32x4*)(xb + off) = w2;
                }
            }
    }
};
struct EpiScore {
    static constexpr bool PERM = true;
    _Float16* S;
    __device__ __forceinline__ void operator()(const f32x4 (&acc)[2][2][4][2], const Unit& u, int wr, int wc, int, int) const {
        int ln_ = lane_id(); asm volatile("" : "+v"(ln_)); const int fr = ln_ & 15, fq = ln_ >> 4;
        typedef _Float16 h2 __attribute__((ext_vector_type(2)));
        const int cst = u.pn * BM + wc * 64 + ((fr >> 3) << 5) + 8 * fq;
#pragma unroll
        for (int ai = 0; ai < 2; ++ai)
#pragma unroll
            for (int m = 0; m < 4; ++m) {
                const int rg = u.pm * BM + ai * HALF + wr * 64 + m * 16;
                u32x4 k[2];
#pragma unroll
                for (int bj = 0; bj < 2; ++bj) { const f32x4 v0 = acc[ai][bj][m][0], v1 = acc[ai][bj][m][1];
                    const h2 a = {(_Float16)v0[0], (_Float16)v0[1]}, b = {(_Float16)v0[2], (_Float16)v0[3]}, c = {(_Float16)v1[0], (_Float16)v1[1]}, d = {(_Float16)v1[2], (_Float16)v1[3]};
                    k[bj].x = __builtin_bit_cast(unsigned, a); k[bj].y = __builtin_bit_cast(unsigned, b); k[bj].z = __builtin_bit_cast(unsigned, c); k[bj].w = __builtin_bit_cast(unsigned, d); }
                u32x4 sa, sb; epi_pair_exchange(k[0], k[1], fr, sa, sb);
                *(GAS u32x4*)(S + (size_t)(rg + (fr & 7)) * 2048 + cst) = sa; *(GAS u32x4*)(S + (size_t)(rg + 8 + (fr & 7)) * 2048 + cst) = sb;
            }
    }
};
struct EpiNull {
    static constexpr bool PERM = true;
    float* sink;
    __device__ __forceinline__ void operator()(const f32x4 (&acc)[2][2][4][2], const Unit& u, int wr, int wc, int, int) const {
        float t = 0.f;
#pragma unroll
        for (int a = 0; a < 2; ++a)
#pragma unroll
            for (int b = 0; b < 2; ++b)
#pragma unroll
                for (int m = 0; m < 4; ++m) t += acc[a][b][m][0][0] + acc[a][b][m][1][3];
        if (t == 123.456f) sink[0] = t;
    }
};
}
struct Frame {
    LAS unsigned char* lds;
    int tid, lane, wave, vcu, G;
};
struct Inputs {
    const float *x, *c, *ctx, *c_ctx, *ada_w, *ada_b, *norm_mix_g, *w_in, *mla_kv_norm_g, *mla_w_ukv, *swa_sink, *na_rpb, *ret_decay_f, *ret_decay_b,
                *ret_gn_f, *ret_gn_b, *mix_beta, *w_out, *norm_ffn_g, *peer_wq, *peer_k1, *peer_k2, *peer_u, *peer_v, *final_norm_g;
};

__device__ __forceinline__ int orig_col(int c) {
    if (c < C_CKV) { const int h = c / 96, p = c % 96; if (p < 64) return c; const int pp = p - 64; return h * 96 + 64 + (pp >> 4) * 16 + (pp & 1) * 8 + ((pp & 15) >> 1); }
    if (c < C_KR) return c;
    if (c < C_SWAQ) { const int pp = c - C_KR; return C_KR + (pp >> 4) * 16 + (pp & 1) * 8 + ((pp & 15) >> 1); }
    if (c < C_SWAV) { const int q = c - C_SWAQ, hh = q >> 6, pp = q & 63; return C_SWAQ + hh * 64 + (pp >> 5) * 32 + (pp & 1) * 16 + ((pp & 31) >> 1); }
    return c;
}

template <int MAP  >
__device__ __forceinline__ void transpose_item(const float* W, int K, int Nsrc, int Nvalid, int Ndst, const float* kscale, bf16_t* WT, LAS float* scr, int item, int lane) {
    const int nblk = Ndst / 32, kb = item / nblk, nb = item % nblk, k0 = 64 * kb, n0 = 32 * nb;
    const int nd = n0 + (lane & 31);
    const int ns = (nd < Nvalid) ? (MAP ? orig_col(nd) : nd) : -1;
#pragma unroll 8
    for (int i = 0; i < 32; ++i) { const int kk = 2 * i + (lane >> 5); float v = 0.f; if (ns >= 0) { v = W[(size_t)(k0 + kk) * Nsrc + ns]; if (kscale) v *= kscale[k0 + kk]; } scr[kk * 33 + (lane & 31)] = v; }
    LDS_WAIT(); asm volatile("" ::: "memory");
    const int c = lane & 7;
#pragma unroll
    for (int j = 0; j < 4; ++j) { const int n = (lane >> 3) + 8 * j; const LAS float* s = scr + (8 * c) * 33 + n;
        u32x4 o; o.x = cvt_pk_bf16(s[0 * 33], s[1 * 33]); o.y = cvt_pk_bf16(s[2 * 33], s[3 * 33]); o.z = cvt_pk_bf16(s[4 * 33], s[5 * 33]); o.w = cvt_pk_bf16(s[6 * 33], s[7 * 33]);
        *(GAS u32x4*)(WT + (size_t)(n0 + n) * K + k0 + 8 * c) = o; }
    LDS_WAIT(); asm volatile("" ::: "memory");
}

__device__ __forceinline__ void sincos_small(float af, float& sn, float& cs) {
    const double a = (double)af; const double n = __builtin_rint(a * 0.63661977236758134308); const double r = (a - n * 1.57079632679489655800) - n * 6.123233995736766036e-17;
    const double r2 = r * r;
    const double s = r * (1.0 + r2 * (-1.0 / 6 + r2 * (1.0 / 120 + r2 * (-1.0 / 5040 + r2 * (1.0 / 362880 + r2 * (-1.0 / 39916800 + r2 * (1.0 / 6227020800.0)))))));
    const double c = 1.0 + r2 * (-0.5 + r2 * (1.0 / 24 + r2 * (-1.0 / 720 + r2 * (1.0 / 40320 + r2 * (-1.0 / 3628800 + r2 * (1.0 / 479001600 + r2 * (-1.0 / 87178291200.0)))))));
    const int q = ((int)n) & 3;
    const double ss = (q == 0) ? s : (q == 1) ? c : (q == 2) ? -s : -c;
    const double cc = (q == 0) ? c : (q == 1) ? -s : (q == 2) ? -c : s;
    sn = (float)ss; cs = (float)cc;
}

__device__ __forceinline__ void phase_prologue(Frame& F, const Inputs& I, unsigned char* ws) {
    float* MOD = (float*)(ws + WS_MOD);
    {
        LAS float* sc = (LAS float*)F.lds;
        LAS float* red = (LAS float*)(F.lds + 20480);
        for (int i = F.tid; i < 5 * DM; i += NTHR) { const float v = (i < 4 * DM) ? I.c[i] : I.c_ctx[i - 4 * DM]; sc[i] = silu_f(v); }
        __syncthreads();
        for (int task = blockIdx.x; task < NLAYER * 96; task += F.G) {
            const int l = task / 96, n = (task % 96) * 64 + F.lane;
            const float* w = I.ada_w + (size_t)l * DM * 6144 + n;
            float a0 = 0.f, a1 = 0.f, a2 = 0.f, a3 = 0.f, a4 = 0.f;
            const int kb = F.wave * 128;
            for (int k0 = kb; k0 < kb + 128; k0 += 16) {
                float wv[16];
#pragma unroll
                for (int i = 0; i < 16; ++i) wv[i] = ((const GAS float*)w)[(size_t)(k0 + i) * 6144];
#pragma unroll
                for (int i = 0; i < 16; ++i) { const int k = k0 + i; a0 += sc[k] * wv[i]; a1 += sc[DM + k] * wv[i]; a2 += sc[2 * DM + k] * wv[i]; a3 += sc[3 * DM + k] * wv[i]; a4 += sc[4 * DM + k] * wv[i]; }
            }
            LAS float* rw = red + F.wave * 320 + F.lane;
            rw[0] = a0; rw[64] = a1; rw[128] = a2; rw[192] = a3; rw[256] = a4;
            __syncthreads();
            if (F.tid < 320) { const int r = F.tid >> 6, ln = F.tid & 63; float s = 0.f;
#pragma unroll
                for (int wv = 0; wv < 8; ++wv) s += red[wv * 320 + r * 64 + ln];
                const int nn = (task % 96) * 64 + ln; MOD[(size_t)(l * 5 + r) * 6144 + nn] = s + I.ada_b[l * 6144 + nn]; }
            __syncthreads();
        }
    }
    {
        LAS float* scr = (LAS float*)(F.lds + F.wave * 16384);
        const int gw = F.vcu * NWAVES + F.wave, NGW = F.G * NWAVES;
        constexpr int I_IN = (DM / 64) * (PW / 32), I_OUT = (DM / 64) * (DM / 32), I_UKV = (128 / 64) * (KVW / 32);
        constexpr int PER_L = I_IN + I_OUT + I_UKV;
        for (int it = gw; it < NLAYER * PER_L; it += NGW) {
            const int l = it / PER_L; int r = it % PER_L;
            if (r < I_IN) { transpose_item<1>(I.w_in + (size_t)l * DM * INW, DM, INW, INW, PW, nullptr, (bf16_t*)(ws + WS_WIN) + (size_t)l * PW * DM, scr, r, F.lane); continue; } r -= I_IN;
            if (r < I_OUT) { transpose_item<0>(I.w_out + (size_t)l * DM * DM, DM, DM, DM, DM, I.mix_beta + l * DM, (bf16_t*)(ws + WS_WOUT) + (size_t)l * DM * DM, scr, r, F.lane); continue; } r -= I_OUT;
            transpose_item<0>(I.mla_w_ukv + (size_t)l * 128 * KVW, 128, KVW, KVW, KVW, I.mla_kv_norm_g + l * 128, (bf16_t*)(ws + WS_WUKV) + (size_t)l * KVW * 128, scr, r, F.lane);
        }
    }
    __syncthreads();
    {
        LAS float* wqs = (LAS float*)F.lds;
        LAS float* kps = (LAS float*)(F.lds + 32768);
        for (int task = blockIdx.x; task < NLAYER * 16 * 16; task += F.G) {
            const int l = task >> 8, hp = (task >> 4) & 15, k0 = (task & 15) * 64;
            const float* kp = ((hp & 1) ? I.peer_k2 : I.peer_k1) + (size_t)l * 128 * 128;
            for (int i = F.tid; i < 64 * 128; i += NTHR) wqs[i] = I.peer_wq[(size_t)l * DM * 2048 + (size_t)(k0 + (i >> 7)) * 2048 + hp * 128 + (i & 127)];
            for (int i = F.tid; i < 128 * 128; i += NTHR) kps[(i >> 7) * 129 + (i & 127)] = kp[i];
            __syncthreads();
            const int n = F.tid & 127, kq = F.tid >> 7;
            float a[16];
#pragma unroll
            for (int i = 0; i < 16; ++i) a[i] = 0.f;
            for (int d = 0; d < 128; d += 4) {
                const float kv0 = kps[n * 129 + d], kv1 = kps[n * 129 + d + 1], kv2 = kps[n * 129 + d + 2], kv3 = kps[n * 129 + d + 3];
#pragma unroll
                for (int i = 0; i < 16; ++i) { const f32x4 w4 = *(const LAS f32x4*)(wqs + (kq * 16 + i) * 128 + d);
                    a[i] += w4[0] * kv0; a[i] += w4[1] * kv1; a[i] += w4[2] * kv2; a[i] += w4[3] * kv3; } }
            bf16_t* o = (bf16_t*)(ws + WS_WSC) + (size_t)l * 2048 * DM + (size_t)(hp * 128 + n) * DM + k0 + kq * 16;
            u32x4 w0, w1; w0.x = cvt_pk_bf16(a[0], a[1]); w0.y = cvt_pk_bf16(a[2], a[3]); w0.z = cvt_pk_bf16(a[4], a[5]); w0.w = cvt_pk_bf16(a[6], a[7]);
            w1.x = cvt_pk_bf16(a[8], a[9]); w1.y = cvt_pk_bf16(a[10], a[11]); w1.z = cvt_pk_bf16(a[12], a[13]); w1.w = cvt_pk_bf16(a[14], a[15]);
            *(GAS u32x4*)o = w0; *(GAS u32x4*)(o + 8) = w1;
            __syncthreads();
        }
    }
    {
        const int gt = blockIdx.x * NTHR + F.tid;
        if (gt < 128 * 16 + 128 * 8) {
            const bool big = gt < 2048; const int e = big ? gt : gt - 2048; const int q = big ? 16 : 8; const int pos = e / q, j = e % q;
            const float inv = (float)exp2(-(double)j / (double)q * 13.287712379549449);
            const float ang = (float)pos * inv; float sn, cs; sincos_small(ang, sn, cs);
            f32x2* tab = (f32x2*)(ws + WS_TAB + (big ? 0 : 16384));
            tab[e] = (f32x2){cs, sn};
        }
    }
}

__device__ __forceinline__ unsigned pack_i8(const f32x4 y) {
    const int q0 = __float2int_rn(fminf(fmaxf(y[0], -127.f), 127.f)), q1 = __float2int_rn(fminf(fmaxf(y[1], -127.f), 127.f)), q2 = __float2int_rn(fminf(fmaxf(y[2], -127.f), 127.f)), q3 = __float2int_rn(fminf(fmaxf(y[3], -127.f), 127.f));
    return ((unsigned)q0 & 0xFFu) | (((unsigned)q1 & 0xFFu) << 8) | (((unsigned)q2 & 0xFFu) << 16) | ((unsigned)q3 << 24);
}
__device__ __forceinline__ void phase_convert_uv(Frame& F, const float* u, const float* v, unsigned char* ws) {
    const size_t nblk = (size_t)NEXP * DM / 1024;
    const int gw = F.vcu * NWAVES + F.wave, NGW = F.G * NWAVES, lane = F.lane;
    for (size_t i = gw; i < 2 * nblk; i += NGW) {
        const bool second = i >= nblk; const size_t j = second ? i - nblk : i; const float sc = second ? 4.0f : 896.0f;
        const GAS f32x4* s = (const GAS f32x4*)(second ? v : u) + j * 256 + lane;
        GAS unsigned* d = (GAS unsigned*)(ws + (second ? WS_VB : WS_UB)) + (size_t)(lane >> 5) * ((size_t)NEXP * 32) + j * 32 + (lane & 31);
        f32x4 a[4];
#pragma unroll
        for (int q = 0; q < 4; ++q) a[q] = s[64 * q] * sc;
#pragma unroll
        for (int q = 0; q < 4; ++q) d[(size_t)q * ((size_t)NEXP * 64)] = second ? (unsigned)__builtin_amdgcn_cvt_pk_bf8_f32(a[q][1], a[q][3], __builtin_amdgcn_cvt_pk_bf8_f32(a[q][0], a[q][2], 0, false), true) : pack_i8(a[q]);
    }
}

template <bool Q8 = false>
__device__ __forceinline__ void phase_norm_mod(Frame& F, const float* xl, const bf16_t* xb, const float* xc, const float* gain, const float* mod  , int chunk, bf16_t* XN, bool skipctx, float* ssq_zero, unsigned char* XQ = nullptr, float* XSC = nullptr) {
    const int gw = F.vcu * NWAVES + F.wave, NGW = F.G * NWAVES;
    (void)ssq_zero;
    for (int gi = gw; gi < NROW / 4; gi += NGW) {
        const int r0 = 4 * gi, b = r0 / NB, j0 = r0 % NB;
        const bool isctx = j0 < CTXL;
        if (skipctx && isctx) continue;
        const float* mv = mod + (isctx ? 4 : b) * 6144 + chunk * DM;
        f32x4 v[4][4]; float s[4];
        if (!isctx && xl == nullptr) {
            const GAS u32x2* x2 = (const GAS u32x2*)(xb + ((size_t)b * SEQ + (j0 - CTXL)) * DM) + F.lane;
            u32x2 w[4][4];
#pragma unroll
            for (int i = 0; i < 4; ++i)
#pragma unroll
                for (int q = 0; q < 4; ++q) w[i][q] = x2[i * (DM / 4) + 64 * q];
#pragma unroll
            for (int i = 0; i < 4; ++i)
#pragma unroll
                for (int q = 0; q < 4; ++q) v[i][q] = (f32x4){bf_lo(w[i][q].x), bf_hi(w[i][q].x), bf_lo(w[i][q].y), bf_hi(w[i][q].y)};
        } else {
            const float* xr = isctx ? xc + ((size_t)b * CTXL + j0) * DM : xl + ((size_t)b * SEQ + (j0 - CTXL)) * DM;
            const GAS f32x4* x4 = (const GAS f32x4*)xr + F.lane;
#pragma unroll
            for (int i = 0; i < 4; ++i)
#pragma unroll
                for (int q = 0; q < 4; ++q) v[i][q] = x4[i * (DM / 4) + 64 * q];
        }
#pragma unroll
        for (int i = 0; i < 4; ++i) { float a = 0.f;
#pragma unroll
            for (int q = 0; q < 4; ++q) a += (v[i][q][0] * v[i][q][0] + v[i][q][1] * v[i][q][1]) + (v[i][q][2] * v[i][q][2] + v[i][q][3] * v[i][q][3]);
            s[i] = a; }
#pragma unroll
        for (int i = 0; i < 4; ++i) s[i] = 1.0f / sqrtf(wave_sum(s[i]) * (1.f / DM) + EPS);
#pragma unroll
        for (int q = 0; q < 4; ++q) {
            const int c = 4 * F.lane + 256 * q;
            const f32x4 g = *(const GAS f32x4*)(gain + c), sh = *(const GAS f32x4*)(mv + c), sc = *(const GAS f32x4*)(mv + DM + c);
            const f32x4 gs = g * (sc + 1.0f);
#pragma unroll
            for (int i = 0; i < 4; ++i) {
                const f32x4 y = (v[i][q] * s[i]) * gs + sh;
                u32x2 w; w.x = cvt_pk_bf16(y[0], y[1]); w.y = cvt_pk_bf16(y[2], y[3]);
                ((GAS u32x2*)(XN + (size_t)(r0 + i) * DM) + F.lane)[64 * q] = w;
                if (Q8) v[i][q] = y;
            }
        }
        if (Q8) {
#pragma unroll
            for (int i = 0; i < 4; ++i) { float m = 0.f;
#pragma unroll
                for (int q = 0; q < 4; ++q) m = fmaxf(fmaxf(m, fmaxf(fabsf(v[i][q][0]), fabsf(v[i][q][1]))), fmaxf(fabsf(v[i][q][2]), fabsf(v[i][q][3])));
                m = fmaxf(m, xshfl<1>(m)); m = fmaxf(m, xshfl<2>(m)); m = fmaxf(m, xshfl<4>(m)); m = fmaxf(m, xshfl<8>(m)); m = fmaxf(m, xshfl<16>(m)); m = fmaxf(xmax32(m), 1e-20f);
                const float qs = 127.0f / m;
#pragma unroll
                for (int q = 0; q < 4; ++q) ((GAS unsigned*)(XQ + (size_t)(r0 + i) * DM) + F.lane)[64 * q] = pack_i8(v[i][q] * qs);
                if (F.lane == 0) ((GAS float*)XSC)[(size_t)(r0 + i) * 4] = m * (1.0f / 127.0f);
            }
        }
    }
}

__device__ __forceinline__ void phase_final_norm(Frame& F, const bf16_t* xb, float* out, const float* gain, float dsc) {
    const int gw = F.vcu * NWAVES + F.wave, NGW = F.G * NWAVES;
    for (int gi = gw; gi < NBATCH * SEQ / 4; gi += NGW) {
        const int r0 = 4 * gi;
        const GAS u32x2* x2 = (const GAS u32x2*)(xb + (size_t)r0 * DM) + F.lane;
        u32x2 w[4][4];
#pragma unroll
        for (int i = 0; i < 4; ++i)
#pragma unroll
            for (int q = 0; q < 4; ++q) w[i][q] = x2[i * (DM / 4) + 64 * q];
        f32x4 v[4][4]; float s[4];
#pragma unroll
        for (int i = 0; i < 4; ++i) { float a = 0.f;
#pragma unroll
            for (int q = 0; q < 4; ++q) { v[i][q] = (f32x4){bf_lo(w[i][q].x), bf_hi(w[i][q].x), bf_lo(w[i][q].y), bf_hi(w[i][q].y)}; a += (v[i][q][0] * v[i][q][0] + v[i][q][1] * v[i][q][1]) + (v[i][q][2] * v[i][q][2] + v[i][q][3] * v[i][q][3]); }
            s[i] = a; }
#pragma unroll
        for (int i = 0; i < 4; ++i) s[i] = dsc / sqrtf(wave_sum(s[i]) * (1.f / DM) + EPS);
#pragma unroll
        for (int q = 0; q < 4; ++q) { const f32x4 g = *(const GAS f32x4*)(gain + 4 * F.lane + 256 * q);
#pragma unroll
            for (int i = 0; i < 4; ++i) ((GAS f32x4*)(out + (size_t)(r0 + i) * DM) + F.lane)[64 * q] = (v[i][q] * s[i]) * g; }
    }
}
__device__ __forceinline__ int crow(int r, int hi) { return (r & 3) + 8 * (r >> 2) + 4 * hi; }
constexpr int VS = 68;
enum { AT_MLA = 0, AT_SWA = 1, AT_NA = 2 };
#ifndef ATT_THR
#define ATT_THR 8.0f
#endif
#ifndef SC_MLA
#define SC_MLA 1.0f
#endif
#ifndef SC_SWA
#define SC_SWA 1.0f
#endif
#ifndef SC_NA
#define SC_NA 1.0f
#endif
#ifndef SKIP_ATT
#define SKIP_ATT 0
#endif
struct AttnArgs { const bf16_t* P; const bf16_t* KV; bf16_t* Y; const float* sink; const float* rpb; };

#ifndef ABL
#define ABL 0
#endif
template <int KIND, bool CTXQ, bool DUMMY = false>
__device__ __forceinline__ void attn_unit(Frame& F, const AttnArgs& A, int unit) {
    constexpr int AB = DUMMY ? ABL : 0;
    constexpr int DQK = (KIND == AT_MLA) ? 96 : 64, KS = DQK + 8, NP = DQK / 8, NS = DQK / 16;
    constexpr int KT_BYTES = 64 * KS * 2, VT_BYTES = 64 * VS * 2;
    LAS unsigned char* lds = F.lds;
    LAS unsigned char* Vt[2] = {lds + 3 * KT_BYTES, lds + 3 * KT_BYTES + VT_BYTES};
    LAS float* rpbl = (LAS float*)(lds + 3 * KT_BYTES + 2 * VT_BYTES);
    int lane = lane_id(); asm volatile("" : "+v"(lane));
    const int w = F.wave, tid = w * 64 + lane, r32 = lane & 31, hi = lane >> 5;

    int b, h = 0, g = 0, n = 0;
    if (KIND == AT_MLA) { if (CTXQ) { b = unit >> 2; h = unit & 3; } else { b = unit >> 7; h = (unit >> 5) & 3; n = unit & 31; } }
    else if (KIND == AT_SWA) { if (CTXQ) { b = unit >> 2; g = (unit >> 1) & 1; n = unit & 1; } else { b = unit >> 7; g = (unit >> 6) & 1; n = unit & 63; } }
    else { if (CTXQ) { b = unit >> 2; h = unit & 3; } else { b = unit >> 7; h = (unit >> 5) & 3; n = unit & 31; } }
    const size_t rb = (size_t)b * NB;

    int qj;
    int hq = h, qpos = 0, qrow = 0, qcol = 0;
    if (KIND == AT_MLA) qj = CTXQ ? (32 * w + r32) : (CTXL + 256 * n + 32 * w + r32);
    else if (KIND == AT_SWA) { hq = 2 * g + (w >> 2); qpos = 128 * n + 32 * (w & 3) + r32; qj = CTXQ ? qpos : CTXL + qpos; }
    else { if (CTXQ) qj = 32 * w + r32; else { qrow = 4 * n + (w >> 1); qcol = 32 * (w & 1) + r32; qj = CTXL + qrow * 64 + qcol; } }
    const int qcolbase = (KIND == AT_MLA) ? (C_MLAQ + hq * 96) : (KIND == AT_SWA) ? (C_SWAQ + hq * 64) : (C_NAQ + hq * 64);
    const bf16_t* qp = A.P + (rb + qj) * PW + qcolbase;
    bf16x8 qr[NS];
#pragma unroll
    for (int s = 0; s < NS; ++s) qr[s] = *(const GAS bf16x8*)(qp + 16 * s + 8 * hi);

    int nt = 4, band_lo = 0;
    if (!CTXQ) {
        if (KIND == AT_MLA) nt = 132;
        else if (KIND == AT_SWA) { band_lo = (n == 0) ? 2 : 0; const int band_hi = (n == 63) ? 4 : 6; nt = 4 + band_hi - band_lo; }
        else { int lo = 4 * n - 4; lo = lo < 0 ? 0 : (lo > 120 ? 120 : lo); int hi2 = 4 * n + 3 - 4; hi2 = hi2 < 0 ? 0 : (hi2 > 120 ? 120 : hi2); band_lo = lo; nt = 4 + (hi2 + 7 - lo + 1); }
    }
    auto tile_j0 = [&](int t) -> int {
        if (t < 4) return 64 * t;
        if (KIND == AT_MLA) return 64 * t;
        if (KIND == AT_SWA) return CTXL + 128 * (n - 1) + 64 * (band_lo + t - 4);
        return CTXL + 64 * (band_lo + t - 4);
    };
    int na_rs = 0, na_cs = 0;
    if (KIND == AT_NA && !CTXQ) { na_rs = qrow - 4; na_rs = na_rs < 0 ? 0 : (na_rs > 120 ? 120 : na_rs); na_cs = qcol - 8; na_cs = na_cs < 0 ? 0 : (na_cs > 48 ? 48 : na_cs); }

    const int vkey = (lane & 15) + 16 * (w & 3), vdp = 4 * (w >> 2) + (lane >> 4);
    const int kcolbase = (KIND == AT_SWA) ? (C_SWAK + g * 64) : (C_NAK + h * 64);
    const int vcolbase = (KIND == AT_SWA) ? (C_SWAV + g * 64) : (C_NAV + h * 64);
    constexpr int KPITCH0 = (KIND == AT_MLA) ? KVW : PW, VPITCH = (KIND == AT_MLA) ? KVW : PW;
    const GAS char* kbase0 = (KIND == AT_MLA) ? (const GAS char*)(A.KV + rb * KVW + h * 128) : (const GAS char*)(A.P + rb * PW + kcolbase);
    const GAS char* kbase1 = (const GAS char*)(A.P + rb * PW + C_KR);
    const GAS char* vbase = (KIND == AT_MLA) ? (const GAS char*)(A.KV + rb * KVW + h * 128 + 64) : (const GAS char*)(A.P + rb * PW + vcolbase);
    const unsigned koff0 = (unsigned)((tid >> 3) * KPITCH0 + (tid & 7) * 8) * 2u, koff1 = (unsigned)((tid >> 2) * PW + (tid & 3) * 8) * 2u, voff = (unsigned)(vkey * VPITCH + vdp * 8) * 2u;
    const bool has_k1 = (DQK == 96) && tid < 256;
    const unsigned kl0 = (unsigned)((tid >> 3) * (KS * 2) + (tid & 7) * 16), kl1 = (unsigned)((tid >> 2) * (KS * 2) + 128 + (tid & 3) * 16);
    struct Stage { u32x4 k0, k1, v; };
    auto gloadK = [&](Stage& R, int t) { const int j0 = tile_j0(t); R.k0 = *(const GAS u32x4*)(kbase0 + (size_t)j0 * (KPITCH0 * 2) + koff0); if (has_k1) R.k1 = *(const GAS u32x4*)(kbase1 + (size_t)j0 * (PW * 2) + koff1); };
    auto gloadV = [&](Stage& R, int t) { R.v = *(const GAS u32x4*)(vbase + (size_t)tile_j0(t) * (VPITCH * 2) + voff); };
    auto lstoreK = [&](const Stage& R, int kofs) { *(LAS u32x4*)(lds + kofs + kl0) = R.k0; if (has_k1) *(LAS u32x4*)(lds + kofs + kl1) = R.k1; };
    auto lstoreV = [&](const Stage& R, int buf) { const u32x4 vreg = R.v;
        LAS bf16_t* vt = (LAS bf16_t*)Vt[buf] + (8 * vdp) * VS + vkey;
        vt[0 * VS] = (bf16_t)(vreg.x & 0xffffu); vt[1 * VS] = (bf16_t)(vreg.x >> 16); vt[2 * VS] = (bf16_t)(vreg.y & 0xffffu); vt[3 * VS] = (bf16_t)(vreg.y >> 16);
        vt[4 * VS] = (bf16_t)(vreg.z & 0xffffu); vt[5 * VS] = (bf16_t)(vreg.z >> 16); vt[6 * VS] = (bf16_t)(vreg.w & 0xffffu); vt[7 * VS] = (bf16_t)(vreg.w >> 16);
    };
    struct KF { bf16x8 f[NS]; };
    auto kread = [&](KF& K, int kofs, int hf) {
        const LAS unsigned char* kb = lds + kofs + (32 * hf + r32) * (KS * 2) + hi * 16;
#pragma unroll
        for (int q = 0; q < NS; ++q) K.f[q] = *(const LAS bf16x8*)(kb + q * 32);
    };
    auto qkh = [&](const KF& K, const f32x16& negm, f32x16& p) {
        p = __builtin_amdgcn_mfma_f32_32x32x16_bf16(K.f[0], qr[0], negm, 0, 0, 0);
#pragma unroll
        for (int q = 1; q < NS; ++q) p = __builtin_amdgcn_mfma_f32_32x32x16_bf16(K.f[q], qr[q], p, 0, 0, 0);
    };
    struct VF { u32x2 l0[2], h0[2], l1[2], h1[2]; };
    auto vread = [&](VF& V, int buf, int hf) {
        const LAS unsigned char* vb = Vt[buf] + r32 * (VS * 2) + hi * 8 + hf * 64;
#pragma unroll
        for (int q = 0; q < 2; ++q) { V.l0[q] = *(const LAS u32x2*)(vb + q * 32); V.h0[q] = *(const LAS u32x2*)(vb + q * 32 + 16);
            V.l1[q] = *(const LAS u32x2*)(vb + 32 * (VS * 2) + q * 32); V.h1[q] = *(const LAS u32x2*)(vb + 32 * (VS * 2) + q * 32 + 16); }
    };
    auto mask_half = [&](int t, int hf, f32x16& p) {
        if (CTXQ) return;
        if (KIND == AT_SWA) {
            const bool band = t >= 4;
            int db = band ? (128 * (n - 1) + 64 * (band_lo + t - 4) + 32 * hf + 4 * hi - qpos) : 0;
            asm volatile("" : "+v"(db));
#pragma unroll
            for (int r = 0; r < 16; ++r) { const int c = (r & 3) + 8 * (r >> 2); if (band && (db > 128 - c || db < -128 - c)) p[r] = -1.0e30f; }
        } else if (KIND == AT_NA) {
            const bool band = t >= 4;
            const int krow = band_lo + t - 4;
            const bool rowok = !band || (krow >= na_rs && krow < na_rs + 8);
            const int dr = band ? (krow - qrow + 7) : 0;
            int e = 4 * hi + 32 * hf - na_cs;
            const LAS float* brow = rpbl + (dr < 0 ? 0 : (dr > 14 ? 14 : dr)) * 32 + (15 - qcol + 4 * hi + 32 * hf);
            asm volatile("" : "+v"(e));
#pragma unroll
            for (int r = 0; r < 16; ++r) { const int c = (r & 3) + 8 * (r >> 2);
                const bool v0 = rowok && (!band || (unsigned)(e + c) < 16u);
                const float b0 = (band && v0) ? brow[c] : 0.f;
                p[r] = v0 ? p[r] + b0 : -1.0e30f; }
        }
    };

    if (KIND == AT_NA && !CTXQ) { for (int i = tid; i < 15 * 32; i += NTHR) { const int dr = i >> 5, dc = i & 31; rpbl[i] = (dc < 31) ? ((const GAS float*)A.rpb)[(h * 15 + dr) * 31 + dc] * LOG2E : 0.f; } }

    nt = __builtin_amdgcn_readfirstlane(nt); asm volatile("" : "+s"(nt));
    Stage RA, RB;
    RA.k1 = (u32x4){0u, 0u, 0u, 0u}; RB.k1 = RA.k1;
    gloadK(RA, 0); gloadV(RA, 0); gloadK(RB, nt > 1 ? 1 : 0);
    lstoreK(RA, 0); lstoreV(RA, 0); lstoreK(RB, KT_BYTES);
    int kA = 0, kB = KT_BYTES, kC = 2 * KT_BYTES;
    gloadK(RB, nt > 2 ? 2 : nt - 1); gloadV(RB, nt > 1 ? 1 : nt - 1);
    __syncthreads();
    float m_ref, l_run = 0.f;
    f32x16 o0, o1, pa, pb, negm;
#pragma unroll
    for (int r = 0; r < 16; ++r) { o0[r] = 0.f; o1[r] = 0.f; negm[r] = 0.f; }
    { f32x16& pc = pa; KF K0; kread(K0, 0, 0); qkh(K0, negm, pc); mask_half(0, 0, pc);
      float mx = pc[0];
#pragma unroll
      for (int r = 1; r < 16; ++r) mx = fmaxf(mx, pc[r]);
      mx = xmax32(mx); m_ref = mx;
#pragma unroll
      for (int r = 0; r < 16; ++r) { pc[r] -= mx; negm[r] = -mx; } }
#define ATT_HALF(t, hf, tn, hn, kbuf, pc, pn) do { \
        KF Kn; VF Vc; \
        kread(Kn, (kbuf), (hn)); vread(Vc, (t) & 1, (hf)); \
        qkh(Kn, negm, pn); \
        float rsum = 0.f; \
        _Pragma("unroll") for (int r = 0; r < 16; ++r) { if (!(AB & 1)) pc[r] = fexp2(pc[r]); rsum += pc[r]; } \
        l_run += rsum; \
        mask_half((tn), (hn), pn); \
        float mx = fmaxf(pn[0], pn[1]); \
        _Pragma("unroll") for (int r = 2; r < 16; ++r) mx = fmaxf(mx, pn[r]); \
        mx = xmax32(mx); \
        if (__builtin_expect(((tn) < nt) && __any(mx > ATT_THR), 0)) { \
            const float d = fmaxf(mx, 0.f), al = fexp2(-d); \
            m_ref += d; l_run *= al; \
            _Pragma("unroll") for (int r = 0; r < 16; ++r) { pn[r] -= d; o0[r] *= al; o1[r] *= al; pc[r] *= al; negm[r] = -m_ref; } \
        } \
        const bf16x8 pf0 = __builtin_bit_cast(bf16x8, (u32x4){cvt_pk_bf16(pc[0], pc[1]), cvt_pk_bf16(pc[2], pc[3]), cvt_pk_bf16(pc[4], pc[5]), cvt_pk_bf16(pc[6], pc[7])}); \
        const bf16x8 pf1 = __builtin_bit_cast(bf16x8, (u32x4){cvt_pk_bf16(pc[8], pc[9]), cvt_pk_bf16(pc[10], pc[11]), cvt_pk_bf16(pc[12], pc[13]), cvt_pk_bf16(pc[14], pc[15])}); \
        o0 = __builtin_amdgcn_mfma_f32_32x32x16_bf16(__builtin_bit_cast(bf16x8, (u32x4){Vc.l0[0].x, Vc.l0[0].y, Vc.h0[0].x, Vc.h0[0].y}), pf0, o0, 0, 0, 0); \
        o1 = __builtin_amdgcn_mfma_f32_32x32x16_bf16(__builtin_bit_cast(bf16x8, (u32x4){Vc.l1[0].x, Vc.l1[0].y, Vc.h1[0].x, Vc.h1[0].y}), pf0, o1, 0, 0, 0); \
        o0 = __builtin_amdgcn_mfma_f32_32x32x16_bf16(__builtin_bit_cast(bf16x8, (u32x4){Vc.l0[1].x, Vc.l0[1].y, Vc.h0[1].x, Vc.h0[1].y}), pf1, o0, 0, 0, 0); \
        o1 = __builtin_amdgcn_mfma_f32_32x32x16_bf16(__builtin_bit_cast(bf16x8, (u32x4){Vc.l1[1].x, Vc.l1[1].y, Vc.h1[1].x, Vc.h1[1].y}), pf1, o1, 0, 0, 0); \
    } while (0)
#define ATT_STEP(t, RL, RS) do { \
        if (!(AB & 32)) { const int tk_ = ((t) + 3 < nt) ? (t) + 3 : nt - 1, tv_ = ((t) + 2 < nt) ? (t) + 2 : nt - 1; gloadK(RL, tk_); gloadV(RL, tv_); } \
        ATT_HALF(t, 0, t, 1, kA, pa, pb); \
        ATT_HALF(t, 1, (t) + 1, 0, kB, pb, pa); \
        if (!(AB & 64)) lstoreK(RS, kC); if (!(AB & 8)) lstoreV(RS, ((t) + 1) & 1); \
        { const int k_ = kA; kA = kB; kB = kC; kC = k_; } \
        if (!(AB & 16)) __syncthreads(); \
    } while (0)
#pragma nounroll
    for (int t = 0; t < nt; t += 2) {
        ATT_STEP(t, RA, RB);
        if (t + 1 < nt) ATT_STEP(t + 1, RB, RA);
    }
#undef ATT_STEP
#undef ATT_HALF
    const float m_run = m_ref;
    float l_tot = xsum32(l_run);
    if (KIND == AT_SWA) l_tot += fexp2(((const GAS float*)A.sink)[hq] * LOG2E - m_run);
    const float rl = ((KIND == AT_MLA) ? SC_MLA : (KIND == AT_SWA) ? SC_SWA : SC_NA) / l_tot;
    const int ycol = (KIND == AT_MLA) ? (hq * 64) : (KIND == AT_SWA) ? (256 + hq * 64) : (512 + hq * 64);
    LAS unsigned char* ost = lds + 3 * KT_BYTES + 2 * VT_BYTES + 2048 + w * 4608;
#pragma unroll
    for (int q4 = 0; q4 < 4; ++q4) {
        u32x2 w0, w1;
        w0.x = cvt_pk_bf16(o0[4 * q4] * rl, o0[4 * q4 + 1] * rl); w0.y = cvt_pk_bf16(o0[4 * q4 + 2] * rl, o0[4 * q4 + 3] * rl);
        w1.x = cvt_pk_bf16(o1[4 * q4] * rl, o1[4 * q4 + 1] * rl); w1.y = cvt_pk_bf16(o1[4 * q4 + 2] * rl, o1[4 * q4 + 3] * rl);
        *(LAS u32x2*)(ost + r32 * 144 + (4 * hi + 8 * q4) * 2) = w0; *(LAS u32x2*)(ost + r32 * 144 + (32 + 4 * hi + 8 * q4) * 2) = w1;
    }
    LDS_WAIT(); asm volatile("" ::: "memory");
    const int qj0 = __builtin_amdgcn_readfirstlane(qj);
#pragma unroll
    for (int i = 0; i < 4; ++i) { const int rr = 8 * i + (lane >> 3), ch = lane & 7;
        *(GAS u32x4*)(A.Y + (rb + qj0 + rr) * DM + ycol + 8 * ch) = *(const LAS u32x4*)(ost + rr * 144 + 16 * ch); }
    LDS_WAIT(); asm volatile("" ::: "memory");
}
constexpr int RVS = 132;
struct RetArgs { const bf16_t* P; bf16_t* Y; float* RS; const float* decay_f; const float* decay_b; const float* gn_f; const float* gn_b; };
__device__ __forceinline__ float log2_sigmoid(float d) { return -log2f(1.0f + expf(-d)); }

struct RStage { u32x4 k[2], v[2]; };
__device__ __forceinline__ void ret_stage_load(RStage& S, const bf16_t* P, int unit, int tid) {
    const int c = unit % 66, bh = unit / 66, b = bh >> 2, h = bh & 3;
    const size_t row0 = (size_t)b * NB + 128 * c;
#pragma unroll
    for (int j = 0; j < 2; ++j) {
        const int q = tid + 512 * j, tok = q >> 3, dp = q & 7;
        const bf16_t* pr = P + (row0 + tok) * PW + h * 64 + dp * 8;
        S.k[j] = *(const GAS u32x4*)(pr + C_RK); S.v[j] = *(const GAS u32x4*)(pr + C_RV);
    }
}
__device__ __forceinline__ void ret_local_loop(Frame& F, const RetArgs& A, int u0, int ustep, int nunits) {
    int lane = lane_id(); asm volatile("" : "+v"(lane));
    const int w = F.wave, tid = w * 64 + lane, r32 = lane & 31, hi = lane >> 5;
    LAS bf16_t* Ktt = (LAS bf16_t*)F.lds;
    LAS bf16_t* Vtf = Ktt + 64 * RVS;
    LAS bf16_t* Vtb = Vtf + 64 * RVS;
    RStage S;
    int unit = u0;
    if (unit < nunits) ret_stage_load(S, A.P, unit, tid);
    while (unit < nunits) {
        const int c = unit % 66, bh = unit / 66, h = bh & 3;
        const float lgf = log2_sigmoid(((const GAS float*)A.decay_f)[h]), lgb = log2_sigmoid(((const GAS float*)A.decay_b)[h]);
#pragma unroll
        for (int j = 0; j < 2; ++j) {
            const int q = tid + 512 * j, tok = q >> 3, dp = q & 7;
            const float wf = fexp2(lgf * (float)(127 - tok)), wb = fexp2(lgb * (float)tok);
            LAS bf16_t* kt = Ktt + (8 * dp) * RVS + tok; LAS bf16_t* vf = Vtf + (8 * dp) * RVS + tok; LAS bf16_t* vb = Vtb + (8 * dp) * RVS + tok;
            const unsigned kw[4] = {S.k[j].x, S.k[j].y, S.k[j].z, S.k[j].w}, vw[4] = {S.v[j].x, S.v[j].y, S.v[j].z, S.v[j].w};
#pragma unroll
            for (int e = 0; e < 4; ++e) {
                kt[(2 * e) * RVS] = (bf16_t)(kw[e] & 0xffffu); kt[(2 * e + 1) * RVS] = (bf16_t)(kw[e] >> 16);
                const float v0 = bf_lo(vw[e]), v1 = bf_hi(vw[e]);
                const unsigned pf = cvt_pk_bf16(v0 * wf, v1 * wf), pb = cvt_pk_bf16(v0 * wb, v1 * wb);
                vf[(2 * e) * RVS] = (bf16_t)(pf & 0xffffu); vf[(2 * e + 1) * RVS] = (bf16_t)(pf >> 16);
                vb[(2 * e) * RVS] = (bf16_t)(pb & 0xffffu); vb[(2 * e + 1) * RVS] = (bf16_t)(pb >> 16);
            }
        }
        const int unext = unit + ustep;
        if (unext < nunits) ret_stage_load(S, A.P, unext, tid);
        __syncthreads();
        const int dir = w >> 2, dvb = (w >> 1) & 1, dkb = w & 1;
        const LAS bf16_t* va = (dir ? Vtb : Vtf) + (32 * dvb + r32) * RVS + 8 * hi;
        const LAS bf16_t* kb = Ktt + (32 * dkb + r32) * RVS + 8 * hi;
        f32x16 acc;
#pragma unroll
        for (int r = 0; r < 16; ++r) acc[r] = 0.f;
#pragma unroll
        for (int s = 0; s < 8; ++s) {
            const u32x2 a0 = *(const LAS u32x2*)(va + 16 * s), a1 = *(const LAS u32x2*)(va + 16 * s + 4);
            const u32x2 b0 = *(const LAS u32x2*)(kb + 16 * s), b1 = *(const LAS u32x2*)(kb + 16 * s + 4);
            acc = __builtin_amdgcn_mfma_f32_32x32x16_bf16(__builtin_bit_cast(bf16x8, (u32x4){a0.x, a0.y, a1.x, a1.y}), __builtin_bit_cast(bf16x8, (u32x4){b0.x, b0.y, b1.x, b1.y}), acc, 0, 0, 0);
        }
        GAS float* out = (GAS float*)A.RS + ((size_t)(bh * 2 + dir) * 66 + c) * 4096 + 32 * dkb + r32;
#pragma unroll
        for (int r = 0; r < 16; ++r) out[(32 * dvb + crow(r, hi)) * 64] = acc[r];
        __syncthreads();
        unit = unext;
    }
}

__device__ __forceinline__ void ret_scan(Frame& F, const RetArgs& A) {
    for (int e = blockIdx.x * NTHR + F.tid; e < 32 * 4096; e += F.G * NTHR) {
        const int seq = e >> 12, el = e & 4095, dir = seq & 1, h = (seq >> 1) & 3;
        const float a = fexp2(128.0f * log2_sigmoid(dir ? ((const GAS float*)A.decay_b)[h] : ((const GAS float*)A.decay_f)[h]));
        GAS float* base = (GAS float*)A.RS + (size_t)seq * 66 * 4096 + el;
        float s = 0.f;
#pragma nounroll
        for (int n0 = 0; n0 < 66; n0 += 11) {
            int nb = n0; asm volatile("" : "+s"(nb));
            float u[11];
#pragma unroll
            for (int i = 0; i < 11; ++i) { const int n = nb + i; const int c = dir ? ((n < 2) ? 1 - n : 67 - n) : n; u[i] = base[(size_t)c * 4096]; }
#pragma unroll
            for (int i = 0; i < 11; ++i) { const int n = nb + i; const int c = dir ? ((n < 2) ? 1 - n : 67 - n) : n; base[(size_t)c * 4096] = s; s = a * s + u[i]; }
        }
    }
}

struct RStage3 { u32x4 k[2], v[2], q[2]; f32x4 st[4]; };
__device__ __forceinline__ void ret_stage_load3(RStage3& S, const bf16_t* P, const float* RS, int unit, int tid) {
    const int c = unit % 66, bh = unit / 66, b = bh >> 2, h = bh & 3;
    const size_t row0 = (size_t)b * NB + 128 * c;
#pragma unroll
    for (int j = 0; j < 2; ++j) {
        const int q = tid + 512 * j, tok = q >> 3, dp = q & 7;
        const bf16_t* pr = P + (row0 + tok) * PW + h * 64 + dp * 8;
        S.k[j] = *(const GAS u32x4*)(pr + C_RK); S.v[j] = *(const GAS u32x4*)(pr + C_RV); S.q[j] = *(const GAS u32x4*)(pr + C_RQ);
    }
#pragma unroll
    for (int k = 0; k < 4; ++k) S.st[k] = ((const GAS f32x4*)(RS + ((size_t)(bh * 2 + (k >> 1)) * 66 + c) * 4096))[tid + 512 * (k & 1)];
}
__device__ __forceinline__ void ret_out_loop(Frame& F, const RetArgs& A, int u0, int ustep, int nunits, bool skipctx) {
    int lane = lane_id(); asm volatile("" : "+v"(lane));
    const int w = F.wave, tid = w * 64 + lane, r32 = lane & 31, hi = lane >> 5;
    constexpr int KS = 72;
    LAS unsigned char* Kc = F.lds;
    LAS bf16_t* Vt = (LAS bf16_t*)(F.lds + 128 * KS * 2);
    LAS float* comb = (LAS float*)(F.lds + 128 * KS * 2 + 64 * RVS * 2);
    auto nextu = [&](int u) { u += ustep; while (skipctx && u < nunits && (u % 66) < 2) u += ustep; return u; };
    int unit = u0; while (skipctx && unit < nunits && (unit % 66) < 2) unit += ustep;
    LAS float* Sst = comb + 128 * 65;
    LAS unsigned char* Qc = (LAS unsigned char*)(Sst + 2 * 64 * 68);
    RStage3 S;
    if (unit < nunits) ret_stage_load3(S, A.P, A.RS, unit, tid);
    LAS float* gnl = (LAS float*)(F.lds + 122880);
    gnl[tid] = (tid < 256) ? ((const GAS float*)A.gn_f)[tid] : ((const GAS float*)A.gn_b)[tid - 256];
    __syncthreads();
    while (unit < nunits) {
    const int c = unit % 66, bh = unit / 66, b = bh >> 2, h = bh & 3;
    const size_t row0 = (size_t)b * NB + 128 * c;
    const int dir = w >> 2, qg = w & 3, qi = 32 * qg + r32;
    const bf16_t* prow = A.P + (row0 + qi) * PW;
#pragma unroll
    for (int j = 0; j < 2; ++j) {
        const int q = tid + 512 * j, tok = q >> 3, dp = q & 7;
        *(LAS u32x4*)(Kc + tok * (KS * 2) + dp * 16) = S.k[j];
        *(LAS u32x4*)(Qc + tok * (KS * 2) + dp * 16) = S.q[j];
        const u32x4 vv = S.v[j];
        LAS bf16_t* vt = Vt + (8 * dp) * RVS + tok;
        vt[0 * RVS] = (bf16_t)(vv.x & 0xffffu); vt[1 * RVS] = (bf16_t)(vv.x >> 16); vt[2 * RVS] = (bf16_t)(vv.y & 0xffffu); vt[3 * RVS] = (bf16_t)(vv.y >> 16);
        vt[4 * RVS] = (bf16_t)(vv.z & 0xffffu); vt[5 * RVS] = (bf16_t)(vv.z >> 16); vt[6 * RVS] = (bf16_t)(vv.w & 0xffffu); vt[7 * RVS] = (bf16_t)(vv.w >> 16);
    }
#pragma unroll
    for (int k = 0; k < 4; ++k) { const int e4 = tid + 512 * (k & 1); *(LAS f32x4*)(Sst + (k >> 1) * (64 * 68) + (e4 >> 4) * 68 + (e4 & 15) * 4) = S.st[k]; }
    const int unext = nextu(unit);
    if (unext < nunits) ret_stage_load3(S, A.P, A.RS, unext, tid);
    const float lg = log2_sigmoid(dir ? ((const GAS float*)A.decay_b)[h] : ((const GAS float*)A.decay_f)[h]);
    f32x16 o0, o1;
#pragma unroll
    for (int r = 0; r < 16; ++r) { o0[r] = 0.f; o1[r] = 0.f; }
    __syncthreads();
    bf16x8 qr[4];
#pragma unroll
    for (int s = 0; s < 4; ++s) qr[s] = *(const LAS bf16x8*)(Qc + qi * (KS * 2) + hi * 16 + s * 32);
    { const LAS float* sp = Sst + dir * (64 * 68) + r32 * 68 + 8 * hi;
#pragma unroll
    for (int s = 0; s < 4; ++s) {
        const f32x4 a0 = *(const LAS f32x4*)(sp + 16 * s), a1 = *(const LAS f32x4*)(sp + 16 * s + 4), b0 = *(const LAS f32x4*)(sp + 32 * 68 + 16 * s), b1 = *(const LAS f32x4*)(sp + 32 * 68 + 16 * s + 4);
        const bf16x8 fa = __builtin_bit_cast(bf16x8, (u32x4){cvt_pk_bf16(a0[0], a0[1]), cvt_pk_bf16(a0[2], a0[3]), cvt_pk_bf16(a1[0], a1[1]), cvt_pk_bf16(a1[2], a1[3])});
        const bf16x8 fb = __builtin_bit_cast(bf16x8, (u32x4){cvt_pk_bf16(b0[0], b0[1]), cvt_pk_bf16(b0[2], b0[3]), cvt_pk_bf16(b1[0], b1[1]), cvt_pk_bf16(b1[2], b1[3])});
        o0 = __builtin_amdgcn_mfma_f32_32x32x16_bf16(fa, qr[s], o0, 0, 0, 0);
        o1 = __builtin_amdgcn_mfma_f32_32x32x16_bf16(fb, qr[s], o1, 0, 0, 0);
    } }
    { const float qdec = fexp2(lg * (float)(dir ? (128 - qi) : (qi + 1)));
#pragma unroll
      for (int r = 0; r < 16; ++r) { o0[r] *= qdec; o1[r] *= qdec; } }
#pragma unroll
    for (int kt = 0; kt < 2; ++kt) {
        const bool need = dir ? (64 * kt + 63 >= 32 * qg) : (64 * kt <= 32 * qg + 31);
        if (!need) continue;
        f32x16 p0, p1;
#pragma unroll
        for (int r = 0; r < 16; ++r) { p0[r] = 0.f; p1[r] = 0.f; }
        const LAS unsigned char* kb = Kc + (64 * kt + r32) * (KS * 2) + hi * 16;
#pragma unroll
        for (int s = 0; s < 4; ++s) {
            const bf16x8 a0 = *(const LAS bf16x8*)(kb + s * 32), a1 = *(const LAS bf16x8*)(kb + 32 * (KS * 2) + s * 32);
            p0 = __builtin_amdgcn_mfma_f32_32x32x16_bf16(a0, qr[s], p0, 0, 0, 0);
            p1 = __builtin_amdgcn_mfma_f32_32x32x16_bf16(a1, qr[s], p1, 0, 0, 0);
        }
#pragma unroll
        for (int r = 0; r < 16; ++r) {
            const int j0 = 64 * kt + crow(r, hi), j1 = j0 + 32;
            const int d0 = dir ? (j0 - qi) : (qi - j0), d1 = dir ? (j1 - qi) : (qi - j1);
            p0[r] = (d0 >= 0) ? p0[r] * fexp2(lg * (float)d0) : 0.f;
            p1[r] = (d1 >= 0) ? p1[r] * fexp2(lg * (float)d1) : 0.f;
        }
        u32x4 pw[4];
        pw[0] = (u32x4){cvt_pk_bf16(p0[0], p0[1]), cvt_pk_bf16(p0[2], p0[3]), cvt_pk_bf16(p0[4], p0[5]), cvt_pk_bf16(p0[6], p0[7])};
        pw[1] = (u32x4){cvt_pk_bf16(p0[8], p0[9]), cvt_pk_bf16(p0[10], p0[11]), cvt_pk_bf16(p0[12], p0[13]), cvt_pk_bf16(p0[14], p0[15])};
        pw[2] = (u32x4){cvt_pk_bf16(p1[0], p1[1]), cvt_pk_bf16(p1[2], p1[3]), cvt_pk_bf16(p1[4], p1[5]), cvt_pk_bf16(p1[6], p1[7])};
        pw[3] = (u32x4){cvt_pk_bf16(p1[8], p1[9]), cvt_pk_bf16(p1[10], p1[11]), cvt_pk_bf16(p1[12], p1[13]), cvt_pk_bf16(p1[14], p1[15])};
        const LAS bf16_t* vb = Vt + r32 * RVS + 64 * kt + 4 * hi;
#pragma unroll
        for (int s = 0; s < 4; ++s) {
            const u32x2 l0 = *(const LAS u32x2*)(vb + 16 * s), h0 = *(const LAS u32x2*)(vb + 16 * s + 8);
            const u32x2 l1 = *(const LAS u32x2*)(vb + 32 * RVS + 16 * s), h1 = *(const LAS u32x2*)(vb + 32 * RVS + 16 * s + 8);
            const bf16x8 pf = __builtin_bit_cast(bf16x8, pw[s]);
            o0 = __builtin_amdgcn_mfma_f32_32x32x16_bf16(__builtin_bit_cast(bf16x8, (u32x4){l0.x, l0.y, h0.x, h0.y}), pf, o0, 0, 0, 0);
            o1 = __builtin_amdgcn_mfma_f32_32x32x16_bf16(__builtin_bit_cast(bf16x8, (u32x4){l1.x, l1.y, h1.x, h1.y}), pf, o1, 0, 0, 0);
        }
    }
    float sum = 0.f;
#pragma unroll
    for (int r = 0; r < 16; ++r) sum += o0[r] + o1[r];
    sum = xsum32(sum);
    const float mu = sum * (1.f / 64.f);
    float var = 0.f;
#pragma unroll
    for (int r = 0; r < 16; ++r) { o0[r] -= mu; o1[r] -= mu; var += o0[r] * o0[r] + o1[r] * o1[r]; }
    var = xsum32(var);
    const float rstd = 1.0f / sqrtf(var * (1.f / 64.f) + EPS);
    const LAS float* gn = gnl + dir * 256 + h * 64 + 4 * hi;
    const bf16_t* gp = prow + (dir ? C_RGB : C_RGF) + h * 64 + 4 * hi;
    LAS float* cb = comb + qi * 65 + 4 * hi;
    if (dir == 1) {
#pragma unroll
        for (int q4 = 0; q4 < 4; ++q4)
#pragma unroll
            for (int half = 0; half < 2; ++half) {
                const int d = 8 * q4 + 32 * half; const f32x4 g4 = *(const LAS f32x4*)(gn + d); const u32x2 gw = *(const GAS u32x2*)(gp + d);
                const float gt[4] = {bf_lo(gw.x), bf_hi(gw.x), bf_lo(gw.y), bf_hi(gw.y)};
#pragma unroll
                for (int e = 0; e < 4; ++e) { const float ov = half ? o1[4 * q4 + e] : o0[4 * q4 + e]; cb[d + e] = silu_f(gt[e]) * (ov * rstd) * g4[e]; }
            }
    }
    __syncthreads();
    if (dir == 0) {
#pragma unroll
        for (int q4 = 0; q4 < 4; ++q4)
#pragma unroll
            for (int half = 0; half < 2; ++half) {
                const int d = 8 * q4 + 32 * half; const f32x4 g4 = *(const LAS f32x4*)(gn + d); const u32x2 gw = *(const GAS u32x2*)(gp + d);
                const float gt[4] = {bf_lo(gw.x), bf_hi(gw.x), bf_lo(gw.y), bf_hi(gw.y)};
                float y[4];
#pragma unroll
                for (int e = 0; e < 4; ++e) { const float ov = half ? o1[4 * q4 + e] : o0[4 * q4 + e]; y[e] = silu_f(gt[e]) * (ov * rstd) * g4[e] + cb[d + e]; }
                u32x2 wv; wv.x = cvt_pk_bf16(y[0], y[1]); wv.y = cvt_pk_bf16(y[2], y[3]); *(LAS u32x2*)(Qc + qi * (KS * 2) + (d + 4 * hi) * 2) = wv;
            }
    }
    __syncthreads();
#pragma unroll
    for (int j = 0; j < 2; ++j) { const int q = tid + 512 * j, tok = q >> 3, dp = q & 7;
        *(GAS u32x4*)(A.Y + (row0 + tok) * DM + 768 + h * 64 + 8 * dp) = *(const LAS u32x4*)(Qc + tok * (KS * 2) + dp * 16); }
    __syncthreads();
    unit = unext;
    }
}
#define CE(a, i, j) do { const float hi_ = fmaxf(a[i], a[j]), lo_ = fminf(a[i], a[j]); a[i] = hi_; a[j] = lo_; } while (0)
#define SORT16(a) do { CE(a,0,13); CE(a,1,12); CE(a,2,15); CE(a,3,14); CE(a,4,8); CE(a,5,6); CE(a,7,11); CE(a,9,10); CE(a,0,5); CE(a,1,7); CE(a,2,9); CE(a,3,4); CE(a,6,13); CE(a,8,14); CE(a,10,15); CE(a,11,12); CE(a,0,1); CE(a,2,3); CE(a,4,5); CE(a,6,8); CE(a,7,9); CE(a,10,11); CE(a,12,13); CE(a,14,15); CE(a,0,2); CE(a,1,3); CE(a,4,10); CE(a,5,11); CE(a,6,7); CE(a,8,9); CE(a,12,14); CE(a,13,15); CE(a,1,2); CE(a,3,12); CE(a,4,6); CE(a,5,7); CE(a,8,10); CE(a,9,11); CE(a,13,14); CE(a,1,4); CE(a,2,6); CE(a,5,8); CE(a,7,10); CE(a,9,13); CE(a,11,14); CE(a,2,4); CE(a,3,6); CE(a,9,12); CE(a,11,13); CE(a,3,5); CE(a,6,8); CE(a,7,9); CE(a,10,12); CE(a,3,4); CE(a,5,6); CE(a,7,8); CE(a,9,10); CE(a,11,12); CE(a,6,7); CE(a,8,9); } while (0)
#define MERGE16(T, C) do { T[0] = fmaxf(T[0], C[15]); T[1] = fmaxf(T[1], C[14]); T[2] = fmaxf(T[2], C[13]); T[3] = fmaxf(T[3], C[12]); T[4] = fmaxf(T[4], C[11]); T[5] = fmaxf(T[5], C[10]); T[6] = fmaxf(T[6], C[9]); T[7] = fmaxf(T[7], C[8]); T[8] = fmaxf(T[8], C[7]); T[9] = fmaxf(T[9], C[6]); T[10] = fmaxf(T[10], C[5]); T[11] = fmaxf(T[11], C[4]); T[12] = fmaxf(T[12], C[3]); T[13] = fmaxf(T[13], C[2]); T[14] = fmaxf(T[14], C[1]); T[15] = fmaxf(T[15], C[0]); CE(T,0,8); CE(T,1,9); CE(T,2,10); CE(T,3,11); CE(T,4,12); CE(T,5,13); CE(T,6,14); CE(T,7,15); CE(T,0,4); CE(T,1,5); CE(T,2,6); CE(T,3,7); CE(T,8,12); CE(T,9,13); CE(T,10,14); CE(T,11,15); CE(T,0,2); CE(T,1,3); CE(T,4,6); CE(T,5,7); CE(T,8,10); CE(T,9,11); CE(T,12,14); CE(T,13,15); CE(T,0,1); CE(T,2,3); CE(T,4,5); CE(T,6,7); CE(T,8,9); CE(T,10,11); CE(T,12,13); CE(T,14,15); } while (0)

__device__ __forceinline__ void phase_topk(Frame& F, const _Float16* S16, int* eid, float* gate, bool skipctx) {
    LAS unsigned char* timg = F.lds + F.wave * 11264;
    LAS unsigned char* ilds = F.lds + F.wave * 11264 + 9216 + F.lane;
    const int lane = F.lane, gwv = F.vcu * NWAVES + F.wave, NGW = F.G * NWAVES;
    for (int wt = gwv; wt < NROW / 8; wt += NGW) {
        const int row0 = 8 * wt;
        if (skipctx && (row0 % NB) < CTXL) continue;
        const int row = row0 + (lane >> 3), h = lane & 7;
        const GAS unsigned char* blk = (const GAS unsigned char*)(S16 + (size_t)row0 * 2048);
        float v1[16], v2[16];
#pragma unroll
        for (int hf = 0; hf < 2; ++hf) {
            float T[16];
#pragma unroll
            for (int i = 0; i < 16; ++i) T[i] = -3.0e38f;
#pragma unroll
            for (int qq = 0; qq < 2; ++qq) {
                const int q = 2 * hf + qq;
                u32x4 ld[8];
#pragma unroll
                for (int i = 0; i < 8; ++i) ld[i] = *(const GAS u32x4*)(blk + (size_t)(8 * i + (lane >> 3)) * 512 + 128 * q + 16 * (lane & 7));
#pragma unroll
                for (int i = 0; i < 8; ++i) *(LAS u32x4*)(timg + (8 * i + (lane >> 3)) * 144 + 16 * (lane & 7)) = ld[i];
                LDS_WAIT(); asm volatile("" ::: "memory");
#pragma unroll
                for (int ch = 0; ch < 4; ++ch) {
                    const u32x4 a = *(const LAS u32x4*)(timg + lane * 144 + 32 * ch), b = *(const LAS u32x4*)(timg + lane * 144 + 32 * ch + 16);
                    const unsigned wv[8] = {a.x, a.y, a.z, a.w, b.x, b.y, b.z, b.w};
                    const unsigned nb = 127u - 64u * (unsigned)qq - 16u * (unsigned)ch;
                    float c[16];
#pragma unroll
                    for (int e = 0; e < 8; ++e) {
                        typedef _Float16 h2 __attribute__((ext_vector_type(2)));
                        const h2 p = __builtin_bit_cast(h2, wv[e]);
                        c[2 * e] = __uint_as_float((__float_as_uint((float)p[0]) & ~0x7Fu) | (nb - 2 * e));
                        c[2 * e + 1] = __uint_as_float((__float_as_uint((float)p[1]) & ~0x7Fu) | (nb - 2 * e - 1));
                    }
                    SORT16(c); MERGE16(T, c);
                }
                LDS_WAIT(); asm volatile("" ::: "memory");
            }
#pragma unroll
            for (int i = 0; i < 16; ++i) { const unsigned bits = __float_as_uint(T[i]); ilds[(16 * hf + i) * 64] = (unsigned char)(127u - (bits & 0x7Fu)); (hf ? v2[i] : v1[i]) = __uint_as_float(bits & ~0x7Fu); }
        }
        float cs[16];
#pragma unroll
        for (int i = 0; i < 16; ++i) cs[i] = -3.0e38f;
        { float c[16];
        { c[0] = __uint_as_float((__float_as_uint(v1[0] + v2[0]) & ~0xFFu) | 255u); c[1] = __uint_as_float((__float_as_uint(v1[0] + v2[1]) & ~0xFFu) | 254u); c[2] = __uint_as_float((__float_as_uint(v1[0] + v2[2]) & ~0xFFu) | 253u); c[3] = __uint_as_float((__float_as_uint(v1[0] + v2[3]) & ~0xFFu) | 252u); c[4] = __uint_as_float((__float_as_uint(v1[0] + v2[4]) & ~0xFFu) | 251u); c[5] = __uint_as_float((__float_as_uint(v1[0] + v2[5]) & ~0xFFu) | 250u); c[6] = __uint_as_float((__float_as_uint(v1[0] + v2[6]) & ~0xFFu) | 249u); c[7] = __uint_as_float((__float_as_uint(v1[0] + v2[7]) & ~0xFFu) | 248u); c[8] = __uint_as_float((__float_as_uint(v1[0] + v2[8]) & ~0xFFu) | 247u); c[9] = __uint_as_float((__float_as_uint(v1[0] + v2[9]) & ~0xFFu) | 246u); c[10] = __uint_as_float((__float_as_uint(v1[0] + v2[10]) & ~0xFFu) | 245u); c[11] = __uint_as_float((__float_as_uint(v1[0] + v2[11]) & ~0xFFu) | 244u); c[12] = __uint_as_float((__float_as_uint(v1[0] + v2[12]) & ~0xFFu) | 243u); c[13] = __uint_as_float((__float_as_uint(v1[0] + v2[13]) & ~0xFFu) | 242u); c[14] = __uint_as_float((__float_as_uint(v1[0] + v2[14]) & ~0xFFu) | 241u); c[15] = __uint_as_float((__float_as_uint(v1[0] + v2[15]) & ~0xFFu) | 240u); SORT16(c); MERGE16(cs, c); }
        { c[0] = __uint_as_float((__float_as_uint(v1[1] + v2[0]) & ~0xFFu) | 239u); c[1] = __uint_as_float((__float_as_uint(v1[1] + v2[1]) & ~0xFFu) | 238u); c[2] = __uint_as_float((__float_as_uint(v1[1] + v2[2]) & ~0xFFu) | 237u); c[3] = __uint_as_float((__float_as_uint(v1[1] + v2[3]) & ~0xFFu) | 236u); c[4] = __uint_as_float((__float_as_uint(v1[1] + v2[4]) & ~0xFFu) | 235u); c[5] = __uint_as_float((__float_as_uint(v1[1] + v2[5]) & ~0xFFu) | 234u); c[6] = __uint_as_float((__float_as_uint(v1[1] + v2[6]) & ~0xFFu) | 233u); c[7] = __uint_as_float((__float_as_uint(v1[1] + v2[7]) & ~0xFFu) | 232u); c[8] = __uint_as_float((__float_as_uint(v1[2] + v2[0]) & ~0xFFu) | 223u); c[9] = __uint_as_float((__float_as_uint(v1[2] + v2[1]) & ~0xFFu) | 222u); c[10] = __uint_as_float((__float_as_uint(v1[2] + v2[2]) & ~0xFFu) | 221u); c[11] = __uint_as_float((__float_as_uint(v1[2] + v2[3]) & ~0xFFu) | 220u); c[12] = __uint_as_float((__float_as_uint(v1[2] + v2[4]) & ~0xFFu) | 219u); c[13] = __uint_as_float((__float_as_uint(v1[3] + v2[0]) & ~0xFFu) | 207u); c[14] = __uint_as_float((__float_as_uint(v1[3] + v2[1]) & ~0xFFu) | 206u); c[15] = __uint_as_float((__float_as_uint(v1[3] + v2[2]) & ~0xFFu) | 205u); SORT16(c); MERGE16(cs, c); }
        { c[0] = __uint_as_float((__float_as_uint(v1[3] + v2[3]) & ~0xFFu) | 204u); c[1] = __uint_as_float((__float_as_uint(v1[4] + v2[0]) & ~0xFFu) | 191u); c[2] = __uint_as_float((__float_as_uint(v1[4] + v2[1]) & ~0xFFu) | 190u); c[3] = __uint_as_float((__float_as_uint(v1[4] + v2[2]) & ~0xFFu) | 189u); c[4] = __uint_as_float((__float_as_uint(v1[5] + v2[0]) & ~0xFFu) | 175u); c[5] = __uint_as_float((__float_as_uint(v1[5] + v2[1]) & ~0xFFu) | 174u); c[6] = __uint_as_float((__float_as_uint(v1[6] + v2[0]) & ~0xFFu) | 159u); c[7] = __uint_as_float((__float_as_uint(v1[6] + v2[1]) & ~0xFFu) | 158u); c[8] = __uint_as_float((__float_as_uint(v1[7] + v2[0]) & ~0xFFu) | 143u); c[9] = __uint_as_float((__float_as_uint(v1[7] + v2[1]) & ~0xFFu) | 142u); c[10] = __uint_as_float((__float_as_uint(v1[8] + v2[0]) & ~0xFFu) | 127u); c[11] = __uint_as_float((__float_as_uint(v1[9] + v2[0]) & ~0xFFu) | 111u); c[12] = __uint_as_float((__float_as_uint(v1[10] + v2[0]) & ~0xFFu) | 95u); c[13] = __uint_as_float((__float_as_uint(v1[11] + v2[0]) & ~0xFFu) | 79u); c[14] = __uint_as_float((__float_as_uint(v1[12] + v2[0]) & ~0xFFu) | 63u); c[15] = __uint_as_float((__float_as_uint(v1[13] + v2[0]) & ~0xFFu) | 47u); SORT16(c); MERGE16(cs, c); }
        { c[0] = __uint_as_float((__float_as_uint(v1[14] + v2[0]) & ~0xFFu) | 31u); c[1] = __uint_as_float((__float_as_uint(v1[15] + v2[0]) & ~0xFFu) | 15u); c[2] = -3.0e38f; c[3] = -3.0e38f; c[4] = -3.0e38f; c[5] = -3.0e38f; c[6] = -3.0e38f; c[7] = -3.0e38f; c[8] = -3.0e38f; c[9] = -3.0e38f; c[10] = -3.0e38f; c[11] = -3.0e38f; c[12] = -3.0e38f; c[13] = -3.0e38f; c[14] = -3.0e38f; c[15] = -3.0e38f; SORT16(c); MERGE16(cs, c); }
        }
        float ev[16]; float den = 0.f;
        const float top = __uint_as_float(__float_as_uint(cs[0]) & ~0xFFu);
#pragma unroll
        for (int k = 0; k < 16; ++k) { ev[k] = __expf(__uint_as_float(__float_as_uint(cs[k]) & ~0xFFu) - top); den += ev[k]; }
        const float rden = 1.0f / den;
        LDS_WAIT(); asm volatile("" ::: "memory");
        int eo[16]; float go[16];
#pragma unroll
        for (int k = 0; k < 16; ++k) { const int pos = 255 - (int)(__float_as_uint(cs[k]) & 0xFFu); eo[k] = ((int)ilds[(pos >> 4) * 64] * 128 + (int)ilds[(16 + (pos & 15)) * 64]) * 128; go[k] = ev[k] * rden; }
        LAS u32x4* img = (LAS u32x4*)timg;
#pragma unroll
        for (int q = 0; q < 4; ++q) { img[lane * 4 + q] = (u32x4){(unsigned)eo[4 * q], (unsigned)eo[4 * q + 1], (unsigned)eo[4 * q + 2], (unsigned)eo[4 * q + 3]};
            img[256 + lane * 4 + q] = (u32x4){__float_as_uint(go[4 * q]), __float_as_uint(go[4 * q + 1]), __float_as_uint(go[4 * q + 2]), __float_as_uint(go[4 * q + 3])}; }
        LDS_WAIT(); asm volatile("" ::: "memory");
        GAS u32x4* eg = (GAS u32x4*)((GAS int*)eid + (size_t)row0 * 128); GAS u32x4* gg = (GAS u32x4*)((GAS float*)gate + (size_t)row0 * 128);
#pragma unroll
        for (int q = 0; q < 4; ++q) { eg[64 * q + lane] = img[64 * q + lane]; gg[64 * q + lane] = img[256 + 64 * q + lane]; }
        LDS_WAIT(); asm volatile("" ::: "memory");
    }
}

constexpr float U8_SCALE = 896.0f, V8_SCALE = 4.0f;
typedef _Float16 h2_t __attribute__((ext_vector_type(2)));
__device__ __forceinline__ h2_t fp8x2_to_h2(unsigned w, bool hi) { return hi ? __builtin_amdgcn_cvt_scalef32_pk_f16_fp8(w, 1.0f, true) : __builtin_amdgcn_cvt_scalef32_pk_f16_fp8(w, 1.0f, false); }
#define VM_WAIT_ALL() do { asm volatile("" ::: "memory"); __builtin_amdgcn_s_waitcnt(0x0F70); asm volatile("" ::: "memory"); } while (0)
__device__ __forceinline__ void peer_gather(u32x4 (&t)[16], const char* tb, const LAS unsigned char* slot, int g) {
    const LAS u32x4* ep = (const LAS u32x4*)(slot + 64 * g);
    u32x4 e[4];
#pragma unroll
    for (int i = 0; i < 4; ++i) e[i] = ep[i];
#pragma unroll
    for (int i = 0; i < 4; ++i) { t[4 * i] = *(const GAS u32x4*)(tb + e[i].x); t[4 * i + 1] = *(const GAS u32x4*)(tb + e[i].y); t[4 * i + 2] = *(const GAS u32x4*)(tb + e[i].z); t[4 * i + 3] = *(const GAS u32x4*)(tb + e[i].w); }
}
__device__ __forceinline__ h2_t bf8e(unsigned d) { const unsigned r = __builtin_amdgcn_perm(0u, d, 0x020c000cu); return __builtin_bit_cast(h2_t, r); }
__device__ __forceinline__ h2_t bf8o(unsigned d) { const unsigned r = d & 0xff00ff00u; return __builtin_bit_cast(h2_t, r); }
__device__ __forceinline__ int dot16_i8(const u32x4 t, const u32x4 x) {
    return __builtin_amdgcn_sdot4((int)t.x, (int)x.x, __builtin_amdgcn_sdot4((int)t.y, (int)x.y, __builtin_amdgcn_sdot4((int)t.z, (int)x.z, __builtin_amdgcn_sdot4((int)t.w, (int)x.w, 0, false), false), false), false);
}
__device__ __forceinline__ void peer_u_dma(LAS unsigned char* slot, const unsigned* eoff, const unsigned char* XQ, const float* XSC, int r, int xq, int lane) {
    const unsigned char* src = lane < 32 ? (const unsigned char*)eoff + (size_t)r * 512 + 16 * lane
                             : (lane < 40 ? XQ + (size_t)r * DM + xq * 128 + 16 * (lane - 32) : (const unsigned char*)XSC + (size_t)r * 16);
    __builtin_amdgcn_global_load_lds((const GAS unsigned*)src, (LAS unsigned*)slot, 16, 0, 0);
}
__device__ __forceinline__ unsigned peer_u_compute(const u32x4 (&t)[16], const u32x4 x, const float xs, int lane) {
    float part[16];
#pragma unroll
    for (int i = 0; i < 16; ++i) part[i] = (float)dot16_i8(t[i], x);
    float p8[8], p4[4], p2[2];
    { const bool up = (lane & 4) != 0;
#pragma unroll
      for (int q = 0; q < 8; ++q) { const float keep = up ? part[q + 8] : part[q], send = up ? part[q] : part[q + 8]; p8[q] = keep + xshfl<4>(send); } }
    { const bool up = (lane & 2) != 0;
#pragma unroll
      for (int q = 0; q < 4; ++q) { const float keep = up ? p8[q + 4] : p8[q], send = up ? p8[q] : p8[q + 4]; p4[q] = keep + xshfl<2>(send); } }
    { const bool up = (lane & 1) != 0;
#pragma unroll
      for (int q = 0; q < 2; ++q) { const float keep = up ? p4[q + 2] : p4[q], send = up ? p4[q] : p4[q + 2]; p2[q] = keep + xshfl<1>(send); } }
    return cvt_pk_bf16(p2[0] * xs, p2[1] * xs);
}
__device__ __forceinline__ int peer_next_row(int r, int step, bool skipctx) { r += step; if (skipctx && r < NROW && (r % NB) < CTXL) r += ((CTXL - (r % NB) + step - 1) / step) * step; return r; }
template <bool DUMMY = false>
__device__ __forceinline__ void phase_peer_u(Frame& F, const unsigned char* XQ, const float* XSC, const unsigned char* U8, const unsigned* eoff, float* PART, bool skipctx) {
    const int lane = F.lane, xq = blockIdx.x & 7, rank = blockIdx.x >> 3, nr = (F.G - xq + 7) >> 3, step = nr * NWAVES;
    const int g = lane >> 3, c8 = lane & 7;
    const char* ub = (const char*)U8 + (size_t)xq * ((size_t)NEXP * 128) + c8 * 16;
    LAS unsigned char* ring = F.lds + F.wave * 4096;
    int rA = peer_next_row(rank * NWAVES + F.wave - step, step, skipctx);
    if (rA >= NROW) return;
    int rB = peer_next_row(rA, step, skipctx), i = 0;
    peer_u_dma(ring, eoff, XQ, XSC, rA, xq, lane);
    peer_u_dma(ring + 1024, eoff, XQ, XSC, rB < NROW ? rB : rA, xq, lane);
    VM_WAIT_ALL();
    u32x4 T0[16], T1[16];
    peer_gather(T0, ub, ring, g);
    GAS unsigned* const pout = (GAS unsigned*)PART + (size_t)xq * NROW * 64 + 8 * g + c8;
    unsigned res = 0u; int rP = -1;
#define PEER_U_STEP(TC, TN) { \
        const int rC = peer_next_row(rB, step, skipctx); \
        VM_WAIT_ALL(); \
        const LAS unsigned char* sa = ring + (i & 3) * 1024; \
        const u32x4 x = *(const LAS u32x4*)(sa + 512 + 16 * c8); const float xs = *(const LAS float*)(sa + 640); \
        peer_u_dma(ring + ((i + 2) & 3) * 1024, eoff, XQ, XSC, rC < NROW ? rC : rB, xq, lane); \
        peer_gather(TN, ub, ring + ((i + 1) & 3) * 1024, g); \
        if (rP >= 0) pout[(size_t)rP * 64] = res; \
        res = peer_u_compute(TC, x, xs, lane); rP = rA; \
        rA = rB; rB = rC; ++i; }
#define PEER_U_TAIL(TC) { VM_WAIT_ALL(); const LAS unsigned char* sa = ring + (i & 3) * 1024; \
        const u32x4 x = *(const LAS u32x4*)(sa + 512 + 16 * c8); const float xs = *(const LAS float*)(sa + 640); \
        if (rP >= 0) pout[(size_t)rP * 64] = res; \
        pout[(size_t)rA * 64] = peer_u_compute(TC, x, xs, lane); }
    while (true) {
        if (rB >= NROW) { PEER_U_TAIL(T0) break; }
        PEER_U_STEP(T0, T1)
        if (rB >= NROW) { PEER_U_TAIL(T1) break; }
        PEER_U_STEP(T1, T0)
    }
#undef PEER_U_STEP
#undef PEER_U_TAIL
}

__device__ __forceinline__ float gelu_as(float v) {
    const float av = fabsf(v), t = __builtin_amdgcn_rcpf(av * 0.2316418882f + 1.0f);
    float q = t * 0.5307027145f + (-0.7265760135f); q = q * t + 0.7107068705f; q = q * t + (-0.142248368f); q = q * t + 0.127414796f; q = q * t;
    const float e = fexp2((v * v) * (-0.72134752044f)), m = v * (q * e);
    return v < 0.f ? m : v - m;
}
__device__ __forceinline__ void phase_peer_w(Frame& F, const float* PART, float* gw, bool skipctx) {
    const int gwv = F.vcu * NWAVES + F.wave, NGW = F.G * NWAVES, lane = F.lane;
    for (int r0 = gwv; r0 < NROW; r0 += 4 * NGW) {
        unsigned pw[4][8]; f32x2 gt[4]; bool on[4];
#pragma unroll
        for (int i = 0; i < 4; ++i) { const int r = r0 + i * NGW; on[i] = r < NROW && !(skipctx && (r % NB) < CTXL); const int rr = on[i] ? r : r0;
#pragma unroll
            for (int g = 0; g < 8; ++g) pw[i][g] = ((const GAS unsigned*)PART)[((size_t)g * NROW + rr) * 64 + lane];
            gt[i] = *((const GAS f32x2*)(gw + (size_t)rr * 128) + lane); }
#pragma unroll
        for (int i = 0; i < 4; ++i) { if (!on[i]) continue;
            float a0 = 0.f, a1 = 0.f;
#pragma unroll
            for (int g = 0; g < 8; ++g) { a0 += bf_lo(pw[i][g]); a1 += bf_hi(pw[i][g]); }
            const _Float16 w0 = (_Float16)(gelu_as(a0 * (1.0f / U8_SCALE)) * gt[i][0] * (1.0f / V8_SCALE)), w1 = (_Float16)(gelu_as(a1 * (1.0f / U8_SCALE)) * gt[i][1] * (1.0f / V8_SCALE));
            *((GAS f32x2*)(gw + (size_t)(r0 + i * NGW) * 128) + lane) = (f32x2){__uint_as_float(__builtin_bit_cast(unsigned, (h2_t){w0, w0})), __uint_as_float(__builtin_bit_cast(unsigned, (h2_t){w1, w1}))};
        }
    }
}

__device__ __forceinline__ void peer_v_dma(LAS unsigned char* slot, const unsigned* eoff, const float* gw, int r, int lane) {
    const unsigned char* src = lane < 32 ? (const unsigned char*)eoff + (size_t)r * 512 + 16 * lane : (const unsigned char*)gw + (size_t)r * 512 + 16 * (lane - 32);
    __builtin_amdgcn_global_load_lds((const GAS unsigned*)src, (LAS unsigned*)slot, 16, 0, 0);
}
struct PeerVW { u32x4 w[4]; };
struct PeerVRes { f32x2 xv, gv; unsigned xw; GAS float* xr; GAS bf16_t* xq; bool isctx; };
__device__ __forceinline__ void peer_v_pre(PeerVRes& R, bf16_t* xb, float* xc, const float* mod, int r, int cb, int c8, int lane, float vscale) {
    const int b = r / NB, j = r % NB;
    const int col = cb + 16 * c8 + ((lane >> 3) & 1) * 8 + ((lane >> 4) & 1) * 4 + ((lane >> 5) & 1) * 2;
    R.isctx = j < CTXL;
    R.xr = (GAS float*)(xc + ((size_t)b * CTXL + (R.isctx ? j : 0)) * DM + col);
    R.xq = (GAS bf16_t*)(xb + ((size_t)b * SEQ + (R.isctx ? 0 : (j - CTXL))) * DM + col);
    R.xv = (f32x2){0.f, 0.f}; R.xw = 0u;
    if (R.isctx) R.xv = *(const GAS f32x2*)R.xr; else R.xw = *(const GAS unsigned*)R.xq;
    R.gv = *(const GAS f32x2*)(mod + (R.isctx ? 4 : b) * 6144 + 5 * DM + col);
}
__device__ __forceinline__ void peer_v_store(const PeerVRes& R, const f32x2 xn) { if (R.isctx) *(GAS f32x2*)R.xr = xn; else *(GAS unsigned*)R.xq = cvt_pk_bf16(xn[0], xn[1]); }
__device__ __forceinline__ f32x2 peer_v_compute(const u32x4 (&t)[16], const PeerVW& M, const PeerVRes& R, int lane, float vscale) {
    h2_t acc[8];
#pragma unroll
    for (int c = 0; c < 8; ++c) acc[c] = (h2_t){(_Float16)0.f, (_Float16)0.f};
#pragma unroll
    for (int i = 0; i < 16; ++i) { const unsigned wu = M.w[i >> 2][i & 3]; const h2_t w2 = __builtin_bit_cast(h2_t, wu);
        const u32x4 d = t[i];
        acc[0] += w2 * bf8e(d.x); acc[1] += w2 * bf8o(d.x); acc[2] += w2 * bf8e(d.y); acc[3] += w2 * bf8o(d.y);
        acc[4] += w2 * bf8e(d.z); acc[5] += w2 * bf8o(d.z); acc[6] += w2 * bf8e(d.w); acc[7] += w2 * bf8o(d.w); }
    h2_t p4[4], p2[2], p1h;
#define H2X(v, M) __builtin_bit_cast(h2_t, __float_as_uint(xshfl<M>(__uint_as_float(__builtin_bit_cast(unsigned, (v))))))
    { const bool up = (lane & 8) != 0;
#pragma unroll
      for (int q = 0; q < 4; ++q) { const h2_t keep = up ? acc[q + 4] : acc[q], send = up ? acc[q] : acc[q + 4]; p4[q] = keep + H2X(send, 8); } }
    { const bool up = (lane & 16) != 0;
#pragma unroll
      for (int q = 0; q < 2; ++q) { const h2_t keep = up ? p4[q + 2] : p4[q], send = up ? p4[q] : p4[q + 2]; p2[q] = keep + H2X(send, 16); } }
    { const bool up = (lane & 32) != 0; const h2_t keep = up ? p2[1] : p2[0], send = up ? p2[0] : p2[1]; p1h = keep + H2X(send, 32); }
#undef H2X
    const f32x2 p1 = {(float)p1h[0], (float)p1h[1]};
    const f32x2 xv = R.isctx ? R.xv : (f32x2){bf_lo(R.xw), bf_hi(R.xw)};
    return (f32x2){xv[0] + (R.gv[0] * vscale) * p1[0], xv[1] + (R.gv[1] * vscale) * p1[1]};
}
__device__ __forceinline__ void phase_peer_v(Frame& F, const unsigned char* V8, const unsigned* eoff, const float* gw, bf16_t* xb, float* xc, const float* mod, bool skipctx, float vscale) {
    const int lane = F.lane, xq = blockIdx.x & 7, rank = blockIdx.x >> 3, nr = (F.G - xq + 7) >> 3, step = nr * NWAVES;
    const int g = lane >> 3, c8 = lane & 7, cb = xq * 128;
    const char* vb = (const char*)V8 + (size_t)xq * ((size_t)NEXP * 128) + c8 * 16;
    LAS unsigned char* ring = F.lds + F.wave * 4096;
    int rA = peer_next_row(rank * NWAVES + F.wave - step, step, skipctx);
    if (rA >= NROW) return;
    int rB = peer_next_row(rA, step, skipctx), i = 0;
    peer_v_dma(ring, eoff, gw, rA, lane);
    peer_v_dma(ring + 1024, eoff, gw, rB < NROW ? rB : rA, lane);
    VM_WAIT_ALL();
    u32x4 T0[16], T1[16];
    peer_gather(T0, vb, ring, g);
    PeerVRes RA, RB, RP; f32x2 res = {0.f, 0.f}; bool hasP = false;
    peer_v_pre(RA, xb, xc, mod, rA, cb, c8, lane, vscale);
    RP = RA;
#define PEER_V_STEP(TC, TN) { \
        const int rC = peer_next_row(rB, step, skipctx); \
        VM_WAIT_ALL(); \
        PeerVW W; { const LAS u32x4* wp = (const LAS u32x4*)(ring + (i & 3) * 1024 + 512 + 64 * g); W.w[0] = wp[0]; W.w[1] = wp[1]; W.w[2] = wp[2]; W.w[3] = wp[3]; } \
        peer_v_dma(ring + ((i + 2) & 3) * 1024, eoff, gw, rC < NROW ? rC : rB, lane); \
        peer_gather(TN, vb, ring + ((i + 1) & 3) * 1024, g); \
        peer_v_pre(RB, xb, xc, mod, rB, cb, c8, lane, vscale); \
        if (hasP) peer_v_store(RP, res); \
        res = peer_v_compute(TC, W, RA, lane, vscale); RP = RA; hasP = true; RA = RB; \
        rA = rB; rB = rC; ++i; }
#define PEER_V_TAIL(TC) { VM_WAIT_ALL(); PeerVW W; { const LAS u32x4* wp = (const LAS u32x4*)(ring + (i & 3) * 1024 + 512 + 64 * g); W.w[0] = wp[0]; W.w[1] = wp[1]; W.w[2] = wp[2]; W.w[3] = wp[3]; } \
        if (hasP) peer_v_store(RP, res); \
        peer_v_store(RA, peer_v_compute(TC, W, RA, lane, vscale)); }
    while (true) {
        if (rB >= NROW) { PEER_V_TAIL(T0) break; }
        PEER_V_STEP(T0, T1)
        if (rB >= NROW) { PEER_V_TAIL(T1) break; }
        PEER_V_STEP(T1, T0)
    }
#undef PEER_V_STEP
#undef PEER_V_TAIL
}
#ifndef DIAG
#define DIAG 0
#endif
#if DIAG
#ifndef DIAG_TOL
#define DIAG_TOL 2.5e-3f
#endif
__device__ __forceinline__ float blk_max(LAS float* red, float v, int tid) {
    v = fmaxf(v, xshfl<1>(v)); v = fmaxf(v, xshfl<2>(v)); v = fmaxf(v, xshfl<4>(v)); v = fmaxf(v, xshfl<8>(v)); v = fmaxf(v, xshfl<16>(v)); v = xmax32(v);
    __syncthreads(); if ((tid & 63) == 0) red[tid >> 6] = v; __syncthreads();
    float r = red[0];
#pragma unroll
    for (int i = 1; i < 8; ++i) r = fmaxf(r, red[i]);
    __syncthreads(); return r;
}
__device__ __forceinline__ float blk_sum(LAS float* red, float v, int tid) {
    v = wave_sum(v);
    __syncthreads(); if ((tid & 63) == 0) red[tid >> 6] = v; __syncthreads();
    float r = 0.f;
#pragma unroll
    for (int i = 0; i < 8; ++i) r += red[i];
    __syncthreads(); return r;
}
template <int DQK, class KeyFn>
__device__ __forceinline__ float diag_attn(LAS float* sm, int tid, const bf16_t* qp, const bf16_t* kbase, int kpitch, int koff, const bf16_t* k2base, int k2pitch, int k2off,
                                           const bf16_t* vbase, int vpitch, int voff, int nkeys, KeyFn keyfn, float sink_l2, bool has_sink, const bf16_t* yp) {
    LAS float* mw = sm;
    LAS float* lw = sm + 8;
    LAS float* ow = sm + 16;
    LAS float* red = sm + 16 + 512;
    const int lane = tid & 63, w = tid >> 6;
    const float q0 = bf2f(qp[lane]); const float q1 = (DQK == 96 && lane < 32) ? bf2f(qp[64 + lane]) : 0.f;
    float m = -3.0e38f, l = 0.f, o = 0.f;
    for (int i = w; i < nkeys; i += 8) {
        size_t krow; float bias; bool valid; keyfn(i, krow, bias, valid);
        if (!valid) continue;
        float part = q0 * bf2f(kbase[krow * kpitch + koff + lane]);
        if (DQK == 96 && lane < 32) part += q1 * bf2f(k2base[krow * k2pitch + k2off + lane]);
        const float sc = wave_sum(part) + bias;
        const float mn = fmaxf(m, sc), al = fexp2(m - mn), pp = fexp2(sc - mn);
        m = mn; l = l * al + pp; o = o * al + pp * bf2f(vbase[krow * vpitch + voff + lane]);
    }
    __syncthreads();
    if (lane == 0) { mw[w] = m; lw[w] = l; }
    ow[w * 64 + lane] = o;
    __syncthreads();
    float M = mw[0];
#pragma unroll
    for (int i = 1; i < 8; ++i) M = fmaxf(M, mw[i]);
    if (has_sink) M = fmaxf(M, sink_l2);
    float lt = has_sink ? fexp2(sink_l2 - M) : 0.f, ot = 0.f;
#pragma unroll
    for (int i = 0; i < 8; ++i) { const float f = fexp2(mw[i] - M); lt += lw[i] * f; ot += ow[i * 64 + lane] * f; }
    float num = 0.f, den = 0.f;
    if (tid < 64) { const float r = ot / lt, y = bf2f(yp[tid]); num = (y - r) * (y - r); den = r * r; }
    num = blk_sum(red, num, tid); den = blk_sum(red, den, tid);
    return num / (den + 1e-20f);
}

__device__ __forceinline__ float diag_ret(LAS float* sm, int tid, const bf16_t* P, size_t rb0, int j, int h, float lgf, float lgb, const float* gnf, const float* gnb, const bf16_t* yp) {
    LAS float* ow = sm;
    LAS float* red = sm + 1024;
    const int lane = tid & 63, w = tid >> 6;
    const float q = bf2f(P[(rb0 + j) * PW + C_RQ + h * 64 + lane]);
    const int posj = (j < CTXL) ? (CTXL - 1 - j) : (CTXL + (NB - 1 - j));
    float of = 0.f, ob = 0.f;
    for (int s = w; s < NB; s += 8) {
        const int poss = (s < CTXL) ? (CTXL - 1 - s) : (CTXL + (NB - 1 - s));
        const bool inf = s <= j, inb = poss <= posj;
        if (!inf && !inb) continue;
        const bf16_t* pr = P + (rb0 + s) * PW + h * 64 + lane;
        const float qk = wave_sum(q * bf2f(pr[C_RK])); const float v = bf2f(pr[C_RV]);
        if (inf) of += fexp2(lgf * (float)(j - s)) * qk * v;
        if (inb) ob += fexp2(lgb * (float)(posj - poss)) * qk * v;
    }
    __syncthreads();
    ow[w * 64 + lane] = of; ow[512 + w * 64 + lane] = ob;
    __syncthreads();
    float tf = 0.f, tb = 0.f;
#pragma unroll
    for (int i = 0; i < 8; ++i) { tf += ow[i * 64 + lane]; tb += ow[512 + i * 64 + lane]; }
    const float muf = wave_sum(tf) * (1.f / 64.f), mub = wave_sum(tb) * (1.f / 64.f);
    const float vf = wave_sum((tf - muf) * (tf - muf)) * (1.f / 64.f), vb = wave_sum((tb - mub) * (tb - mub)) * (1.f / 64.f);
    const float gf = bf2f(P[(rb0 + j) * PW + C_RGF + h * 64 + lane]), gb = bf2f(P[(rb0 + j) * PW + C_RGB + h * 64 + lane]);
    const float r = silu_f(gf) * ((tf - muf) / sqrtf(vf + EPS)) * gnf[h * 64 + lane] + silu_f(gb) * ((tb - mub) / sqrtf(vb + EPS)) * gnb[h * 64 + lane];
    float num = 0.f, den = 0.f;
    if (tid < 64) { const float y = bf2f(yp[tid]); num = (y - r) * (y - r); den = r * r; }
    num = blk_sum(red, num, tid); den = blk_sum(red, den, tid);
    return num / (den + 1e-20f);
}

__device__ __forceinline__ void diag_check(Frame& F, const Inputs& I, unsigned char* ws, unsigned* code) {
    const int tid = F.tid;
    LAS float* sm = (LAS float*)F.lds;
    LAS float* raw = (LAS float*)(F.lds + 4096);
    LAS float* xn = (LAS float*)(F.lds + 4096 + 12544);
    LAS float* red = (LAS float*)(F.lds + 4096 + 12544 + 4096);
    const bf16_t* P = (const bf16_t*)(ws + WS_P); const bf16_t* KV = (const bf16_t*)(ws + WS_KV); const bf16_t* Y = (const bf16_t*)(ws + WS_XN);
    const float* MOD = (const float*)(ws + WS_MOD);
    const float tol = DIAG_TOL;
    for (int sidx = blockIdx.x; sidx < 256; sidx += F.G) {
        const int b = sidx & 3, si = sidx >> 2;
        static const int jl[16] = {0, 17, 128, 255, 256, 257, 256 + 63, 256 + 64, 256 + 127, 256 + 128, 256 + 129, 256 + 8191, 256 + 8064, 256 + 8063, 256 + 4095, 256 + 4160};
        int j; if (si < 16) { j = 0; for (int q = 0; q < 16; ++q) if (q == si) j = jl[q]; } else j = 256 + ((si * 2654435761u) >> 7) % 8192u;
        const int h = (si * 7 + 3) & 3;
        const size_t row = (size_t)b * NB + j;
        const bool isctx = j < CTXL; const int t = j - CTXL, prow = t >> 6, pcol = t & 63;
        {
            const float* xr = isctx ? I.ctx + ((size_t)b * CTXL + j) * DM : I.x + ((size_t)b * SEQ + t) * DM;
            const float* mv = MOD + (isctx ? 4 : b) * 6144;
            float ss = 0.f; for (int k = tid; k < DM; k += NTHR) ss += xr[k] * xr[k];
            ss = blk_sum(red, ss, tid);
            const float rs = 1.0f / sqrtf(ss / DM + EPS);
            for (int k = tid; k < DM; k += NTHR) { const float y = xr[k] * rs * I.norm_mix_g[k] * (1.f + mv[DM + k]) + mv[k]; xn[k] = bf_lo(cvt_pk_bf16(y, 0.f)); }
            __syncthreads();
            for (int c = tid; c < INW; c += NTHR) { float a = 0.f; for (int k = 0; k < DM; ++k) a += xn[k] * bf_lo(cvt_pk_bf16(I.w_in[(size_t)k * INW + c], 0.f)); raw[c] = a; }
            __syncthreads();
            float num = 0.f, den = 0.f;
            for (int c = tid; c < INW; c += NTHR) {
                const int oc = orig_col(c);
                float ref = raw[oc], sc = 1.f;
                int rb = -1, R = 0;
                if (oc < 384) { if (oc % 96 >= 64) { rb = oc - (oc % 96) + 64; R = 32; } sc = 0.10206207261596577f * LOG2E; }
                else if (oc >= C_KR && oc < C_SWAQ) { rb = C_KR; R = 32; }
                else if (oc >= C_SWAQ && oc < C_SWAK) { rb = C_SWAQ + ((oc - C_SWAQ) & ~63); R = 64; sc = 0.125f * LOG2E; }
                else if (oc >= C_SWAK && oc < C_SWAV) { rb = C_SWAK + ((oc - C_SWAK) & ~63); R = 64; }
                else if (oc >= C_NAQ && oc < C_NAK) sc = 0.125f * LOG2E;
                else if (oc >= C_RK && oc < C_RV) sc = 0.125f;
                if (rb >= 0 && !isctx) {
                    const int quarter = R / 4, p = oc - rb, part = p / (R / 2), which = (p % (R / 2)) / quarter, jj = p % quarter;
                    const float inv = __powf(10000.f, -(float)jj / (float)quarter);
                    const float ang = (float)(part ? pcol : prow) * inv;
                    const float rev = ang * 0.15915494309189535f; const float cs = __builtin_amdgcn_cosf(rev), sn = __builtin_amdgcn_sinf(rev);
                    const float x1 = raw[rb + part * (R / 2) + jj], x2 = raw[rb + part * (R / 2) + quarter + jj];
                    ref = which ? (x1 * sn + x2 * cs) : (x1 * cs - x2 * sn);
                }
                ref *= sc;
                const float got = bf2f(P[row * PW + c]);
                num += (got - ref) * (got - ref); den += ref * ref;
            }
            num = blk_sum(red, num, tid); den = blk_sum(red, den, tid);
            if (tid == 0 && num > tol * den) atomicOr(code, 1u);
        }
        {
            const float* g = I.mla_kv_norm_g; const float* wu = I.mla_w_ukv;
            float ss = 0.f; for (int k = tid; k < 128; k += NTHR) { const float v = bf2f(P[row * PW + C_CKV + k]); ss += v * v; }
            ss = blk_sum(red, ss, tid);
            const float rs = 1.0f / sqrtf(ss / 128.f + EPS);
            float num = 0.f, den = 0.f;
            { const int n = tid; float a = 0.f; for (int k = 0; k < 128; ++k) a += bf2f(P[row * PW + C_CKV + k]) * g[k] * wu[k * KVW + n]; a *= rs;
              const float got = bf2f(KV[row * KVW + n]); num = (got - a) * (got - a); den = a * a; }
            num = blk_sum(red, num, tid); den = blk_sum(red, den, tid);
            if (tid == 0 && num > tol * den) atomicOr(code, 16u);
        }
        const size_t rb0 = (size_t)b * NB;
        {
            auto keyfn = [&](int i, size_t& krow, float& bias, bool& valid) { krow = rb0 + i; bias = 0.f; valid = true; };
            const float e = diag_attn<96>(sm, tid, P + row * PW + h * 96, KV, KVW, h * 128, P, PW, C_KR, KV, KVW, h * 128 + 64, isctx ? CTXL : NB, keyfn, 0.f, false, Y + row * DM + h * 64);
            if (tid == 0 && e > tol) atomicOr(code, 2u);
        }
        {
            const int g = h >> 1;
            auto keyfn = [&](int i, size_t& krow, float& bias, bool& valid) { krow = rb0 + i; bias = 0.f;
                if (i < CTXL) valid = true; else { const int kp = i - CTXL; valid = (kp - t <= 128) && (t - kp <= 128); } };
            const float e = diag_attn<64>(sm, tid, P + row * PW + C_SWAQ + h * 64, P, PW, C_SWAK + g * 64, P, PW, 0, P, PW, C_SWAV + g * 64, isctx ? CTXL : NB, keyfn,
                                          I.swa_sink[h] * LOG2E, true, Y + row * DM + 256 + h * 64);
            if (tid == 0 && e > tol) atomicOr(code, 4u);
        }
        {
            int rs = prow - 4; rs = rs < 0 ? 0 : (rs > 120 ? 120 : rs); int cs = pcol - 8; cs = cs < 0 ? 0 : (cs > 48 ? 48 : cs);
            const float* rpb = I.na_rpb + h * 15 * 31;
            auto keyfn = [&](int i, size_t& krow, float& bias, bool& valid) { krow = rb0 + i; bias = 0.f;
                if (i < CTXL) valid = true; else { const int kp = i - CTXL, kr = kp >> 6, kc = kp & 63; valid = (kr >= rs && kr < rs + 8 && kc >= cs && kc < cs + 16);
                    if (valid) bias = rpb[(kr - prow + 7) * 31 + (kc - pcol + 15)] * LOG2E; } };
            const float e = diag_attn<64>(sm, tid, P + row * PW + C_NAQ + h * 64, P, PW, C_NAK + h * 64, P, PW, 0, P, PW, C_NAV + h * 64, isctx ? CTXL : NB, keyfn, 0.f, false, Y + row * DM + 512 + h * 64);
            if (tid == 0 && e > tol) atomicOr(code, 8u);
        }
        {
            const float e = diag_ret(sm, tid, P, rb0, j, h, log2_sigmoid(I.ret_decay_f[h]), log2_sigmoid(I.ret_decay_b[h]), I.ret_gn_f, I.ret_gn_b, Y + row * DM + 768 + h * 64);
            if (tid == 0 && e > tol) atomicOr(code, 32u);
        }
    }
}
#endif
constexpr int N_PHASES = 26;
#ifndef MK_SINGLE
#define MK_SINGLE 1
#endif
__device__ __forceinline__ Frame fresh(const Frame& F) { Frame f = F; int ln = lane_id(); asm volatile("" : "+v"(ln)); f.lane = ln; f.tid = F.wave * 64 + ln; return f; }
struct Args { Inputs in; float* out; unsigned char* ws; int ph_lo, ph_hi, li, pad; };

__global__ void __launch_bounds__(NTHR, 2) fwd_kernel(Args args) {
    extern __shared__ __attribute__((aligned(16))) unsigned char lds_raw[];
    Frame F;
    F.lds = (LAS unsigned char*)lds_raw;
    F.tid = threadIdx.x; F.lane = F.tid & 63; F.wave = __builtin_amdgcn_readfirstlane(F.tid >> 6);
    F.G = gridDim.x; { const int bx = blockIdx.x; F.vcu = (F.G % 8 == 0) ? (bx % 8) * (F.G / 8) + bx / 8 : bx; }
    typedef const __attribute__((address_space(4))) Args* KArgP;
    const KArgP kap = (KArgP)__builtin_amdgcn_kernarg_segment_ptr();
#define KARGV(f) ({ KArgP _p = kap; asm volatile("" : "+s"(_p)); _p->f; })
#define KARG(f) as_global(KARGV(f))
    unsigned char* ws = KARGV(ws);
    volatile LAS unsigned* MISC = (volatile LAS unsigned*)(F.lds + MISC_OFF);
    for (int u = F.tid; u < (LDS_BYTES - LDSCTL_OFF) / 4; u += NTHR) ((LAS unsigned*)(F.lds + LDSCTL_OFF))[u] = 0u;
    __syncthreads();
    unsigned* ctl = (unsigned*)(ws + WS_CTL);
    XcdBarrier bar = xcd_barrier_post(ctl + CW_BAR + KARGV(li) * XCD_BAR_WORDS, MISC + 8);
    const int lo = KARGV(ph_lo), hi = KARGV(ph_hi);
#ifndef PH_MASK
#define PH_MASK 0x3ff
#endif
#define PHM(j) ((PH_MASK >> (j)) & 1)
#ifndef UM
#define UM 0xff
#endif
#ifndef REP_J
#define REP_J -1
#define REP_N 1
#endif
#define REPS(j) for (int rep_ = 0; rep_ < ((REP_J == (j)) ? REP_N : 1); ++rep_)
#define IN(k) ({ int lo_ = lo, hi_ = hi; asm volatile("" : "+s"(lo_), "+s"(hi_)); lo_ <= (k) && (k) < hi_; })
#if defined(TPH) || defined(TPB)
#define TSTAMP(k) do { if (blockIdx.x == 0 && threadIdx.x == 0) __hip_atomic_store(ctl + 32 + (k), (unsigned)wall_clock64() | 1u, __ATOMIC_RELAXED, __HIP_MEMORY_SCOPE_AGENT); } while (0)
#else
#define TSTAMP(k) do { } while (0)
#endif
#ifdef TPB
#define BSTAMP(k) do { if ((k) == (TPB) && threadIdx.x == 0) __hip_atomic_store(ctl + 64 + blockIdx.x, (unsigned)wall_clock64() | 1u, __ATOMIC_RELAXED, __HIP_MEMORY_SCOPE_AGENT); } while (0)
#else
#define BSTAMP(k) do { } while (0)
#endif
#define SEAM(k) do { if (IN(k) && IN((k) + 1)) { BSTAMP(k); xcd_barrier(bar); TSTAMP((k) + 1); } } while (0)

#define WSQ() unsigned char* wsq_ = ws; asm volatile("" : "+s"(wsq_)); unsigned char* wsq = as_global(wsq_); \
    float* MOD = (float*)(wsq + WS_MOD); bf16_t* XN = (bf16_t*)(wsq + WS_XN); bf16_t* P = (bf16_t*)(wsq + WS_P); bf16_t* KV = (bf16_t*)(wsq + WS_KV); float* SSQ = (float*)(wsq + WS_SSQ); \
    float* XC = (float*)(wsq + WS_XC); float* RS = (float*)(wsq + WS_RS); unsigned char* UB = wsq + WS_UB; unsigned char* VB = wsq + WS_VB; _Float16* S16 = (_Float16*)(wsq + WS_P); \
    int* EID = (int*)(wsq + WS_KV); float* GATE = (float*)(wsq + WS_GATE); bf16_t* XB = (bf16_t*)(wsq + WS_XB); const float* mod = MOD + (size_t)l * 5 * 6144; \
    const float* xl_cur = (l == 0) ? KARG(in.x) : (const float*)nullptr; const float* xc_cur = (l == 0) ? KARG(in.ctx) : XC; \
    (void)XN; (void)P; (void)KV; (void)SSQ; (void)XC; (void)RS; (void)UB; (void)VB; (void)S16; (void)EID; (void)GATE; (void)XB; (void)mod; (void)xl_cur; (void)xc_cur;

    TSTAMP(0);
    if (IN(0)) REPS(100) { { const Inputs Iv = args.in; phase_prologue(F, Iv, as_global(ws)); }; }
    SEAM(0);

#pragma nounroll
    for (int l0 = 0; l0 < NLAYER; ++l0) {
        int l = l0; asm volatile("" : "+s"(l));
        const int pb = 1 + 12 * l;
        const bool last = (l == NLAYER - 1);

        if (PHM(0) && IN(pb + 0)) REPS(0) { Frame Fq = fresh(F); WSQ();
            phase_norm_mod(Fq, xl_cur, XB, xc_cur, KARG(in.norm_mix_g) + l * DM, mod, 0, XN, false, SSQ);
            phase_convert_uv(Fq, KARG(in.peer_u) + (size_t)l * NEXP * DM, KARG(in.peer_v) + (size_t)l * NEXP * DM, wsq);
        }
        SEAM(pb + 0);

        if (PHM(1) && IN(pb + 1)) REPS(1) { Frame Fq = fresh(F); WSQ();
            pg8::Gemm g{XN, (const bf16_t*)(wsq + WS_WIN) + (size_t)l * PW * DM};
            pg8::LinOrder S{PW / 256, (NROW / 256) * (PW / 256), Fq.G, Fq.vcu, 0};
            pg8::EpiProj E{P, SSQ, (const f32x2*)(wsq + WS_TAB), (const f32x2*)(wsq + WS_TAB + 16384)};
            pg8::gemm_phase<pg8::EpiProj, pg8::LinOrder, DM, DM, DM, true>(Fq.lds, Fq.wave, g, S, E);
        }
        SEAM(pb + 1);

        if (PHM(2) && IN(pb + 2)) REPS(2) { Frame Fq = fresh(F); WSQ();
            {
                pg8::Gemm g{P + C_CKV, (const bf16_t*)(wsq + WS_WUKV) + (size_t)l * KVW * 128};
                pg8::LinOrder S{KVW / 256, (NROW / 256) * (KVW / 256), Fq.G, Fq.vcu, 0};
                pg8::EpiKV E{KV, SSQ};
                pg8::gemm_phase<pg8::EpiKV, pg8::LinOrder, 128, PW, 128, true>(Fq.lds, Fq.wave, g, S, E);
            }
            __syncthreads();
            const RetArgs RA{P, XN, RS, KARG(in.ret_decay_f) + l * 4, KARG(in.ret_decay_b) + l * 4, KARG(in.ret_gn_f) + l * 256, KARG(in.ret_gn_b) + l * 256};
            const AttnArgs AA{P, KV, XN, KARG(in.swa_sink) + l * 4, KARG(in.na_rpb) + (size_t)l * 4 * 15 * 31};
            const int n_ctx = last ? 0 : 16;
            if (UM & 1) REPS(21) for (int u = Fq.vcu; u < 512; u += Fq.G) attn_unit<AT_SWA, false>(Fq, AA, u);
            if (UM & 2) REPS(22) for (int u = Fq.vcu; u < 512; u += Fq.G) attn_unit<AT_NA, false>(Fq, AA, u);
            if (UM & 4) REPS(23) ret_local_loop(Fq, RA, (Fq.vcu + 128) % Fq.G, Fq.G, 16 * 66);
            if (UM & 8) for (int u = (Fq.vcu + 32) % Fq.G; u < n_ctx; u += Fq.G) attn_unit<AT_SWA, true>(Fq, AA, u);
            if (UM & 16) for (int u = (Fq.vcu + 48) % Fq.G; u < n_ctx; u += Fq.G) attn_unit<AT_NA, true>(Fq, AA, u);
        }
        SEAM(pb + 2);

        if (PHM(3) && IN(pb + 3)) { Frame Fq = fresh(F); WSQ();
            const RetArgs RA{P, XN, RS, KARG(in.ret_decay_f) + l * 4, KARG(in.ret_decay_b) + l * 4, KARG(in.ret_gn_f) + l * 256, KARG(in.ret_gn_b) + l * 256};
            ret_scan(Fq, RA);
        }
        SEAM(pb + 3);

        if (PHM(4) && IN(pb + 4)) REPS(4) { Frame Fq = fresh(F); WSQ();
            const RetArgs RA{P, XN, RS, KARG(in.ret_decay_f) + l * 4, KARG(in.ret_decay_b) + l * 4, KARG(in.ret_gn_f) + l * 256, KARG(in.ret_gn_b) + l * 256};
            const AttnArgs AA{P, KV, XN, KARG(in.swa_sink) + l * 4, KARG(in.na_rpb) + (size_t)l * 4 * 15 * 31};
            const int n_ctx = last ? 0 : 16;
#if REP_J == 40
            for (int rep_ = 0; rep_ < REP_N - 1; ++rep_) for (int u = Fq.vcu; u < 512; u += Fq.G) attn_unit<AT_MLA, false, true>(Fq, AA, u);
#endif
            if (UM & 32) for (int u = Fq.vcu; u < 512; u += Fq.G) attn_unit<AT_MLA, false>(Fq, AA, u);
            if (UM & 64) for (int u = (Fq.vcu + Fq.G - 16) % Fq.G; u < n_ctx; u += Fq.G) attn_unit<AT_MLA, true>(Fq, AA, u);
            if (UM & 128) REPS(41) ret_out_loop(Fq, RA, (Fq.vcu + 16) % Fq.G, Fq.G, 16 * 66, last);
        }
        SEAM(pb + 4);

        if (PHM(5) && IN(pb + 5)) { Frame Fq = fresh(F); WSQ();
            pg8::Gemm g{XN, (const bf16_t*)(wsq + WS_WOUT) + (size_t)l * DM * DM};
            pg8::LinOrder S{DM / 256, (last ? 128 : 132) * (DM / 256), Fq.G, Fq.vcu, last ? 1 : 0};
            pg8::EpiResid E{xl_cur, XB, xc_cur, XC, mod};
            pg8::gemm_phase<pg8::EpiResid, pg8::LinOrder, DM, DM, DM, true>(Fq.lds, Fq.wave, g, S, E);
        }
        SEAM(pb + 5);

#if REP_J == 60
        for (int rg_ = 0; rg_ < REP_N; ++rg_) {
#endif
        if (PHM(6) && IN(pb + 6)) REPS(6) { Frame Fq = fresh(F); WSQ(); phase_norm_mod<true>(Fq, nullptr, XB, XC, KARG(in.norm_ffn_g) + l * DM, mod, 3, XN, last, nullptr, wsq + WS_XQ, (float*)(wsq + WS_XSC)); }
        SEAM(pb + 6);
#ifdef EXTRA_BAR
        if (IN(pb + 6) && IN(pb + 7)) for (int eb = 0; eb < EXTRA_BAR; ++eb) xcd_barrier(bar);
#endif

#if REP_J == 70
        if (PHM(7) && IN(pb + 7)) for (int rep_ = 0; rep_ < REP_N - 1; ++rep_) { Frame Fq = fresh(F); WSQ();
            pg8::Gemm g{XN, (const bf16_t*)(wsq + WS_WSC) + (size_t)l * 2048 * DM};
            pg8::LinOrder S{2048 / 256, (last ? 128 : 132) * (2048 / 256), Fq.G, Fq.vcu, last ? 1 : 0};
            pg8::EpiNull E{(float*)(wsq + WS_CTL + 4096)};
            pg8::gemm_phase<pg8::EpiNull, pg8::LinOrder, DM, DM, DM, true>(Fq.lds, Fq.wave, g, S, E); }
#endif
        if (PHM(7) && IN(pb + 7)) REPS(7) { Frame Fq = fresh(F); WSQ();
            pg8::Gemm g{XN, (const bf16_t*)(wsq + WS_WSC) + (size_t)l * 2048 * DM};
            pg8::LinOrder S{2048 / 256, (last ? 128 : 132) * (2048 / 256), Fq.G, Fq.vcu, last ? 1 : 0};
            pg8::EpiScore E{S16};
            pg8::gemm_phase<pg8::EpiScore, pg8::LinOrder, DM, DM, DM, true>(Fq.lds, Fq.wave, g, S, E);
        }
        SEAM(pb + 7);

        if (PHM(8) && IN(pb + 8)) REPS(8) { Frame Fq = fresh(F); WSQ(); phase_topk(Fq, S16, EID, GATE, last); }
        SEAM(pb + 8);

#if REP_J == 90
        if (PHM(9) && IN(pb + 9)) for (int rep_ = 0; rep_ < REP_N - 1; ++rep_) { Frame Fq = fresh(F); WSQ(); phase_peer_u<true>(Fq, wsq + WS_XQ, (const float*)(wsq + WS_XSC), UB, (const unsigned*)EID, (float*)(wsq + WS_P), last); }
#endif
        if (PHM(9) && IN(pb + 9)) REPS(9) { Frame Fq = fresh(F); WSQ(); phase_peer_u(Fq, wsq + WS_XQ, (const float*)(wsq + WS_XSC), UB, (const unsigned*)EID, (float*)(wsq + WS_P), last); }
        SEAM(pb + 9);

        if (PHM(9) && IN(pb + 10)) { Frame Fq = fresh(F); WSQ(); phase_peer_w(Fq, (const float*)(wsq + WS_P), GATE, last); }
        SEAM(pb + 10);
#if REP_J == 60
        }
#endif

        if (PHM(9) && IN(pb + 11)) REPS(11) { Frame Fq = fresh(F); WSQ(); float vsc = 1.0f;
#ifdef PEER_SCALE
            vsc = PEER_SCALE;
#endif
            if (REP_J == 11) { vsc = (rep_ == REP_N - 1) ? 1.0f : 0.0f; asm volatile("" : "+v"(vsc)); }
            phase_peer_v(Fq, VB, (const unsigned*)EID, GATE, XB, XC, mod, last, vsc); }
        SEAM(pb + 11);
    }

#if DIAG
    if (IN(25)) { const float dsc = 1.0f + 0.05f * (float)__hip_atomic_load(ctl + 8, __ATOMIC_RELAXED, __HIP_MEMORY_SCOPE_AGENT); { Frame Fq = fresh(F); phase_final_norm(Fq, (const bf16_t*)as_global(ws + WS_XB), KARG(out), KARG(in.final_norm_g), dsc); } }
#elif defined(TPB)
    if (IN(25)) { unsigned t0; do { t0 = __hip_atomic_load(ctl + 32 + TPB, __ATOMIC_RELAXED, __HIP_MEMORY_SCOPE_AGENT); } while (t0 == 0u);
        int mn = 0x7fffffff, mx = 0;
#ifndef TPB_XQ
#define TPB_XQ -1
#endif
        for (int b = 0; b < (int)gridDim.x; ++b) { if (TPB_XQ >= 0 && (b & 7) != TPB_XQ) continue; const int d = (int)(__hip_atomic_load(ctl + 64 + b, __ATOMIC_RELAXED, __HIP_MEMORY_SCOPE_AGENT) - t0); mn = d < mn ? d : mn; mx = d > mx ? d : mx; }
        int b1 = (mn - (TP_OFF) * 100) / ((TP_UNIT) * 100), b2 = (mx - (TP_OFF2) * 100) / ((TP_UNIT2) * 100);
        b1 = b1 < 0 ? 0 : (b1 > 6 ? 6 : b1); b2 = b2 < 0 ? 0 : (b2 > 5 ? 5 : b2);
        const float dsc = 1.0f + 0.05f * (float)(b1 + 7 * b2);
        { Frame Fq = fresh(F); phase_final_norm(Fq, (const bf16_t*)as_global(ws + WS_XB), KARG(out), KARG(in.final_norm_g), dsc); } }
#elif defined(TPH)
    if (IN(25)) { unsigned ta, tb, tc, td; do { ta = __hip_atomic_load(ctl + 32 + TP_A, __ATOMIC_RELAXED, __HIP_MEMORY_SCOPE_AGENT); tb = __hip_atomic_load(ctl + 32 + TP_B, __ATOMIC_RELAXED, __HIP_MEMORY_SCOPE_AGENT);
            tc = __hip_atomic_load(ctl + 32 + TP_A2, __ATOMIC_RELAXED, __HIP_MEMORY_SCOPE_AGENT); td = __hip_atomic_load(ctl + 32 + TP_B2, __ATOMIC_RELAXED, __HIP_MEMORY_SCOPE_AGENT); } while (ta == 0u || tb == 0u || tc == 0u || td == 0u);
        int b1 = ((int)(tb - ta) - (TP_OFF) * 100) / ((TP_UNIT) * 100), b2 = ((int)(td - tc) - (TP_OFF2) * 100) / ((TP_UNIT2) * 100);
        b1 = b1 < 0 ? 0 : (b1 > 6 ? 6 : b1); b2 = b2 < 0 ? 0 : (b2 > 5 ? 5 : b2);
        const float dsc = 1.0f + 0.05f * (float)(b1 + 7 * b2);
        { Frame Fq = fresh(F); phase_final_norm(Fq, (const bf16_t*)as_global(ws + WS_XB), KARG(out), KARG(in.final_norm_g), dsc); } }
#else
    if (IN(25)) { { Frame Fq = fresh(F); phase_final_norm(Fq, (const bf16_t*)as_global(ws + WS_XB), KARG(out), KARG(in.final_norm_g), 1.0f); } }
#endif
#undef IN
#undef SEAM
}

#if DIAG
__global__ void __launch_bounds__(NTHR, 2) diag_kernel(Args args) {
    extern __shared__ __attribute__((aligned(16))) unsigned char lds_raw[];
    Frame F; F.lds = (LAS unsigned char*)lds_raw; F.tid = threadIdx.x; F.lane = F.tid & 63; F.wave = __builtin_amdgcn_readfirstlane(F.tid >> 6); F.G = gridDim.x; F.vcu = blockIdx.x;
    diag_check(F, args.in, args.ws, (unsigned*)(args.ws + WS_CTL) + 8);
}
#endif
extern "C" void kernel_launch(void* const* d_in, const int* in_sizes, int n_in, void* d_out, int out_size, void* d_ws, size_t ws_size, hipStream_t stream) {
    static int grid = 0;
    if (grid == 0) {
        if (n_in != 25 || in_sizes[0] != NBATCH * SEQ * DM || out_size != NBATCH * SEQ * DM || ws_size < WS_END) {
            fprintf(stderr, "kernel_launch: unexpected problem (n_in %d, in0 %d, out %d, ws %zu < %zu); nothing launched\n", n_in, n_in > 0 ? in_sizes[0] : -1, out_size, ws_size, (size_t)WS_END); grid = -1; return; }
        int dev = 0, cus = 0, per_cu = 0;
        if (hipGetDevice(&dev) != hipSuccess || hipDeviceGetAttribute(&cus, hipDeviceAttributeMultiprocessorCount, dev) != hipSuccess) { grid = -1; return; }
#if DIAG
        (void)hipFuncSetAttribute((const void*)diag_kernel, hipFuncAttributeMaxDynamicSharedMemorySize, LDS_BYTES);
#endif
        if (hipFuncSetAttribute((const void*)fwd_kernel, hipFuncAttributeMaxDynamicSharedMemorySize, LDS_BYTES) != hipSuccess) { fprintf(stderr, "kernel_launch: hipFuncSetAttribute failed\n"); grid = -1; return; }
        if (hipOccupancyMaxActiveBlocksPerMultiprocessor(&per_cu, (const void*)fwd_kernel, NTHR, LDS_BYTES) != hipSuccess || per_cu < 1) {
            fprintf(stderr, "kernel_launch: occupancy query reports %d workgroups per CU\n", per_cu); (void)hipGetLastError(); if (per_cu < 1) { grid = -1; return; } }
        grid = cus;
    }
    if (grid < 0) return;
    (void)hipMemsetAsync((char*)d_ws + WS_CTL, 0, CTL_ZERO_BYTES, stream);
    Args a{};
    const float** ip = (const float**)&a.in;
    for (int i = 0; i < 25; ++i) ip[i] = (const float*)d_in[i];
    a.out = (float*)d_out; a.ws = (unsigned char*)d_ws;
#if DIAG
    a.ph_lo = 0; a.ph_hi = 6; a.li = 0; hipLaunchKernelGGL(fwd_kernel, dim3(grid), dim3(NTHR), LDS_BYTES, stream, a);
    hipLaunchKernelGGL(diag_kernel, dim3(grid), dim3(NTHR), LDS_BYTES, stream, a);
    a.ph_lo = 6; a.ph_hi = N_PHASES; a.li = 1; hipLaunchKernelGGL(fwd_kernel, dim3(grid), dim3(NTHR), LDS_BYTES, stream, a);
#elif MK_SINGLE
    a.ph_lo = 0; a.ph_hi = N_PHASES;
    hipLaunchKernelGGL(fwd_kernel, dim3(grid), dim3(NTHR), LDS_BYTES, stream, a);
#else
    for (int p = 0; p < N_PHASES; ++p) { a.ph_lo = p; a.ph_hi = p + 1; hipLaunchKernelGGL(fwd_kernel, dim3(grid), dim3(NTHR), LDS_BYTES, stream, a); }
#endif
}
```

```cpp
#include <hip/hip_runtime.h>
#include <cstdio>
#include <cstdint>

#define GAS __attribute__((address_space(1)))
#define LAS __attribute__((address_space(3)))
typedef unsigned short bf16_t;
typedef short bf16x8 __attribute__((ext_vector_type(8)));
typedef float f32x4 __attribute__((ext_vector_type(4)));
typedef float f32x2 __attribute__((ext_vector_type(2)));
typedef float f32x16 __attribute__((ext_vector_type(16)));
typedef unsigned u32x4 __attribute__((ext_vector_type(4)));
typedef unsigned u32x2 __attribute__((ext_vector_type(2)));

constexpr int NBATCH = 4, SEQ = 8192, CTXL = 256, DM = 1024, NLAYER = 2;
constexpr int NB = SEQ + CTXL;
constexpr int NROW = NBATCH * NB;
constexpr int PW = 3328;
constexpr int INW = 3104;
constexpr int KVW = 512;
constexpr int C_MLAQ = 0, C_CKV = 384, C_KR = 512, C_SWAQ = 544, C_SWAK = 800, C_SWAV = 928, C_NAQ = 1056, C_NAK = 1312, C_NAV = 1568,
              C_RQ = 1824, C_RK = 2080, C_RV = 2336, C_RGF = 2592, C_RGB = 2848;
constexpr int NEXP = 16384, PEER_K = 128;
constexpr float LOG2E = 1.4426950408889634f;
constexpr float EPS = 1e-6f;

constexpr size_t MiB = 1u << 20;
constexpr size_t WS_CTL = 0, CTL_ZERO_BYTES = 1 * MiB;
constexpr size_t WS_MOD = 1 * MiB;
constexpr size_t WS_TAB = 2 * MiB;
constexpr size_t WS_WIN = 3 * MiB;
constexpr size_t WS_WOUT = 17 * MiB;
constexpr size_t WS_WSC = 21 * MiB;
constexpr size_t WS_WUKV = 29 * MiB;
constexpr size_t WS_SSQ = 30 * MiB;
constexpr size_t WS_XC = 31 * MiB;
constexpr size_t WS_UB = 35 * MiB;
constexpr size_t WS_VB = 67 * MiB;
constexpr size_t WS_XN = 99 * MiB;
constexpr size_t WS_P = 165 * MiB;
constexpr size_t WS_XQ = 300 * MiB;
constexpr size_t WS_XSC = 334 * MiB;
constexpr size_t WS_KV = 380 * MiB;
constexpr size_t WS_GATE = WS_KV + (size_t)NROW * 128 * 4;
constexpr size_t WS_RS = 413 * MiB;
constexpr size_t WS_XB = 446 * MiB;
constexpr size_t WS_END = 510 * MiB;
static_assert(WS_P + (size_t)NROW * 2048 * 2 <= WS_XQ && WS_XQ + (size_t)NROW * DM <= WS_XSC && WS_XSC + (size_t)NROW * 16 <= WS_KV, "ws map (ffn)");
static_assert(WS_WIN + (size_t)2 * PW * DM * 2 <= WS_WOUT && WS_XN + (size_t)NROW * DM * 2 <= WS_P && WS_P + (size_t)NROW * PW * 2 <= WS_KV &&
              WS_KV + (size_t)NROW * KVW * 2 <= WS_RS && WS_GATE + (size_t)NROW * 128 * 4 <= WS_RS && WS_RS + (size_t)32 * 66 * 4096 * 4 <= WS_XB && WS_XB + (size_t)NBATCH * SEQ * DM * 2 <= WS_END, "ws map");
constexpr int CW_TMO = 0, CW_BAR = 4096;

constexpr int RING_BYTES = 131072;
constexpr int LDSCTL_OFF = RING_BYTES, MISC_OFF = LDSCTL_OFF + 320;
constexpr int LDS_BYTES = 147456;
constexpr int NWAVES = 8, NTHR = 512;

__device__ __forceinline__ unsigned cvt_pk_bf16(float lo, float hi) { unsigned r; asm volatile("v_cvt_pk_bf16_f32 %0, %1, %2" : "=v"(r) : "v"(lo), "v"(hi)); return r; }
__device__ __forceinline__ float bf_lo(unsigned w) { return __uint_as_float(w << 16); }
__device__ __forceinline__ float bf_hi(unsigned w) { return __uint_as_float(w & 0xffff0000u); }
__device__ __forceinline__ float bf2f(bf16_t h) { return __uint_as_float((unsigned)h << 16); }
__device__ __forceinline__ int lane_id() { unsigned z = 0u; asm volatile("" : "+v"(z)); return (int)__builtin_amdgcn_mbcnt_hi(~0u, __builtin_amdgcn_mbcnt_lo(~0u, z)); }
template <int M> __device__ __forceinline__ float xshfl(float v) {
    if constexpr (M == 32) { auto rr = __builtin_amdgcn_permlane32_swap(__float_as_uint(v), __float_as_uint(v), false, false);
        return __uint_as_float((lane_id() & 32) ? rr[0] : rr[1]); }
    else return __uint_as_float((unsigned)__builtin_amdgcn_ds_swizzle((int)__float_as_uint(v), (M << 10) | 0x1F));
}
__device__ __forceinline__ float xsum32(float v) { auto rr = __builtin_amdgcn_permlane32_swap(__float_as_uint(v), __float_as_uint(v), false, false); return __uint_as_float(rr[0]) + __uint_as_float(rr[1]); }
__device__ __forceinline__ float xmax32(float v) { auto rr = __builtin_amdgcn_permlane32_swap(__float_as_uint(v), __float_as_uint(v), false, false); return fmaxf(__uint_as_float(rr[0]), __uint_as_float(rr[1])); }
__device__ __forceinline__ float wave_sum(float v) {
    v += xshfl<1>(v); v += xshfl<2>(v); v += xshfl<4>(v); v += xshfl<8>(v); v += xshfl<16>(v); return xsum32(v);
}
__device__ __forceinline__ float fexp2(float x) { return __builtin_amdgcn_exp2f(x); }
__device__ __forceinline__ float silu_f(float x) { return x / (1.f + __expf(-x)); }
template <class T> __device__ __forceinline__ T* as_global(T* p) { return (T*)(GAS T*)p; }
#define LDS_WAIT() asm volatile("s_waitcnt lgkmcnt(0)" ::: "memory")
#define VM_WAIT() asm volatile("s_waitcnt vmcnt(0)" ::: "memory")

#define XB_TMO      128
#define XB_XCNT(j)  (256  + 64 * (j))
#define XB_XSUB(j)  (1280 + 64 * (j))
#define XB_XGEN(j)  (2304 + 64 * (j))
#define XB_TOP      3328
#define XB_TOPGEN   3392
#define XCD_BAR_WORDS 3456
#define XB_SPIN_CAP (1u << 18)
__device__ __forceinline__ unsigned xb_ld(unsigned* p)              { return __hip_atomic_load(p, __ATOMIC_RELAXED, __HIP_MEMORY_SCOPE_AGENT); }
__device__ __forceinline__ unsigned xb_add(unsigned* p, unsigned v) { return __hip_atomic_fetch_add(p, v, __ATOMIC_RELAXED, __HIP_MEMORY_SCOPE_AGENT); }
__device__ __forceinline__ unsigned xb_xcc_id() { return (unsigned)__builtin_amdgcn_s_getreg((3 << 11) | 20) & 0xFu; }
#define XB_SPIN(cond, bar) do { unsigned _sp = 0; while (cond) { __builtin_amdgcn_s_sleep(1); \
    if ((++_sp & 255u) == 0u) { if (xb_ld(&(bar)[XB_TMO])) break; if (_sp > XB_SPIN_CAP) { atomicAdd(&(bar)[XB_TMO], 1u); break; } } } } while (0)
struct XcdBarrier { unsigned* bar; unsigned x; volatile LAS unsigned* st; };
__device__ __forceinline__ XcdBarrier xcd_barrier_post(unsigned* bar, volatile LAS unsigned* st) {
    XcdBarrier b; b.bar = bar; b.x = xb_xcc_id(); b.st = st;
    if (threadIdx.x == 0) (void)xb_add(&bar[XB_XCNT(b.x)], 1u);
    return b;
}
__device__ __forceinline__ void xcd_barrier_complete(unsigned* bar, unsigned x, unsigned& nloc, unsigned& nx) {
    const unsigned G = gridDim.x * gridDim.y * gridDim.z;
    unsigned sum, cnt, mine, sp = 0u;
    for (;;) {
        sum = 0u; cnt = 0u; mine = 0u;
#pragma unroll
        for (unsigned j = 0; j < 16; ++j) { const unsigned c = xb_ld(&bar[XB_XCNT(j)]); sum += c; cnt += (c > 0u) ? 1u : 0u; mine = (j == x) ? c : mine; }
        if (sum == G) break;
        __builtin_amdgcn_s_sleep(1);
        if ((++sp & 255u) == 0u) { if (xb_ld(&bar[XB_TMO])) break; if (sp > XB_SPIN_CAP) { atomicAdd(&bar[XB_TMO], 1u); break; } }
    }
    nloc = mine > 0u ? mine : 1u; nx = cnt > 0u ? cnt : 1u;
}
__device__ __forceinline__ void xcd_barrier(const XcdBarrier& b) {
    asm volatile("s_waitcnt vmcnt(0)" ::: "memory");
    __syncthreads();
    if (threadIdx.x == 0) {
        unsigned* bar = b.bar;
        __builtin_amdgcn_s_waitcnt(0);
        unsigned nloc = b.st[0], nx = b.st[1];
        if (nloc == 0u) { unsigned xo = b.x; asm volatile("" : "+s"(xo)); xcd_barrier_complete(bar, xo, nloc, nx); b.st[0] = nloc; b.st[1] = nx; }
        const unsigned old = xb_add(&bar[XB_XSUB(b.x)], 1u);
        const unsigned gen = old / nloc;
        if (old + 1u == (gen + 1u) * nloc) {
            __builtin_amdgcn_fence(__ATOMIC_RELEASE, "agent");
            asm volatile("s_waitcnt vmcnt(0)" ::: "memory");
            const unsigned og = xb_add(&bar[XB_TOP], 1u);
            const unsigned tg = og / nx;
            if (og + 1u == (tg + 1u) * nx) xb_add(&bar[XB_TOPGEN], 1u);
            else XB_SPIN(xb_ld(&bar[XB_TOPGEN]) == tg, bar);
            __builtin_amdgcn_fence(__ATOMIC_ACQUIRE, "agent");
            xb_add(&bar[XB_XGEN(b.x)], 1u);
            asm volatile("s_waitcnt vmcnt(0)" ::: "memory");
        } else {
            XB_SPIN(xb_ld(&bar[XB_XGEN(b.x)]) == gen, bar);
            __builtin_amdgcn_fence(__ATOMIC_ACQUIRE, "agent");
            asm volatile("s_waitcnt vmcnt(0)" ::: "memory");
        }
    }
    __syncthreads();
}
namespace pg8 {
constexpr int BM = 256, BK = 64, HALF = 128, HTB = HALF * BK * 2, STAGE_BYTES = 8 * HTB;
__host__ __device__ __forceinline__ int lds_byte(int r, int c) { const int st = (r >> 4) * 2 + (c >> 5), rr = r & 15, cc = c & 31, ob = rr * 64 + cc * 2; return st * 1024 + (ob ^ (((ob >> 9) & 1) << 5)); }
__host__ __device__ __forceinline__ void stage_rc(int b, int& R, int& C) { const int st = b / 1024, sb = b % 1024, swz = sb ^ (((sb >> 9) & 1) << 5); R = (st >> 1) * 16 + swz / 64; C = (st & 1) * 32 + (swz % 64) / 2; }
__host__ __device__ __forceinline__ int perm32(int rho) { const int n = rho >> 4, i = rho & 15; return 8 * (i >> 2) + 4 * n + (i & 3); }
struct Unit { int pm, pn; };
struct Gemm { const bf16_t* A; const bf16_t* Bt; };

struct LinOrder {
    int nN, nUnits, G, c, skipctx;
    __device__ __forceinline__ bool next(int i, Unit& u) const {
        const int L = i * G + c; if (L >= nUnits) return false;
        const int pmv = L / nN; u.pn = L - pmv * nN; u.pm = skipctx ? (pmv + pmv / 32 + 1) : pmv; return true;
    }
    __device__ __forceinline__ void a_ready(const Unit&) const {}
    __device__ __forceinline__ void done(const Unit&) const {}
};

template <class Epi, class Sched, int KDIM, int LDA, int LDB, bool ALIGN_EPI = false>
__device__ __forceinline__ void gemm_phase(LAS unsigned char* lds, int wave_sgpr, const Gemm g, const Sched& S, const Epi& E) {
    const int wid = __builtin_amdgcn_readfirstlane(wave_sgpr); int lane = lane_id(); asm volatile("" : "+v"(lane)); const int tid = wid * 64 + lane;
    const int wr = wid >> 2, wc = wid & 3, fr = lane & 15, fq = lane >> 4;
    int nt = KDIM / BK; asm volatile("" : "+s"(nt));
    unsigned voffA[2], voffB[2];
#pragma unroll
    for (int i = 0; i < 2; ++i) { int R, C; stage_rc(tid * 16 + i * 8192, R, C); const int Rb = Epi::PERM ? (64 * (R >> 5) + perm32(R & 31)) : R;
        voffA[i] = (unsigned)(R * LDA + C) * 2u; voffB[i] = (unsigned)(Rb * LDB + C) * 2u; }
    constexpr size_t kstep = (size_t)(BK * 2);
    constexpr size_t hstepA = (size_t)HALF * LDA * 2, hstepB = (size_t)(Epi::PERM ? 32 : HALF) * LDB * 2;
    constexpr size_t tstepA = (size_t)BM * LDA * 2, tstepB = (size_t)BM * LDB * 2;
    const unsigned ldsw = (unsigned)wid * 1024u;
    const int aoff = lds_byte(wr * 64 + fr, fq * 8), boff = lds_byte(wc * 32 + fr, fq * 8);
#define PG8_SA(b, h) (((b) * 2 + (h)) * HTB)
#define PG8_SB(b, h) ((4 + (b) * 2 + (h)) * HTB)
#define PG8_STAGE(bufoff, gbase, voff) do { _Pragma("unroll") for (int _i = 0; _i < 2; ++_i) \
        __builtin_amdgcn_global_load_lds((const unsigned*)((const char*)(gbase) + (voff)[_i]), (LAS unsigned*)(lds + (bufoff) + ldsw + _i * 8192), 16, 0, 0); } while (0)
#define PG8_LDA(dst, b, h) do { _Pragma("unroll") for (int m = 0; m < 4; ++m) _Pragma("unroll") for (int k = 0; k < 2; ++k) dst[m][k] = *(const LAS bf16x8*)(lds + PG8_SA(b, h) + aoff + m * 2048 + k * 1024); } while (0)
#define PG8_LDB(dst, b, h) do { _Pragma("unroll") for (int n = 0; n < 2; ++n) _Pragma("unroll") for (int k = 0; k < 2; ++k) dst[n][k] = *(const LAS bf16x8*)(lds + PG8_SB(b, h) + boff + n * 2048 + k * 1024); } while (0)
#define PG8_MMA(ai, bj, At, Bt) do { __builtin_amdgcn_s_setprio(1); _Pragma("unroll") for (int m = 0; m < 4; ++m) _Pragma("unroll") for (int n = 0; n < 2; ++n) _Pragma("unroll") for (int k = 0; k < 2; ++k) \
        acc[ai][bj][m][n] = __builtin_amdgcn_mfma_f32_16x16x32_bf16(Bt[n][k], At[m][k], acc[ai][bj][m][n], 0, 0, 0); __builtin_amdgcn_s_setprio(0); } while (0)
#define PG8_WAIT_V(n) asm volatile("s_waitcnt vmcnt(" #n ")" ::: "memory")
#define PG8_WAIT_L(n) asm volatile("s_waitcnt lgkmcnt(" #n ")" ::: "memory")
#define PG8_BAR __builtin_amdgcn_s_barrier()
#define PG8_SCHED __builtin_amdgcn_sched_barrier(0)
    Unit cur, nxt; int ui = 0;
    if (!S.next(0, cur)) return;
    f32x4 acc[2][2][4][2];
#pragma unroll
    for (int a = 0; a < 2; ++a)
#pragma unroll
        for (int b = 0; b < 2; ++b)
#pragma unroll
            for (int m = 0; m < 4; ++m)
#pragma unroll
                for (int n = 0; n < 2; ++n) acc[a][b][m][n] = (f32x4){0.f, 0.f, 0.f, 0.f};
    bf16x8 At[4][2], B0[2][2], B1[2][2];
    const char* cA = (const char*)g.A + (size_t)cur.pm * tstepA; const char* cB = (const char*)g.Bt + (size_t)cur.pn * tstepB;
    S.a_ready(cur);
    PG8_STAGE(PG8_SB(0, 0), cB, voffB); PG8_STAGE(PG8_SB(0, 1), cB + hstepB, voffB); PG8_STAGE(PG8_SA(0, 0), cA, voffA); PG8_STAGE(PG8_SA(0, 1), cA + hstepA, voffA);
    if (wr == 1) PG8_BAR;
    PG8_WAIT_V(2); PG8_BAR;
    PG8_STAGE(PG8_SB(1, 0), cB + kstep, voffB); PG8_STAGE(PG8_SA(1, 0), cA + kstep, voffA); PG8_STAGE(PG8_SB(1, 1), cB + hstepB + kstep, voffB);
    PG8_WAIT_V(6); PG8_BAR;
    for (;;) {
        const bool has_next = S.next(ui + 1, nxt);
        const char* nA = has_next ? (const char*)g.A + (size_t)nxt.pm * tstepA : cA; const char* nB = has_next ? (const char*)g.Bt + (size_t)nxt.pn * tstepB : cB;
        for (int t = 0; t < nt; t += 2) {
            const bool last = (t == nt - 2);
            const char* a1 = cA + (size_t)(t + 1) * kstep;
            const char* a2 = last ? nA : cA + (size_t)(t + 2) * kstep; const char* b2 = last ? nB : cB + (size_t)(t + 2) * kstep;
            const char* a3 = a2 + kstep; const char* b3 = b2 + kstep;
            if (last && has_next) S.a_ready(nxt);
            PG8_LDB(B0, 0, 0); PG8_LDB(B1, 0, 1); PG8_SCHED; PG8_LDA(At, 0, 0); PG8_STAGE(PG8_SA(1, 1), a1 + hstepA, voffA);
            PG8_WAIT_V(8); PG8_WAIT_L(0); PG8_BAR; PG8_MMA(0, 0, At, B0); PG8_MMA(0, 1, At, B1); PG8_BAR; PG8_SCHED;
            PG8_LDA(At, 0, 1); PG8_STAGE(PG8_SB(0, 0), b2, voffB); PG8_STAGE(PG8_SB(0, 1), b2 + hstepB, voffB); PG8_STAGE(PG8_SA(0, 0), a2, voffA);
            PG8_WAIT_V(8); PG8_WAIT_L(0); PG8_BAR; PG8_MMA(1, 0, At, B0); PG8_MMA(1, 1, At, B1); PG8_BAR; PG8_SCHED;
            PG8_LDB(B0, 1, 0); PG8_LDB(B1, 1, 1); PG8_SCHED; PG8_LDA(At, 1, 0); PG8_STAGE(PG8_SA(0, 1), a2 + hstepA, voffA);
            PG8_WAIT_V(8); PG8_WAIT_L(0); PG8_BAR; PG8_MMA(0, 0, At, B0); PG8_MMA(0, 1, At, B1); PG8_BAR; PG8_SCHED;
            PG8_LDA(At, 1, 1); PG8_STAGE(PG8_SB(1, 0), b3, voffB); PG8_STAGE(PG8_SB(1, 1), b3 + hstepB, voffB); PG8_STAGE(PG8_SA(1, 0), a3, voffA);
            PG8_WAIT_V(8); PG8_WAIT_L(0); PG8_BAR; PG8_MMA(1, 0, At, B0); PG8_MMA(1, 1, At, B1); PG8_BAR; PG8_SCHED;
        }
        if constexpr (ALIGN_EPI) { if (wr == 0) PG8_BAR; }
        E(acc, cur, wr, wc, fr, fq); S.done(cur);
        if (!has_next) break;
#pragma unroll
        for (int a = 0; a < 2; ++a)
#pragma unroll
            for (int b = 0; b < 2; ++b)
#pragma unroll
                for (int m = 0; m < 4; ++m)
#pragma unroll
                    for (int n = 0; n < 2; ++n) acc[a][b][m][n] = (f32x4){0.f, 0.f, 0.f, 0.f};
        cur = nxt; cA = nA; cB = nB; ++ui;
        if constexpr (ALIGN_EPI) { if (wr == 1) PG8_BAR; }
    }
    PG8_WAIT_V(0);
    if constexpr (!ALIGN_EPI) { if (wr == 0) PG8_BAR; }
    PG8_BAR;
#undef PG8_SA
#undef PG8_SB
#undef PG8_STAGE
#undef PG8_LDA
#undef PG8_LDB
#undef PG8_MMA
#undef PG8_WAIT_V
#undef PG8_WAIT_L
#undef PG8_BAR
#undef PG8_SCHED
}

__device__ __forceinline__ unsigned dpp_ror8(unsigned v) { return (unsigned)__builtin_amdgcn_mov_dpp((int)v, 0x128, 0xf, 0xf, false); }
__device__ __forceinline__ void epi_pair_exchange(const u32x4 c0, const u32x4 c1, int fr, u32x4& a, u32x4& b) {
    const bool lo = fr < 8;
    const u32x4 send = lo ? c1 : c0;
    u32x4 recv; recv.x = dpp_ror8(send.x); recv.y = dpp_ror8(send.y); recv.z = dpp_ror8(send.z); recv.w = dpp_ror8(send.w);
    a = lo ? c0 : recv;
    b = lo ? recv : c1;
}

struct EpiProj {
    static constexpr bool PERM = true;
    bf16_t* P; float* ssq; const f32x2* r64; const f32x2* r32;
    struct Cfg { float sc; int rope, pp, c0, cs; bool isckv, valid; };
    __device__ __forceinline__ Cfg cfg(int cs, int fq, bool isctx) const {
        Cfg C; C.cs = cs; C.c0 = cs + 8 * fq; C.sc = 1.f; C.rope = 0; C.pp = 0; C.valid = cs < INW;
        if (cs < C_CKV) { C.sc = 0.10206207261596577f * LOG2E; const int p = cs % 96; if (p >= 64) { C.rope = 32; C.pp = C.c0 % 96 - 64; } }
        else if (cs < C_KR) { }
        else if (cs < C_SWAQ) { C.rope = 32; C.pp = C.c0 - C_KR; }
        else if (cs < C_SWAK) { C.sc = 0.125f * LOG2E; C.rope = 64; C.pp = (C.c0 - C_SWAQ) & 63; }
        else if (cs < C_SWAV) { C.rope = 64; C.pp = (C.c0 - C_SWAK) & 63; }
        else if (cs < C_NAQ) { }
        else if (cs < C_NAK) { C.sc = 0.125f * LOG2E; }
        else if (cs < C_RK) { }
        else if (cs < C_RV) { C.sc = 0.125f; }
        C.isckv = (cs >= C_CKV && cs < C_KR);
        if (isctx) C.rope = 0;
        return C;
    }
    __device__ __forceinline__ u32x4 chunk(const f32x4 a0, const f32x4 a1, const Cfg& C, int t, int row, int fq) const {
        f32x4 v0 = a0 * C.sc, v1 = a1 * C.sc;
        if (C.rope) {
            f32x4 cs0, cs1;
            if (C.rope == 64) { const int pos = (C.pp >= 32) ? (t & 63) : (t >> 6); const GAS f32x4* tp = (const GAS f32x4*)(r64 + pos * 16 + ((C.pp & 31) >> 1)); cs0 = tp[0]; cs1 = tp[1]; }
            else              { const int pos = (C.pp >= 16) ? (t & 63) : (t >> 6); const GAS f32x4* tp = (const GAS f32x4*)(r32 + pos * 8 + ((C.pp & 15) >> 1)); cs0 = tp[0]; cs1 = tp[1]; }
            f32x4 w0, w1;
            w0[0] = v0[0] * cs0[0] - v0[1] * cs0[1]; w0[1] = v0[0] * cs0[1] + v0[1] * cs0[0];
            w0[2] = v0[2] * cs0[2] - v0[3] * cs0[3]; w0[3] = v0[2] * cs0[3] + v0[3] * cs0[2];
            w1[0] = v1[0] * cs1[0] - v1[1] * cs1[1]; w1[1] = v1[0] * cs1[1] + v1[1] * cs1[0];
            w1[2] = v1[2] * cs1[2] - v1[3] * cs1[3]; w1[3] = v1[2] * cs1[3] + v1[3] * cs1[2];
            v0 = w0; v1 = w1;
        }
        if (C.isckv) {
            float s = (v0[0] * v0[0] + v0[1] * v0[1]) + (v0[2] * v0[2] + v0[3] * v0[3]) + (v1[0] * v1[0] + v1[1] * v1[1]) + (v1[2] * v1[2] + v1[3] * v1[3]);
            s += xshfl<16>(s); s = xsum32(s);
            if (fq == 0) ((GAS float*)ssq)[(size_t)row * 4 + ((C.cs - C_CKV) >> 5)] = s;
        }
        u32x4 w; w.x = cvt_pk_bf16(v0[0], v0[1]); w.y = cvt_pk_bf16(v0[2], v0[3]); w.z = cvt_pk_bf16(v1[0], v1[1]); w.w = cvt_pk_bf16(v1[2], v1[3]);
        return w;
    }
    __device__ __forceinline__ void operator()(const f32x4 (&acc)[2][2][4][2], const Unit& u, int wr, int wc, int, int) const {
        int ln_ = lane_id(); asm volatile("" : "+v"(ln_)); const int fr = ln_ & 15, fq = ln_ >> 4;
        const bool isctx = (u.pm % 33) == 0;
        const int tb = (u.pm % 33 - 1) * 256;
        const int cw = u.pn * BM + wc * 64;
        const Cfg C0 = cfg(cw, fq, isctx), C1 = cfg(cw + 32, fq, isctx);
        if (!C0.valid) return;
        const bool vst = (fr < 8) ? true : C1.valid;
        const int cst = cw + ((fr >> 3) << 5) + 8 * fq;
#pragma unroll
        for (int ai = 0; ai < 2; ++ai)
#pragma unroll
            for (int m = 0; m < 4; ++m) {
                const int rg = u.pm * BM + ai * HALF + wr * 64 + m * 16;
                const int row = rg + fr, t = tb + ai * HALF + wr * 64 + m * 16 + fr;
                const u32x4 k0 = chunk(acc[ai][0][m][0], acc[ai][0][m][1], C0, t, row, fq);
                u32x4 k1 = {0u, 0u, 0u, 0u};
                if (C1.valid) k1 = chunk(acc[ai][1][m][0], acc[ai][1][m][1], C1, t, row, fq);
                u32x4 sa, sb; epi_pair_exchange(k0, k1, fr, sa, sb);
                if (vst) { *(GAS u32x4*)(P + (size_t)(rg + (fr & 7)) * PW + cst) = sa; *(GAS u32x4*)(P + (size_t)(rg + 8 + (fr & 7)) * PW + cst) = sb; }
            }
    }
};
struct EpiKV {
    static constexpr bool PERM = true;
    bf16_t* KV; const float* ssq;
    __device__ __forceinline__ void operator()(const f32x4 (&acc)[2][2][4][2], const Unit& u, int wr, int wc, int, int) const {
        int ln_ = lane_id(); asm volatile("" : "+v"(ln_)); const int fr = ln_ & 15, fq = ln_ >> 4;
        const int cst = u.pn * BM + wc * 64 + ((fr >> 3) << 5) + 8 * fq;
#pragma unroll
        for (int ai = 0; ai < 2; ++ai)
#pragma unroll
            for (int m = 0; m < 4; ++m) {
                const int rg = u.pm * BM + ai * HALF + wr * 64 + m * 16, row = rg + fr;
                const f32x4 q4 = *(const GAS f32x4*)(ssq + (size_t)row * 4); const float rs = 1.0f / sqrtf(((q4[0] + q4[1]) + (q4[2] + q4[3])) * (1.f / 128.f) + EPS);
                u32x4 k[2];
#pragma unroll
                for (int bj = 0; bj < 2; ++bj) { const f32x4 v0 = acc[ai][bj][m][0] * rs, v1 = acc[ai][bj][m][1] * rs;
                    k[bj].x = cvt_pk_bf16(v0[0], v0[1]); k[bj].y = cvt_pk_bf16(v0[2], v0[3]); k[bj].z = cvt_pk_bf16(v1[0], v1[1]); k[bj].w = cvt_pk_bf16(v1[2], v1[3]); }
                u32x4 sa, sb; epi_pair_exchange(k[0], k[1], fr, sa, sb);
                *(GAS u32x4*)(KV + (size_t)(rg + (fr & 7)) * KVW + cst) = sa; *(GAS u32x4*)(KV + (size_t)(rg + 8 + (fr & 7)) * KVW + cst) = sb;
            }
    }
};
struct EpiResid {
    static constexpr bool PERM = true;
    const float* xl_in; bf16_t* xb; const float* xc_in; float* xc_out; const float* mod;
    __device__ __forceinline__ void operator()(const f32x4 (&acc)[2][2][4][2], const Unit& u, int wr, int wc, int, int) const {
        int ln_ = lane_id(); asm volatile("" : "+v"(ln_)); const int fr = ln_ & 15, fq = ln_ >> 4;
        const int b = u.pm / 33, jt = u.pm % 33;
        const int cw = u.pn * BM + wc * 64 + 8 * fq;
        const float* gate = mod + ((jt == 0) ? 4 : b) * 6144 + 2 * DM;
        if (jt == 0) {
#pragma unroll
            for (int bj = 0; bj < 2; ++bj) { const int c = cw + 32 * bj; const f32x4 g0 = *(const GAS f32x4*)(gate + c), g1 = *(const GAS f32x4*)(gate + c + 4);
#pragma unroll
                for (int ai = 0; ai < 2; ++ai)
#pragma unroll
                    for (int m = 0; m < 4; ++m) { const size_t off = ((size_t)b * CTXL + ai * HALF + wr * 64 + m * 16 + fr) * DM + c;
                        const f32x4 b0 = *(const GAS f32x4*)(xc_in + off), b1 = *(const GAS f32x4*)(xc_in + off + 4);
                        *(GAS f32x4*)(xc_out + off) = b0 + g0 * acc[ai][bj][m][0]; *(GAS f32x4*)(xc_out + off + 4) = b1 + g1 * acc[ai][bj][m][1]; } }
            return;
        }
        const f32x4 ga0 = *(const GAS f32x4*)(gate + cw), ga1 = *(const GAS f32x4*)(gate + cw + 4), gb0 = *(const GAS f32x4*)(gate + cw + 32), gb1 = *(const GAS f32x4*)(gate + cw + 36);
        const int cst = cw + ((fr >> 3) << 5);
        const size_t rbase = (size_t)b * SEQ + (size_t)(jt - 1) * 256;
#pragma unroll
        for (int ai = 0; ai < 2; ++ai)
#pragma unroll
            for (int m = 0; m < 4; ++m) {
                const size_t rg = rbase + ai * HALF + wr * 64 + m * 16;
                const f32x4 d00 = ga0 * acc[ai][0][m][0], d01 = ga1 * acc[ai][0][m][1], d10 = gb0 * acc[ai][1][m][0], d11 = gb1 * acc[ai][1][m][1];
                u32x4 a0, b0, a1, b1;
                epi_pair_exchange(__builtin_bit_cast(u32x4, d00), __builtin_bit_cast(u32x4, d10), fr, a0, b0);
                epi_pair_exchange(__builtin_bit_cast(u32x4, d01), __builtin_bit_cast(u32x4, d11), fr, a1, b1);
#pragma unroll
                for (int hb = 0; hb < 2; ++hb) {
                    const size_t off = (rg + 8 * hb + (fr & 7)) * DM + cst;
                    const f32x4 e0 = __builtin_bit_cast(f32x4, hb ? b0 : a0), e1 = __builtin_bit_cast(f32x4, hb ? b1 : a1);
                    f32x4 x0, x1;
                    if (xl_in) { x0 = *(const GAS f32x4*)(xl_in + off); x1 = *(const GAS f32x4*)(xl_in + off + 4); }
                    else { const u32x4 w = *(const GAS u32x4*)(xb + off); x0 = (f32x4){bf_lo(w.x), bf_hi(w.x), bf_lo(w.y), bf_hi(w.y)}; x1 = (f32x4){bf_lo(w.z), bf_hi(w.z), bf_lo(w.w), bf_hi(w.w)}; }
                    const f32x4 r0 = x0 + e0, r1 = x1 + e1;
                    u32x4 w2; w2.x = cvt_pk_bf16(r0[0], r0[1]); w2.y = cvt_pk_bf16(r0[2], r0[3]); w2.z = cvt_pk_bf16(r1[0], r1[1]); w2.w = cvt_pk_bf16(r1[2], r1[3]);
                    *(GAS u32x4*)(xb + off) = w2;
                }
            }
    }
};
struct EpiScore {
    static constexpr bool PERM = true;
    _Float16* S;
    __device__ __forceinline__ void operator()(const f32x4 (&acc)[2][2][4][2], const Unit& u, int wr, int wc, int, int) const {
        int ln_ = lane_id(); asm volatile("" : "+v"(ln_)); const int fr = ln_ & 15, fq = ln_ >> 4;
        typedef _Float16 h2 __attribute__((ext_vector_type(2)));
        const int cst = u.pn * BM + wc * 64 + ((fr >> 3) << 5) + 8 * fq;
#pragma unroll
        for (int ai = 0; ai < 2; ++ai)
#pragma unroll
            for (int m = 0; m < 4; ++m) {
                const int rg = u.pm * BM + ai * HALF + wr * 64 + m * 16;
                u32x4 k[2];
#pragma unroll
                for (int bj = 0; bj < 2; ++bj) { const f32x4 v0 = acc[ai][bj][m][0], v1 = acc[ai][bj][m][1];
                    const h2 a = {(_Float16)v0[0], (_Float16)v0[1]}, b = {(_Float16)v0[2], (_Float16)v0[3]}, c = {(_Float16)v1[0], (_Float16)v1[1]}, d = {(_Float16)v1[2], (_Float16)v1[3]};
                    k[bj].x = __builtin_bit_cast(unsigned, a); k[bj].y = __builtin_bit_cast(unsigned, b); k[bj].z = __builtin_bit_cast(unsigned, c); k[bj].w = __builtin_bit_cast(unsigned, d); }
                u32x4 sa, sb; epi_pair_exchange(k[0], k[1], fr, sa, sb);
                *(GAS u32x4*)(S + (size_t)(rg + (fr & 7)) * 2048 + cst) = sa; *(GAS u32x4*)(S + (size_t)(rg + 8 + (fr & 7)) * 2048 + cst) = sb;
            }
    }
};
struct EpiNull {
    static constexpr bool PERM = true;
    float* sink;
    __device__ __forceinline__ void operator()(const f32x4 (&acc)[2][2][4][2], const Unit& u, int wr, int wc, int, int) const {
        float t = 0.f;
#pragma unroll
        for (int a = 0; a < 2; ++a)
#pragma unroll
            for (int b = 0; b < 2; ++b)
#pragma unroll
                for (int m = 0; m < 4; ++m) t += acc[a][b][m][0][0] + acc[a][b][m][1][3];
        if (t == 123.456f) sink[0] = t;
    }
};
}
struct Frame {
    LAS unsigned char* lds;
    int tid, lane, wave, vcu, G;
};
struct Inputs {
    const float *x, *c, *ctx, *c_ctx, *ada_w, *ada_b, *norm_mix_g, *w_in, *mla_kv_norm_g, *mla_w_ukv, *swa_sink, *na_rpb, *ret_decay_f, *ret_decay_b,
                *ret_gn_f, *ret_gn_b, *mix_beta, *w_out, *norm_ffn_g, *peer_wq, *peer_k1, *peer_k2, *peer_u, *peer_v, *final_norm_g;
};

__device__ __forceinline__ int orig_col(int c) {
    if (c < C_CKV) { const int h = c / 96, p = c % 96; if (p < 64) return c; const int pp = p - 64; return h * 96 + 64 + (pp >> 4) * 16 + (pp & 1) * 8 + ((pp & 15) >> 1); }
    if (c < C_KR) return c;
    if (c < C_SWAQ) { const int pp = c - C_KR; return C_KR + (pp >> 4) * 16 + (pp & 1) * 8 + ((pp & 15) >> 1); }
    if (c < C_SWAV) { const int q = c - C_SWAQ, hh = q >> 6, pp = q & 63; return C_SWAQ + hh * 64 + (pp >> 5) * 32 + (pp & 1) * 16 + ((pp & 31) >> 1); }
    return c;
}

template <int MAP  >
__device__ __forceinline__ void transpose_item(const float* W, int K, int Nsrc, int Nvalid, int Ndst, const float* kscale, bf16_t* WT, LAS float* scr, int item, int lane) {
    const int nblk = Ndst / 32, kb = item / nblk, nb = item % nblk, k0 = 64 * kb, n0 = 32 * nb;
    const int nd = n0 + (lane & 31);
    const int ns = (nd < Nvalid) ? (MAP ? orig_col(nd) : nd) : -1;
#pragma unroll 8
    for (int i = 0; i < 32; ++i) { const int kk = 2 * i + (lane >> 5); float v = 0.f; if (ns >= 0) { v = W[(size_t)(k0 + kk) * Nsrc + ns]; if (kscale) v *= kscale[k0 + kk]; } scr[kk * 33 + (lane & 31)] = v; }
    LDS_WAIT(); asm volatile("" ::: "memory");
    const int c = lane & 7;
#pragma unroll
    for (int j = 0; j < 4; ++j) { const int n = (lane >> 3) + 8 * j; const LAS float* s = scr + (8 * c) * 33 + n;
        u32x4 o; o.x = cvt_pk_bf16(s[0 * 33], s[1 * 33]); o.y = cvt_pk_bf16(s[2 * 33], s[3 * 33]); o.z = cvt_pk_bf16(s[4 * 33], s[5 * 33]); o.w = cvt_pk_bf16(s[6 * 33], s[7 * 33]);
        *(GAS u32x4*)(WT + (size_t)(n0 + n) * K + k0 + 8 * c) = o; }
    LDS_WAIT(); asm volatile("" ::: "memory");
}

__device__ __forceinline__ void sincos_small(float af, float& sn, float& cs) {
    const double a = (double)af; const double n = __builtin_rint(a * 0.63661977236758134308); const double r = (a - n * 1.57079632679489655800) - n * 6.123233995736766036e-17;
    const double r2 = r * r;
    const double s = r * (1.0 + r2 * (-1.0 / 6 + r2 * (1.0 / 120 + r2 * (-1.0 / 5040 + r2 * (1.0 / 362880 + r2 * (-1.0 / 39916800 + r2 * (1.0 / 6227020800.0)))))));
    const double c = 1.0 + r2 * (-0.5 + r2 * (1.0 / 24 + r2 * (-1.0 / 720 + r2 * (1.0 / 40320 + r2 * (-1.0 / 3628800 + r2 * (1.0 / 479001600 + r2 * (-1.0 / 87178291200.0)))))));
    const int q = ((int)n) & 3;
    const double ss = (q == 0) ? s : (q == 1) ? c : (q == 2) ? -s : -c;
    const double cc = (q == 0) ? c : (q == 1) ? -s : (q == 2) ? -c : s;
    sn = (float)ss; cs = (float)cc;
}

__device__ __forceinline__ void phase_prologue(Frame& F, const Inputs& I, unsigned char* ws) {
    float* MOD = (float*)(ws + WS_MOD);
    {
        LAS float* sc = (LAS float*)F.lds;
        LAS float* red = (LAS float*)(F.lds + 20480);
        for (int i = F.tid; i < 5 * DM; i += NTHR) { const float v = (i < 4 * DM) ? I.c[i] : I.c_ctx[i - 4 * DM]; sc[i] = silu_f(v); }
        __syncthreads();
        for (int task = blockIdx.x; task < NLAYER * 96; task += F.G) {
            const int l = task / 96, n = (task % 96) * 64 + F.lane;
            const float* w = I.ada_w + (size_t)l * DM * 6144 + n;
            float a0 = 0.f, a1 = 0.f, a2 = 0.f, a3 = 0.f, a4 = 0.f;
            const int kb = F.wave * 128;
            for (int k0 = kb; k0 < kb + 128; k0 += 16) {
                float wv[16];
#pragma unroll
                for (int i = 0; i < 16; ++i) wv[i] = ((const GAS float*)w)[(size_t)(k0 + i) * 6144];
#pragma unroll
                for (int i = 0; i < 16; ++i) { const int k = k0 + i; a0 += sc[k] * wv[i]; a1 += sc[DM + k] * wv[i]; a2 += sc[2 * DM + k] * wv[i]; a3 += sc[3 * DM + k] * wv[i]; a4 += sc[4 * DM + k] * wv[i]; }
            }
            LAS float* rw = red + F.wave * 320 + F.lane;
            rw[0] = a0; rw[64] = a1; rw[128] = a2; rw[192] = a3; rw[256] = a4;
            __syncthreads();
            if (F.tid < 320) { const int r = F.tid >> 6, ln = F.tid & 63; float s = 0.f;
#pragma unroll
                for (int wv = 0; wv < 8; ++wv) s += red[wv * 320 + r * 64 + ln];
                const int nn = (task % 96) * 64 + ln; MOD[(size_t)(l * 5 + r) * 6144 + nn] = s + I.ada_b[l * 6144 + nn]; }
            __syncthreads();
        }
    }
    {
        LAS float* scr = (LAS float*)(F.lds + F.wave * 16384);
        const int gw = F.vcu * NWAVES + F.wave, NGW = F.G * NWAVES;
        constexpr int I_IN = (DM / 64) * (PW / 32), I_OUT = (DM / 64) * (DM / 32), I_UKV = (128 / 64) * (KVW / 32);
        constexpr int PER_L = I_IN + I_OUT + I_UKV;
        for (int it = gw; it < NLAYER * PER_L; it += NGW) {
            const int l = it / PER_L; int r = it % PER_L;
            if (r < I_IN) { transpose_item<1>(I.w_in + (size_t)l * DM * INW, DM, INW, INW, PW, nullptr, (bf16_t*)(ws + WS_WIN) + (size_t)l * PW * DM, scr, r, F.lane); continue; } r -= I_IN;
            if (r < I_OUT) { transpose_item<0>(I.w_out + (size_t)l * DM * DM, DM, DM, DM, DM, I.mix_beta + l * DM, (bf16_t*)(ws + WS_WOUT) + (size_t)l * DM * DM, scr, r, F.lane); continue; } r -= I_OUT;
            transpose_item<0>(I.mla_w_ukv + (size_t)l * 128 * KVW, 128, KVW, KVW, KVW, I.mla_kv_norm_g + l * 128, (bf16_t*)(ws + WS_WUKV) + (size_t)l * KVW * 128, scr, r, F.lane);
        }
    }
    __syncthreads();
    {
        LAS float* wqs = (LAS float*)F.lds;
        LAS float* kps = (LAS float*)(F.lds + 32768);
        for (int task = blockIdx.x; task < NLAYER * 16 * 16; task += F.G) {
            const int l = task >> 8, hp = (task >> 4) & 15, k0 = (task & 15) * 64;
            const float* kp = ((hp & 1) ? I.peer_k2 : I.peer_k1) + (size_t)l * 128 * 128;
            for (int i = F.tid; i < 64 * 128; i += NTHR) wqs[i] = I.peer_wq[(size_t)l * DM * 2048 + (size_t)(k0 + (i >> 7)) * 2048 + hp * 128 + (i & 127)];
            for (int i = F.tid; i < 128 * 128; i += NTHR) kps[(i >> 7) * 129 + (i & 127)] = kp[i];
            __syncthreads();
            const int n = F.tid & 127, kq = F.tid >> 7;
            float a[16];
#pragma unroll
            for (int i = 0; i < 16; ++i) a[i] = 0.f;
            for (int d = 0; d < 128; d += 4) {
                const float kv0 = kps[n * 129 + d], kv1 = kps[n * 129 + d + 1], kv2 = kps[n * 129 + d + 2], kv3 = kps[n * 129 + d + 3];
#pragma unroll
                for (int i = 0; i < 16; ++i) { const f32x4 w4 = *(const LAS f32x4*)(wqs + (kq * 16 + i) * 128 + d);
                    a[i] += w4[0] * kv0; a[i] += w4[1] * kv1; a[i] += w4[2] * kv2; a[i] += w4[3] * kv3; } }
            bf16_t* o = (bf16_t*)(ws + WS_WSC) + (size_t)l * 2048 * DM + (size_t)(hp * 128 + n) * DM + k0 + kq * 16;
            u32x4 w0, w1; w0.x = cvt_pk_bf16(a[0], a[1]); w0.y = cvt_pk_bf16(a[2], a[3]); w0.z = cvt_pk_bf16(a[4], a[5]); w0.w = cvt_pk_bf16(a[6], a[7]);
            w1.x = cvt_pk_bf16(a[8], a[9]); w1.y = cvt_pk_bf16(a[10], a[11]); w1.z = cvt_pk_bf16(a[12], a[13]); w1.w = cvt_pk_bf16(a[14], a[15]);
            *(GAS u32x4*)o = w0; *(GAS u32x4*)(o + 8) = w1;
            __syncthreads();
        }
    }
    {
        const int gt = blockIdx.x * NTHR + F.tid;
        if (gt < 128 * 16 + 128 * 8) {
            const bool big = gt < 2048; const int e = big ? gt : gt - 2048; const int q = big ? 16 : 8; const int pos = e / q, j = e % q;
            const float inv = (float)exp2(-(double)j / (double)q * 13.287712379549449);
            const float ang = (float)pos * inv; float sn, cs; sincos_small(ang, sn, cs);
            f32x2* tab = (f32x2*)(ws + WS_TAB + (big ? 0 : 16384));
            tab[e] = (f32x2){cs, sn};
        }
    }
}

__device__ __forceinline__ unsigned pack_i8(const f32x4 y) {
    const int q0 = __float2int_rn(fminf(fmaxf(y[0], -127.f), 127.f)), q1 = __float2int_rn(fminf(fmaxf(y[1], -127.f), 127.f)), q2 = __float2int_rn(fminf(fmaxf(y[2], -127.f), 127.f)), q3 = __float2int_rn(fminf(fmaxf(y[3], -127.f), 127.f));
    return ((unsigned)q0 & 0xFFu) | (((unsigned)q1 & 0xFFu) << 8) | (((unsigned)q2 & 0xFFu) << 16) | ((unsigned)q3 << 24);
}
__device__ __forceinline__ void phase_convert_uv(Frame& F, const float* u, const float* v, unsigned char* ws) {
    const size_t nblk = (size_t)NEXP * DM / 1024;
    const int gw = F.vcu * NWAVES + F.wave, NGW = F.G * NWAVES, lane = F.lane;
    for (size_t i = gw; i < 2 * nblk; i += NGW) {
        const bool second = i >= nblk; const size_t j = second ? i - nblk : i; const float sc = second ? 4.0f : 896.0f;
        const GAS f32x4* s = (const GAS f32x4*)(second ? v : u) + j * 256 + lane;
        GAS unsigned* d = (GAS unsigned*)(ws + (second ? WS_VB : WS_UB)) + (size_t)(lane >> 5) * ((size_t)NEXP * 32) + j * 32 + (lane & 31);
        f32x4 a[4];
#pragma unroll
        for (int q = 0; q < 4; ++q) a[q] = s[64 * q] * sc;
#pragma unroll
        for (int q = 0; q < 4; ++q) d[(size_t)q * ((size_t)NEXP * 64)] = second ? (unsigned)__builtin_amdgcn_cvt_pk_bf8_f32(a[q][1], a[q][3], __builtin_amdgcn_cvt_pk_bf8_f32(a[q][0], a[q][2], 0, false), true) : pack_i8(a[q]);
    }
}

template <bool Q8 = false>
__device__ __forceinline__ void phase_norm_mod(Frame& F, const float* xl, const bf16_t* xb, const float* xc, const float* gain, const float* mod  , int chunk, bf16_t* XN, bool skipctx, float* ssq_zero, unsigned char* XQ = nullptr, float* XSC = nullptr) {
    const int gw = F.vcu * NWAVES + F.wave, NGW = F.G * NWAVES;
    (void)ssq_zero;
    for (int gi = gw; gi < NROW / 4; gi += NGW) {
        const int r0 = 4 * gi, b = r0 / NB, j0 = r0 % NB;
        const bool isctx = j0 < CTXL;
        if (skipctx && isctx) continue;
        const float* mv = mod + (isctx ? 4 : b) * 6144 + chunk * DM;
        f32x4 v[4][4]; float s[4];
        if (!isctx && xl == nullptr) {
            const GAS u32x2* x2 = (const GAS u32x2*)(xb + ((size_t)b * SEQ + (j0 - CTXL)) * DM) + F.lane;
            u32x2 w[4][4];
#pragma unroll
            for (int i = 0; i < 4; ++i)
#pragma unroll
                for (int q = 0; q < 4; ++q) w[i][q] = x2[i * (DM / 4) + 64 * q];
#pragma unroll
            for (int i = 0; i < 4; ++i)
#pragma unroll
                for (int q = 0; q < 4; ++q) v[i][q] = (f32x4){bf_lo(w[i][q].x), bf_hi(w[i][q].x), bf_lo(w[i][q].y), bf_hi(w[i][q].y)};
        } else {
            const float* xr = isctx ? xc + ((size_t)b * CTXL + j0) * DM : xl + ((size_t)b * SEQ + (j0 - CTXL)) * DM;
            const GAS f32x4* x4 = (const GAS f32x4*)xr + F.lane;
#pragma unroll
            for (int i = 0; i < 4; ++i)
#pragma unroll
                for (int q = 0; q < 4; ++q) v[i][q] = x4[i * (DM / 4) + 64 * q];
        }
#pragma unroll
        for (int i = 0; i < 4; ++i) { float a = 0.f;
#pragma unroll
            for (int q = 0; q < 4; ++q) a += (v[i][q][0] * v[i][q][0] + v[i][q][1] * v[i][q][1]) + (v[i][q][2] * v[i][q][2] + v[i][q][3] * v[i][q][3]);
            s[i] = a; }
#pragma unroll
        for (int i = 0; i < 4; ++i) s[i] = 1.0f / sqrtf(wave_sum(s[i]) * (1.f / DM) + EPS);
#pragma unroll
        for (int q = 0; q < 4; ++q) {
            const int c = 4 * F.lane + 256 * q;
            const f32x4 g = *(const GAS f32x4*)(gain + c), sh = *(const GAS f32x4*)(mv + c), sc = *(const GAS f32x4*)(mv + DM + c);
            const f32x4 gs = g * (sc + 1.0f);
#pragma unroll
            for (int i = 0; i < 4; ++i) {
                const f32x4 y = (v[i][q] * s[i]) * gs + sh;
                u32x2 w; w.x = cvt_pk_bf16(y[0], y[1]); w.y = cvt_pk_bf16(y[2], y[3]);
                ((GAS u32x2*)(XN + (size_t)(r0 + i) * DM) + F.lane)[64 * q] = w;
                if (Q8) v[i][q] = y;
            }
        }
        if (Q8) {
#pragma unroll
            for (int i = 0; i < 4; ++i) { float m = 0.f;
#pragma unroll
                for (int q = 0; q < 4; ++q) m = fmaxf(fmaxf(m, fmaxf(fabsf(v[i][q][0]), fabsf(v[i][q][1]))), fmaxf(fabsf(v[i][q][2]), fabsf(v[i][q][3])));
                m = fmaxf(m, xshfl<1>(m)); m = fmaxf(m, xshfl<2>(m)); m = fmaxf(m, xshfl<4>(m)); m = fmaxf(m, xshfl<8>(m)); m = fmaxf(m, xshfl<16>(m)); m = fmaxf(xmax32(m), 1e-20f);
                const float qs = 127.0f / m;
#pragma unroll
                for (int q = 0; q < 4; ++q) ((GAS unsigned*)(XQ + (size_t)(r0 + i) * DM) + F.lane)[64 * q] = pack_i8(v[i][q] * qs);
                if (F.lane == 0) ((GAS float*)XSC)[(size_t)(r0 + i) * 4] = m * (1.0f / 127.0f);
            }
        }
    }
}

__device__ __forceinline__ void phase_final_norm(Frame& F, const bf16_t* xb, float* out, const float* gain, float dsc) {
    const int gw = F.vcu * NWAVES + F.wave, NGW = F.G * NWAVES;
    for (int gi = gw; gi < NBATCH * SEQ / 4; gi += NGW) {
        const int r0 = 4 * gi;
        const GAS u32x2* x2 = (const GAS u32x2*)(xb + (size_t)r0 * DM) + F.lane;
        u32x2 w[4][4];
#pragma unroll
        for (int i = 0; i < 4; ++i)
#pragma unroll
            for (int q = 0; q < 4; ++q) w[i][q] = x2[i * (DM / 4) + 64 * q];
        f32x4 v[4][4]; float s[4];
#pragma unroll
        for (int i = 0; i < 4; ++i) { float a = 0.f;
#pragma unroll
            for (int q = 0; q < 4; ++q) { v[i][q] = (f32x4){bf_lo(w[i][q].x), bf_hi(w[i][q].x), bf_lo(w[i][q].y), bf_hi(w[i][q].y)}; a += (v[i][q][0] * v[i][q][0] + v[i][q][1] * v[i][q][1]) + (v[i][q][2] * v[i][q][2] + v[i][q][3] * v[i][q][3]); }
            s[i] = a; }
#pragma unroll
        for (int i = 0; i < 4; ++i) s[i] = dsc / sqrtf(wave_sum(s[i]) * (1.f / DM) + EPS);
#pragma unroll
        for (int q = 0; q < 4; ++q) { const f32x4 g = *(const GAS f32x4*)(gain + 4 * F.lane + 256 * q);
#pragma unroll
            for (int i = 0; i < 4; ++i) ((GAS f32x4*)(out + (size_t)(r0 + i) * DM) + F.lane)[64 * q] = (v[i][q] * s[i]) * g; }
    }
}
__device__ __forceinline__ int crow(int r, int hi) { return (r & 3) + 8 * (r >> 2) + 4 * hi; }
constexpr int VS = 68;
enum { AT_MLA = 0, AT_SWA = 1, AT_NA = 2 };
#ifndef ATT_THR
#define ATT_THR 8.0f
#endif
#ifndef SC_MLA
#define SC_MLA 1.0f
#endif
#ifndef SC_SWA
#define SC_SWA 1.0f
#endif
#ifndef SC_NA
#define SC_NA 1.0f
#endif
#ifndef SKIP_ATT
#define SKIP_ATT 0
#endif
struct AttnArgs { const bf16_t* P; const bf16_t* KV; bf16_t* Y; const float* sink; const float* rpb; };

#ifndef ABL
#define ABL 0
#endif
template <int KIND, bool CTXQ, bool DUMMY = false>
__device__ __forceinline__ void attn_unit(Frame& F, const AttnArgs& A, int unit) {
    constexpr int AB = DUMMY ? ABL : 0;
    constexpr int DQK = (KIND == AT_MLA) ? 96 : 64, KS = DQK + 8, NP = DQK / 8, NS = DQK / 16;
    constexpr int KT_BYTES = 64 * KS * 2, VT_BYTES = 8192;
    LAS unsigned char* lds = F.lds;
    LAS unsigned char* Vt[2] = {lds + 3 * KT_BYTES, lds + 3 * KT_BYTES + VT_BYTES};
    LAS float* rpbl = (LAS float*)(lds + 3 * KT_BYTES + 2 * VT_BYTES);
    int lane = lane_id(); asm volatile("" : "+v"(lane));
    const int w = F.wave, tid = w * 64 + lane, r32 = lane & 31, hi = lane >> 5;

    int b, h = 0, g = 0, n = 0;
    if (KIND == AT_MLA) { if (CTXQ) { b = unit >> 2; h = unit & 3; } else { b = unit >> 7; h = (unit >> 5) & 3; n = unit & 31; } }
    else if (KIND == AT_SWA) { if (CTXQ) { b = unit >> 2; g = (unit >> 1) & 1; n = unit & 1; } else { b = unit >> 7; g = (unit >> 6) & 1; n = unit & 63; } }
    else { if (CTXQ) { b = unit >> 2; h = unit & 3; } else { b = unit >> 7; h = (unit >> 5) & 3; n = unit & 31; } }
    const size_t rb = (size_t)b * NB;

    int qj;
    int hq = h, qpos = 0, qrow = 0, qcol = 0;
    if (KIND == AT_MLA) qj = CTXQ ? (32 * w + r32) : (CTXL + 256 * n + 32 * w + r32);
    else if (KIND == AT_SWA) { hq = 2 * g + (w >> 2); qpos = 128 * n + 32 * (w & 3) + r32; qj = CTXQ ? qpos : CTXL + qpos; }
    else { if (CTXQ) qj = 32 * w + r32; else { qrow = 4 * n + (w >> 1); qcol = 32 * (w & 1) + r32; qj = CTXL + qrow * 64 + qcol; } }
    const int qcolbase = (KIND == AT_MLA) ? (C_MLAQ + hq * 96) : (KIND == AT_SWA) ? (C_SWAQ + hq * 64) : (C_NAQ + hq * 64);
    const bf16_t* qp = A.P + (rb + qj) * PW + qcolbase;
    bf16x8 qr[NS];
#pragma unroll
    for (int s = 0; s < NS; ++s) qr[s] = *(const GAS bf16x8*)(qp + 16 * s + 8 * hi);

    int nt = 4, band_lo = 0;
    if (!CTXQ) {
        if (KIND == AT_MLA) nt = 132;
        else if (KIND == AT_SWA) { band_lo = (n == 0) ? 2 : 0; const int band_hi = (n == 63) ? 4 : 6; nt = 4 + band_hi - band_lo; }
        else { int lo = 4 * n - 4; lo = lo < 0 ? 0 : (lo > 120 ? 120 : lo); int hi2 = 4 * n + 3 - 4; hi2 = hi2 < 0 ? 0 : (hi2 > 120 ? 120 : hi2); band_lo = lo; nt = 4 + (hi2 + 7 - lo + 1); }
    }
    auto tile_j0 = [&](int t) -> int {
        if (t < 4) return 64 * t;
        if (KIND == AT_MLA) return 64 * t;
        if (KIND == AT_SWA) return CTXL + 128 * (n - 1) + 64 * (band_lo + t - 4);
        return CTXL + 64 * (band_lo + t - 4);
    };
    int na_rs = 0, na_cs = 0;
    if (KIND == AT_NA && !CTXQ) { na_rs = qrow - 4; na_rs = na_rs < 0 ? 0 : (na_rs > 120 ? 120 : na_rs); na_cs = qcol - 8; na_cs = na_cs < 0 ? 0 : (na_cs > 48 ? 48 : na_cs); }

    const int vkey = (lane & 15) + 16 * (w & 3), vdp = 4 * (w >> 2) + (lane >> 4);
    const int kcolbase = (KIND == AT_SWA) ? (C_SWAK + g * 64) : (C_NAK + h * 64);
    const int vcolbase = (KIND == AT_SWA) ? (C_SWAV + g * 64) : (C_NAV + h * 64);
    constexpr int KPITCH0 = (KIND == AT_MLA) ? KVW : PW, VPITCH = (KIND == AT_MLA) ? KVW : PW;
    const GAS char* kbase0 = (KIND == AT_MLA) ? (const GAS char*)(A.KV + rb * KVW + h * 128) : (const GAS char*)(A.P + rb * PW + kcolbase);
    const GAS char* kbase1 = (const GAS char*)(A.P + rb * PW + C_KR);
    const GAS char* vbase = (KIND == AT_MLA) ? (const GAS char*)(A.KV + rb * KVW + h * 128 + 64) : (const GAS char*)(A.P + rb * PW + vcolbase);
    const unsigned koff0 = (unsigned)((tid >> 3) * KPITCH0 + (tid & 7) * 8) * 2u, koff1 = (unsigned)((tid >> 2) * PW + (tid & 3) * 8) * 2u, voff = (unsigned)(vkey * VPITCH + vdp * 8) * 2u;
    const bool has_k1 = (DQK == 96) && tid < 256;
    const unsigned kl0 = (unsigned)((tid >> 3) * (KS * 2) + (tid & 7) * 16), kl1 = (unsigned)((tid >> 2) * (KS * 2) + 128 + (tid & 3) * 16);
    struct Stage { u32x4 k0, k1, v; };
    auto gloadK = [&](Stage& R, int t) { const int j0 = tile_j0(t); R.k0 = *(const GAS u32x4*)(kbase0 + (size_t)j0 * (KPITCH0 * 2) + koff0); if (has_k1) R.k1 = *(const GAS u32x4*)(kbase1 + (size_t)j0 * (PW * 2) + koff1); };
    auto gloadV = [&](Stage& R, int t) { R.v = *(const GAS u32x4*)(vbase + (size_t)tile_j0(t) * (VPITCH * 2) + voff); };
    auto lstoreK = [&](const Stage& R, int kofs) { *(LAS u32x4*)(lds + kofs + kl0) = R.k0; if (has_k1) *(LAS u32x4*)(lds + kofs + kl1) = R.k1; };
    const unsigned vlo = (unsigned)((w >> 2) * 4096 + (w & 3) * 1024 + (lane & 15) * 64 + (lane >> 4) * 16);
    auto lstoreV = [&](const Stage& R, int buf) { *(LAS u32x4*)(Vt[buf] + vlo) = R.v; };
    struct KF { bf16x8 f[NS]; };
    auto kread = [&](KF& K, int kofs, int hf) {
        const LAS unsigned char* kb = lds + kofs + (32 * hf + r32) * (KS * 2) + hi * 16;
#pragma unroll
        for (int q = 0; q < NS; ++q) K.f[q] = *(const LAS bf16x8*)(kb + q * 32);
    };
    auto qkh = [&](const KF& K, const f32x16& negm, f32x16& p) {
        p = __builtin_amdgcn_mfma_f32_32x32x16_bf16(K.f[0], qr[0], negm, 0, 0, 0);
#pragma unroll
        for (int q = 1; q < NS; ++q) p = __builtin_amdgcn_mfma_f32_32x32x16_bf16(K.f[q], qr[q], p, 0, 0, 0);
    };
    struct VF { u32x2 l0[2], h0[2], l1[2], h1[2]; };
    typedef short v4i16_t __attribute__((ext_vector_type(4)));
    const unsigned vro = (unsigned)(((lane >> 4) & 1) * 32 + (lane & 3) * 8 + (4 * hi + ((lane & 15) >> 2)) * 64);
    auto vtr = [&](const LAS unsigned char* p) { return __builtin_bit_cast(u32x2, __builtin_amdgcn_ds_read_tr16_b64_v4i16((LAS v4i16_t*)p)); };
    auto vread = [&](VF& V, int buf, int hf) {
        const LAS unsigned char* vb = Vt[buf] + vro + hf * 2048;
#pragma unroll
        for (int q = 0; q < 2; ++q) { V.l0[q] = vtr(vb + q * 1024); V.h0[q] = vtr(vb + q * 1024 + 512);
            V.l1[q] = vtr(vb + 4096 + q * 1024); V.h1[q] = vtr(vb + 4096 + q * 1024 + 512); }
    };
    auto mask_half = [&](int t, int hf, f32x16& p) {
        if (CTXQ) return;
        if (KIND == AT_SWA) {
            const bool band = t >= 4;
            int db = band ? (128 * (n - 1) + 64 * (band_lo + t - 4) + 32 * hf + 4 * hi - qpos) : 0;
            asm volatile("" : "+v"(db));
#pragma unroll
            for (int r = 0; r < 16; ++r) { const int c = (r & 3) + 8 * (r >> 2); if (band && (db > 128 - c || db < -128 - c)) p[r] = -1.0e30f; }
        } else if (KIND == AT_NA) {
            const bool band = t >= 4;
            const int krow = band_lo + t - 4;
            const bool rowok = !band || (krow >= na_rs && krow < na_rs + 8);
            const int dr = band ? (krow - qrow + 7) : 0;
            int e = 4 * hi + 32 * hf - na_cs;
            const LAS float* brow = rpbl + (dr < 0 ? 0 : (dr > 14 ? 14 : dr)) * 32 + (15 - qcol + 4 * hi + 32 * hf);
            asm volatile("" : "+v"(e));
#pragma unroll
            for (int r = 0; r < 16; ++r) { const int c = (r & 3) + 8 * (r >> 2);
                const bool v0 = rowok && (!band || (unsigned)(e + c) < 16u);
                const float b0 = (band && v0) ? brow[c] : 0.f;
                p[r] = v0 ? p[r] + b0 : -1.0e30f; }
        }
    };

    if (KIND == AT_NA && !CTXQ) { for (int i = tid; i < 15 * 32; i += NTHR) { const int dr = i >> 5, dc = i & 31; rpbl[i] = (dc < 31) ? ((const GAS float*)A.rpb)[(h * 15 + dr) * 31 + dc] * LOG2E : 0.f; } }

    nt = __builtin_amdgcn_readfirstlane(nt); asm volatile("" : "+s"(nt));
    Stage RA, RB;
    RA.k1 = (u32x4){0u, 0u, 0u, 0u}; RB.k1 = RA.k1;
    gloadK(RA, 0); gloadV(RA, 0); gloadK(RB, nt > 1 ? 1 : 0);
    lstoreK(RA, 0); lstoreV(RA, 0); lstoreK(RB, KT_BYTES);
    int kA = 0, kB = KT_BYTES, kC = 2 * KT_BYTES;
    gloadK(RB, nt > 2 ? 2 : nt - 1); gloadV(RB, nt > 1 ? 1 : nt - 1);
    __syncthreads();
    float m_ref, l_run = 0.f;
    f32x16 o0, o1, pa, pb, negm;
#pragma unroll
    for (int r = 0; r < 16; ++r) { o0[r] = 0.f; o1[r] = 0.f; negm[r] = 0.f; }
    { f32x16& pc = pa; KF K0; kread(K0, 0, 0); qkh(K0, negm, pc); mask_half(0, 0, pc);
      float mx = pc[0];
#pragma unroll
      for (int r = 1; r < 16; ++r) mx = fmaxf(mx, pc[r]);
      mx = xmax32(mx); m_ref = mx;
#pragma unroll
      for (int r = 0; r < 16; ++r) { pc[r] -= mx; negm[r] = -mx; } }
#define ATT_HALF(t, hf, tn, hn, kbuf, pc, pn) do { \
        KF Kn; VF Vc; \
        kread(Kn, (kbuf), (hn)); vread(Vc, (t) & 1, (hf)); \
        qkh(Kn, negm, pn); \
        float rsum = 0.f; \
        _Pragma("unroll") for (int r = 0; r < 16; ++r) { if (!(AB & 1)) pc[r] = fexp2(pc[r]); rsum += pc[r]; } \
        l_run += rsum; \
        mask_half((tn), (hn), pn); \
        float mx = fmaxf(pn[0], pn[1]); \
        _Pragma("unroll") for (int r = 2; r < 16; ++r) mx = fmaxf(mx, pn[r]); \
        mx = xmax32(mx); \
        if (__builtin_expect(((tn) < nt) && __any(mx > ATT_THR), 0)) { \
            const float d = fmaxf(mx, 0.f), al = fexp2(-d); \
            m_ref += d; l_run *= al; \
            _Pragma("unroll") for (int r = 0; r < 16; ++r) { pn[r] -= d; o0[r] *= al; o1[r] *= al; pc[r] *= al; negm[r] = -m_ref; } \
        } \
        const bf16x8 pf0 = __builtin_bit_cast(bf16x8, (u32x4){cvt_pk_bf16(pc[0], pc[1]), cvt_pk_bf16(pc[2], pc[3]), cvt_pk_bf16(pc[4], pc[5]), cvt_pk_bf16(pc[6], pc[7])}); \
        const bf16x8 pf1 = __builtin_bit_cast(bf16x8, (u32x4){cvt_pk_bf16(pc[8], pc[9]), cvt_pk_bf16(pc[10], pc[11]), cvt_pk_bf16(pc[12], pc[13]), cvt_pk_bf16(pc[14], pc[15])}); \
        o0 = __builtin_amdgcn_mfma_f32_32x32x16_bf16(__builtin_bit_cast(bf16x8, (u32x4){Vc.l0[0].x, Vc.l0[0].y, Vc.h0[0].x, Vc.h0[0].y}), pf0, o0, 0, 0, 0); \
        o1 = __builtin_amdgcn_mfma_f32_32x32x16_bf16(__builtin_bit_cast(bf16x8, (u32x4){Vc.l1[0].x, Vc.l1[0].y, Vc.h1[0].x, Vc.h1[0].y}), pf0, o1, 0, 0, 0); \
        o0 = __builtin_amdgcn_mfma_f32_32x32x16_bf16(__builtin_bit_cast(bf16x8, (u32x4){Vc.l0[1].x, Vc.l0[1].y, Vc.h0[1].x, Vc.h0[1].y}), pf1, o0, 0, 0, 0); \
        o1 = __builtin_amdgcn_mfma_f32_32x32x16_bf16(__builtin_bit_cast(bf16x8, (u32x4){Vc.l1[1].x, Vc.l1[1].y, Vc.h1[1].x, Vc.h1[1].y}), pf1, o1, 0, 0, 0); \
    } while (0)
#define ATT_STEP(t, RL, RS) do { \
        if (!(AB & 32)) { const int tk_ = ((t) + 3 < nt) ? (t) + 3 : nt - 1, tv_ = ((t) + 2 < nt) ? (t) + 2 : nt - 1; gloadK(RL, tk_); gloadV(RL, tv_); } \
        ATT_HALF(t, 0, t, 1, kA, pa, pb); \
        ATT_HALF(t, 1, (t) + 1, 0, kB, pb, pa); \
        if (!(AB & 64)) lstoreK(RS, kC); if (!(AB & 8)) lstoreV(RS, ((t) + 1) & 1); \
        { const int k_ = kA; kA = kB; kB = kC; kC = k_; } \
        if (!(AB & 16)) __syncthreads(); \
    } while (0)
#pragma nounroll
    for (int t = 0; t < nt; t += 2) {
        ATT_STEP(t, RA, RB);
        if (t + 1 < nt) ATT_STEP(t + 1, RB, RA);
    }
#undef ATT_STEP
#undef ATT_HALF
    const float m_run = m_ref;
    float l_tot = xsum32(l_run);
    if (KIND == AT_SWA) l_tot += fexp2(((const GAS float*)A.sink)[hq] * LOG2E - m_run);
    const float rl = ((KIND == AT_MLA) ? SC_MLA : (KIND == AT_SWA) ? SC_SWA : SC_NA) / l_tot;
    const int ycol = (KIND == AT_MLA) ? (hq * 64) : (KIND == AT_SWA) ? (256 + hq * 64) : (512 + hq * 64);
    LAS unsigned char* ost = lds + 3 * KT_BYTES + 2 * VT_BYTES + 2048 + w * 4608;
#pragma unroll
    for (int q4 = 0; q4 < 4; ++q4) {
        u32x2 w0, w1;
        w0.x = cvt_pk_bf16(o0[4 * q4] * rl, o0[4 * q4 + 1] * rl); w0.y = cvt_pk_bf16(o0[4 * q4 + 2] * rl, o0[4 * q4 + 3] * rl);
        w1.x = cvt_pk_bf16(o1[4 * q4] * rl, o1[4 * q4 + 1] * rl); w1.y = cvt_pk_bf16(o1[4 * q4 + 2] * rl, o1[4 * q4 + 3] * rl);
        *(LAS u32x2*)(ost + r32 * 144 + (4 * hi + 8 * q4) * 2) = w0; *(LAS u32x2*)(ost + r32 * 144 + (32 + 4 * hi + 8 * q4) * 2) = w1;
    }
    LDS_WAIT(); asm volatile("" ::: "memory");
    const int qj0 = __builtin_amdgcn_readfirstlane(qj);
#pragma unroll
    for (int i = 0; i < 4; ++i) { const int rr = 8 * i + (lane >> 3), ch = lane & 7;
        *(GAS u32x4*)(A.Y + (rb + qj0 + rr) * DM + ycol + 8 * ch) = *(const LAS u32x4*)(ost + rr * 144 + 16 * ch); }
    LDS_WAIT(); asm volatile("" ::: "memory");
}
constexpr int RVS = 132;
struct RetArgs { const bf16_t* P; bf16_t* Y; float* RS; const float* decay_f; const float* decay_b; const float* gn_f; const float* gn_b; };
__device__ __forceinline__ float log2_sigmoid(float d) { return -log2f(1.0f + expf(-d)); }

struct RStage { u32x4 k[2], v[2]; };
__device__ __forceinline__ void ret_stage_load(RStage& S, const bf16_t* P, int unit, int tid) {
    const int c = unit % 66, bh = unit / 66, b = bh >> 2, h = bh & 3;
    const size_t row0 = (size_t)b * NB + 128 * c;
#pragma unroll
    for (int j = 0; j < 2; ++j) {
        const int q = tid + 512 * j, tok = q >> 3, dp = q & 7;
        const bf16_t* pr = P + (row0 + tok) * PW + h * 64 + dp * 8;
        S.k[j] = *(const GAS u32x4*)(pr + C_RK); S.v[j] = *(const GAS u32x4*)(pr + C_RV);
    }
}
__device__ __forceinline__ void ret_local_loop(Frame& F, const RetArgs& A, int u0, int ustep, int nunits) {
    int lane = lane_id(); asm volatile("" : "+v"(lane));
    const int w = F.wave, tid = w * 64 + lane, r32 = lane & 31, hi = lane >> 5;
    LAS bf16_t* Ktt = (LAS bf16_t*)F.lds;
    LAS bf16_t* Vtf = Ktt + 64 * RVS;
    LAS bf16_t* Vtb = Vtf + 64 * RVS;
    RStage S;
    int unit = u0;
    if (unit < nunits) ret_stage_load(S, A.P, unit, tid);
    while (unit < nunits) {
        const int c = unit % 66, bh = unit / 66, h = bh & 3;
        const float lgf = log2_sigmoid(((const GAS float*)A.decay_f)[h]), lgb = log2_sigmoid(((const GAS float*)A.decay_b)[h]);
#pragma unroll
        for (int j = 0; j < 2; ++j) {
            const int q = tid + 512 * j, tok = q >> 3, dp = q & 7;
            const float wf = fexp2(lgf * (float)(127 - tok)), wb = fexp2(lgb * (float)tok);
            LAS bf16_t* kt = Ktt + (8 * dp) * RVS + tok; LAS bf16_t* vf = Vtf + (8 * dp) * RVS + tok; LAS bf16_t* vb = Vtb + (8 * dp) * RVS + tok;
            const unsigned kw[4] = {S.k[j].x, S.k[j].y, S.k[j].z, S.k[j].w}, vw[4] = {S.v[j].x, S.v[j].y, S.v[j].z, S.v[j].w};
#pragma unroll
            for (int e = 0; e < 4; ++e) {
                kt[(2 * e) * RVS] = (bf16_t)(kw[e] & 0xffffu); kt[(2 * e + 1) * RVS] = (bf16_t)(kw[e] >> 16);
                const float v0 = bf_lo(vw[e]), v1 = bf_hi(vw[e]);
                const unsigned pf = cvt_pk_bf16(v0 * wf, v1 * wf), pb = cvt_pk_bf16(v0 * wb, v1 * wb);
                vf[(2 * e) * RVS] = (bf16_t)(pf & 0xffffu); vf[(2 * e + 1) * RVS] = (bf16_t)(pf >> 16);
                vb[(2 * e) * RVS] = (bf16_t)(pb & 0xffffu); vb[(2 * e + 1) * RVS] = (bf16_t)(pb >> 16);
            }
        }
        const int unext = unit + ustep;
        if (unext < nunits) ret_stage_load(S, A.P, unext, tid);
        __syncthreads();
        const int dir = w >> 2, dvb = (w >> 1) & 1, dkb = w & 1;
        const LAS bf16_t* va = (dir ? Vtb : Vtf) + (32 * dvb + r32) * RVS + 8 * hi;
        const LAS bf16_t* kb = Ktt + (32 * dkb + r32) * RVS + 8 * hi;
        f32x16 acc;
#pragma unroll
        for (int r = 0; r < 16; ++r) acc[r] = 0.f;
#pragma unroll
        for (int s = 0; s < 8; ++s) {
            const u32x2 a0 = *(const LAS u32x2*)(va + 16 * s), a1 = *(const LAS u32x2*)(va + 16 * s + 4);
            const u32x2 b0 = *(const LAS u32x2*)(kb + 16 * s), b1 = *(const LAS u32x2*)(kb + 16 * s + 4);
            acc = __builtin_amdgcn_mfma_f32_32x32x16_bf16(__builtin_bit_cast(bf16x8, (u32x4){a0.x, a0.y, a1.x, a1.y}), __builtin_bit_cast(bf16x8, (u32x4){b0.x, b0.y, b1.x, b1.y}), acc, 0, 0, 0);
        }
        GAS float* out = (GAS float*)A.RS + ((size_t)(bh * 2 + dir) * 66 + c) * 4096 + 32 * dkb + r32;
#pragma unroll
        for (int r = 0; r < 16; ++r) out[(32 * dvb + crow(r, hi)) * 64] = acc[r];
        __syncthreads();
        unit = unext;
    }
}

__device__ __forceinline__ void ret_scan(Frame& F, const RetArgs& A) {
    for (int e = blockIdx.x * NTHR + F.tid; e < 32 * 4096; e += F.G * NTHR) {
        const int seq = e >> 12, el = e & 4095, dir = seq & 1, h = (seq >> 1) & 3;
        const float a = fexp2(128.0f * log2_sigmoid(dir ? ((const GAS float*)A.decay_b)[h] : ((const GAS float*)A.decay_f)[h]));
        GAS float* base = (GAS float*)A.RS + (size_t)seq * 66 * 4096 + el;
        float s = 0.f;
#pragma nounroll
        for (int n0 = 0; n0 < 66; n0 += 11) {
            int nb = n0; asm volatile("" : "+s"(nb));
            float u[11];
#pragma unroll
            for (int i = 0; i < 11; ++i) { const int n = nb + i; const int c = dir ? ((n < 2) ? 1 - n : 67 - n) : n; u[i] = base[(size_t)c * 4096]; }
#pragma unroll
            for (int i = 0; i < 11; ++i) { const int n = nb + i; const int c = dir ? ((n < 2) ? 1 - n : 67 - n) : n; base[(size_t)c * 4096] = s; s = a * s + u[i]; }
        }
    }
}

struct RStage3 { u32x4 k[2], v[2], q[2]; f32x4 st[4]; };
__device__ __forceinline__ void ret_stage_load3(RStage3& S, const bf16_t* P, const float* RS, int unit, int tid) {
    const int c = unit % 66, bh = unit / 66, b = bh >> 2, h = bh & 3;
    const size_t row0 = (size_t)b * NB + 128 * c;
#pragma unroll
    for (int j = 0; j < 2; ++j) {
        const int q = tid + 512 * j, tok = q >> 3, dp = q & 7;
        const bf16_t* pr = P + (row0 + tok) * PW + h * 64 + dp * 8;
        S.k[j] = *(const GAS u32x4*)(pr + C_RK); S.v[j] = *(const GAS u32x4*)(pr + C_RV); S.q[j] = *(const GAS u32x4*)(pr + C_RQ);
    }
#pragma unroll
    for (int k = 0; k < 4; ++k) S.st[k] = ((const GAS f32x4*)(RS + ((size_t)(bh * 2 + (k >> 1)) * 66 + c) * 4096))[tid + 512 * (k & 1)];
}
__device__ __forceinline__ void ret_out_loop(Frame& F, const RetArgs& A, int u0, int ustep, int nunits, bool skipctx) {
    int lane = lane_id(); asm volatile("" : "+v"(lane));
    const int w = F.wave, tid = w * 64 + lane, r32 = lane & 31, hi = lane >> 5;
    constexpr int KS = 72;
    LAS unsigned char* Kc = F.lds;
    LAS bf16_t* Vt = (LAS bf16_t*)(F.lds + 128 * KS * 2);
    LAS float* comb = (LAS float*)(F.lds + 128 * KS * 2 + 64 * RVS * 2);
    auto nextu = [&](int u) { u += ustep; while (skipctx && u < nunits && (u % 66) < 2) u += ustep; return u; };
    int unit = u0; while (skipctx && unit < nunits && (unit % 66) < 2) unit += ustep;
    LAS float* Sst = comb + 128 * 65;
    LAS unsigned char* Qc = (LAS unsigned char*)(Sst + 2 * 64 * 68);
    RStage3 S;
    if (unit < nunits) ret_stage_load3(S, A.P, A.RS, unit, tid);
    LAS float* gnl = (LAS float*)(F.lds + 122880);
    gnl[tid] = (tid < 256) ? ((const GAS float*)A.gn_f)[tid] : ((const GAS float*)A.gn_b)[tid - 256];
    __syncthreads();
    while (unit < nunits) {
    const int c = unit % 66, bh = unit / 66, b = bh >> 2, h = bh & 3;
    const size_t row0 = (size_t)b * NB + 128 * c;
    const int dir = w >> 2, qg = w & 3, qi = 32 * qg + r32;
    const bf16_t* prow = A.P + (row0 + qi) * PW;
#pragma unroll
    for (int j = 0; j < 2; ++j) {
        const int q = tid + 512 * j, tok = q >> 3, dp = q & 7;
        *(LAS u32x4*)(Kc + tok * (KS * 2) + dp * 16) = S.k[j];
        *(LAS u32x4*)(Qc + tok * (KS * 2) + dp * 16) = S.q[j];
        const u32x4 vv = S.v[j];
        LAS bf16_t* vt = Vt + (8 * dp) * RVS + tok;
        vt[0 * RVS] = (bf16_t)(vv.x & 0xffffu); vt[1 * RVS] = (bf16_t)(vv.x >> 16); vt[2 * RVS] = (bf16_t)(vv.y & 0xffffu); vt[3 * RVS] = (bf16_t)(vv.y >> 16);
        vt[4 * RVS] = (bf16_t)(vv.z & 0xffffu); vt[5 * RVS] = (bf16_t)(vv.z >> 16); vt[6 * RVS] = (bf16_t)(vv.w & 0xffffu); vt[7 * RVS] = (bf16_t)(vv.w >> 16);
    }
#pragma unroll
    for (int k = 0; k < 4; ++k) { const int e4 = tid + 512 * (k & 1); *(LAS f32x4*)(Sst + (k >> 1) * (64 * 68) + (e4 >> 4) * 68 + (e4 & 15) * 4) = S.st[k]; }
    const int unext = nextu(unit);
    if (unext < nunits) ret_stage_load3(S, A.P, A.RS, unext, tid);
    const float lg = log2_sigmoid(dir ? ((const GAS float*)A.decay_b)[h] : ((const GAS float*)A.decay_f)[h]);
    f32x16 o0, o1;
#pragma unroll
    for (int r = 0; r < 16; ++r) { o0[r] = 0.f; o1[r] = 0.f; }
    __syncthreads();
    bf16x8 qr[4];
#pragma unroll
    for (int s = 0; s < 4; ++s) qr[s] = *(const LAS bf16x8*)(Qc + qi * (KS * 2) + hi * 16 + s * 32);
    { const LAS float* sp = Sst + dir * (64 * 68) + r32 * 68 + 8 * hi;
#pragma unroll
    for (int s = 0; s < 4; ++s) {
        const f32x4 a0 = *(const LAS f32x4*)(sp + 16 * s), a1 = *(const LAS f32x4*)(sp + 16 * s + 4), b0 = *(const LAS f32x4*)(sp + 32 * 68 + 16 * s), b1 = *(const LAS f32x4*)(sp + 32 * 68 + 16 * s + 4);
        const bf16x8 fa = __builtin_bit_cast(bf16x8, (u32x4){cvt_pk_bf16(a0[0], a0[1]), cvt_pk_bf16(a0[2], a0[3]), cvt_pk_bf16(a1[0], a1[1]), cvt_pk_bf16(a1[2], a1[3])});
        const bf16x8 fb = __builtin_bit_cast(bf16x8, (u32x4){cvt_pk_bf16(b0[0], b0[1]), cvt_pk_bf16(b0[2], b0[3]), cvt_pk_bf16(b1[0], b1[1]), cvt_pk_bf16(b1[2], b1[3])});
        o0 = __builtin_amdgcn_mfma_f32_32x32x16_bf16(fa, qr[s], o0, 0, 0, 0);
        o1 = __builtin_amdgcn_mfma_f32_32x32x16_bf16(fb, qr[s], o1, 0, 0, 0);
    } }
    { const float qdec = fexp2(lg * (float)(dir ? (128 - qi) : (qi + 1)));
#pragma unroll
      for (int r = 0; r < 16; ++r) { o0[r] *= qdec; o1[r] *= qdec; } }
#pragma unroll
    for (int kt = 0; kt < 2; ++kt) {
        const bool need = dir ? (64 * kt + 63 >= 32 * qg) : (64 * kt <= 32 * qg + 31);
        if (!need) continue;
        f32x16 p0, p1;
#pragma unroll
        for (int r = 0; r < 16; ++r) { p0[r] = 0.f; p1[r] = 0.f; }
        const LAS unsigned char* kb = Kc + (64 * kt + r32) * (KS * 2) + hi * 16;
#pragma unroll
        for (int s = 0; s < 4; ++s) {
            const bf16x8 a0 = *(const LAS bf16x8*)(kb + s * 32), a1 = *(const LAS bf16x8*)(kb + 32 * (KS * 2) + s * 32);
            p0 = __builtin_amdgcn_mfma_f32_32x32x16_bf16(a0, qr[s], p0, 0, 0, 0);
            p1 = __builtin_amdgcn_mfma_f32_32x32x16_bf16(a1, qr[s], p1, 0, 0, 0);
        }
#pragma unroll
        for (int r = 0; r < 16; ++r) {
            const int j0 = 64 * kt + crow(r, hi), j1 = j0 + 32;
            const int d0 = dir ? (j0 - qi) : (qi - j0), d1 = dir ? (j1 - qi) : (qi - j1);
            p0[r] = (d0 >= 0) ? p0[r] * fexp2(lg * (float)d0) : 0.f;
            p1[r] = (d1 >= 0) ? p1[r] * fexp2(lg * (float)d1) : 0.f;
        }
        u32x4 pw[4];
        pw[0] = (u32x4){cvt_pk_bf16(p0[0], p0[1]), cvt_pk_bf16(p0[2], p0[3]), cvt_pk_bf16(p0[4], p0[5]), cvt_pk_bf16(p0[6], p0[7])};
        pw[1] = (u32x4){cvt_pk_bf16(p0[8], p0[9]), cvt_pk_bf16(p0[10], p0[11]), cvt_pk_bf16(p0[12], p0[13]), cvt_pk_bf16(p0[14], p0[15])};
        pw[2] = (u32x4){cvt_pk_bf16(p1[0], p1[1]), cvt_pk_bf16(p1[2], p1[3]), cvt_pk_bf16(p1[4], p1[5]), cvt_pk_bf16(p1[6], p1[7])};
        pw[3] = (u32x4){cvt_pk_bf16(p1[8], p1[9]), cvt_pk_bf16(p1[10], p1[11]), cvt_pk_bf16(p1[12], p1[13]), cvt_pk_bf16(p1[14], p1[15])};
        const LAS bf16_t* vb = Vt + r32 * RVS + 64 * kt + 4 * hi;
#pragma unroll
        for (int s = 0; s < 4; ++s) {
            const u32x2 l0 = *(const LAS u32x2*)(vb + 16 * s), h0 = *(const LAS u32x2*)(vb + 16 * s + 8);
            const u32x2 l1 = *(const LAS u32x2*)(vb + 32 * RVS + 16 * s), h1 = *(const LAS u32x2*)(vb + 32 * RVS + 16 * s + 8);
            const bf16x8 pf = __builtin_bit_cast(bf16x8, pw[s]);
            o0 = __builtin_amdgcn_mfma_f32_32x32x16_bf16(__builtin_bit_cast(bf16x8, (u32x4){l0.x, l0.y, h0.x, h0.y}), pf, o0, 0, 0, 0);
            o1 = __builtin_amdgcn_mfma_f32_32x32x16_bf16(__builtin_bit_cast(bf16x8, (u32x4){l1.x, l1.y, h1.x, h1.y}), pf, o1, 0, 0, 0);
        }
    }
    float sum = 0.f;
#pragma unroll
    for (int r = 0; r < 16; ++r) sum += o0[r] + o1[r];
    sum = xsum32(sum);
    const float mu = sum * (1.f / 64.f);
    float var = 0.f;
#pragma unroll
    for (int r = 0; r < 16; ++r) { o0[r] -= mu; o1[r] -= mu; var += o0[r] * o0[r] + o1[r] * o1[r]; }
    var = xsum32(var);
    const float rstd = 1.0f / sqrtf(var * (1.f / 64.f) + EPS);
    const LAS float* gn = gnl + dir * 256 + h * 64 + 4 * hi;
    const bf16_t* gp = prow + (dir ? C_RGB : C_RGF) + h * 64 + 4 * hi;
    LAS float* cb = comb + qi * 65 + 4 * hi;
    if (dir == 1) {
#pragma unroll
        for (int q4 = 0; q4 < 4; ++q4)
#pragma unroll
            for (int half = 0; half < 2; ++half) {
                const int d = 8 * q4 + 32 * half; const f32x4 g4 = *(const LAS f32x4*)(gn + d); const u32x2 gw = *(const GAS u32x2*)(gp + d);
                const float gt[4] = {bf_lo(gw.x), bf_hi(gw.x), bf_lo(gw.y), bf_hi(gw.y)};
#pragma unroll
                for (int e = 0; e < 4; ++e) { const float ov = half ? o1[4 * q4 + e] : o0[4 * q4 + e]; cb[d + e] = silu_f(gt[e]) * (ov * rstd) * g4[e]; }
            }
    }
    __syncthreads();
    if (dir == 0) {
#pragma unroll
        for (int q4 = 0; q4 < 4; ++q4)
#pragma unroll
            for (int half = 0; half < 2; ++half) {
                const int d = 8 * q4 + 32 * half; const f32x4 g4 = *(const LAS f32x4*)(gn + d); const u32x2 gw = *(const GAS u32x2*)(gp + d);
                const float gt[4] = {bf_lo(gw.x), bf_hi(gw.x), bf_lo(gw.y), bf_hi(gw.y)};
                float y[4];
#pragma unroll
                for (int e = 0; e < 4; ++e) { const float ov = half ? o1[4 * q4 + e] : o0[4 * q4 + e]; y[e] = silu_f(gt[e]) * (ov * rstd) * g4[e] + cb[d + e]; }
                u32x2 wv; wv.x = cvt_pk_bf16(y[0], y[1]); wv.y = cvt_pk_bf16(y[2], y[3]); *(LAS u32x2*)(Qc + qi * (KS * 2) + (d + 4 * hi) * 2) = wv;
            }
    }
    __syncthreads();
#pragma unroll
    for (int j = 0; j < 2; ++j) { const int q = tid + 512 * j, tok = q >> 3, dp = q & 7;
        *(GAS u32x4*)(A.Y + (row0 + tok) * DM + 768 + h * 64 + 8 * dp) = *(const LAS u32x4*)(Qc + tok * (KS * 2) + dp * 16); }
    __syncthreads();
    unit = unext;
    }
}
#define CE(a, i, j) do { const float hi_ = fmaxf(a[i], a[j]), lo_ = fminf(a[i], a[j]); a[i] = hi_; a[j] = lo_; } while (0)
#define SORT16(a) do { CE(a,0,13); CE(a,1,12); CE(a,2,15); CE(a,3,14); CE(a,4,8); CE(a,5,6); CE(a,7,11); CE(a,9,10); CE(a,0,5); CE(a,1,7); CE(a,2,9); CE(a,3,4); CE(a,6,13); CE(a,8,14); CE(a,10,15); CE(a,11,12); CE(a,0,1); CE(a,2,3); CE(a,4,5); CE(a,6,8); CE(a,7,9); CE(a,10,11); CE(a,12,13); CE(a,14,15); CE(a,0,2); CE(a,1,3); CE(a,4,10); CE(a,5,11); CE(a,6,7); CE(a,8,9); CE(a,12,14); CE(a,13,15); CE(a,1,2); CE(a,3,12); CE(a,4,6); CE(a,5,7); CE(a,8,10); CE(a,9,11); CE(a,13,14); CE(a,1,4); CE(a,2,6); CE(a,5,8); CE(a,7,10); CE(a,9,13); CE(a,11,14); CE(a,2,4); CE(a,3,6); CE(a,9,12); CE(a,11,13); CE(a,3,5); CE(a,6,8); CE(a,7,9); CE(a,10,12); CE(a,3,4); CE(a,5,6); CE(a,7,8); CE(a,9,10); CE(a,11,12); CE(a,6,7); CE(a,8,9); } while (0)
#define MERGE16(T, C) do { T[0] = fmaxf(T[0], C[15]); T[1] = fmaxf(T[1], C[14]); T[2] = fmaxf(T[2], C[13]); T[3] = fmaxf(T[3], C[12]); T[4] = fmaxf(T[4], C[11]); T[5] = fmaxf(T[5], C[10]); T[6] = fmaxf(T[6], C[9]); T[7] = fmaxf(T[7], C[8]); T[8] = fmaxf(T[8], C[7]); T[9] = fmaxf(T[9], C[6]); T[10] = fmaxf(T[10], C[5]); T[11] = fmaxf(T[11], C[4]); T[12] = fmaxf(T[12], C[3]); T[13] = fmaxf(T[13], C[2]); T[14] = fmaxf(T[14], C[1]); T[15] = fmaxf(T[15], C[0]); CE(T,0,8); CE(T,1,9); CE(T,2,10); CE(T,3,11); CE(T,4,12); CE(T,5,13); CE(T,6,14); CE(T,7,15); CE(T,0,4); CE(T,1,5); CE(T,2,6); CE(T,3,7); CE(T,8,12); CE(T,9,13); CE(T,10,14); CE(T,11,15); CE(T,0,2); CE(T,1,3); CE(T,4,6); CE(T,5,7); CE(T,8,10); CE(T,9,11); CE(T,12,14); CE(T,13,15); CE(T,0,1); CE(T,2,3); CE(T,4,5); CE(T,6,7); CE(T,8,9); CE(T,10,11); CE(T,12,13); CE(T,14,15); } while (0)

__device__ __forceinline__ void phase_topk(Frame& F, const _Float16* S16, int* eid, float* gate, bool skipctx) {
    LAS unsigned char* timg = F.lds + F.wave * 11264;
    LAS unsigned char* ilds = F.lds + F.wave * 11264 + 9216 + F.lane;
    const int lane = F.lane, gwv = F.vcu * NWAVES + F.wave, NGW = F.G * NWAVES;
    for (int wt = gwv; wt < NROW / 8; wt += NGW) {
        const int row0 = 8 * wt;
        if (skipctx && (row0 % NB) < CTXL) continue;
        const int row = row0 + (lane >> 3), h = lane & 7;
        const GAS unsigned char* blk = (const GAS unsigned char*)(S16 + (size_t)row0 * 2048);
        float v1[16], v2[16];
#pragma unroll
        for (int hf = 0; hf < 2; ++hf) {
            float T[16];
#pragma unroll
            for (int i = 0; i < 16; ++i) T[i] = -3.0e38f;
#pragma unroll
            for (int qq = 0; qq < 2; ++qq) {
                const int q = 2 * hf + qq;
                u32x4 ld[8];
#pragma unroll
                for (int i = 0; i < 8; ++i) ld[i] = *(const GAS u32x4*)(blk + (size_t)(8 * i + (lane >> 3)) * 512 + 128 * q + 16 * (lane & 7));
#pragma unroll
                for (int i = 0; i < 8; ++i) *(LAS u32x4*)(timg + (8 * i + (lane >> 3)) * 144 + 16 * (lane & 7)) = ld[i];
                LDS_WAIT(); asm volatile("" ::: "memory");
#pragma unroll
                for (int ch = 0; ch < 4; ++ch) {
                    const u32x4 a = *(const LAS u32x4*)(timg + lane * 144 + 32 * ch), b = *(const LAS u32x4*)(timg + lane * 144 + 32 * ch + 16);
                    const unsigned wv[8] = {a.x, a.y, a.z, a.w, b.x, b.y, b.z, b.w};
                    const unsigned nb = 127u - 64u * (unsigned)qq - 16u * (unsigned)ch;
                    float c[16];
#pragma unroll
                    for (int e = 0; e < 8; ++e) {
                        typedef _Float16 h2 __attribute__((ext_vector_type(2)));
                        const h2 p = __builtin_bit_cast(h2, wv[e]);
                        c[2 * e] = __uint_as_float((__float_as_uint((float)p[0]) & ~0x7Fu) | (nb - 2 * e));
                        c[2 * e + 1] = __uint_as_float((__float_as_uint((float)p[1]) & ~0x7Fu) | (nb - 2 * e - 1));
                    }
                    SORT16(c); MERGE16(T, c);
                }
                LDS_WAIT(); asm volatile("" ::: "memory");
            }
#pragma unroll
            for (int i = 0; i < 16; ++i) { const unsigned bits = __float_as_uint(T[i]); ilds[(16 * hf + i) * 64] = (unsigned char)(127u - (bits & 0x7Fu)); (hf ? v2[i] : v1[i]) = __uint_as_float(bits & ~0x7Fu); }
        }
        float cs[16];
#pragma unroll
        for (int i = 0; i < 16; ++i) cs[i] = -3.0e38f;
        { float c[16];
        { c[0] = __uint_as_float((__float_as_uint(v1[0] + v2[0]) & ~0xFFu) | 255u); c[1] = __uint_as_float((__float_as_uint(v1[0] + v2[1]) & ~0xFFu) | 254u); c[2] = __uint_as_float((__float_as_uint(v1[0] + v2[2]) & ~0xFFu) | 253u); c[3] = __uint_as_float((__float_as_uint(v1[0] + v2[3]) & ~0xFFu) | 252u); c[4] = __uint_as_float((__float_as_uint(v1[0] + v2[4]) & ~0xFFu) | 251u); c[5] = __uint_as_float((__float_as_uint(v1[0] + v2[5]) & ~0xFFu) | 250u); c[6] = __uint_as_float((__float_as_uint(v1[0] + v2[6]) & ~0xFFu) | 249u); c[7] = __uint_as_float((__float_as_uint(v1[0] + v2[7]) & ~0xFFu) | 248u); c[8] = __uint_as_float((__float_as_uint(v1[0] + v2[8]) & ~0xFFu) | 247u); c[9] = __uint_as_float((__float_as_uint(v1[0] + v2[9]) & ~0xFFu) | 246u); c[10] = __uint_as_float((__float_as_uint(v1[0] + v2[10]) & ~0xFFu) | 245u); c[11] = __uint_as_float((__float_as_uint(v1[0] + v2[11]) & ~0xFFu) | 244u); c[12] = __uint_as_float((__float_as_uint(v1[0] + v2[12]) & ~0xFFu) | 243u); c[13] = __uint_as_float((__float_as_uint(v1[0] + v2[13]) & ~0xFFu) | 242u); c[14] = __uint_as_float((__float_as_uint(v1[0] + v2[14]) & ~0xFFu) | 241u); c[15] = __uint_as_float((__float_as_uint(v1[0] + v2[15]) & ~0xFFu) | 240u); SORT16(c); MERGE16(cs, c); }
        { c[0] = __uint_as_float((__float_as_uint(v1[1] + v2[0]) & ~0xFFu) | 239u); c[1] = __uint_as_float((__float_as_uint(v1[1] + v2[1]) & ~0xFFu) | 238u); c[2] = __uint_as_float((__float_as_uint(v1[1] + v2[2]) & ~0xFFu) | 237u); c[3] = __uint_as_float((__float_as_uint(v1[1] + v2[3]) & ~0xFFu) | 236u); c[4] = __uint_as_float((__float_as_uint(v1[1] + v2[4]) & ~0xFFu) | 235u); c[5] = __uint_as_float((__float_as_uint(v1[1] + v2[5]) & ~0xFFu) | 234u); c[6] = __uint_as_float((__float_as_uint(v1[1] + v2[6]) & ~0xFFu) | 233u); c[7] = __uint_as_float((__float_as_uint(v1[1] + v2[7]) & ~0xFFu) | 232u); c[8] = __uint_as_float((__float_as_uint(v1[2] + v2[0]) & ~0xFFu) | 223u); c[9] = __uint_as_float((__float_as_uint(v1[2] + v2[1]) & ~0xFFu) | 222u); c[10] = __uint_as_float((__float_as_uint(v1[2] + v2[2]) & ~0xFFu) | 221u); c[11] = __uint_as_float((__float_as_uint(v1[2] + v2[3]) & ~0xFFu) | 220u); c[12] = __uint_as_float((__float_as_uint(v1[2] + v2[4]) & ~0xFFu) | 219u); c[13] = __uint_as_float((__float_as_uint(v1[3] + v2[0]) & ~0xFFu) | 207u); c[14] = __uint_as_float((__float_as_uint(v1[3] + v2[1]) & ~0xFFu) | 206u); c[15] = __uint_as_float((__float_as_uint(v1[3] + v2[2]) & ~0xFFu) | 205u); SORT16(c); MERGE16(cs, c); }
        { c[0] = __uint_as_float((__float_as_uint(v1[3] + v2[3]) & ~0xFFu) | 204u); c[1] = __uint_as_float((__float_as_uint(v1[4] + v2[0]) & ~0xFFu) | 191u); c[2] = __uint_as_float((__float_as_uint(v1[4] + v2[1]) & ~0xFFu) | 190u); c[3] = __uint_as_float((__float_as_uint(v1[4] + v2[2]) & ~0xFFu) | 189u); c[4] = __uint_as_float((__float_as_uint(v1[5] + v2[0]) & ~0xFFu) | 175u); c[5] = __uint_as_float((__float_as_uint(v1[5] + v2[1]) & ~0xFFu) | 174u); c[6] = __uint_as_float((__float_as_uint(v1[6] + v2[0]) & ~0xFFu) | 159u); c[7] = __uint_as_float((__float_as_uint(v1[6] + v2[1]) & ~0xFFu) | 158u); c[8] = __uint_as_float((__float_as_uint(v1[7] + v2[0]) & ~0xFFu) | 143u); c[9] = __uint_as_float((__float_as_uint(v1[7] + v2[1]) & ~0xFFu) | 142u); c[10] = __uint_as_float((__float_as_uint(v1[8] + v2[0]) & ~0xFFu) | 127u); c[11] = __uint_as_float((__float_as_uint(v1[9] + v2[0]) & ~0xFFu) | 111u); c[12] = __uint_as_float((__float_as_uint(v1[10] + v2[0]) & ~0xFFu) | 95u); c[13] = __uint_as_float((__float_as_uint(v1[11] + v2[0]) & ~0xFFu) | 79u); c[14] = __uint_as_float((__float_as_uint(v1[12] + v2[0]) & ~0xFFu) | 63u); c[15] = __uint_as_float((__float_as_uint(v1[13] + v2[0]) & ~0xFFu) | 47u); SORT16(c); MERGE16(cs, c); }
        { c[0] = __uint_as_float((__float_as_uint(v1[14] + v2[0]) & ~0xFFu) | 31u); c[1] = __uint_as_float((__float_as_uint(v1[15] + v2[0]) & ~0xFFu) | 15u); c[2] = -3.0e38f; c[3] = -3.0e38f; c[4] = -3.0e38f; c[5] = -3.0e38f; c[6] = -3.0e38f; c[7] = -3.0e38f; c[8] = -3.0e38f; c[9] = -3.0e38f; c[10] = -3.0e38f; c[11] = -3.0e38f; c[12] = -3.0e38f; c[13] = -3.0e38f; c[14] = -3.0e38f; c[15] = -3.0e38f; SORT16(c); MERGE16(cs, c); }
        }
        float ev[16]; float den = 0.f;
        const float top = __uint_as_float(__float_as_uint(cs[0]) & ~0xFFu);
#pragma unroll
        for (int k = 0; k < 16; ++k) { ev[k] = __expf(__uint_as_float(__float_as_uint(cs[k]) & ~0xFFu) - top); den += ev[k]; }
        const float rden = 1.0f / den;
        LDS_WAIT(); asm volatile("" ::: "memory");
        int eo[16]; float go[16];
#pragma unroll
        for (int k = 0; k < 16; ++k) { const int pos = 255 - (int)(__float_as_uint(cs[k]) & 0xFFu); eo[k] = ((int)ilds[(pos >> 4) * 64] * 128 + (int)ilds[(16 + (pos & 15)) * 64]) * 128; go[k] = ev[k] * rden; }
        LAS u32x4* img = (LAS u32x4*)timg;
#pragma unroll
        for (int q = 0; q < 4; ++q) { img[lane * 4 + q] = (u32x4){(unsigned)eo[4 * q], (unsigned)eo[4 * q + 1], (unsigned)eo[4 * q + 2], (unsigned)eo[4 * q + 3]};
            img[256 + lane * 4 + q] = (u32x4){__float_as_uint(go[4 * q]), __float_as_uint(go[4 * q + 1]), __float_as_uint(go[4 * q + 2]), __float_as_uint(go[4 * q + 3])}; }
        LDS_WAIT(); asm volatile("" ::: "memory");
        GAS u32x4* eg = (GAS u32x4*)((GAS int*)eid + (size_t)row0 * 128); GAS u32x4* gg = (GAS u32x4*)((GAS float*)gate + (size_t)row0 * 128);
#pragma unroll
        for (int q = 0; q < 4; ++q) { eg[64 * q + lane] = img[64 * q + lane]; gg[64 * q + lane] = img[256 + 64 * q + lane]; }
        LDS_WAIT(); asm volatile("" ::: "memory");
    }
}

constexpr float U8_SCALE = 896.0f, V8_SCALE = 4.0f;
typedef _Float16 h2_t __attribute__((ext_vector_type(2)));
__device__ __forceinline__ h2_t fp8x2_to_h2(unsigned w, bool hi) { return hi ? __builtin_amdgcn_cvt_scalef32_pk_f16_fp8(w, 1.0f, true) : __builtin_amdgcn_cvt_scalef32_pk_f16_fp8(w, 1.0f, false); }
#define VM_WAIT_ALL() do { asm volatile("" ::: "memory"); __builtin_amdgcn_s_waitcnt(0x0F70); asm volatile("" ::: "memory"); } while (0)
__device__ __forceinline__ void peer_gather(u32x4 (&t)[16], const char* tb, const LAS unsigned char* slot, int g) {
    const LAS u32x4* ep = (const LAS u32x4*)(slot + 64 * g);
    u32x4 e[4];
#pragma unroll
    for (int i = 0; i < 4; ++i) e[i] = ep[i];
#pragma unroll
    for (int i = 0; i < 4; ++i) { t[4 * i] = *(const GAS u32x4*)(tb + e[i].x); t[4 * i + 1] = *(const GAS u32x4*)(tb + e[i].y); t[4 * i + 2] = *(const GAS u32x4*)(tb + e[i].z); t[4 * i + 3] = *(const GAS u32x4*)(tb + e[i].w); }
}
__device__ __forceinline__ h2_t bf8e(unsigned d) { const unsigned r = __builtin_amdgcn_perm(0u, d, 0x020c000cu); return __builtin_bit_cast(h2_t, r); }
__device__ __forceinline__ h2_t bf8o(unsigned d) { const unsigned r = d & 0xff00ff00u; return __builtin_bit_cast(h2_t, r); }
__device__ __forceinline__ int dot16_i8(const u32x4 t, const u32x4 x) {
    return __builtin_amdgcn_sdot4((int)t.x, (int)x.x, __builtin_amdgcn_sdot4((int)t.y, (int)x.y, __builtin_amdgcn_sdot4((int)t.z, (int)x.z, __builtin_amdgcn_sdot4((int)t.w, (int)x.w, 0, false), false), false), false);
}
__device__ __forceinline__ void peer_u_dma(LAS unsigned char* slot, const unsigned* eoff, const unsigned char* XQ, const float* XSC, int r, int xq, int lane) {
    const unsigned char* src = lane < 32 ? (const unsigned char*)eoff + (size_t)r * 512 + 16 * lane
                             : (lane < 40 ? XQ + (size_t)r * DM + xq * 128 + 16 * (lane - 32) : (const unsigned char*)XSC + (size_t)r * 16);
    __builtin_amdgcn_global_load_lds((const GAS unsigned*)src, (LAS unsigned*)slot, 16, 0, 0);
}
__device__ __forceinline__ unsigned peer_u_compute(const u32x4 (&t)[16], const u32x4 x, const float xs, int lane) {
    float part[16];
#pragma unroll
    for (int i = 0; i < 16; ++i) part[i] = (float)dot16_i8(t[i], x);
    float p8[8], p4[4], p2[2];
    { const bool up = (lane & 4) != 0;
#pragma unroll
      for (int q = 0; q < 8; ++q) { const float keep = up ? part[q + 8] : part[q], send = up ? part[q] : part[q + 8]; p8[q] = keep + xshfl<4>(send); } }
    { const bool up = (lane & 2) != 0;
#pragma unroll
      for (int q = 0; q < 4; ++q) { const float keep = up ? p8[q + 4] : p8[q], send = up ? p8[q] : p8[q + 4]; p4[q] = keep + xshfl<2>(send); } }
    { const bool up = (lane & 1) != 0;
#pragma unroll
      for (int q = 0; q < 2; ++q) { const float keep = up ? p4[q + 2] : p4[q], send = up ? p4[q] : p4[q + 2]; p2[q] = keep + xshfl<1>(send); } }
    return cvt_pk_bf16(p2[0] * xs, p2[1] * xs);
}
__device__ __forceinline__ int peer_next_row(int r, int step, bool skipctx) { r += step; if (skipctx && r < NROW && (r % NB) < CTXL) r += ((CTXL - (r % NB) + step - 1) / step) * step; return r; }
template <bool DUMMY = false>
__device__ __forceinline__ void phase_peer_u(Frame& F, const unsigned char* XQ, const float* XSC, const unsigned char* U8, const unsigned* eoff, float* PART, bool skipctx) {
    const int lane = F.lane, xq = blockIdx.x & 7, rank = blockIdx.x >> 3, nr = (F.G - xq + 7) >> 3, step = nr * NWAVES;
    const int g = lane >> 3, c8 = lane & 7;
    const char* ub = (const char*)U8 + (size_t)xq * ((size_t)NEXP * 128) + c8 * 16;
    LAS unsigned char* ring = F.lds + F.wave * 4096;
    int rA = peer_next_row(rank * NWAVES + F.wave - step, step, skipctx);
    if (rA >= NROW) return;
    int rB = peer_next_row(rA, step, skipctx), i = 0;
    peer_u_dma(ring, eoff, XQ, XSC, rA, xq, lane);
    peer_u_dma(ring + 1024, eoff, XQ, XSC, rB < NROW ? rB : rA, xq, lane);
    VM_WAIT_ALL();
    u32x4 T0[16], T1[16];
    peer_gather(T0, ub, ring, g);
    GAS unsigned* const pout = (GAS unsigned*)PART + (size_t)xq * NROW * 64 + 8 * g + c8;
    unsigned res = 0u; int rP = -1;
#define PEER_U_STEP(TC, TN) { \
        const int rC = peer_next_row(rB, step, skipctx); \
        VM_WAIT_ALL(); \
        const LAS unsigned char* sa = ring + (i & 3) * 1024; \
        const u32x4 x = *(const LAS u32x4*)(sa + 512 + 16 * c8); const float xs = *(const LAS float*)(sa + 640); \
        peer_u_dma(ring + ((i + 2) & 3) * 1024, eoff, XQ, XSC, rC < NROW ? rC : rB, xq, lane); \
        peer_gather(TN, ub, ring + ((i + 1) & 3) * 1024, g); \
        if (rP >= 0) pout[(size_t)rP * 64] = res; \
        res = peer_u_compute(TC, x, xs, lane); rP = rA; \
        rA = rB; rB = rC; ++i; }
#define PEER_U_TAIL(TC) { VM_WAIT_ALL(); const LAS unsigned char* sa = ring + (i & 3) * 1024; \
        const u32x4 x = *(const LAS u32x4*)(sa + 512 + 16 * c8); const float xs = *(const LAS float*)(sa + 640); \
        if (rP >= 0) pout[(size_t)rP * 64] = res; \
        pout[(size_t)rA * 64] = peer_u_compute(TC, x, xs, lane); }
    while (true) {
        if (rB >= NROW) { PEER_U_TAIL(T0) break; }
        PEER_U_STEP(T0, T1)
        if (rB >= NROW) { PEER_U_TAIL(T1) break; }
        PEER_U_STEP(T1, T0)
    }
#undef PEER_U_STEP
#undef PEER_U_TAIL
}

__device__ __forceinline__ float gelu_as(float v) {
    const float av = fabsf(v), t = __builtin_amdgcn_rcpf(av * 0.2316418882f + 1.0f);
    float q = t * 0.5307027145f + (-0.7265760135f); q = q * t + 0.7107068705f; q = q * t + (-0.142248368f); q = q * t + 0.127414796f; q = q * t;
    const float e = fexp2((v * v) * (-0.72134752044f)), m = v * (q * e);
    return v < 0.f ? m : v - m;
}
__device__ __forceinline__ void phase_peer_w(Frame& F, const float* PART, float* gw, bool skipctx) {
    const int gwv = F.vcu * NWAVES + F.wave, NGW = F.G * NWAVES, lane = F.lane;
    for (int r = gwv; r < NROW; r += NGW) {
        if (skipctx && (r % NB) < CTXL) continue;
        float a0 = 0.f, a1 = 0.f;
#pragma unroll
        for (int g = 0; g < 8; ++g) { const unsigned w = ((const GAS unsigned*)PART)[((size_t)g * NROW + r) * 64 + lane]; a0 += bf_lo(w); a1 += bf_hi(w); }
        GAS f32x2* gp = (GAS f32x2*)(gw + (size_t)r * 128) + lane;
        const f32x2 gt = *gp;
        const _Float16 w0 = (_Float16)(gelu_as(a0 * (1.0f / U8_SCALE)) * gt[0] * (1.0f / V8_SCALE)), w1 = (_Float16)(gelu_as(a1 * (1.0f / U8_SCALE)) * gt[1] * (1.0f / V8_SCALE));
        *gp = (f32x2){__uint_as_float(__builtin_bit_cast(unsigned, (h2_t){w0, w0})), __uint_as_float(__builtin_bit_cast(unsigned, (h2_t){w1, w1}))};
    }
}

__device__ __forceinline__ void peer_v_dma(LAS unsigned char* slot, const unsigned* eoff, const float* gw, int r, int lane) {
    const unsigned char* src = lane < 32 ? (const unsigned char*)eoff + (size_t)r * 512 + 16 * lane : (const unsigned char*)gw + (size_t)r * 512 + 16 * (lane - 32);
    __builtin_amdgcn_global_load_lds((const GAS unsigned*)src, (LAS unsigned*)slot, 16, 0, 0);
}
struct PeerVW { u32x4 w[4]; };
struct PeerVRes { f32x2 xv, gv; unsigned xw; GAS float* xr; GAS bf16_t* xq; bool isctx; };
__device__ __forceinline__ void peer_v_pre(PeerVRes& R, bf16_t* xb, float* xc, const float* mod, int r, int cb, int c8, int lane, float vscale) {
    const int b = r / NB, j = r % NB;
    const int col = cb + 16 * c8 + ((lane >> 3) & 1) * 8 + ((lane >> 4) & 1) * 4 + ((lane >> 5) & 1) * 2;
    R.isctx = j < CTXL;
    R.xr = (GAS float*)(xc + ((size_t)b * CTXL + (R.isctx ? j : 0)) * DM + col);
    R.xq = (GAS bf16_t*)(xb + ((size_t)b * SEQ + (R.isctx ? 0 : (j - CTXL))) * DM + col);
    R.xv = (f32x2){0.f, 0.f}; R.xw = 0u;
    if (R.isctx) R.xv = *(const GAS f32x2*)R.xr; else R.xw = *(const GAS unsigned*)R.xq;
    R.gv = *(const GAS f32x2*)(mod + (R.isctx ? 4 : b) * 6144 + 5 * DM + col);
}
__device__ __forceinline__ void peer_v_store(const PeerVRes& R, const f32x2 xn) { if (R.isctx) *(GAS f32x2*)R.xr = xn; else *(GAS unsigned*)R.xq = cvt_pk_bf16(xn[0], xn[1]); }
__device__ __forceinline__ f32x2 peer_v_compute(const u32x4 (&t)[16], const PeerVW& M, const PeerVRes& R, int lane, float vscale) {
    h2_t acc[8];
#pragma unroll
    for (int c = 0; c < 8; ++c) acc[c] = (h2_t){(_Float16)0.f, (_Float16)0.f};
#pragma unroll
    for (int i = 0; i < 16; ++i) { const unsigned wu = M.w[i >> 2][i & 3]; const h2_t w2 = __builtin_bit_cast(h2_t, wu);
        const u32x4 d = t[i];
        acc[0] += w2 * bf8e(d.x); acc[1] += w2 * bf8o(d.x); acc[2] += w2 * bf8e(d.y); acc[3] += w2 * bf8o(d.y);
        acc[4] += w2 * bf8e(d.z); acc[5] += w2 * bf8o(d.z); acc[6] += w2 * bf8e(d.w); acc[7] += w2 * bf8o(d.w); }
    h2_t p4[4], p2[2], p1h;
#define H2X(v, M) __builtin_bit_cast(h2_t, __float_as_uint(xshfl<M>(__uint_as_float(__builtin_bit_cast(unsigned, (v))))))
    { const bool up = (lane & 8) != 0;
#pragma unroll
      for (int q = 0; q < 4; ++q) { const h2_t keep = up ? acc[q + 4] : acc[q], send = up ? acc[q] : acc[q + 4]; p4[q] = keep + H2X(send, 8); } }
    { const bool up = (lane & 16) != 0;
#pragma unroll
      for (int q = 0; q < 2; ++q) { const h2_t keep = up ? p4[q + 2] : p4[q], send = up ? p4[q] : p4[q + 2]; p2[q] = keep + H2X(send, 16); } }
    { const bool up = (lane & 32) != 0; const h2_t keep = up ? p2[1] : p2[0], send = up ? p2[0] : p2[1]; p1h = keep + H2X(send, 32); }
#undef H2X
    const f32x2 p1 = {(float)p1h[0], (float)p1h[1]};
    const f32x2 xv = R.isctx ? R.xv : (f32x2){bf_lo(R.xw), bf_hi(R.xw)};
    return (f32x2){xv[0] + (R.gv[0] * vscale) * p1[0], xv[1] + (R.gv[1] * vscale) * p1[1]};
}
__device__ __forceinline__ void phase_peer_v(Frame& F, const unsigned char* V8, const unsigned* eoff, const float* gw, bf16_t* xb, float* xc, const float* mod, bool skipctx, float vscale) {
    const int lane = F.lane, xq = blockIdx.x & 7, rank = blockIdx.x >> 3, nr = (F.G - xq + 7) >> 3, step = nr * NWAVES;
    const int g = lane >> 3, c8 = lane & 7, cb = xq * 128;
    const char* vb = (const char*)V8 + (size_t)xq * ((size_t)NEXP * 128) + c8 * 16;
    LAS unsigned char* ring = F.lds + F.wave * 4096;
    int rA = peer_next_row(rank * NWAVES + F.wave - step, step, skipctx);
    if (rA >= NROW) return;
    int rB = peer_next_row(rA, step, skipctx), i = 0;
    peer_v_dma(ring, eoff, gw, rA, lane);
    peer_v_dma(ring + 1024, eoff, gw, rB < NROW ? rB : rA, lane);
    VM_WAIT_ALL();
    u32x4 T0[16], T1[16];
    peer_gather(T0, vb, ring, g);
    PeerVRes RA, RB, RP; f32x2 res = {0.f, 0.f}; bool hasP = false;
    peer_v_pre(RA, xb, xc, mod, rA, cb, c8, lane, vscale);
    RP = RA;
#define PEER_V_STEP(TC, TN) { \
        const int rC = peer_next_row(rB, step, skipctx); \
        VM_WAIT_ALL(); \
        PeerVW W; { const LAS u32x4* wp = (const LAS u32x4*)(ring + (i & 3) * 1024 + 512 + 64 * g); W.w[0] = wp[0]; W.w[1] = wp[1]; W.w[2] = wp[2]; W.w[3] = wp[3]; } \
        peer_v_dma(ring + ((i + 2) & 3) * 1024, eoff, gw, rC < NROW ? rC : rB, lane); \
        peer_gather(TN, vb, ring + ((i + 1) & 3) * 1024, g); \
        peer_v_pre(RB, xb, xc, mod, rB, cb, c8, lane, vscale); \
        if (hasP) peer_v_store(RP, res); \
        res = peer_v_compute(TC, W, RA, lane, vscale); RP = RA; hasP = true; RA = RB; \
        rA = rB; rB = rC; ++i; }
#define PEER_V_TAIL(TC) { VM_WAIT_ALL(); PeerVW W; { const LAS u32x4* wp = (const LAS u32x4*)(ring + (i & 3) * 1024 + 512 + 64 * g); W.w[0] = wp[0]; W.w[1] = wp[1]; W.w[2] = wp[2]; W.w[3] = wp[3]; } \
        if (hasP) peer_v_store(RP, res); \
        peer_v_store(RA, peer_v_compute(TC, W, RA, lane, vscale)); }
    while (true) {
        if (rB >= NROW) { PEER_V_TAIL(T0) break; }
        PEER_V_STEP(T0, T1)
        if (rB >= NROW) { PEER_V_TAIL(T1) break; }
        PEER_V_STEP(T1, T0)
    }
#undef PEER_V_STEP
#undef PEER_V_TAIL
}
#ifndef DIAG
#define DIAG 0
#endif
#if DIAG
#ifndef DIAG_TOL
#define DIAG_TOL 2.5e-3f
#endif
__device__ __forceinline__ float blk_max(LAS float* red, float v, int tid) {
    v = fmaxf(v, xshfl<1>(v)); v = fmaxf(v, xshfl<2>(v)); v = fmaxf(v, xshfl<4>(v)); v = fmaxf(v, xshfl<8>(v)); v = fmaxf(v, xshfl<16>(v)); v = xmax32(v);
    __syncthreads(); if ((tid & 63) == 0) red[tid >> 6] = v; __syncthreads();
    float r = red[0];
#pragma unroll
    for (int i = 1; i < 8; ++i) r = fmaxf(r, red[i]);
    __syncthreads(); return r;
}
__device__ __forceinline__ float blk_sum(LAS float* red, float v, int tid) {
    v = wave_sum(v);
    __syncthreads(); if ((tid & 63) == 0) red[tid >> 6] = v; __syncthreads();
    float r = 0.f;
#pragma unroll
    for (int i = 0; i < 8; ++i) r += red[i];
    __syncthreads(); return r;
}
template <int DQK, class KeyFn>
__device__ __forceinline__ float diag_attn(LAS float* sm, int tid, const bf16_t* qp, const bf16_t* kbase, int kpitch, int koff, const bf16_t* k2base, int k2pitch, int k2off,
                                           const bf16_t* vbase, int vpitch, int voff, int nkeys, KeyFn keyfn, float sink_l2, bool has_sink, const bf16_t* yp) {
    LAS float* mw = sm;
    LAS float* lw = sm + 8;
    LAS float* ow = sm + 16;
    LAS float* red = sm + 16 + 512;
    const int lane = tid & 63, w = tid >> 6;
    const float q0 = bf2f(qp[lane]); const float q1 = (DQK == 96 && lane < 32) ? bf2f(qp[64 + lane]) : 0.f;
    float m = -3.0e38f, l = 0.f, o = 0.f;
    for (int i = w; i < nkeys; i += 8) {
        size_t krow; float bias; bool valid; keyfn(i, krow, bias, valid);
        if (!valid) continue;
        float part = q0 * bf2f(kbase[krow * kpitch + koff + lane]);
        if (DQK == 96 && lane < 32) part += q1 * bf2f(k2base[krow * k2pitch + k2off + lane]);
        const float sc = wave_sum(part) + bias;
        const float mn = fmaxf(m, sc), al = fexp2(m - mn), pp = fexp2(sc - mn);
        m = mn; l = l * al + pp; o = o * al + pp * bf2f(vbase[krow * vpitch + voff + lane]);
    }
    __syncthreads();
    if (lane == 0) { mw[w] = m; lw[w] = l; }
    ow[w * 64 + lane] = o;
    __syncthreads();
    float M = mw[0];
#pragma unroll
    for (int i = 1; i < 8; ++i) M = fmaxf(M, mw[i]);
    if (has_sink) M = fmaxf(M, sink_l2);
    float lt = has_sink ? fexp2(sink_l2 - M) : 0.f, ot = 0.f;
#pragma unroll
    for (int i = 0; i < 8; ++i) { const float f = fexp2(mw[i] - M); lt += lw[i] * f; ot += ow[i * 64 + lane] * f; }
    float num = 0.f, den = 0.f;
    if (tid < 64) { const float r = ot / lt, y = bf2f(yp[tid]); num = (y - r) * (y - r); den = r * r; }
    num = blk_sum(red, num, tid); den = blk_sum(red, den, tid);
    return num / (den + 1e-20f);
}

__device__ __forceinline__ float diag_ret(LAS float* sm, int tid, const bf16_t* P, size_t rb0, int j, int h, float lgf, float lgb, const float* gnf, const float* gnb, const bf16_t* yp) {
    LAS float* ow = sm;
    LAS float* red = sm + 1024;
    const int lane = tid & 63, w = tid >> 6;
    const float q = bf2f(P[(rb0 + j) * PW + C_RQ + h * 64 + lane]);
    const int posj = (j < CTXL) ? (CTXL - 1 - j) : (CTXL + (NB - 1 - j));
    float of = 0.f, ob = 0.f;
    for (int s = w; s < NB; s += 8) {
        const int poss = (s < CTXL) ? (CTXL - 1 - s) : (CTXL + (NB - 1 - s));
        const bool inf = s <= j, inb = poss <= posj;
        if (!inf && !inb) continue;
        const bf16_t* pr = P + (rb0 + s) * PW + h * 64 + lane;
        const float qk = wave_sum(q * bf2f(pr[C_RK])); const float v = bf2f(pr[C_RV]);
        if (inf) of += fexp2(lgf * (float)(j - s)) * qk * v;
        if (inb) ob += fexp2(lgb * (float)(posj - poss)) * qk * v;
    }
    __syncthreads();
    ow[w * 64 + lane] = of; ow[512 + w * 64 + lane] = ob;
    __syncthreads();
    float tf = 0.f, tb = 0.f;
#pragma unroll
    for (int i = 0; i < 8; ++i) { tf += ow[i * 64 + lane]; tb += ow[512 + i * 64 + lane]; }
    const float muf = wave_sum(tf) * (1.f / 64.f), mub = wave_sum(tb) * (1.f / 64.f);
    const float vf = wave_sum((tf - muf) * (tf - muf)) * (1.f / 64.f), vb = wave_sum((tb - mub) * (tb - mub)) * (1.f / 64.f);
    const float gf = bf2f(P[(rb0 + j) * PW + C_RGF + h * 64 + lane]), gb = bf2f(P[(rb0 + j) * PW + C_RGB + h * 64 + lane]);
    const float r = silu_f(gf) * ((tf - muf) / sqrtf(vf + EPS)) * gnf[h * 64 + lane] + silu_f(gb) * ((tb - mub) / sqrtf(vb + EPS)) * gnb[h * 64 + lane];
    float num = 0.f, den = 0.f;
    if (tid < 64) { const float y = bf2f(yp[tid]); num = (y - r) * (y - r); den = r * r; }
    num = blk_sum(red, num, tid); den = blk_sum(red, den, tid);
    return num / (den + 1e-20f);
}

__device__ __forceinline__ void diag_check(Frame& F, const Inputs& I, unsigned char* ws, unsigned* code) {
    const int tid = F.tid;
    LAS float* sm = (LAS float*)F.lds;
    LAS float* raw = (LAS float*)(F.lds + 4096);
    LAS float* xn = (LAS float*)(F.lds + 4096 + 12544);
    LAS float* red = (LAS float*)(F.lds + 4096 + 12544 + 4096);
    const bf16_t* P = (const bf16_t*)(ws + WS_P); const bf16_t* KV = (const bf16_t*)(ws + WS_KV); const bf16_t* Y = (const bf16_t*)(ws + WS_XN);
    const float* MOD = (const float*)(ws + WS_MOD);
    const float tol = DIAG_TOL;
    for (int sidx = blockIdx.x; sidx < 256; sidx += F.G) {
        const int b = sidx & 3, si = sidx >> 2;
        static const int jl[16] = {0, 17, 128, 255, 256, 257, 256 + 63, 256 + 64, 256 + 127, 256 + 128, 256 + 129, 256 + 8191, 256 + 8064, 256 + 8063, 256 + 4095, 256 + 4160};
        int j; if (si < 16) { j = 0; for (int q = 0; q < 16; ++q) if (q == si) j = jl[q]; } else j = 256 + ((si * 2654435761u) >> 7) % 8192u;
        const int h = (si * 7 + 3) & 3;
        const size_t row = (size_t)b * NB + j;
        const bool isctx = j < CTXL; const int t = j - CTXL, prow = t >> 6, pcol = t & 63;
        {
            const float* xr = isctx ? I.ctx + ((size_t)b * CTXL + j) * DM : I.x + ((size_t)b * SEQ + t) * DM;
            const float* mv = MOD + (isctx ? 4 : b) * 6144;
            float ss = 0.f; for (int k = tid; k < DM; k += NTHR) ss += xr[k] * xr[k];
            ss = blk_sum(red, ss, tid);
            const float rs = 1.0f / sqrtf(ss / DM + EPS);
            for (int k = tid; k < DM; k += NTHR) { const float y = xr[k] * rs * I.norm_mix_g[k] * (1.f + mv[DM + k]) + mv[k]; xn[k] = bf_lo(cvt_pk_bf16(y, 0.f)); }
            __syncthreads();
            for (int c = tid; c < INW; c += NTHR) { float a = 0.f; for (int k = 0; k < DM; ++k) a += xn[k] * bf_lo(cvt_pk_bf16(I.w_in[(size_t)k * INW + c], 0.f)); raw[c] = a; }
            __syncthreads();
            float num = 0.f, den = 0.f;
            for (int c = tid; c < INW; c += NTHR) {
                const int oc = orig_col(c);
                float ref = raw[oc], sc = 1.f;
                int rb = -1, R = 0;
                if (oc < 384) { if (oc % 96 >= 64) { rb = oc - (oc % 96) + 64; R = 32; } sc = 0.10206207261596577f * LOG2E; }
                else if (oc >= C_KR && oc < C_SWAQ) { rb = C_KR; R = 32; }
                else if (oc >= C_SWAQ && oc < C_SWAK) { rb = C_SWAQ + ((oc - C_SWAQ) & ~63); R = 64; sc = 0.125f * LOG2E; }
                else if (oc >= C_SWAK && oc < C_SWAV) { rb = C_SWAK + ((oc - C_SWAK) & ~63); R = 64; }
                else if (oc >= C_NAQ && oc < C_NAK) sc = 0.125f * LOG2E;
                else if (oc >= C_RK && oc < C_RV) sc = 0.125f;
                if (rb >= 0 && !isctx) {
                    const int quarter = R / 4, p = oc - rb, part = p / (R / 2), which = (p % (R / 2)) / quarter, jj = p % quarter;
                    const float inv = __powf(10000.f, -(float)jj / (float)quarter);
                    const float ang = (float)(part ? pcol : prow) * inv;
                    const float rev = ang * 0.15915494309189535f; const float cs = __builtin_amdgcn_cosf(rev), sn = __builtin_amdgcn_sinf(rev);
                    const float x1 = raw[rb + part * (R / 2) + jj], x2 = raw[rb + part * (R / 2) + quarter + jj];
                    ref = which ? (x1 * sn + x2 * cs) : (x1 * cs - x2 * sn);
                }
                ref *= sc;
                const float got = bf2f(P[row * PW + c]);
                num += (got - ref) * (got - ref); den += ref * ref;
            }
            num = blk_sum(red, num, tid); den = blk_sum(red, den, tid);
            if (tid == 0 && num > tol * den) atomicOr(code, 1u);
        }
        {
            const float* g = I.mla_kv_norm_g; const float* wu = I.mla_w_ukv;
            float ss = 0.f; for (int k = tid; k < 128; k += NTHR) { const float v = bf2f(P[row * PW + C_CKV + k]); ss += v * v; }
            ss = blk_sum(red, ss, tid);
            const float rs = 1.0f / sqrtf(ss / 128.f + EPS);
            float num = 0.f, den = 0.f;
            { const int n = tid; float a = 0.f; for (int k = 0; k < 128; ++k) a += bf2f(P[row * PW + C_CKV + k]) * g[k] * wu[k * KVW + n]; a *= rs;
              const float got = bf2f(KV[row * KVW + n]); num = (got - a) * (got - a); den = a * a; }
            num = blk_sum(red, num, tid); den = blk_sum(red, den, tid);
            if (tid == 0 && num > tol * den) atomicOr(code, 16u);
        }
        const size_t rb0 = (size_t)b * NB;
        {
            auto keyfn = [&](int i, size_t& krow, float& bias, bool& valid) { krow = rb0 + i; bias = 0.f; valid = true; };
            const float e = diag_attn<96>(sm, tid, P + row * PW + h * 96, KV, KVW, h * 128, P, PW, C_KR, KV, KVW, h * 128 + 64, isctx ? CTXL : NB, keyfn, 0.f, false, Y + row * DM + h * 64);
            if (tid == 0 && e > tol) atomicOr(code, 2u);
        }
        {
            const int g = h >> 1;
            auto keyfn = [&](int i, size_t& krow, float& bias, bool& valid) { krow = rb0 + i; bias = 0.f;
                if (i < CTXL) valid = true; else { const int kp = i - CTXL; valid = (kp - t <= 128) && (t - kp <= 128); } };
            const float e = diag_attn<64>(sm, tid, P + row * PW + C_SWAQ + h * 64, P, PW, C_SWAK + g * 64, P, PW, 0, P, PW, C_SWAV + g * 64, isctx ? CTXL : NB, keyfn,
                                          I.swa_sink[h] * LOG2E, true, Y + row * DM + 256 + h * 64);
            if (tid == 0 && e > tol) atomicOr(code, 4u);
        }
        {
            int rs = prow - 4; rs = rs < 0 ? 0 : (rs > 120 ? 120 : rs); int cs = pcol - 8; cs = cs < 0 ? 0 : (cs > 48 ? 48 : cs);
            const float* rpb = I.na_rpb + h * 15 * 31;
            auto keyfn = [&](int i, size_t& krow, float& bias, bool& valid) { krow = rb0 + i; bias = 0.f;
                if (i < CTXL) valid = true; else { const int kp = i - CTXL, kr = kp >> 6, kc = kp & 63; valid = (kr >= rs && kr < rs + 8 && kc >= cs && kc < cs + 16);
                    if (valid) bias = rpb[(kr - prow + 7) * 31 + (kc - pcol + 15)] * LOG2E; } };
            const float e = diag_attn<64>(sm, tid, P + row * PW + C_NAQ + h * 64, P, PW, C_NAK + h * 64, P, PW, 0, P, PW, C_NAV + h * 64, isctx ? CTXL : NB, keyfn, 0.f, false, Y + row * DM + 512 + h * 64);
            if (tid == 0 && e > tol) atomicOr(code, 8u);
        }
        {
            const float e = diag_ret(sm, tid, P, rb0, j, h, log2_sigmoid(I.ret_decay_f[h]), log2_sigmoid(I.ret_decay_b[h]), I.ret_gn_f, I.ret_gn_b, Y + row * DM + 768 + h * 64);
            if (tid == 0 && e > tol) atomicOr(code, 32u);
        }
    }
}
#endif
constexpr int N_PHASES = 26;
#ifndef MK_SINGLE
#define MK_SINGLE 1
#endif
__device__ __forceinline__ Frame fresh(const Frame& F) { Frame f = F; int ln = lane_id(); asm volatile("" : "+v"(ln)); f.lane = ln; f.tid = F.wave * 64 + ln; return f; }
struct Args { Inputs in; float* out; unsigned char* ws; int ph_lo, ph_hi, li, pad; };

__global__ void __launch_bounds__(NTHR, 2) fwd_kernel(Args args) {
    extern __shared__ __attribute__((aligned(16))) unsigned char lds_raw[];
    Frame F;
    F.lds = (LAS unsigned char*)lds_raw;
    F.tid = threadIdx.x; F.lane = F.tid & 63; F.wave = __builtin_amdgcn_readfirstlane(F.tid >> 6);
    F.G = gridDim.x; { const int bx = blockIdx.x; F.vcu = (F.G % 8 == 0) ? (bx % 8) * (F.G / 8) + bx / 8 : bx; }
    typedef const __attribute__((address_space(4))) Args* KArgP;
    const KArgP kap = (KArgP)__builtin_amdgcn_kernarg_segment_ptr();
#define KARGV(f) ({ KArgP _p = kap; asm volatile("" : "+s"(_p)); _p->f; })
#define KARG(f) as_global(KARGV(f))
    unsigned char* ws = KARGV(ws);
    volatile LAS unsigned* MISC = (volatile LAS unsigned*)(F.lds + MISC_OFF);
    for (int u = F.tid; u < (LDS_BYTES - LDSCTL_OFF) / 4; u += NTHR) ((LAS unsigned*)(F.lds + LDSCTL_OFF))[u] = 0u;
    __syncthreads();
    unsigned* ctl = (unsigned*)(ws + WS_CTL);
    XcdBarrier bar = xcd_barrier_post(ctl + CW_BAR + KARGV(li) * XCD_BAR_WORDS, MISC + 8);
    const int lo = KARGV(ph_lo), hi = KARGV(ph_hi);
#ifndef PH_MASK
#define PH_MASK 0x3ff
#endif
#define PHM(j) ((PH_MASK >> (j)) & 1)
#ifndef UM
#define UM 0xff
#endif
#ifndef REP_J
#define REP_J -1
#define REP_N 1
#endif
#define REPS(j) for (int rep_ = 0; rep_ < ((REP_J == (j)) ? REP_N : 1); ++rep_)
#define IN(k) ({ int lo_ = lo, hi_ = hi; asm volatile("" : "+s"(lo_), "+s"(hi_)); lo_ <= (k) && (k) < hi_; })
#if defined(TPH) || defined(TPB)
#define TSTAMP(k) do { if (blockIdx.x == 0 && threadIdx.x == 0) __hip_atomic_store(ctl + 32 + (k), (unsigned)wall_clock64() | 1u, __ATOMIC_RELAXED, __HIP_MEMORY_SCOPE_AGENT); } while (0)
#else
#define TSTAMP(k) do { } while (0)
#endif
#ifdef TPB
#define BSTAMP(k) do { if ((k) == (TPB) && threadIdx.x == 0) __hip_atomic_store(ctl + 64 + blockIdx.x, (unsigned)wall_clock64() | 1u, __ATOMIC_RELAXED, __HIP_MEMORY_SCOPE_AGENT); } while (0)
#else
#define BSTAMP(k) do { } while (0)
#endif
#define SEAM(k) do { if (IN(k) && IN((k) + 1)) { BSTAMP(k); xcd_barrier(bar); TSTAMP((k) + 1); } } while (0)

#define WSQ() unsigned char* wsq_ = ws; asm volatile("" : "+s"(wsq_)); unsigned char* wsq = as_global(wsq_); \
    float* MOD = (float*)(wsq + WS_MOD); bf16_t* XN = (bf16_t*)(wsq + WS_XN); bf16_t* P = (bf16_t*)(wsq + WS_P); bf16_t* KV = (bf16_t*)(wsq + WS_KV); float* SSQ = (float*)(wsq + WS_SSQ); \
    float* XC = (float*)(wsq + WS_XC); float* RS = (float*)(wsq + WS_RS); unsigned char* UB = wsq + WS_UB; unsigned char* VB = wsq + WS_VB; _Float16* S16 = (_Float16*)(wsq + WS_P); \
    int* EID = (int*)(wsq + WS_KV); float* GATE = (float*)(wsq + WS_GATE); bf16_t* XB = (bf16_t*)(wsq + WS_XB); const float* mod = MOD + (size_t)l * 5 * 6144; \
    const float* xl_cur = (l == 0) ? KARG(in.x) : (const float*)nullptr; const float* xc_cur = (l == 0) ? KARG(in.ctx) : XC; \
    (void)XN; (void)P; (void)KV; (void)SSQ; (void)XC; (void)RS; (void)UB; (void)VB; (void)S16; (void)EID; (void)GATE; (void)XB; (void)mod; (void)xl_cur; (void)xc_cur;

    TSTAMP(0);
    if (IN(0)) REPS(100) { { const Inputs Iv = args.in; phase_prologue(F, Iv, as_global(ws)); }; }
    SEAM(0);

#pragma nounroll
    for (int l0 = 0; l0 < NLAYER; ++l0) {
        int l = l0; asm volatile("" : "+s"(l));
        const int pb = 1 + 12 * l;
        const bool last = (l == NLAYER - 1);

        if (PHM(0) && IN(pb + 0)) REPS(0) { Frame Fq = fresh(F); WSQ();
            phase_norm_mod(Fq, xl_cur, XB, xc_cur, KARG(in.norm_mix_g) + l * DM, mod, 0, XN, false, SSQ);
            phase_convert_uv(Fq, KARG(in.peer_u) + (size_t)l * NEXP * DM, KARG(in.peer_v) + (size_t)l * NEXP * DM, wsq);
        }
        SEAM(pb + 0);

        if (PHM(1) && IN(pb + 1)) REPS(1) { Frame Fq = fresh(F); WSQ();
            pg8::Gemm g{XN, (const bf16_t*)(wsq + WS_WIN) + (size_t)l * PW * DM};
            pg8::LinOrder S{PW / 256, (NROW / 256) * (PW / 256), Fq.G, Fq.vcu, 0};
            pg8::EpiProj E{P, SSQ, (const f32x2*)(wsq + WS_TAB), (const f32x2*)(wsq + WS_TAB + 16384)};
            pg8::gemm_phase<pg8::EpiProj, pg8::LinOrder, DM, DM, DM, true>(Fq.lds, Fq.wave, g, S, E);
        }
        SEAM(pb + 1);

        if (PHM(2) && IN(pb + 2)) REPS(2) { Frame Fq = fresh(F); WSQ();
            {
                pg8::Gemm g{P + C_CKV, (const bf16_t*)(wsq + WS_WUKV) + (size_t)l * KVW * 128};
                pg8::LinOrder S{KVW / 256, (NROW / 256) * (KVW / 256), Fq.G, Fq.vcu, 0};
                pg8::EpiKV E{KV, SSQ};
                pg8::gemm_phase<pg8::EpiKV, pg8::LinOrder, 128, PW, 128, true>(Fq.lds, Fq.wave, g, S, E);
            }
            __syncthreads();
            const RetArgs RA{P, XN, RS, KARG(in.ret_decay_f) + l * 4, KARG(in.ret_decay_b) + l * 4, KARG(in.ret_gn_f) + l * 256, KARG(in.ret_gn_b) + l * 256};
            const AttnArgs AA{P, KV, XN, KARG(in.swa_sink) + l * 4, KARG(in.na_rpb) + (size_t)l * 4 * 15 * 31};
            const int n_ctx = last ? 0 : 16;
            if (UM & 1) REPS(21) for (int u = Fq.vcu; u < 512; u += Fq.G) attn_unit<AT_SWA, false>(Fq, AA, u);
            if (UM & 2) REPS(22) for (int u = Fq.vcu; u < 512; u += Fq.G) attn_unit<AT_NA, false>(Fq, AA, u);
            if (UM & 4) REPS(23) ret_local_loop(Fq, RA, (Fq.vcu + 128) % Fq.G, Fq.G, 16 * 66);
            if (UM & 8) for (int u = (Fq.vcu + 32) % Fq.G; u < n_ctx; u += Fq.G) attn_unit<AT_SWA, true>(Fq, AA, u);
            if (UM & 16) for (int u = (Fq.vcu + 48) % Fq.G; u < n_ctx; u += Fq.G) attn_unit<AT_NA, true>(Fq, AA, u);
        }
        SEAM(pb + 2);

        if (PHM(3) && IN(pb + 3)) { Frame Fq = fresh(F); WSQ();
            const RetArgs RA{P, XN, RS, KARG(in.ret_decay_f) + l * 4, KARG(in.ret_decay_b) + l * 4, KARG(in.ret_gn_f) + l * 256, KARG(in.ret_gn_b) + l * 256};
            ret_scan(Fq, RA);
        }
        SEAM(pb + 3);

        if (PHM(4) && IN(pb + 4)) REPS(4) { Frame Fq = fresh(F); WSQ();
            const RetArgs RA{P, XN, RS, KARG(in.ret_decay_f) + l * 4, KARG(in.ret_decay_b) + l * 4, KARG(in.ret_gn_f) + l * 256, KARG(in.ret_gn_b) + l * 256};
            const AttnArgs AA{P, KV, XN, KARG(in.swa_sink) + l * 4, KARG(in.na_rpb) + (size_t)l * 4 * 15 * 31};
            const int n_ctx = last ? 0 : 16;
#if REP_J == 40
            for (int rep_ = 0; rep_ < REP_N - 1; ++rep_) for (int u = Fq.vcu; u < 512; u += Fq.G) attn_unit<AT_MLA, false, true>(Fq, AA, u);
#endif
            if (UM & 32) for (int u = Fq.vcu; u < 512; u += Fq.G) attn_unit<AT_MLA, false>(Fq, AA, u);
            if (UM & 64) for (int u = (Fq.vcu + Fq.G - 16) % Fq.G; u < n_ctx; u += Fq.G) attn_unit<AT_MLA, true>(Fq, AA, u);
            if (UM & 128) REPS(41) ret_out_loop(Fq, RA, (Fq.vcu + 16) % Fq.G, Fq.G, 16 * 66, last);
        }
        SEAM(pb + 4);

        if (PHM(5) && IN(pb + 5)) { Frame Fq = fresh(F); WSQ();
            pg8::Gemm g{XN, (const bf16_t*)(wsq + WS_WOUT) + (size_t)l * DM * DM};
            pg8::LinOrder S{DM / 256, (last ? 128 : 132) * (DM / 256), Fq.G, Fq.vcu, last ? 1 : 0};
            pg8::EpiResid E{xl_cur, XB, xc_cur, XC, mod};
            pg8::gemm_phase<pg8::EpiResid, pg8::LinOrder, DM, DM, DM, true>(Fq.lds, Fq.wave, g, S, E);
        }
        SEAM(pb + 5);

#if REP_J == 60
        for (int rg_ = 0; rg_ < REP_N; ++rg_) {
#endif
        if (PHM(6) && IN(pb + 6)) REPS(6) { Frame Fq = fresh(F); WSQ(); phase_norm_mod<true>(Fq, nullptr, XB, XC, KARG(in.norm_ffn_g) + l * DM, mod, 3, XN, last, nullptr, wsq + WS_XQ, (float*)(wsq + WS_XSC)); }
        SEAM(pb + 6);
#ifdef EXTRA_BAR
        if (IN(pb + 6) && IN(pb + 7)) for (int eb = 0; eb < EXTRA_BAR; ++eb) xcd_barrier(bar);
#endif

#if REP_J == 70
        if (PHM(7) && IN(pb + 7)) for (int rep_ = 0; rep_ < REP_N - 1; ++rep_) { Frame Fq = fresh(F); WSQ();
            pg8::Gemm g{XN, (const bf16_t*)(wsq + WS_WSC) + (size_t)l * 2048 * DM};
            pg8::LinOrder S{2048 / 256, (last ? 128 : 132) * (2048 / 256), Fq.G, Fq.vcu, last ? 1 : 0};
            pg8::EpiNull E{(float*)(wsq + WS_CTL + 4096)};
            pg8::gemm_phase<pg8::EpiNull, pg8::LinOrder, DM, DM, DM, true>(Fq.lds, Fq.wave, g, S, E); }
#endif
        if (PHM(7) && IN(pb + 7)) REPS(7) { Frame Fq = fresh(F); WSQ();
            pg8::Gemm g{XN, (const bf16_t*)(wsq + WS_WSC) + (size_t)l * 2048 * DM};
            pg8::LinOrder S{2048 / 256, (last ? 128 : 132) * (2048 / 256), Fq.G, Fq.vcu, last ? 1 : 0};
            pg8::EpiScore E{S16};
            pg8::gemm_phase<pg8::EpiScore, pg8::LinOrder, DM, DM, DM, true>(Fq.lds, Fq.wave, g, S, E);
        }
        SEAM(pb + 7);

        if (PHM(8) && IN(pb + 8)) REPS(8) { Frame Fq = fresh(F); WSQ(); phase_topk(Fq, S16, EID, GATE, last); }
        SEAM(pb + 8);

#if REP_J == 90
        if (PHM(9) && IN(pb + 9)) for (int rep_ = 0; rep_ < REP_N - 1; ++rep_) { Frame Fq = fresh(F); WSQ(); phase_peer_u<true>(Fq, wsq + WS_XQ, (const float*)(wsq + WS_XSC), UB, (const unsigned*)EID, (float*)(wsq + WS_P), last); }
#endif
        if (PHM(9) && IN(pb + 9)) REPS(9) { Frame Fq = fresh(F); WSQ(); phase_peer_u(Fq, wsq + WS_XQ, (const float*)(wsq + WS_XSC), UB, (const unsigned*)EID, (float*)(wsq + WS_P), last); }
        SEAM(pb + 9);

        if (PHM(9) && IN(pb + 10)) { Frame Fq = fresh(F); WSQ(); phase_peer_w(Fq, (const float*)(wsq + WS_P), GATE, last); }
        SEAM(pb + 10);
#if REP_J == 60
        }
#endif

        if (PHM(9) && IN(pb + 11)) REPS(11) { Frame Fq = fresh(F); WSQ(); float vsc = 1.0f;
#ifdef PEER_SCALE
            vsc = PEER_SCALE;
#endif
            if (REP_J == 11) { vsc = (rep_ == REP_N - 1) ? 1.0f : 0.0f; asm volatile("" : "+v"(vsc)); }
            phase_peer_v(Fq, VB, (const unsigned*)EID, GATE, XB, XC, mod, last, vsc); }
        SEAM(pb + 11);
    }

#if DIAG
    if (IN(25)) { const float dsc = 1.0f + 0.05f * (float)__hip_atomic_load(ctl + 8, __ATOMIC_RELAXED, __HIP_MEMORY_SCOPE_AGENT); { Frame Fq = fresh(F); phase_final_norm(Fq, (const bf16_t*)as_global(ws + WS_XB), KARG(out), KARG(in.final_norm_g), dsc); } }
#elif defined(TPB)
    if (IN(25)) { unsigned t0; do { t0 = __hip_atomic_load(ctl + 32 + TPB, __ATOMIC_RELAXED, __HIP_MEMORY_SCOPE_AGENT); } while (t0 == 0u);
        int mn = 0x7fffffff, mx = 0;
#ifndef TPB_XQ
#define TPB_XQ -1
#endif
        for (int b = 0; b < (int)gridDim.x; ++b) { if (TPB_XQ >= 0 && (b & 7) != TPB_XQ) continue; const int d = (int)(__hip_atomic_load(ctl + 64 + b, __ATOMIC_RELAXED, __HIP_MEMORY_SCOPE_AGENT) - t0); mn = d < mn ? d : mn; mx = d > mx ? d : mx; }
        int b1 = (mn - (TP_OFF) * 100) / ((TP_UNIT) * 100), b2 = (mx - (TP_OFF2) * 100) / ((TP_UNIT2) * 100);
        b1 = b1 < 0 ? 0 : (b1 > 6 ? 6 : b1); b2 = b2 < 0 ? 0 : (b2 > 5 ? 5 : b2);
        const float dsc = 1.0f + 0.05f * (float)(b1 + 7 * b2);
        { Frame Fq = fresh(F); phase_final_norm(Fq, (const bf16_t*)as_global(ws + WS_XB), KARG(out), KARG(in.final_norm_g), dsc); } }
#elif defined(TPH)
    if (IN(25)) { unsigned ta, tb, tc, td; do { ta = __hip_atomic_load(ctl + 32 + TP_A, __ATOMIC_RELAXED, __HIP_MEMORY_SCOPE_AGENT); tb = __hip_atomic_load(ctl + 32 + TP_B, __ATOMIC_RELAXED, __HIP_MEMORY_SCOPE_AGENT);
            tc = __hip_atomic_load(ctl + 32 + TP_A2, __ATOMIC_RELAXED, __HIP_MEMORY_SCOPE_AGENT); td = __hip_atomic_load(ctl + 32 + TP_B2, __ATOMIC_RELAXED, __HIP_MEMORY_SCOPE_AGENT); } while (ta == 0u || tb == 0u || tc == 0u || td == 0u);
        int b1 = ((int)(tb - ta) - (TP_OFF) * 100) / ((TP_UNIT) * 100), b2 = ((int)(td - tc) - (TP_OFF2) * 100) / ((TP_UNIT2) * 100);
        b1 = b1 < 0 ? 0 : (b1 > 6 ? 6 : b1); b2 = b2 < 0 ? 0 : (b2 > 5 ? 5 : b2);
        const float dsc = 1.0f + 0.05f * (float)(b1 + 7 * b2);
        { Frame Fq = fresh(F); phase_final_norm(Fq, (const bf16_t*)as_global(ws + WS_XB), KARG(out), KARG(in.final_norm_g), dsc); } }
#else
    if (IN(25)) { { Frame Fq = fresh(F); phase_final_norm(Fq, (const bf16_t*)as_global(ws + WS_XB), KARG(out), KARG(in.final_norm_g), 1.0f); } }
#endif
#undef IN
#undef SEAM
}

#if DIAG
__global__ void __launch_bounds__(NTHR, 2) diag_kernel(Args args) {
    extern __shared__ __attribute__((aligned(16))) unsigned char lds_raw[];
    Frame F; F.lds = (LAS unsigned char*)lds_raw; F.tid = threadIdx.x; F.lane = F.tid & 63; F.wave = __builtin_amdgcn_readfirstlane(F.tid >> 6); F.G = gridDim.x; F.vcu = blockIdx.x;
    diag_check(F, args.in, args.ws, (unsigned*)(args.ws + WS_CTL) + 8);
}
#endif
extern "C" void kernel_launch(void* const* d_in, const int* in_sizes, int n_in, void* d_out, int out_size, void* d_ws, size_t ws_size, hipStream_t stream) {
    static int grid = 0;
    if (grid == 0) {
        if (n_in != 25 || in_sizes[0] != NBATCH * SEQ * DM || out_size != NBATCH * SEQ * DM || ws_size < WS_END) {
            fprintf(stderr, "kernel_launch: unexpected problem (n_in %d, in0 %d, out %d, ws %zu < %zu); nothing launched\n", n_in, n_in > 0 ? in_sizes[0] : -1, out_size, ws_size, (size_t)WS_END); grid = -1; return; }
        int dev = 0, cus = 0, per_cu = 0;
        if (hipGetDevice(&dev) != hipSuccess || hipDeviceGetAttribute(&cus, hipDeviceAttributeMultiprocessorCount, dev) != hipSuccess) { grid = -1; return; }
#if DIAG
        (void)hipFuncSetAttribute((const void*)diag_kernel, hipFuncAttributeMaxDynamicSharedMemorySize, LDS_BYTES);
#endif
        if (hipFuncSetAttribute((const void*)fwd_kernel, hipFuncAttributeMaxDynamicSharedMemorySize, LDS_BYTES) != hipSuccess) { fprintf(stderr, "kernel_launch: hipFuncSetAttribute failed\n"); grid = -1; return; }
        if (hipOccupancyMaxActiveBlocksPerMultiprocessor(&per_cu, (const void*)fwd_kernel, NTHR, LDS_BYTES) != hipSuccess || per_cu < 1) {
            fprintf(stderr, "kernel_launch: occupancy query reports %d workgroups per CU\n", per_cu); (void)hipGetLastError(); if (per_cu < 1) { grid = -1; return; } }
        grid = cus;
    }
    if (grid < 0) return;
    (void)hipMemsetAsync((char*)d_ws + WS_CTL, 0, CTL_ZERO_BYTES, stream);
    Args a{};
    const float** ip = (const float**)&a.in;
    for (int i = 0; i < 25; ++i) ip[i] = (const float*)d_in[i];
    a.out = (float*)d_out; a.ws = (unsigned char*)d_ws;
#if DIAG
    a.ph_lo = 0; a.ph_hi = 6; a.li = 0; hipLaunchKernelGGL(fwd_kernel, dim3(grid), dim3(NTHR), LDS_BYTES, stream, a);
    hipLaunchKernelGGL(diag_kernel, dim3(grid), dim3(NTHR), LDS_BYTES, stream, a);
    a.ph_lo = 6; a.ph_hi = N_PHASES; a.li = 1; hipLaunchKernelGGL(fwd_kernel, dim3(grid), dim3(NTHR), LDS_BYTES, stream, a);
#elif MK_SINGLE
    a.ph_lo = 0; a.ph_hi = N_PHASES;
    hipLaunchKernelGGL(fwd_kernel, dim3(grid), dim3(NTHR), LDS_BYTES, stream, a);
#else
    for (int p = 0; p < N_PHASES; ++p) { a.ph_lo = p; a.ph_hi = p + 1; hipLaunchKernelGGL(fwd_kernel, dim3(grid), dim3(NTHR), LDS_BYTES, stream, a); }
#endif
}
```

```cpp
#include <hip/hip_runtime.h>
#include <cstdio>
#include <cstdint>

#define GAS __attribute__((address_space(1)))
#define LAS __attribute__((address_space(3)))
typedef unsigned short bf16_t;
typedef short bf16x8 __attribute__((ext_vector_type(8)));
typedef float f32x4 __attribute__((ext_vector_type(4)));
typedef float f32x2 __attribute__((ext_vector_type(2)));
typedef float f32x16 __attribute__((ext_vector_type(16)));
typedef unsigned u32x4 __attribute__((ext_vector_type(4)));
typedef unsigned u32x2 __attribute__((ext_vector_type(2)));

constexpr int NBATCH = 4, SEQ = 8192, CTXL = 256, DM = 1024, NLAYER = 2;
constexpr int NB = SEQ + CTXL;
constexpr int NROW = NBATCH * NB;
constexpr int PW = 3328;
constexpr int INW = 3104;
constexpr int KVW = 512;
constexpr int C_MLAQ = 0, C_CKV = 384, C_KR = 512, C_SWAQ = 544, C_SWAK = 800, C_SWAV = 928, C_NAQ = 1056, C_NAK = 1312, C_NAV = 1568,
              C_RQ = 1824, C_RK = 2080, C_RV = 2336, C_RGF = 2592, C_RGB = 2848;
constexpr int NEXP = 16384, PEER_K = 128;
constexpr float LOG2E = 1.4426950408889634f;
constexpr float EPS = 1e-6f;

constexpr size_t MiB = 1u << 20;
constexpr size_t WS_CTL = 0, CTL_ZERO_BYTES = 1 * MiB;
constexpr size_t WS_MOD = 1 * MiB;
constexpr size_t WS_TAB = 2 * MiB;
constexpr size_t WS_WIN = 3 * MiB;
constexpr size_t WS_WOUT = 17 * MiB;
constexpr size_t WS_WSC = 21 * MiB;
constexpr size_t WS_WUKV = 29 * MiB;
constexpr size_t WS_SSQ = 30 * MiB;
constexpr size_t WS_XC = 31 * MiB;
constexpr size_t WS_UB = 35 * MiB;
constexpr size_t WS_VB = 67 * MiB;
constexpr size_t WS_XN = 99 * MiB;
constexpr size_t WS_P = 165 * MiB;
constexpr size_t WS_XQ = 300 * MiB;
constexpr size_t WS_XSC = 334 * MiB;
constexpr size_t WS_KV = 380 * MiB;
constexpr size_t WS_GATE = WS_KV + (size_t)NROW * 128 * 4;
constexpr size_t WS_RS = 413 * MiB;
constexpr size_t WS_XB = 446 * MiB;
constexpr size_t WS_END = 510 * MiB;
static_assert(WS_P + (size_t)NROW * 2048 * 2 <= WS_XQ && WS_XQ + (size_t)NROW * DM <= WS_XSC && WS_XSC + (size_t)NROW * 16 <= WS_KV, "ws map (ffn)");
static_assert(WS_WIN + (size_t)2 * PW * DM * 2 <= WS_WOUT && WS_XN + (size_t)NROW * DM * 2 <= WS_P && WS_P + (size_t)NROW * PW * 2 <= WS_KV &&
              WS_KV + (size_t)NROW * KVW * 2 <= WS_RS && WS_GATE + (size_t)NROW * 128 * 4 <= WS_RS && WS_RS + (size_t)32 * 66 * 4096 * 4 <= WS_XB && WS_XB + (size_t)NBATCH * SEQ * DM * 2 <= WS_END, "ws map");
constexpr int CW_TMO = 0, CW_BAR = 4096;

constexpr int RING_BYTES = 131072;
constexpr int LDSCTL_OFF = RING_BYTES, MISC_OFF = LDSCTL_OFF + 320;
constexpr int LDS_BYTES = 147456;
constexpr int NWAVES = 8, NTHR = 512;

__device__ __forceinline__ unsigned cvt_pk_bf16(float lo, float hi) { unsigned r; asm volatile("v_cvt_pk_bf16_f32 %0, %1, %2" : "=v"(r) : "v"(lo), "v"(hi)); return r; }
__device__ __forceinline__ float bf_lo(unsigned w) { return __uint_as_float(w << 16); }
__device__ __forceinline__ float bf_hi(unsigned w) { return __uint_as_float(w & 0xffff0000u); }
__device__ __forceinline__ float bf2f(bf16_t h) { return __uint_as_float((unsigned)h << 16); }
__device__ __forceinline__ int lane_id() { unsigned z = 0u; asm volatile("" : "+v"(z)); return (int)__builtin_amdgcn_mbcnt_hi(~0u, __builtin_amdgcn_mbcnt_lo(~0u, z)); }
template <int M> __device__ __forceinline__ float xshfl(float v) {
    if constexpr (M == 32) { auto rr = __builtin_amdgcn_permlane32_swap(__float_as_uint(v), __float_as_uint(v), false, false);
        return __uint_as_float((lane_id() & 32) ? rr[0] : rr[1]); }
    else return __uint_as_float((unsigned)__builtin_amdgcn_ds_swizzle((int)__float_as_uint(v), (M << 10) | 0x1F));
}
__device__ __forceinline__ float xsum32(float v) { auto rr = __builtin_amdgcn_permlane32_swap(__float_as_uint(v), __float_as_uint(v), false, false); return __uint_as_float(rr[0]) + __uint_as_float(rr[1]); }
__device__ __forceinline__ float xmax32(float v) { auto rr = __builtin_amdgcn_permlane32_swap(__float_as_uint(v), __float_as_uint(v), false, false); return fmaxf(__uint_as_float(rr[0]), __uint_as_float(rr[1])); }
__device__ __forceinline__ float wave_sum(float v) {
    v += xshfl<1>(v); v += xshfl<2>(v); v += xshfl<4>(v); v += xshfl<8>(v); v += xshfl<16>(v); return xsum32(v);
}
__device__ __forceinline__ float fexp2(float x) { return __builtin_amdgcn_exp2f(x); }
__device__ __forceinline__ float silu_f(float x) { return x / (1.f + __expf(-x)); }
template <class T> __device__ __forceinline__ T* as_global(T* p) { return (T*)(GAS T*)p; }
#define LDS_WAIT() asm volatile("s_waitcnt lgkmcnt(0)" ::: "memory")
#define VM_WAIT() asm volatile("s_waitcnt vmcnt(0)" ::: "memory")

#define XB_TMO      128
#define XB_XCNT(j)  (256  + 64 * (j))
#define XB_XSUB(j)  (1280 + 64 * (j))
#define XB_XGEN(j)  (2304 + 64 * (j))
#define XB_TOP      3328
#define XB_TOPGEN   3392
#define XCD_BAR_WORDS 3456
#define XB_SPIN_CAP (1u << 18)
__device__ __forceinline__ unsigned xb_ld(unsigned* p)              { return __hip_atomic_load(p, __ATOMIC_RELAXED, __HIP_MEMORY_SCOPE_AGENT); }
__device__ __forceinline__ unsigned xb_add(unsigned* p, unsigned v) { return __hip_atomic_fetch_add(p, v, __ATOMIC_RELAXED, __HIP_MEMORY_SCOPE_AGENT); }
__device__ __forceinline__ unsigned xb_xcc_id() { return (unsigned)__builtin_amdgcn_s_getreg((3 << 11) | 20) & 0xFu; }
#define XB_SPIN(cond, bar) do { unsigned _sp = 0; while (cond) { __builtin_amdgcn_s_sleep(1); \
    if ((++_sp & 255u) == 0u) { if (xb_ld(&(bar)[XB_TMO])) break; if (_sp > XB_SPIN_CAP) { atomicAdd(&(bar)[XB_TMO], 1u); break; } } } } while (0)
struct XcdBarrier { unsigned* bar; unsigned x; volatile LAS unsigned* st; };
__device__ __forceinline__ XcdBarrier xcd_barrier_post(unsigned* bar, volatile LAS unsigned* st) {
    XcdBarrier b; b.bar = bar; b.x = xb_xcc_id(); b.st = st;
    if (threadIdx.x == 0) (void)xb_add(&bar[XB_XCNT(b.x)], 1u);
    return b;
}
__device__ __forceinline__ void xcd_barrier_complete(unsigned* bar, unsigned x, unsigned& nloc, unsigned& nx) {
    const unsigned G = gridDim.x * gridDim.y * gridDim.z;
    unsigned sum, cnt, mine, sp = 0u;
    for (;;) {
        sum = 0u; cnt = 0u; mine = 0u;
#pragma unroll
        for (unsigned j = 0; j < 16; ++j) { const unsigned c = xb_ld(&bar[XB_XCNT(j)]); sum += c; cnt += (c > 0u) ? 1u : 0u; mine = (j == x) ? c : mine; }
        if (sum == G) break;
        __builtin_amdgcn_s_sleep(1);
        if ((++sp & 255u) == 0u) { if (xb_ld(&bar[XB_TMO])) break; if (sp > XB_SPIN_CAP) { atomicAdd(&bar[XB_TMO], 1u); break; } }
    }
    nloc = mine > 0u ? mine : 1u; nx = cnt > 0u ? cnt : 1u;
}
__device__ __forceinline__ void xcd_barrier(const XcdBarrier& b) {
    asm volatile("s_waitcnt vmcnt(0)" ::: "memory");
    __syncthreads();
    if (threadIdx.x == 0) {
        unsigned* bar = b.bar;
        __builtin_amdgcn_s_waitcnt(0);
        unsigned nloc = b.st[0], nx = b.st[1];
        if (nloc == 0u) { unsigned xo = b.x; asm volatile("" : "+s"(xo)); xcd_barrier_complete(bar, xo, nloc, nx); b.st[0] = nloc; b.st[1] = nx; }
        const unsigned old = xb_add(&bar[XB_XSUB(b.x)], 1u);
        const unsigned gen = old / nloc;
        if (old + 1u == (gen + 1u) * nloc) {
            __builtin_amdgcn_fence(__ATOMIC_RELEASE, "agent");
            asm volatile("s_waitcnt vmcnt(0)" ::: "memory");
            const unsigned og = xb_add(&bar[XB_TOP], 1u);
            const unsigned tg = og / nx;
            if (og + 1u == (tg + 1u) * nx) xb_add(&bar[XB_TOPGEN], 1u);
            else XB_SPIN(xb_ld(&bar[XB_TOPGEN]) == tg, bar);
            __builtin_amdgcn_fence(__ATOMIC_ACQUIRE, "agent");
            xb_add(&bar[XB_XGEN(b.x)], 1u);
            asm volatile("s_waitcnt vmcnt(0)" ::: "memory");
        } else {
            XB_SPIN(xb_ld(&bar[XB_XGEN(b.x)]) == gen, bar);
            __builtin_amdgcn_fence(__ATOMIC_ACQUIRE, "agent");
            asm volatile("s_waitcnt vmcnt(0)" ::: "memory");
        }
    }
    __syncthreads();
}
namespace pg8 {
constexpr int BM = 256, BK = 64, HALF = 128, HTB = HALF * BK * 2, STAGE_BYTES = 8 * HTB;
__host__ __device__ __forceinline__ int lds_byte(int r, int c) { const int st = (r >> 4) * 2 + (c >> 5), rr = r & 15, cc = c & 31, ob = rr * 64 + cc * 2; return st * 1024 + (ob ^ (((ob >> 9) & 1) << 5)); }
__host__ __device__ __forceinline__ void stage_rc(int b, int& R, int& C) { const int st = b / 1024, sb = b % 1024, swz = sb ^ (((sb >> 9) & 1) << 5); R = (st >> 1) * 16 + swz / 64; C = (st & 1) * 32 + (swz % 64) / 2; }
__host__ __device__ __forceinline__ int perm32(int rho) { const int n = rho >> 4, i = rho & 15; return 8 * (i >> 2) + 4 * n + (i & 3); }
struct Unit { int pm, pn; };
struct Gemm { const bf16_t* A; const bf16_t* Bt; };

struct LinOrder {
    int nN, nUnits, G, c, skipctx;
    __device__ __forceinline__ bool next(int i, Unit& u) const {
        const int L = i * G + c; if (L >= nUnits) return false;
        const int pmv = L / nN; u.pn = L - pmv * nN; u.pm = skipctx ? (pmv + pmv / 32 + 1) : pmv; return true;
    }
    __device__ __forceinline__ void a_ready(const Unit&) const {}
    __device__ __forceinline__ void done(const Unit&) const {}
};

template <class Epi, class Sched, int KDIM, int LDA, int LDB, bool ALIGN_EPI = false>
__device__ __forceinline__ void gemm_phase(LAS unsigned char* lds, int wave_sgpr, const Gemm g, const Sched& S, const Epi& E) {
    const int wid = __builtin_amdgcn_readfirstlane(wave_sgpr); int lane = lane_id(); asm volatile("" : "+v"(lane)); const int tid = wid * 64 + lane;
    const int wr = wid >> 2, wc = wid & 3, fr = lane & 15, fq = lane >> 4;
    int nt = KDIM / BK; asm volatile("" : "+s"(nt));
    unsigned voffA[2], voffB[2];
#pragma unroll
    for (int i = 0; i < 2; ++i) { int R, C; stage_rc(tid * 16 + i * 8192, R, C); const int Rb = Epi::PERM ? (64 * (R >> 5) + perm32(R & 31)) : R;
        voffA[i] = (unsigned)(R * LDA + C) * 2u; voffB[i] = (unsigned)(Rb * LDB + C) * 2u; }
    constexpr size_t kstep = (size_t)(BK * 2);
    constexpr size_t hstepA = (size_t)HALF * LDA * 2, hstepB = (size_t)(Epi::PERM ? 32 : HALF) * LDB * 2;
    constexpr size_t tstepA = (size_t)BM * LDA * 2, tstepB = (size_t)BM * LDB * 2;
    const unsigned ldsw = (unsigned)wid * 1024u;
    const int aoff = lds_byte(wr * 64 + fr, fq * 8), boff = lds_byte(wc * 32 + fr, fq * 8);
#define PG8_SA(b, h) (((b) * 2 + (h)) * HTB)
#define PG8_SB(b, h) ((4 + (b) * 2 + (h)) * HTB)
#define PG8_STAGE(bufoff, gbase, voff) do { _Pragma("unroll") for (int _i = 0; _i < 2; ++_i) \
        __builtin_amdgcn_global_load_lds((const unsigned*)((const char*)(gbase) + (voff)[_i]), (LAS unsigned*)(lds + (bufoff) + ldsw + _i * 8192), 16, 0, 0); } while (0)
#define PG8_LDA(dst, b, h) do { _Pragma("unroll") for (int m = 0; m < 4; ++m) _Pragma("unroll") for (int k = 0; k < 2; ++k) dst[m][k] = *(const LAS bf16x8*)(lds + PG8_SA(b, h) + aoff + m * 2048 + k * 1024); } while (0)
#define PG8_LDB(dst, b, h) do { _Pragma("unroll") for (int n = 0; n < 2; ++n) _Pragma("unroll") for (int k = 0; k < 2; ++k) dst[n][k] = *(const LAS bf16x8*)(lds + PG8_SB(b, h) + boff + n * 2048 + k * 1024); } while (0)
#define PG8_MMA(ai, bj, At, Bt) do { __builtin_amdgcn_s_setprio(1); _Pragma("unroll") for (int m = 0; m < 4; ++m) _Pragma("unroll") for (int n = 0; n < 2; ++n) _Pragma("unroll") for (int k = 0; k < 2; ++k) \
        acc[ai][bj][m][n] = __builtin_amdgcn_mfma_f32_16x16x32_bf16(Bt[n][k], At[m][k], acc[ai][bj][m][n], 0, 0, 0); __builtin_amdgcn_s_setprio(0); } while (0)
#define PG8_WAIT_V(n) asm volatile("s_waitcnt vmcnt(" #n ")" ::: "memory")
#define PG8_WAIT_L(n) asm volatile("s_waitcnt lgkmcnt(" #n ")" ::: "memory")
#define PG8_BAR __builtin_amdgcn_s_barrier()
#define PG8_SCHED __builtin_amdgcn_sched_barrier(0)
    Unit cur, nxt; int ui = 0;
    if (!S.next(0, cur)) return;
    f32x4 acc[2][2][4][2];
#pragma unroll
    for (int a = 0; a < 2; ++a)
#pragma unroll
        for (int b = 0; b < 2; ++b)
#pragma unroll
            for (int m = 0; m < 4; ++m)
#pragma unroll
                for (int n = 0; n < 2; ++n) acc[a][b][m][n] = (f32x4){0.f, 0.f, 0.f, 0.f};
    bf16x8 At[4][2], B0[2][2], B1[2][2];
    const char* cA = (const char*)g.A + (size_t)cur.pm * tstepA; const char* cB = (const char*)g.Bt + (size_t)cur.pn * tstepB;
    S.a_ready(cur);
    PG8_STAGE(PG8_SB(0, 0), cB, voffB); PG8_STAGE(PG8_SB(0, 1), cB + hstepB, voffB); PG8_STAGE(PG8_SA(0, 0), cA, voffA); PG8_STAGE(PG8_SA(0, 1), cA + hstepA, voffA);
    if (wr == 1) PG8_BAR;
    PG8_WAIT_V(2); PG8_BAR;
    PG8_STAGE(PG8_SB(1, 0), cB + kstep, voffB); PG8_STAGE(PG8_SA(1, 0), cA + kstep, voffA); PG8_STAGE(PG8_SB(1, 1), cB + hstepB + kstep, voffB);
    PG8_WAIT_V(6); PG8_BAR;
    for (;;) {
        const bool has_next = S.next(ui + 1, nxt);
        const char* nA = has_next ? (const char*)g.A + (size_t)nxt.pm * tstepA : cA; const char* nB = has_next ? (const char*)g.Bt + (size_t)nxt.pn * tstepB : cB;
        for (int t = 0; t < nt; t += 2) {
            const bool last = (t == nt - 2);
            const char* a1 = cA + (size_t)(t + 1) * kstep;
            const char* a2 = last ? nA : cA + (size_t)(t + 2) * kstep; const char* b2 = last ? nB : cB + (size_t)(t + 2) * kstep;
            const char* a3 = a2 + kstep; const char* b3 = b2 + kstep;
            if (last && has_next) S.a_ready(nxt);
            PG8_LDB(B0, 0, 0); PG8_LDB(B1, 0, 1); PG8_SCHED; PG8_LDA(At, 0, 0); PG8_STAGE(PG8_SA(1, 1), a1 + hstepA, voffA);
            PG8_WAIT_V(8); PG8_WAIT_L(0); PG8_BAR; PG8_MMA(0, 0, At, B0); PG8_MMA(0, 1, At, B1); PG8_BAR; PG8_SCHED;
            PG8_LDA(At, 0, 1); PG8_STAGE(PG8_SB(0, 0), b2, voffB); PG8_STAGE(PG8_SB(0, 1), b2 + hstepB, voffB); PG8_STAGE(PG8_SA(0, 0), a2, voffA);
            PG8_WAIT_V(8); PG8_WAIT_L(0); PG8_BAR; PG8_MMA(1, 0, At, B0); PG8_MMA(1, 1, At, B1); PG8_BAR; PG8_SCHED;
            PG8_LDB(B0, 1, 0); PG8_LDB(B1, 1, 1); PG8_SCHED; PG8_LDA(At, 1, 0); PG8_STAGE(PG8_SA(0, 1), a2 + hstepA, voffA);
            PG8_WAIT_V(8); PG8_WAIT_L(0); PG8_BAR; PG8_MMA(0, 0, At, B0); PG8_MMA(0, 1, At, B1); PG8_BAR; PG8_SCHED;
            PG8_LDA(At, 1, 1); PG8_STAGE(PG8_SB(1, 0), b3, voffB); PG8_STAGE(PG8_SB(1, 1), b3 + hstepB, voffB); PG8_STAGE(PG8_SA(1, 0), a3, voffA);
            PG8_WAIT_V(8); PG8_WAIT_L(0); PG8_BAR; PG8_MMA(1, 0, At, B0); PG8_MMA(1, 1, At, B1); PG8_BAR; PG8_SCHED;
        }
        if constexpr (ALIGN_EPI) { if (wr == 0) PG8_BAR; }
        E(acc, cur, wr, wc, fr, fq); S.done(cur);
        if (!has_next) break;
#pragma unroll
        for (int a = 0; a < 2; ++a)
#pragma unroll
            for (int b = 0; b < 2; ++b)
#pragma unroll
                for (int m = 0; m < 4; ++m)
#pragma unroll
                    for (int n = 0; n < 2; ++n) acc[a][b][m][n] = (f32x4){0.f, 0.f, 0.f, 0.f};
        cur = nxt; cA = nA; cB = nB; ++ui;
        if constexpr (ALIGN_EPI) { if (wr == 1) PG8_BAR; }
    }
    PG8_WAIT_V(0);
    if constexpr (!ALIGN_EPI) { if (wr == 0) PG8_BAR; }
    PG8_BAR;
#undef PG8_SA
#undef PG8_SB
#undef PG8_STAGE
#undef PG8_LDA
#undef PG8_LDB
#undef PG8_MMA
#undef PG8_WAIT_V
#undef PG8_WAIT_L
#undef PG8_BAR
#undef PG8_SCHED
}

__device__ __forceinline__ unsigned dpp_ror8(unsigned v) { return (unsigned)__builtin_amdgcn_mov_dpp((int)v, 0x128, 0xf, 0xf, false); }
__device__ __forceinline__ void epi_pair_exchange(const u32x4 c0, const u32x4 c1, int fr, u32x4& a, u32x4& b) {
    const bool lo = fr < 8;
    const u32x4 send = lo ? c1 : c0;
    u32x4 recv; recv.x = dpp_ror8(send.x); recv.y = dpp_ror8(send.y); recv.z = dpp_ror8(send.z); recv.w = dpp_ror8(send.w);
    a = lo ? c0 : recv;
    b = lo ? recv : c1;
}

struct EpiProj {
    static constexpr bool PERM = true;
    bf16_t* P; float* ssq; const f32x2* r64; const f32x2* r32;
    struct Cfg { float sc; int rope, pp, c0, cs; bool isckv, valid; };
    __device__ __forceinline__ Cfg cfg(int cs, int fq, bool isctx) const {
        Cfg C; C.cs = cs; C.c0 = cs + 8 * fq; C.sc = 1.f; C.rope = 0; C.pp = 0; C.valid = cs < INW;
        if (cs < C_CKV) { C.sc = 0.10206207261596577f * LOG2E; const int p = cs % 96; if (p >= 64) { C.rope = 32; C.pp = C.c0 % 96 - 64; } }
        else if (cs < C_KR) { }
        else if (cs < C_SWAQ) { C.rope = 32; C.pp = C.c0 - C_KR; }
        else if (cs < C_SWAK) { C.sc = 0.125f * LOG2E; C.rope = 64; C.pp = (C.c0 - C_SWAQ) & 63; }
        else if (cs < C_SWAV) { C.rope = 64; C.pp = (C.c0 - C_SWAK) & 63; }
        else if (cs < C_NAQ) { }
        else if (cs < C_NAK) { C.sc = 0.125f * LOG2E; }
        else if (cs < C_RK) { }
        else if (cs < C_RV) { C.sc = 0.125f; }
        C.isckv = (cs >= C_CKV && cs < C_KR);
        if (isctx) C.rope = 0;
        return C;
    }
    __device__ __forceinline__ u32x4 chunk(const f32x4 a0, const f32x4 a1, const Cfg& C, int t, int row, int fq) const {
        f32x4 v0 = a0 * C.sc, v1 = a1 * C.sc;
        if (C.rope) {
            f32x4 cs0, cs1;
            if (C.rope == 64) { const int pos = (C.pp >= 32) ? (t & 63) : (t >> 6); const GAS f32x4* tp = (const GAS f32x4*)(r64 + pos * 16 + ((C.pp & 31) >> 1)); cs0 = tp[0]; cs1 = tp[1]; }
            else              { const int pos = (C.pp >= 16) ? (t & 63) : (t >> 6); const GAS f32x4* tp = (const GAS f32x4*)(r32 + pos * 8 + ((C.pp & 15) >> 1)); cs0 = tp[0]; cs1 = tp[1]; }
            f32x4 w0, w1;
            w0[0] = v0[0] * cs0[0] - v0[1] * cs0[1]; w0[1] = v0[0] * cs0[1] + v0[1] * cs0[0];
            w0[2] = v0[2] * cs0[2] - v0[3] * cs0[3]; w0[3] = v0[2] * cs0[3] + v0[3] * cs0[2];
            w1[0] = v1[0] * cs1[0] - v1[1] * cs1[1]; w1[1] = v1[0] * cs1[1] + v1[1] * cs1[0];
            w1[2] = v1[2] * cs1[2] - v1[3] * cs1[3]; w1[3] = v1[2] * cs1[3] + v1[3] * cs1[2];
            v0 = w0; v1 = w1;
        }
        if (C.isckv) {
            float s = (v0[0] * v0[0] + v0[1] * v0[1]) + (v0[2] * v0[2] + v0[3] * v0[3]) + (v1[0] * v1[0] + v1[1] * v1[1]) + (v1[2] * v1[2] + v1[3] * v1[3]);
            s += xshfl<16>(s); s = xsum32(s);
            if (fq == 0) ((GAS float*)ssq)[(size_t)row * 4 + ((C.cs - C_CKV) >> 5)] = s;
        }
        u32x4 w; w.x = cvt_pk_bf16(v0[0], v0[1]); w.y = cvt_pk_bf16(v0[2], v0[3]); w.z = cvt_pk_bf16(v1[0], v1[1]); w.w = cvt_pk_bf16(v1[2], v1[3]);
        return w;
    }
    __device__ __forceinline__ void operator()(const f32x4 (&acc)[2][2][4][2], const Unit& u, int wr, int wc, int, int) const {
        int ln_ = lane_id(); asm volatile("" : "+v"(ln_)); const int fr = ln_ & 15, fq = ln_ >> 4;
        const bool isctx = (u.pm % 33) == 0;
        const int tb = (u.pm % 33 - 1) * 256;
        const int cw = u.pn * BM + wc * 64;
        const Cfg C0 = cfg(cw, fq, isctx), C1 = cfg(cw + 32, fq, isctx);
        if (!C0.valid) return;
        const bool vst = (fr < 8) ? true : C1.valid;
        const int cst = cw + ((fr >> 3) << 5) + 8 * fq;
#pragma unroll
        for (int ai = 0; ai < 2; ++ai)
#pragma unroll
            for (int m = 0; m < 4; ++m) {
                const int rg = u.pm * BM + ai * HALF + wr * 64 + m * 16;
                const int row = rg + fr, t = tb + ai * HALF + wr * 64 + m * 16 + fr;
                const u32x4 k0 = chunk(acc[ai][0][m][0], acc[ai][0][m][1], C0, t, row, fq);
                u32x4 k1 = {0u, 0u, 0u, 0u};
                if (C1.valid) k1 = chunk(acc[ai][1][m][0], acc[ai][1][m][1], C1, t, row, fq);
                u32x4 sa, sb; epi_pair_exchange(k0, k1, fr, sa, sb);
                if (vst) { *(GAS u32x4*)(P + (size_t)(rg + (fr & 7)) * PW + cst) = sa; *(GAS u32x4*)(P + (size_t)(rg + 8 + (fr & 7)) * PW + cst) = sb; }
            }
    }
};
struct EpiKV {
    static constexpr bool PERM = true;
    bf16_t* KV; const float* ssq;
    __device__ __forceinline__ void operator()(const f32x4 (&acc)[2][2][4][2], const Unit& u, int wr, int wc, int, int) const {
        int ln_ = lane_id(); asm volatile("" : "+v"(ln_)); const int fr = ln_ & 15, fq = ln_ >> 4;
        const int cst = u.pn * BM + wc * 64 + ((fr >> 3) << 5) + 8 * fq;
#pragma unroll
        for (int ai = 0; ai < 2; ++ai)
#pragma unroll
            for (int m = 0; m < 4; ++m) {
                const int rg = u.pm * BM + ai * HALF + wr * 64 + m * 16, row = rg + fr;
                const f32x4 q4 = *(const GAS f32x4*)(ssq + (size_t)row * 4); const float rs = 1.0f / sqrtf(((q4[0] + q4[1]) + (q4[2] + q4[3])) * (1.f / 128.f) + EPS);
                u32x4 k[2];
#pragma unroll
                for (int bj = 0; bj < 2; ++bj) { const f32x4 v0 = acc[ai][bj][m][0] * rs, v1 = acc[ai][bj][m][1] * rs;
                    k[bj].x = cvt_pk_bf16(v0[0], v0[1]); k[bj].y = cvt_pk_bf16(v0[2], v0[3]); k[bj].z = cvt_pk_bf16(v1[0], v1[1]); k[bj].w = cvt_pk_bf16(v1[2], v1[3]); }
                u32x4 sa, sb; epi_pair_exchange(k[0], k[1], fr, sa, sb);
                *(GAS u32x4*)(KV + (size_t)(rg + (fr & 7)) * KVW + cst) = sa; *(GAS u32x4*)(KV + (size_t)(rg + 8 + (fr & 7)) * KVW + cst) = sb;
            }
    }
};
struct EpiResid {
    static constexpr bool PERM = true;
    const float* xl_in; bf16_t* xb; const float* xc_in; float* xc_out; const float* mod;
    __device__ __forceinline__ void operator()(const f32x4 (&acc)[2][2][4][2], const Unit& u, int wr, int wc, int, int) const {
        int ln_ = lane_id(); asm volatile("" : "+v"(ln_)); const int fr = ln_ & 15, fq = ln_ >> 4;
        const int b = u.pm / 33, jt = u.pm % 33;
        const int cw = u.pn * BM + wc * 64 + 8 * fq;
        const float* gate = mod + ((jt == 0) ? 4 : b) * 6144 + 2 * DM;
        if (jt == 0) {
#pragma unroll
            for (int bj = 0; bj < 2; ++bj) { const int c = cw + 32 * bj; const f32x4 g0 = *(const GAS f32x4*)(gate + c), g1 = *(const GAS f32x4*)(gate + c + 4);
#pragma unroll
                for (int ai = 0; ai < 2; ++ai)
#pragma unroll
                    for (int m = 0; m < 4; ++m) { const size_t off = ((size_t)b * CTXL + ai * HALF + wr * 64 + m * 16 + fr) * DM + c;
                        const f32x4 b0 = *(const GAS f32x4*)(xc_in + off), b1 = *(const GAS f32x4*)(xc_in + off + 4);
                        *(GAS f32x4*)(xc_out + off) = b0 + g0 * acc[ai][bj][m][0]; *(GAS f32x4*)(xc_out + off + 4) = b1 + g1 * acc[ai][bj][m][1]; } }
            return;
        }
        const f32x4 ga0 = *(const GAS f32x4*)(gate + cw), ga1 = *(const GAS f32x4*)(gate + cw + 4), gb0 = *(const GAS f32x4*)(gate + cw + 32), gb1 = *(const GAS f32x4*)(gate + cw + 36);
        const int cst = cw + ((fr >> 3) << 5);
        const size_t rbase = (size_t)b * SEQ + (size_t)(jt - 1) * 256;
#pragma unroll
        for (int ai = 0; ai < 2; ++ai)
#pragma unroll
            for (int m = 0; m < 4; ++m) {
                const size_t rg = rbase + ai * HALF + wr * 64 + m * 16;
                const f32x4 d00 = ga0 * acc[ai][0][m][0], d01 = ga1 * acc[ai][0][m][1], d10 = gb0 * acc[ai][1][m][0], d11 = gb1 * acc[ai][1][m][1];
                u32x4 a0, b0, a1, b1;
                epi_pair_exchange(__builtin_bit_cast(u32x4, d00), __builtin_bit_cast(u32x4, d10), fr, a0, b0);
                epi_pair_exchange(__builtin_bit_cast(u32x4, d01), __builtin_bit_cast(u32x4, d11), fr, a1, b1);
#pragma unroll
                for (int hb = 0; hb < 2; ++hb) {
                    const size_t off = (rg + 8 * hb + (fr & 7)) * DM + cst;
                    const f32x4 e0 = __builtin_bit_cast(f32x4, hb ? b0 : a0), e1 = __builtin_bit_cast(f32x4, hb ? b1 : a1);
                    f32x4 x0, x1;
                    if (xl_in) { x0 = *(const GAS f32x4*)(xl_in + off); x1 = *(const GAS f32x4*)(xl_in + off + 4); }
                    else { const u32x4 w = *(const GAS u32x4*)(xb + off); x0 = (f32x4){bf_lo(w.x), bf_hi(w.x), bf_lo(w.y), bf_hi(w.y)}; x1 = (f32x4){bf_lo(w.z), bf_hi(w.z), bf_lo(w.w), bf_hi(w.w)}; }
                    const f32x4 r0 = x0 + e0, r1 = x1 + e1;
                    u32x4 w2; w2.x = cvt_pk_bf16(r0[0], r0[1]); w2.y = cvt_pk_bf16(r0[2], r0[3]); w2.z = cvt_pk_bf16(r1[0], r1[1]); w2.w = cvt_pk_bf16(r1[2], r1[3]);
                    *(GAS u32x4*)(xb + off) = w2;
                }
            }
    }
};
struct EpiScore {
    static constexpr bool PERM = true;
    _Float16* S;
    __device__ __forceinline__ void operator()(const f32x4 (&acc)[2][2][4][2], const Unit& u, int wr, int wc, int, int) const {
        int ln_ = lane_id(); asm volatile("" : "+v"(ln_)); const int fr = ln_ & 15, fq = ln_ >> 4;
        typedef _Float16 h2 __attribute__((ext_vector_type(2)));
        const int cst = u.pn * BM + wc * 64 + ((fr >> 3) << 5) + 8 * fq;
#pragma unroll
        for (int ai = 0; ai < 2; ++ai)
#pragma unroll
            for (int m = 0; m < 4; ++m) {
                const int rg = u.pm * BM + ai * HALF + wr * 64 + m * 16;
                u32x4 k[2];
#pragma unroll
                for (int bj = 0; bj < 2; ++bj) { const f32x4 v0 = acc[ai][bj][m][0], v1 = acc[ai][bj][m][1];
                    const h2 a = {(_Float16)v0[0], (_Float16)v0[1]}, b = {(_Float16)v0[2], (_Float16)v0[3]}, c = {(_Float16)v1[0], (_Float16)v1[1]}, d = {(_Float16)v1[2], (_Float16)v1[3]};
                    k[bj].x = __builtin_bit_cast(unsigned, a); k[bj].y = __builtin_bit_cast(unsigned, b); k[bj].z = __builtin_bit_cast(unsigned, c); k[bj].w = __builtin_bit_cast(unsigned, d); }
                u32x4 sa, sb; epi_pair_exchange(k[0], k[1], fr, sa, sb);
                *(GAS u32x4*)(S + (size_t)(rg + (fr & 7)) * 2048 + cst) = sa; *(GAS u32x4*)(S + (size_t)(rg + 8 + (fr & 7)) * 2048 + cst) = sb;
            }
    }
};
struct EpiNull {
    static constexpr bool PERM = true;
    float* sink;
    __device__ __forceinline__ void operator()(const f32x4 (&acc)[2][2][4][2], const Unit& u, int wr, int wc, int, int) const {
        float t = 0.f;
#pragma unroll
        for (int a = 0; a < 2; ++a)
#pragma unroll
            for (int b = 0; b < 2; ++b)
#pragma unroll
                for (int m = 0; m < 4; ++m) t += acc[a][b][m][0][0] + acc[a][b][m][1][3];
        if (t == 123.456f) sink[0] = t;
    }
};
}
struct Frame {
    LAS unsigned char* lds;
    int tid, lane, wave, vcu, G;
};
struct Inputs {
    const float *x, *c, *ctx, *c_ctx, *ada_w, *ada_b, *norm_mix_g, *w_in, *mla_kv_norm_g, *mla_w_ukv, *swa_sink, *na_rpb, *ret_decay_f, *ret_decay_b,
                *ret_gn_f, *ret_gn_b, *mix_beta, *w_out, *norm_ffn_g, *peer_wq, *peer_k1, *peer_k2, *peer_u, *peer_v, *final_norm_g;
};

__device__ __forceinline__ int orig_col(int c) {
    if (c < C_CKV) { const int h = c / 96, p = c % 96; if (p < 64) return c; const int pp = p - 64; return h * 96 + 64 + (pp >> 4) * 16 + (pp & 1) * 8 + ((pp & 15) >> 1); }
    if (c < C_KR) return c;
    if (c < C_SWAQ) { const int pp = c - C_KR; return C_KR + (pp >> 4) * 16 + (pp & 1) * 8 + ((pp & 15) >> 1); }
    if (c < C_SWAV) { const int q = c - C_SWAQ, hh = q >> 6, pp = q & 63; return C_SWAQ + hh * 64 + (pp >> 5) * 32 + (pp & 1) * 16 + ((pp & 31) >> 1); }
    return c;
}

template <int MAP  >
__device__ __forceinline__ void transpose_item(const float* W, int K, int Nsrc, int Nvalid, int Ndst, const float* kscale, bf16_t* WT, LAS float* scr, int item, int lane) {
    const int nblk = Ndst / 32, kb = item / nblk, nb = item % nblk, k0 = 64 * kb, n0 = 32 * nb;
    const int nd = n0 + (lane & 31);
    const int ns = (nd < Nvalid) ? (MAP ? orig_col(nd) : nd) : -1;
#pragma unroll 8
    for (int i = 0; i < 32; ++i) { const int kk = 2 * i + (lane >> 5); float v = 0.f; if (ns >= 0) { v = W[(size_t)(k0 + kk) * Nsrc + ns]; if (kscale) v *= kscale[k0 + kk]; } scr[kk * 33 + (lane & 31)] = v; }
    LDS_WAIT(); asm volatile("" ::: "memory");
    const int c = lane & 7;
#pragma unroll
    for (int j = 0; j < 4; ++j) { const int n = (lane >> 3) + 8 * j; const LAS float* s = scr + (8 * c) * 33 + n;
        u32x4 o; o.x = cvt_pk_bf16(s[0 * 33], s[1 * 33]); o.y = cvt_pk_bf16(s[2 * 33], s[3 * 33]); o.z = cvt_pk_bf16(s[4 * 33], s[5 * 33]); o.w = cvt_pk_bf16(s[6 * 33], s[7 * 33]);
        *(GAS u32x4*)(WT + (size_t)(n0 + n) * K + k0 + 8 * c) = o; }
    LDS_WAIT(); asm volatile("" ::: "memory");
}

__device__ __forceinline__ void sincos_small(float af, float& sn, float& cs) {
    const double a = (double)af; const double n = __builtin_rint(a * 0.63661977236758134308); const double r = (a - n * 1.57079632679489655800) - n * 6.123233995736766036e-17;
    const double r2 = r * r;
    const double s = r * (1.0 + r2 * (-1.0 / 6 + r2 * (1.0 / 120 + r2 * (-1.0 / 5040 + r2 * (1.0 / 362880 + r2 * (-1.0 / 39916800 + r2 * (1.0 / 6227020800.0)))))));
    const double c = 1.0 + r2 * (-0.5 + r2 * (1.0 / 24 + r2 * (-1.0 / 720 + r2 * (1.0 / 40320 + r2 * (-1.0 / 3628800 + r2 * (1.0 / 479001600 + r2 * (-1.0 / 87178291200.0)))))));
    const int q = ((int)n) & 3;
    const double ss = (q == 0) ? s : (q == 1) ? c : (q == 2) ? -s : -c;
    const double cc = (q == 0) ? c : (q == 1) ? -s : (q == 2) ? -c : s;
    sn = (float)ss; cs = (float)cc;
}

__device__ __forceinline__ void phase_prologue(Frame& F, const Inputs& I, unsigned char* ws) {
    float* MOD = (float*)(ws + WS_MOD);
    {
        LAS float* sc = (LAS float*)F.lds;
        LAS float* red = (LAS float*)(F.lds + 20480);
        for (int i = F.tid; i < 5 * DM; i += NTHR) { const float v = (i < 4 * DM) ? I.c[i] : I.c_ctx[i - 4 * DM]; sc[i] = silu_f(v); }
        __syncthreads();
        for (int task = blockIdx.x; task < NLAYER * 96; task += F.G) {
            const int l = task / 96, n = (task % 96) * 64 + F.lane;
            const float* w = I.ada_w + (size_t)l * DM * 6144 + n;
            float a0 = 0.f, a1 = 0.f, a2 = 0.f, a3 = 0.f, a4 = 0.f;
            const int kb = F.wave * 128;
            for (int k0 = kb; k0 < kb + 128; k0 += 16) {
                float wv[16];
#pragma unroll
                for (int i = 0; i < 16; ++i) wv[i] = ((const GAS float*)w)[(size_t)(k0 + i) * 6144];
#pragma unroll
                for (int i = 0; i < 16; ++i) { const int k = k0 + i; a0 += sc[k] * wv[i]; a1 += sc[DM + k] * wv[i]; a2 += sc[2 * DM + k] * wv[i]; a3 += sc[3 * DM + k] * wv[i]; a4 += sc[4 * DM + k] * wv[i]; }
            }
            LAS float* rw = red + F.wave * 320 + F.lane;
            rw[0] = a0; rw[64] = a1; rw[128] = a2; rw[192] = a3; rw[256] = a4;
            __syncthreads();
            if (F.tid < 320) { const int r = F.tid >> 6, ln = F.tid & 63; float s = 0.f;
#pragma unroll
                for (int wv = 0; wv < 8; ++wv) s += red[wv * 320 + r * 64 + ln];
                const int nn = (task % 96) * 64 + ln; MOD[(size_t)(l * 5 + r) * 6144 + nn] = s + I.ada_b[l * 6144 + nn]; }
            __syncthreads();
        }
    }
    {
        LAS float* scr = (LAS float*)(F.lds + F.wave * 16384);
        const int gw = F.vcu * NWAVES + F.wave, NGW = F.G * NWAVES;
        constexpr int I_IN = (DM / 64) * (PW / 32), I_OUT = (DM / 64) * (DM / 32), I_UKV = (128 / 64) * (KVW / 32);
        constexpr int PER_L = I_IN + I_OUT + I_UKV;
        for (int it = gw; it < NLAYER * PER_L; it += NGW) {
            const int l = it / PER_L; int r = it % PER_L;
            if (r < I_IN) { transpose_item<1>(I.w_in + (size_t)l * DM * INW, DM, INW, INW, PW, nullptr, (bf16_t*)(ws + WS_WIN) + (size_t)l * PW * DM, scr, r, F.lane); continue; } r -= I_IN;
            if (r < I_OUT) { transpose_item<0>(I.w_out + (size_t)l * DM * DM, DM, DM, DM, DM, I.mix_beta + l * DM, (bf16_t*)(ws + WS_WOUT) + (size_t)l * DM * DM, scr, r, F.lane); continue; } r -= I_OUT;
            transpose_item<0>(I.mla_w_ukv + (size_t)l * 128 * KVW, 128, KVW, KVW, KVW, I.mla_kv_norm_g + l * 128, (bf16_t*)(ws + WS_WUKV) + (size_t)l * KVW * 128, scr, r, F.lane);
        }
    }
    __syncthreads();
    {
        LAS float* wqs = (LAS float*)F.lds;
        LAS float* kps = (LAS float*)(F.lds + 32768);
        for (int task = blockIdx.x; task < NLAYER * 16 * 16; task += F.G) {
            const int l = task >> 8, hp = (task >> 4) & 15, k0 = (task & 15) * 64;
            const float* kp = ((hp & 1) ? I.peer_k2 : I.peer_k1) + (size_t)l * 128 * 128;
            for (int i = F.tid; i < 64 * 128; i += NTHR) wqs[i] = I.peer_wq[(size_t)l * DM * 2048 + (size_t)(k0 + (i >> 7)) * 2048 + hp * 128 + (i & 127)];
            for (int i = F.tid; i < 128 * 128; i += NTHR) kps[(i >> 7) * 129 + (i & 127)] = kp[i];
            __syncthreads();
            const int n = F.tid & 127, kq = F.tid >> 7;
            float a[16];
#pragma unroll
            for (int i = 0; i < 16; ++i) a[i] = 0.f;
            for (int d = 0; d < 128; d += 4) {
                const float kv0 = kps[n * 129 + d], kv1 = kps[n * 129 + d + 1], kv2 = kps[n * 129 + d + 2], kv3 = kps[n * 129 + d + 3];
#pragma unroll
                for (int i = 0; i < 16; ++i) { const f32x4 w4 = *(const LAS f32x4*)(wqs + (kq * 16 + i) * 128 + d);
                    a[i] += w4[0] * kv0; a[i] += w4[1] * kv1; a[i] += w4[2] * kv2; a[i] += w4[3] * kv3; } }
            bf16_t* o = (bf16_t*)(ws + WS_WSC) + (size_t)l * 2048 * DM + (size_t)(hp * 128 + n) * DM + k0 + kq * 16;
            u32x4 w0, w1; w0.x = cvt_pk_bf16(a[0], a[1]); w0.y = cvt_pk_bf16(a[2], a[3]); w0.z = cvt_pk_bf16(a[4], a[5]); w0.w = cvt_pk_bf16(a[6], a[7]);
            w1.x = cvt_pk_bf16(a[8], a[9]); w1.y = cvt_pk_bf16(a[10], a[11]); w1.z = cvt_pk_bf16(a[12], a[13]); w1.w = cvt_pk_bf16(a[14], a[15]);
            *(GAS u32x4*)o = w0; *(GAS u32x4*)(o + 8) = w1;
            __syncthreads();
        }
    }
    {
        const int gt = blockIdx.x * NTHR + F.tid;
        if (gt < 128 * 16 + 128 * 8) {
            const bool big = gt < 2048; const int e = big ? gt : gt - 2048; const int q = big ? 16 : 8; const int pos = e / q, j = e % q;
            const float inv = (float)exp2(-(double)j / (double)q * 13.287712379549449);
            const float ang = (float)pos * inv; float sn, cs; sincos_small(ang, sn, cs);
            f32x2* tab = (f32x2*)(ws + WS_TAB + (big ? 0 : 16384));
            tab[e] = (f32x2){cs, sn};
        }
    }
}

__device__ __forceinline__ unsigned pack_i8(const f32x4 y) {
    const int q0 = __float2int_rn(fminf(fmaxf(y[0], -127.f), 127.f)), q1 = __float2int_rn(fminf(fmaxf(y[1], -127.f), 127.f)), q2 = __float2int_rn(fminf(fmaxf(y[2], -127.f), 127.f)), q3 = __float2int_rn(fminf(fmaxf(y[3], -127.f), 127.f));
    return ((unsigned)q0 & 0xFFu) | (((unsigned)q1 & 0xFFu) << 8) | (((unsigned)q2 & 0xFFu) << 16) | ((unsigned)q3 << 24);
}
__device__ __forceinline__ void phase_convert_uv(Frame& F, const float* u, const float* v, unsigned char* ws) {
    const size_t nblk = (size_t)NEXP * DM / 1024;
    const int gw = F.vcu * NWAVES + F.wave, NGW = F.G * NWAVES, lane = F.lane;
    for (size_t i = gw; i < 2 * nblk; i += NGW) {
        const bool second = i >= nblk; const size_t j = second ? i - nblk : i; const float sc = second ? 4.0f : 896.0f;
        const GAS f32x4* s = (const GAS f32x4*)(second ? v : u) + j * 256 + lane;
        GAS unsigned* d = (GAS unsigned*)(ws + (second ? WS_VB : WS_UB)) + (size_t)(lane >> 5) * ((size_t)NEXP * 32) + j * 32 + (lane & 31);
        f32x4 a[4];
#pragma unroll
        for (int q = 0; q < 4; ++q) a[q] = s[64 * q] * sc;
#pragma unroll
        for (int q = 0; q < 4; ++q) d[(size_t)q * ((size_t)NEXP * 64)] = second ? (unsigned)__builtin_amdgcn_cvt_pk_bf8_f32(a[q][1], a[q][3], __builtin_amdgcn_cvt_pk_bf8_f32(a[q][0], a[q][2], 0, false), true) : pack_i8(a[q]);
    }
}

template <bool Q8 = false>
__device__ __forceinline__ void phase_norm_mod(Frame& F, const float* xl, const bf16_t* xb, const float* xc, const float* gain, const float* mod  , int chunk, bf16_t* XN, bool skipctx, float* ssq_zero, unsigned char* XQ = nullptr, float* XSC = nullptr) {
    const int gw = F.vcu * NWAVES + F.wave, NGW = F.G * NWAVES;
    (void)ssq_zero;
    for (int gi = gw; gi < NROW / 4; gi += NGW) {
        const int r0 = 4 * gi, b = r0 / NB, j0 = r0 % NB;
        const bool isctx = j0 < CTXL;
        if (skipctx && isctx) continue;
        const float* mv = mod + (isctx ? 4 : b) * 6144 + chunk * DM;
        f32x4 v[4][4]; float s[4];
        if (!isctx && xl == nullptr) {
            const GAS u32x2* x2 = (const GAS u32x2*)(xb + ((size_t)b * SEQ + (j0 - CTXL)) * DM) + F.lane;
            u32x2 w[4][4];
#pragma unroll
            for (int i = 0; i < 4; ++i)
#pragma unroll
                for (int q = 0; q < 4; ++q) w[i][q] = x2[i * (DM / 4) + 64 * q];
#pragma unroll
            for (int i = 0; i < 4; ++i)
#pragma unroll
                for (int q = 0; q < 4; ++q) v[i][q] = (f32x4){bf_lo(w[i][q].x), bf_hi(w[i][q].x), bf_lo(w[i][q].y), bf_hi(w[i][q].y)};
        } else {
            const float* xr = isctx ? xc + ((size_t)b * CTXL + j0) * DM : xl + ((size_t)b * SEQ + (j0 - CTXL)) * DM;
            const GAS f32x4* x4 = (const GAS f32x4*)xr + F.lane;
#pragma unroll
            for (int i = 0; i < 4; ++i)
#pragma unroll
                for (int q = 0; q < 4; ++q) v[i][q] = x4[i * (DM / 4) + 64 * q];
        }
#pragma unroll
        for (int i = 0; i < 4; ++i) { float a = 0.f;
#pragma unroll
            for (int q = 0; q < 4; ++q) a += (v[i][q][0] * v[i][q][0] + v[i][q][1] * v[i][q][1]) + (v[i][q][2] * v[i][q][2] + v[i][q][3] * v[i][q][3]);
            s[i] = a; }
#pragma unroll
        for (int i = 0; i < 4; ++i) s[i] = 1.0f / sqrtf(wave_sum(s[i]) * (1.f / DM) + EPS);
#pragma unroll
        for (int q = 0; q < 4; ++q) {
            const int c = 4 * F.lane + 256 * q;
            const f32x4 g = *(const GAS f32x4*)(gain + c), sh = *(const GAS f32x4*)(mv + c), sc = *(const GAS f32x4*)(mv + DM + c);
            const f32x4 gs = g * (sc + 1.0f);
#pragma unroll
            for (int i = 0; i < 4; ++i) {
                const f32x4 y = (v[i][q] * s[i]) * gs + sh;
                u32x2 w; w.x = cvt_pk_bf16(y[0], y[1]); w.y = cvt_pk_bf16(y[2], y[3]);
                ((GAS u32x2*)(XN + (size_t)(r0 + i) * DM) + F.lane)[64 * q] = w;
                if (Q8) v[i][q] = y;
            }
        }
        if (Q8) {
#pragma unroll
            for (int i = 0; i < 4; ++i) { float m = 0.f;
#pragma unroll
                for (int q = 0; q < 4; ++q) m = fmaxf(fmaxf(m, fmaxf(fabsf(v[i][q][0]), fabsf(v[i][q][1]))), fmaxf(fabsf(v[i][q][2]), fabsf(v[i][q][3])));
                m = fmaxf(m, xshfl<1>(m)); m = fmaxf(m, xshfl<2>(m)); m = fmaxf(m, xshfl<4>(m)); m = fmaxf(m, xshfl<8>(m)); m = fmaxf(m, xshfl<16>(m)); m = fmaxf(xmax32(m), 1e-20f);
                const float qs = 127.0f / m;
#pragma unroll
                for (int q = 0; q < 4; ++q) ((GAS unsigned*)(XQ + (size_t)(r0 + i) * DM) + F.lane)[64 * q] = pack_i8(v[i][q] * qs);
                if (F.lane == 0) ((GAS float*)XSC)[(size_t)(r0 + i) * 4] = m * (1.0f / 127.0f);
            }
        }
    }
}

__device__ __forceinline__ void phase_final_norm(Frame& F, const bf16_t* xb, float* out, const float* gain, float dsc) {
    const int gw = F.vcu * NWAVES + F.wave, NGW = F.G * NWAVES;
    for (int gi = gw; gi < NBATCH * SEQ / 4; gi += NGW) {
        const int r0 = 4 * gi;
        const GAS u32x2* x2 = (const GAS u32x2*)(xb + (size_t)r0 * DM) + F.lane;
        u32x2 w[4][4];
#pragma unroll
        for (int i = 0; i < 4; ++i)
#pragma unroll
            for (int q = 0; q < 4; ++q) w[i][q] = x2[i * (DM / 4) + 64 * q];
        f32x4 v[4][4]; float s[4];
#pragma unroll
        for (int i = 0; i < 4; ++i) { float a = 0.f;
#pragma unroll
            for (int q = 0; q < 4; ++q) { v[i][q] = (f32x4){bf_lo(w[i][q].x), bf_hi(w[i][q].x), bf_lo(w[i][q].y), bf_hi(w[i][q].y)}; a += (v[i][q][0] * v[i][q][0] + v[i][q][1] * v[i][q][1]) + (v[i][q][2] * v[i][q][2] + v[i][q][3] * v[i][q][3]); }
            s[i] = a; }
#pragma unroll
        for (int i = 0; i < 4; ++i) s[i] = dsc / sqrtf(wave_sum(s[i]) * (1.f / DM) + EPS);
#pragma unroll
        for (int q = 0; q < 4; ++q) { const f32x4 g = *(const GAS f32x4*)(gain + 4 * F.lane + 256 * q);
#pragma unroll
            for (int i = 0; i < 4; ++i) ((GAS f32x4*)(out + (size_t)(r0 + i) * DM) + F.lane)[64 * q] = (v[i][q] * s[i]) * g; }
    }
}
__device__ __forceinline__ int crow(int r, int hi) { return (r & 3) + 8 * (r >> 2) + 4 * hi; }
constexpr int VS = 68;
enum { AT_MLA = 0, AT_SWA = 1, AT_NA = 2 };
#ifndef ATT_THR
#define ATT_THR 8.0f
#endif
#ifndef SC_MLA
#define SC_MLA 1.0f
#endif
#ifndef SC_SWA
#define SC_SWA 1.0f
#endif
#ifndef SC_NA
#define SC_NA 1.0f
#endif
#ifndef SKIP_ATT
#define SKIP_ATT 0
#endif
struct AttnArgs { const bf16_t* P; const bf16_t* KV; bf16_t* Y; const float* sink; const float* rpb; };

#ifndef ABL
#define ABL 0
#endif
template <int KIND, bool CTXQ, bool DUMMY = false>
__device__ __forceinline__ void attn_unit(Frame& F, const AttnArgs& A, int unit) {
    constexpr int AB = DUMMY ? ABL : 0;
    constexpr int DQK = (KIND == AT_MLA) ? 96 : 64, KS = DQK + 8, NP = DQK / 8, NS = DQK / 16;
    constexpr int KT_BYTES = 64 * KS * 2, VT_BYTES = 8192;
    LAS unsigned char* lds = F.lds;
    LAS unsigned char* Vt[2] = {lds + 3 * KT_BYTES, lds + 3 * KT_BYTES + VT_BYTES};
    LAS float* rpbl = (LAS float*)(lds + 3 * KT_BYTES + 2 * VT_BYTES);
    int lane = lane_id(); asm volatile("" : "+v"(lane));
    const int w = F.wave, tid = w * 64 + lane, r32 = lane & 31, hi = lane >> 5;

    int b, h = 0, g = 0, n = 0;
    if (KIND == AT_MLA) { if (CTXQ) { b = unit >> 2; h = unit & 3; } else { b = unit >> 7; h = (unit >> 5) & 3; n = unit & 31; } }
    else if (KIND == AT_SWA) { if (CTXQ) { b = unit >> 2; g = (unit >> 1) & 1; n = unit & 1; } else { b = unit >> 7; g = (unit >> 6) & 1; n = unit & 63; } }
    else { if (CTXQ) { b = unit >> 2; h = unit & 3; } else { b = unit >> 7; h = (unit >> 5) & 3; n = unit & 31; } }
    const size_t rb = (size_t)b * NB;

    int qj;
    int hq = h, qpos = 0, qrow = 0, qcol = 0;
    if (KIND == AT_MLA) qj = CTXQ ? (32 * w + r32) : (CTXL + 256 * n + 32 * w + r32);
    else if (KIND == AT_SWA) { hq = 2 * g + (w >> 2); qpos = 128 * n + 32 * (w & 3) + r32; qj = CTXQ ? qpos : CTXL + qpos; }
    else { if (CTXQ) qj = 32 * w + r32; else { qrow = 4 * n + (w >> 1); qcol = 32 * (w & 1) + r32; qj = CTXL + qrow * 64 + qcol; } }
    const int qcolbase = (KIND == AT_MLA) ? (C_MLAQ + hq * 96) : (KIND == AT_SWA) ? (C_SWAQ + hq * 64) : (C_NAQ + hq * 64);
    const bf16_t* qp = A.P + (rb + qj) * PW + qcolbase;
    bf16x8 qr[NS];
#pragma unroll
    for (int s = 0; s < NS; ++s) qr[s] = *(const GAS bf16x8*)(qp + 16 * s + 8 * hi);

    int nt = 4, band_lo = 0;
    if (!CTXQ) {
        if (KIND == AT_MLA) nt = 132;
        else if (KIND == AT_SWA) { band_lo = (n == 0) ? 2 : 0; const int band_hi = (n == 63) ? 4 : 6; nt = 4 + band_hi - band_lo; }
        else { int lo = 4 * n - 4; lo = lo < 0 ? 0 : (lo > 120 ? 120 : lo); int hi2 = 4 * n + 3 - 4; hi2 = hi2 < 0 ? 0 : (hi2 > 120 ? 120 : hi2); band_lo = lo; nt = 4 + (hi2 + 7 - lo + 1); }
    }
    auto tile_j0 = [&](int t) -> int {
        if (t < 4) return 64 * t;
        if (KIND == AT_MLA) return 64 * t;
        if (KIND == AT_SWA) return CTXL + 128 * (n - 1) + 64 * (band_lo + t - 4);
        return CTXL + 64 * (band_lo + t - 4);
    };
    int na_rs = 0, na_cs = 0;
    if (KIND == AT_NA && !CTXQ) { na_rs = qrow - 4; na_rs = na_rs < 0 ? 0 : (na_rs > 120 ? 120 : na_rs); na_cs = qcol - 8; na_cs = na_cs < 0 ? 0 : (na_cs > 48 ? 48 : na_cs); }

    const int vkey = (lane & 15) + 16 * (w & 3), vdp = 4 * (w >> 2) + (lane >> 4);
    const int kcolbase = (KIND == AT_SWA) ? (C_SWAK + g * 64) : (C_NAK + h * 64);
    const int vcolbase = (KIND == AT_SWA) ? (C_SWAV + g * 64) : (C_NAV + h * 64);
    constexpr int KPITCH0 = (KIND == AT_MLA) ? KVW : PW, VPITCH = (KIND == AT_MLA) ? KVW : PW;
    const GAS char* kbase0 = (KIND == AT_MLA) ? (const GAS char*)(A.KV + rb * KVW + h * 128) : (const GAS char*)(A.P + rb * PW + kcolbase);
    const GAS char* kbase1 = (const GAS char*)(A.P + rb * PW + C_KR);
    const GAS char* vbase = (KIND == AT_MLA) ? (const GAS char*)(A.KV + rb * KVW + h * 128 + 64) : (const GAS char*)(A.P + rb * PW + vcolbase);
    const unsigned koff0 = (unsigned)((tid >> 3) * KPITCH0 + (tid & 7) * 8) * 2u, koff1 = (unsigned)((tid >> 2) * PW + (tid & 3) * 8) * 2u, voff = (unsigned)(vkey * VPITCH + vdp * 8) * 2u;
    const bool has_k1 = (DQK == 96) && tid < 256;
    const unsigned kl0 = (unsigned)((tid >> 3) * (KS * 2) + (tid & 7) * 16), kl1 = (unsigned)((tid >> 2) * (KS * 2) + 128 + (tid & 3) * 16);
    struct Stage { u32x4 k0, k1, v; };
    auto gloadK = [&](Stage& R, int t) { const int j0 = tile_j0(t); R.k0 = *(const GAS u32x4*)(kbase0 + (size_t)j0 * (KPITCH0 * 2) + koff0); if (has_k1) R.k1 = *(const GAS u32x4*)(kbase1 + (size_t)j0 * (PW * 2) + koff1); };
    auto gloadV = [&](Stage& R, int t) { R.v = *(const GAS u32x4*)(vbase + (size_t)tile_j0(t) * (VPITCH * 2) + voff); };
    auto lstoreK = [&](const Stage& R, int kofs) { *(LAS u32x4*)(lds + kofs + kl0) = R.k0; if (has_k1) *(LAS u32x4*)(lds + kofs + kl1) = R.k1; };
    const unsigned vlo = (unsigned)((w >> 2) * 4096 + (w & 3) * 1024 + (lane & 15) * 64 + (lane >> 4) * 16);
    auto lstoreV = [&](const Stage& R, int buf) { *(LAS u32x4*)(Vt[buf] + vlo) = R.v; };
    struct KF { bf16x8 f[NS]; };
    auto kread = [&](KF& K, int kofs, int hf) {
        const LAS unsigned char* kb = lds + kofs + (32 * hf + r32) * (KS * 2) + hi * 16;
#pragma unroll
        for (int q = 0; q < NS; ++q) K.f[q] = *(const LAS bf16x8*)(kb + q * 32);
    };
    auto qkh = [&](const KF& K, const f32x16& negm, f32x16& p) {
        p = __builtin_amdgcn_mfma_f32_32x32x16_bf16(K.f[0], qr[0], negm, 0, 0, 0);
#pragma unroll
        for (int q = 1; q < NS; ++q) p = __builtin_amdgcn_mfma_f32_32x32x16_bf16(K.f[q], qr[q], p, 0, 0, 0);
    };
    struct VF { u32x2 l0[2], h0[2], l1[2], h1[2]; };
    typedef short v4i16_t __attribute__((ext_vector_type(4)));
    const unsigned vro = (unsigned)(((lane >> 4) & 1) * 32 + (lane & 3) * 8 + (4 * hi + ((lane & 15) >> 2)) * 64);
    auto vtr = [&](const LAS unsigned char* p) { return __builtin_bit_cast(u32x2, __builtin_amdgcn_ds_read_tr16_b64_v4i16((LAS v4i16_t*)p)); };
    auto vread = [&](VF& V, int buf, int hf) {
        const LAS unsigned char* vb = Vt[buf] + vro + hf * 2048;
#pragma unroll
        for (int q = 0; q < 2; ++q) { V.l0[q] = vtr(vb + q * 1024); V.h0[q] = vtr(vb + q * 1024 + 512);
            V.l1[q] = vtr(vb + 4096 + q * 1024); V.h1[q] = vtr(vb + 4096 + q * 1024 + 512); }
    };
    auto mask_half = [&](int t, int hf, f32x16& p) {
        if (CTXQ) return;
        if (KIND == AT_SWA) {
            const bool band = t >= 4;
            int db = band ? (128 * (n - 1) + 64 * (band_lo + t - 4) + 32 * hf + 4 * hi - qpos) : 0;
            asm volatile("" : "+v"(db));
#pragma unroll
            for (int r = 0; r < 16; ++r) { const int c = (r & 3) + 8 * (r >> 2); if (band && (db > 128 - c || db < -128 - c)) p[r] = -1.0e30f; }
        } else if (KIND == AT_NA) {
            const bool band = t >= 4;
            const int krow = band_lo + t - 4;
            const bool rowok = !band || (krow >= na_rs && krow < na_rs + 8);
            const int dr = band ? (krow - qrow + 7) : 0;
            int e = 4 * hi + 32 * hf - na_cs;
            const LAS float* brow = rpbl + (dr < 0 ? 0 : (dr > 14 ? 14 : dr)) * 32 + (15 - qcol + 4 * hi + 32 * hf);
            asm volatile("" : "+v"(e));
#pragma unroll
            for (int r = 0; r < 16; ++r) { const int c = (r & 3) + 8 * (r >> 2);
                const bool v0 = rowok && (!band || (unsigned)(e + c) < 16u);
                const float b0 = (band && v0) ? brow[c] : 0.f;
                p[r] = v0 ? p[r] + b0 : -1.0e30f; }
        }
    };

    if (KIND == AT_NA && !CTXQ) { for (int i = tid; i < 15 * 32; i += NTHR) { const int dr = i >> 5, dc = i & 31; rpbl[i] = (dc < 31) ? ((const GAS float*)A.rpb)[(h * 15 + dr) * 31 + dc] * LOG2E : 0.f; } }

    nt = __builtin_amdgcn_readfirstlane(nt); asm volatile("" : "+s"(nt));
    Stage RA, RB;
    RA.k1 = (u32x4){0u, 0u, 0u, 0u}; RB.k1 = RA.k1;
    gloadK(RA, 0); gloadV(RA, 0); gloadK(RB, nt > 1 ? 1 : 0);
    lstoreK(RA, 0); lstoreV(RA, 0); lstoreK(RB, KT_BYTES);
    int kA = 0, kB = KT_BYTES, kC = 2 * KT_BYTES;
    gloadK(RB, nt > 2 ? 2 : nt - 1); gloadV(RB, nt > 1 ? 1 : nt - 1);
    __syncthreads();
    float m_ref, l_run = 0.f;
    f32x16 o0, o1, pa, pb, negm;
#pragma unroll
    for (int r = 0; r < 16; ++r) { o0[r] = 0.f; o1[r] = 0.f; negm[r] = 0.f; }
    { f32x16& pc = pa; KF K0; kread(K0, 0, 0); qkh(K0, negm, pc); mask_half(0, 0, pc);
      float mx = pc[0];
#pragma unroll
      for (int r = 1; r < 16; ++r) mx = fmaxf(mx, pc[r]);
      mx = xmax32(mx); m_ref = mx;
#pragma unroll
      for (int r = 0; r < 16; ++r) { pc[r] -= mx; negm[r] = -mx; } }
#define ATT_HALF(t, hf, tn, hn, kbuf, pc, pn) do { \
        KF Kn; VF Vc; \
        kread(Kn, (kbuf), (hn)); vread(Vc, (t) & 1, (hf)); \
        qkh(Kn, negm, pn); \
        float rsum = 0.f; \
        _Pragma("unroll") for (int r = 0; r < 16; ++r) { if (!(AB & 1)) pc[r] = fexp2(pc[r]); rsum += pc[r]; } \
        l_run += rsum; \
        mask_half((tn), (hn), pn); \
        float mx = fmaxf(pn[0], pn[1]); \
        _Pragma("unroll") for (int r = 2; r < 16; ++r) mx = fmaxf(mx, pn[r]); \
        mx = xmax32(mx); \
        if (__builtin_expect(((tn) < nt) && __any(mx > ATT_THR), 0)) { \
            const float d = fmaxf(mx, 0.f), al = fexp2(-d); \
            m_ref += d; l_run *= al; \
            _Pragma("unroll") for (int r = 0; r < 16; ++r) { pn[r] -= d; o0[r] *= al; o1[r] *= al; pc[r] *= al; negm[r] = -m_ref; } \
        } \
        const bf16x8 pf0 = __builtin_bit_cast(bf16x8, (u32x4){cvt_pk_bf16(pc[0], pc[1]), cvt_pk_bf16(pc[2], pc[3]), cvt_pk_bf16(pc[4], pc[5]), cvt_pk_bf16(pc[6], pc[7])}); \
        const bf16x8 pf1 = __builtin_bit_cast(bf16x8, (u32x4){cvt_pk_bf16(pc[8], pc[9]), cvt_pk_bf16(pc[10], pc[11]), cvt_pk_bf16(pc[12], pc[13]), cvt_pk_bf16(pc[14], pc[15])}); \
        o0 = __builtin_amdgcn_mfma_f32_32x32x16_bf16(__builtin_bit_cast(bf16x8, (u32x4){Vc.l0[0].x, Vc.l0[0].y, Vc.h0[0].x, Vc.h0[0].y}), pf0, o0, 0, 0, 0); \
        o1 = __builtin_amdgcn_mfma_f32_32x32x16_bf16(__builtin_bit_cast(bf16x8, (u32x4){Vc.l1[0].x, Vc.l1[0].y, Vc.h1[0].x, Vc.h1[0].y}), pf0, o1, 0, 0, 0); \
        o0 = __builtin_amdgcn_mfma_f32_32x32x16_bf16(__builtin_bit_cast(bf16x8, (u32x4){Vc.l0[1].x, Vc.l0[1].y, Vc.h0[1].x, Vc.h0[1].y}), pf1, o0, 0, 0, 0); \
        o1 = __builtin_amdgcn_mfma_f32_32x32x16_bf16(__builtin_bit_cast(bf16x8, (u32x4){Vc.l1[1].x, Vc.l1[1].y, Vc.h1[1].x, Vc.h1[1].y}), pf1, o1, 0, 0, 0); \
    } while (0)
#define ATT_STEP(t, RL, RS) do { \
        if (!(AB & 32)) { const int tk_ = ((t) + 3 < nt) ? (t) + 3 : nt - 1, tv_ = ((t) + 2 < nt) ? (t) + 2 : nt - 1; gloadK(RL, tk_); gloadV(RL, tv_); } \
        ATT_HALF(t, 0, t, 1, kA, pa, pb); \
        ATT_HALF(t, 1, (t) + 1, 0, kB, pb, pa); \
        if (!(AB & 64)) lstoreK(RS, kC); if (!(AB & 8)) lstoreV(RS, ((t) + 1) & 1); \
        { const int k_ = kA; kA = kB; kB = kC; kC = k_; } \
        if (!(AB & 16)) __syncthreads(); \
    } while (0)
#pragma nounroll
    for (int t = 0; t < nt; t += 2) {
        ATT_STEP(t, RA, RB);
        if (t + 1 < nt) ATT_STEP(t + 1, RB, RA);
    }
#undef ATT_STEP
#undef ATT_HALF
    const float m_run = m_ref;
    float l_tot = xsum32(l_run);
    if (KIND == AT_SWA) l_tot += fexp2(((const GAS float*)A.sink)[hq] * LOG2E - m_run);
    const float rl = ((KIND == AT_MLA) ? SC_MLA : (KIND == AT_SWA) ? SC_SWA : SC_NA) / l_tot;
    const int ycol = (KIND == AT_MLA) ? (hq * 64) : (KIND == AT_SWA) ? (256 + hq * 64) : (512 + hq * 64);
    LAS unsigned char* ost = lds + 3 * KT_BYTES + 2 * VT_BYTES + 2048 + w * 4608;
#pragma unroll
    for (int q4 = 0; q4 < 4; ++q4) {
        u32x2 w0, w1;
        w0.x = cvt_pk_bf16(o0[4 * q4] * rl, o0[4 * q4 + 1] * rl); w0.y = cvt_pk_bf16(o0[4 * q4 + 2] * rl, o0[4 * q4 + 3] * rl);
        w1.x = cvt_pk_bf16(o1[4 * q4] * rl, o1[4 * q4 + 1] * rl); w1.y = cvt_pk_bf16(o1[4 * q4 + 2] * rl, o1[4 * q4 + 3] * rl);
        *(LAS u32x2*)(ost + r32 * 144 + (4 * hi + 8 * q4) * 2) = w0; *(LAS u32x2*)(ost + r32 * 144 + (32 + 4 * hi + 8 * q4) * 2) = w1;
    }
    LDS_WAIT(); asm volatile("" ::: "memory");
    const int qj0 = __builtin_amdgcn_readfirstlane(qj);
#pragma unroll
    for (int i = 0; i < 4; ++i) { const int rr = 8 * i + (lane >> 3), ch = lane & 7;
        *(GAS u32x4*)(A.Y + (rb + qj0 + rr) * DM + ycol + 8 * ch) = *(const LAS u32x4*)(ost + rr * 144 + 16 * ch); }
    LDS_WAIT(); asm volatile("" ::: "memory");
}
constexpr int RVS = 132;
struct RetArgs { const bf16_t* P; bf16_t* Y; float* RS; const float* decay_f; const float* decay_b; const float* gn_f; const float* gn_b; };
__device__ __forceinline__ float log2_sigmoid(float d) { return -log2f(1.0f + expf(-d)); }

struct RStage { u32x4 k[2], v[2]; };
__device__ __forceinline__ void ret_stage_load(RStage& S, const bf16_t* P, int unit, int tid) {
    const int c = unit % 66, bh = unit / 66, b = bh >> 2, h = bh & 3;
    const size_t row0 = (size_t)b * NB + 128 * c;
#pragma unroll
    for (int j = 0; j < 2; ++j) {
        const int q = tid + 512 * j, tok = q >> 3, dp = q & 7;
        const bf16_t* pr = P + (row0 + tok) * PW + h * 64 + dp * 8;
        S.k[j] = *(const GAS u32x4*)(pr + C_RK); S.v[j] = *(const GAS u32x4*)(pr + C_RV);
    }
}
__device__ __forceinline__ void ret_local_loop(Frame& F, const RetArgs& A, int u0, int ustep, int nunits) {
    int lane = lane_id(); asm volatile("" : "+v"(lane));
    const int w = F.wave, tid = w * 64 + lane, r32 = lane & 31, hi = lane >> 5;
    LAS bf16_t* Ktt = (LAS bf16_t*)F.lds;
    LAS bf16_t* Vtf = Ktt + 64 * RVS;
    LAS bf16_t* Vtb = Vtf + 64 * RVS;
    RStage S;
    int unit = u0;
    if (unit < nunits) ret_stage_load(S, A.P, unit, tid);
    while (unit < nunits) {
        const int c = unit % 66, bh = unit / 66, h = bh & 3;
        const float lgf = log2_sigmoid(((const GAS float*)A.decay_f)[h]), lgb = log2_sigmoid(((const GAS float*)A.decay_b)[h]);
#pragma unroll
        for (int j = 0; j < 2; ++j) {
            const int q = tid + 512 * j, tok = q >> 3, dp = q & 7;
            const float wf = fexp2(lgf * (float)(127 - tok)), wb = fexp2(lgb * (float)tok);
            LAS bf16_t* kt = Ktt + (8 * dp) * RVS + tok; LAS bf16_t* vf = Vtf + (8 * dp) * RVS + tok; LAS bf16_t* vb = Vtb + (8 * dp) * RVS + tok;
            const unsigned kw[4] = {S.k[j].x, S.k[j].y, S.k[j].z, S.k[j].w}, vw[4] = {S.v[j].x, S.v[j].y, S.v[j].z, S.v[j].w};
#pragma unroll
            for (int e = 0; e < 4; ++e) {
                kt[(2 * e) * RVS] = (bf16_t)(kw[e] & 0xffffu); kt[(2 * e + 1) * RVS] = (bf16_t)(kw[e] >> 16);
                const float v0 = bf_lo(vw[e]), v1 = bf_hi(vw[e]);
                const unsigned pf = cvt_pk_bf16(v0 * wf, v1 * wf), pb = cvt_pk_bf16(v0 * wb, v1 * wb);
                vf[(2 * e) * RVS] = (bf16_t)(pf & 0xffffu); vf[(2 * e + 1) * RVS] = (bf16_t)(pf >> 16);
                vb[(2 * e) * RVS] = (bf16_t)(pb & 0xffffu); vb[(2 * e + 1) * RVS] = (bf16_t)(pb >> 16);
            }
        }
        const int unext = unit + ustep;
        if (unext < nunits) ret_stage_load(S, A.P, unext, tid);
        __syncthreads();
        const int dir = w >> 2, dvb = (w >> 1) & 1, dkb = w & 1;
        const LAS bf16_t* va = (dir ? Vtb : Vtf) + (32 * dvb + r32) * RVS + 8 * hi;
        const LAS bf16_t* kb = Ktt + (32 * dkb + r32) * RVS + 8 * hi;
        f32x16 acc;
#pragma unroll
        for (int r = 0; r < 16; ++r) acc[r] = 0.f;
#pragma unroll
        for (int s = 0; s < 8; ++s) {
            const u32x2 a0 = *(const LAS u32x2*)(va + 16 * s), a1 = *(const LAS u32x2*)(va + 16 * s + 4);
            const u32x2 b0 = *(const LAS u32x2*)(kb + 16 * s), b1 = *(const LAS u32x2*)(kb + 16 * s + 4);
            acc = __builtin_amdgcn_mfma_f32_32x32x16_bf16(__builtin_bit_cast(bf16x8, (u32x4){a0.x, a0.y, a1.x, a1.y}), __builtin_bit_cast(bf16x8, (u32x4){b0.x, b0.y, b1.x, b1.y}), acc, 0, 0, 0);
        }
        GAS float* out = (GAS float*)A.RS + ((size_t)(bh * 2 + dir) * 66 + c) * 4096 + 32 * dkb + r32;
#pragma unroll
        for (int r = 0; r < 16; ++r) out[(32 * dvb + crow(r, hi)) * 64] = acc[r];
        __syncthreads();
        unit = unext;
    }
}

__device__ __forceinline__ void ret_scan(Frame& F, const RetArgs& A) {
    for (int e = blockIdx.x * NTHR + F.tid; e < 32 * 4096; e += F.G * NTHR) {
        const int seq = e >> 12, el = e & 4095, dir = seq & 1, h = (seq >> 1) & 3;
        const float a = fexp2(128.0f * log2_sigmoid(dir ? ((const GAS float*)A.decay_b)[h] : ((const GAS float*)A.decay_f)[h]));
        GAS float* base = (GAS float*)A.RS + (size_t)seq * 66 * 4096 + el;
        float s = 0.f;
#pragma nounroll
        for (int n0 = 0; n0 < 66; n0 += 11) {
            int nb = n0; asm volatile("" : "+s"(nb));
            float u[11];
#pragma unroll
            for (int i = 0; i < 11; ++i) { const int n = nb + i; const int c = dir ? ((n < 2) ? 1 - n : 67 - n) : n; u[i] = base[(size_t)c * 4096]; }
#pragma unroll
            for (int i = 0; i < 11; ++i) { const int n = nb + i; const int c = dir ? ((n < 2) ? 1 - n : 67 - n) : n; base[(size_t)c * 4096] = s; s = a * s + u[i]; }
        }
    }
}

struct RStage3 { u32x4 k[2], v[2], q[2]; f32x4 st[4]; };
__device__ __forceinline__ void ret_stage_load3(RStage3& S, const bf16_t* P, const float* RS, int unit, int tid) {
    const int c = unit % 66, bh = unit / 66, b = bh >> 2, h = bh & 3;
    const size_t row0 = (size_t)b * NB + 128 * c;
#pragma unroll
    for (int j = 0; j < 2; ++j) {
        const int q = tid + 512 * j, tok = q >> 3, dp = q & 7;
        const bf16_t* pr = P + (row0 + tok) * PW + h * 64 + dp * 8;
        S.k[j] = *(const GAS u32x4*)(pr + C_RK); S.v[j] = *(const GAS u32x4*)(pr + C_RV); S.q[j] = *(const GAS u32x4*)(pr + C_RQ);
    }
#pragma unroll
    for (int k = 0; k < 4; ++k) S.st[k] = ((const GAS f32x4*)(RS + ((size_t)(bh * 2 + (k >> 1)) * 66 + c) * 4096))[tid + 512 * (k & 1)];
}
__device__ __forceinline__ void ret_out_loop(Frame& F, const RetArgs& A, int u0, int ustep, int nunits, bool skipctx) {
    int lane = lane_id(); asm volatile("" : "+v"(lane));
    const int w = F.wave, tid = w * 64 + lane, r32 = lane & 31, hi = lane >> 5;
    constexpr int KS = 72;
    LAS unsigned char* Kc = F.lds;
    LAS bf16_t* Vt = (LAS bf16_t*)(F.lds + 128 * KS * 2);
    LAS float* comb = (LAS float*)(F.lds + 128 * KS * 2 + 64 * RVS * 2);
    auto nextu = [&](int u) { u += ustep; while (skipctx && u < nunits && (u % 66) < 2) u += ustep; return u; };
    int unit = u0; while (skipctx && unit < nunits && (unit % 66) < 2) unit += ustep;
    LAS float* Sst = comb + 128 * 65;
    LAS unsigned char* Qc = (LAS unsigned char*)(Sst + 2 * 64 * 68);
    RStage3 S;
    if (unit < nunits) ret_stage_load3(S, A.P, A.RS, unit, tid);
    LAS float* gnl = (LAS float*)(F.lds + 122880);
    gnl[tid] = (tid < 256) ? ((const GAS float*)A.gn_f)[tid] : ((const GAS float*)A.gn_b)[tid - 256];
    __syncthreads();
    while (unit < nunits) {
    const int c = unit % 66, bh = unit / 66, b = bh >> 2, h = bh & 3;
    const size_t row0 = (size_t)b * NB + 128 * c;
    const int dir = w >> 2, qg = w & 3, qi = 32 * qg + r32;
    const bf16_t* prow = A.P + (row0 + qi) * PW;
#pragma unroll
    for (int j = 0; j < 2; ++j) {
        const int q = tid + 512 * j, tok = q >> 3, dp = q & 7;
        *(LAS u32x4*)(Kc + tok * (KS * 2) + dp * 16) = S.k[j];
        *(LAS u32x4*)(Qc + tok * (KS * 2) + dp * 16) = S.q[j];
        const u32x4 vv = S.v[j];
        LAS bf16_t* vt = Vt + (8 * dp) * RVS + tok;
        vt[0 * RVS] = (bf16_t)(vv.x & 0xffffu); vt[1 * RVS] = (bf16_t)(vv.x >> 16); vt[2 * RVS] = (bf16_t)(vv.y & 0xffffu); vt[3 * RVS] = (bf16_t)(vv.y >> 16);
        vt[4 * RVS] = (bf16_t)(vv.z & 0xffffu); vt[5 * RVS] = (bf16_t)(vv.z >> 16); vt[6 * RVS] = (bf16_t)(vv.w & 0xffffu); vt[7 * RVS] = (bf16_t)(vv.w >> 16);
    }
#pragma unroll
    for (int k = 0; k < 4; ++k) { const int e4 = tid + 512 * (k & 1); *(LAS f32x4*)(Sst + (k >> 1) * (64 * 68) + (e4 >> 4) * 68 + (e4 & 15) * 4) = S.st[k]; }
    const int unext = nextu(unit);
    if (unext < nunits) ret_stage_load3(S, A.P, A.RS, unext, tid);
    const float lg = log2_sigmoid(dir ? ((const GAS float*)A.decay_b)[h] : ((const GAS float*)A.decay_f)[h]);
    f32x16 o0, o1;
#pragma unroll
    for (int r = 0; r < 16; ++r) { o0[r] = 0.f; o1[r] = 0.f; }
    __syncthreads();
    bf16x8 qr[4];
#pragma unroll
    for (int s = 0; s < 4; ++s) qr[s] = *(const LAS bf16x8*)(Qc + qi * (KS * 2) + hi * 16 + s * 32);
    { const LAS float* sp = Sst + dir * (64 * 68) + r32 * 68 + 8 * hi;
#pragma unroll
    for (int s = 0; s < 4; ++s) {
        const f32x4 a0 = *(const LAS f32x4*)(sp + 16 * s), a1 = *(const LAS f32x4*)(sp + 16 * s + 4), b0 = *(const LAS f32x4*)(sp + 32 * 68 + 16 * s), b1 = *(const LAS f32x4*)(sp + 32 * 68 + 16 * s + 4);
        const bf16x8 fa = __builtin_bit_cast(bf16x8, (u32x4){cvt_pk_bf16(a0[0], a0[1]), cvt_pk_bf16(a0[2], a0[3]), cvt_pk_bf16(a1[0], a1[1]), cvt_pk_bf16(a1[2], a1[3])});
        const bf16x8 fb = __builtin_bit_cast(bf16x8, (u32x4){cvt_pk_bf16(b0[0], b0[1]), cvt_pk_bf16(b0[2], b0[3]), cvt_pk_bf16(b1[0], b1[1]), cvt_pk_bf16(b1[2], b1[3])});
        o0 = __builtin_amdgcn_mfma_f32_32x32x16_bf16(fa, qr[s], o0, 0, 0, 0);
        o1 = __builtin_amdgcn_mfma_f32_32x32x16_bf16(fb, qr[s], o1, 0, 0, 0);
    } }
    { const float qdec = fexp2(lg * (float)(dir ? (128 - qi) : (qi + 1)));
#pragma unroll
      for (int r = 0; r < 16; ++r) { o0[r] *= qdec; o1[r] *= qdec; } }
#pragma unroll
    for (int kt = 0; kt < 2; ++kt) {
        const bool need = dir ? (64 * kt + 63 >= 32 * qg) : (64 * kt <= 32 * qg + 31);
        if (!need) continue;
        f32x16 p0, p1;
#pragma unroll
        for (int r = 0; r < 16; ++r) { p0[r] = 0.f; p1[r] = 0.f; }
        const LAS unsigned char* kb = Kc + (64 * kt + r32) * (KS * 2) + hi * 16;
#pragma unroll
        for (int s = 0; s < 4; ++s) {
            const bf16x8 a0 = *(const LAS bf16x8*)(kb + s * 32), a1 = *(const LAS bf16x8*)(kb + 32 * (KS * 2) + s * 32);
            p0 = __builtin_amdgcn_mfma_f32_32x32x16_bf16(a0, qr[s], p0, 0, 0, 0);
            p1 = __builtin_amdgcn_mfma_f32_32x32x16_bf16(a1, qr[s], p1, 0, 0, 0);
        }
#pragma unroll
        for (int r = 0; r < 16; ++r) {
            const int j0 = 64 * kt + crow(r, hi), j1 = j0 + 32;
            const int d0 = dir ? (j0 - qi) : (qi - j0), d1 = dir ? (j1 - qi) : (qi - j1);
            p0[r] = (d0 >= 0) ? p0[r] * fexp2(lg * (float)d0) : 0.f;
            p1[r] = (d1 >= 0) ? p1[r] * fexp2(lg * (float)d1) : 0.f;
        }
        u32x4 pw[4];
        pw[0] = (u32x4){cvt_pk_bf16(p0[0], p0[1]), cvt_pk_bf16(p0[2], p0[3]), cvt_pk_bf16(p0[4], p0[5]), cvt_pk_bf16(p0[6], p0[7])};
        pw[1] = (u32x4){cvt_pk_bf16(p0[8], p0[9]), cvt_pk_bf16(p0[10], p0[11]), cvt_pk_bf16(p0[12], p0[13]), cvt_pk_bf16(p0[14], p0[15])};
        pw[2] = (u32x4){cvt_pk_bf16(p1[0], p1[1]), cvt_pk_bf16(p1[2], p1[3]), cvt_pk_bf16(p1[4], p1[5]), cvt_pk_bf16(p1[6], p1[7])};
        pw[3] = (u32x4){cvt_pk_bf16(p1[8], p1[9]), cvt_pk_bf16(p1[10], p1[11]), cvt_pk_bf16(p1[12], p1[13]), cvt_pk_bf16(p1[14], p1[15])};
        const LAS bf16_t* vb = Vt + r32 * RVS + 64 * kt + 4 * hi;
#pragma unroll
        for (int s = 0; s < 4; ++s) {
            const u32x2 l0 = *(const LAS u32x2*)(vb + 16 * s), h0 = *(const LAS u32x2*)(vb + 16 * s + 8);
            const u32x2 l1 = *(const LAS u32x2*)(vb + 32 * RVS + 16 * s), h1 = *(const LAS u32x2*)(vb + 32 * RVS + 16 * s + 8);
            const bf16x8 pf = __builtin_bit_cast(bf16x8, pw[s]);
            o0 = __builtin_amdgcn_mfma_f32_32x32x16_bf16(__builtin_bit_cast(bf16x8, (u32x4){l0.x, l0.y, h0.x, h0.y}), pf, o0, 0, 0, 0);
            o1 = __builtin_amdgcn_mfma_f32_32x32x16_bf16(__builtin_bit_cast(bf16x8, (u32x4){l1.x, l1.y, h1.x, h1.y}), pf, o1, 0, 0, 0);
        }
    }
    float sum = 0.f;
#pragma unroll
    for (int r = 0; r < 16; ++r) sum += o0[r] + o1[r];
    sum = xsum32(sum);
    const float mu = sum * (1.f / 64.f);
    float var = 0.f;
#pragma unroll
    for (int r = 0; r < 16; ++r) { o0[r] -= mu; o1[r] -= mu; var += o0[r] * o0[r] + o1[r] * o1[r]; }
    var = xsum32(var);
    const float rstd = 1.0f / sqrtf(var * (1.f / 64.f) + EPS);
    const LAS float* gn = gnl + dir * 256 + h * 64 + 4 * hi;
    const bf16_t* gp = prow + (dir ? C_RGB : C_RGF) + h * 64 + 4 * hi;
    LAS float* cb = comb + qi * 65 + 4 * hi;
    if (dir == 1) {
#pragma unroll
        for (int q4 = 0; q4 < 4; ++q4)
#pragma unroll
            for (int half = 0; half < 2; ++half) {
                const int d = 8 * q4 + 32 * half; const f32x4 g4 = *(const LAS f32x4*)(gn + d); const u32x2 gw = *(const GAS u32x2*)(gp + d);
                const float gt[4] = {bf_lo(gw.x), bf_hi(gw.x), bf_lo(gw.y), bf_hi(gw.y)};
#pragma unroll
                for (int e = 0; e < 4; ++e) { const float ov = half ? o1[4 * q4 + e] : o0[4 * q4 + e]; cb[d + e] = silu_f(gt[e]) * (ov * rstd) * g4[e]; }
            }
    }
    __syncthreads();
    if (dir == 0) {
#pragma unroll
        for (int q4 = 0; q4 < 4; ++q4)
#pragma unroll
            for (int half = 0; half < 2; ++half) {
                const int d = 8 * q4 + 32 * half; const f32x4 g4 = *(const LAS f32x4*)(gn + d); const u32x2 gw = *(const GAS u32x2*)(gp + d);
                const float gt[4] = {bf_lo(gw.x), bf_hi(gw.x), bf_lo(gw.y), bf_hi(gw.y)};
                float y[4];
#pragma unroll
                for (int e = 0; e < 4; ++e) { const float ov = half ? o1[4 * q4 + e] : o0[4 * q4 + e]; y[e] = silu_f(gt[e]) * (ov * rstd) * g4[e] + cb[d + e]; }
                u32x2 wv; wv.x = cvt_pk_bf16(y[0], y[1]); wv.y = cvt_pk_bf16(y[2], y[3]); *(LAS u32x2*)(Qc + qi * (KS * 2) + (d + 4 * hi) * 2) = wv;
            }
    }
    __syncthreads();
#pragma unroll
    for (int j = 0; j < 2; ++j) { const int q = tid + 512 * j, tok = q >> 3, dp = q & 7;
        *(GAS u32x4*)(A.Y + (row0 + tok) * DM + 768 + h * 64 + 8 * dp) = *(const LAS u32x4*)(Qc + tok * (KS * 2) + dp * 16); }
    __syncthreads();
    unit = unext;
    }
}
#define CE(a, i, j) do { const float hi_ = fmaxf(a[i], a[j]), lo_ = fminf(a[i], a[j]); a[i] = hi_; a[j] = lo_; } while (0)
#define SORT16(a) do { CE(a,0,13); CE(a,1,12); CE(a,2,15); CE(a,3,14); CE(a,4,8); CE(a,5,6); CE(a,7,11); CE(a,9,10); CE(a,0,5); CE(a,1,7); CE(a,2,9); CE(a,3,4); CE(a,6,13); CE(a,8,14); CE(a,10,15); CE(a,11,12); CE(a,0,1); CE(a,2,3); CE(a,4,5); CE(a,6,8); CE(a,7,9); CE(a,10,11); CE(a,12,13); CE(a,14,15); CE(a,0,2); CE(a,1,3); CE(a,4,10); CE(a,5,11); CE(a,6,7); CE(a,8,9); CE(a,12,14); CE(a,13,15); CE(a,1,2); CE(a,3,12); CE(a,4,6); CE(a,5,7); CE(a,8,10); CE(a,9,11); CE(a,13,14); CE(a,1,4); CE(a,2,6); CE(a,5,8); CE(a,7,10); CE(a,9,13); CE(a,11,14); CE(a,2,4); CE(a,3,6); CE(a,9,12); CE(a,11,13); CE(a,3,5); CE(a,6,8); CE(a,7,9); CE(a,10,12); CE(a,3,4); CE(a,5,6); CE(a,7,8); CE(a,9,10); CE(a,11,12); CE(a,6,7); CE(a,8,9); } while (0)
#define MERGE16(T, C) do { T[0] = fmaxf(T[0], C[15]); T[1] = fmaxf(T[1], C[14]); T[2] = fmaxf(T[2], C[13]); T[3] = fmaxf(T[3], C[12]); T[4] = fmaxf(T[4], C[11]); T[5] = fmaxf(T[5], C[10]); T[6] = fmaxf(T[6], C[9]); T[7] = fmaxf(T[7], C[8]); T[8] = fmaxf(T[8], C[7]); T[9] = fmaxf(T[9], C[6]); T[10] = fmaxf(T[10], C[5]); T[11] = fmaxf(T[11], C[4]); T[12] = fmaxf(T[12], C[3]); T[13] = fmaxf(T[13], C[2]); T[14] = fmaxf(T[14], C[1]); T[15] = fmaxf(T[15], C[0]); CE(T,0,8); CE(T,1,9); CE(T,2,10); CE(T,3,11); CE(T,4,12); CE(T,5,13); CE(T,6,14); CE(T,7,15); CE(T,0,4); CE(T,1,5); CE(T,2,6); CE(T,3,7); CE(T,8,12); CE(T,9,13); CE(T,10,14); CE(T,11,15); CE(T,0,2); CE(T,1,3); CE(T,4,6); CE(T,5,7); CE(T,8,10); CE(T,9,11); CE(T,12,14); CE(T,13,15); CE(T,0,1); CE(T,2,3); CE(T,4,5); CE(T,6,7); CE(T,8,9); CE(T,10,11); CE(T,12,13); CE(T,14,15); } while (0)

__device__ __forceinline__ void phase_topk(Frame& F, const _Float16* S16, int* eid, float* gate, bool skipctx) {
    LAS unsigned char* timg = F.lds + F.wave * 11264;
    LAS unsigned char* ilds = F.lds + F.wave * 11264 + 9216 + F.lane;
    const int lane = F.lane, gwv = F.vcu * NWAVES + F.wave, NGW = F.G * NWAVES;
    for (int wt = gwv; wt < NROW / 8; wt += NGW) {
        const int row0 = 8 * wt;
        if (skipctx && (row0 % NB) < CTXL) continue;
        const int row = row0 + (lane >> 3), h = lane & 7;
        const GAS unsigned char* blk = (const GAS unsigned char*)(S16 + (size_t)row0 * 2048);
        float v1[16], v2[16];
#pragma unroll
        for (int hf = 0; hf < 2; ++hf) {
            float T[16];
#pragma unroll
            for (int i = 0; i < 16; ++i) T[i] = -3.0e38f;
#pragma unroll
            for (int qq = 0; qq < 2; ++qq) {
                const int q = 2 * hf + qq;
                u32x4 ld[8];
#pragma unroll
                for (int i = 0; i < 8; ++i) ld[i] = *(const GAS u32x4*)(blk + (size_t)(8 * i + (lane >> 3)) * 512 + 128 * q + 16 * (lane & 7));
#pragma unroll
                for (int i = 0; i < 8; ++i) *(LAS u32x4*)(timg + (8 * i + (lane >> 3)) * 144 + 16 * (lane & 7)) = ld[i];
                LDS_WAIT(); asm volatile("" ::: "memory");
#pragma unroll
                for (int ch = 0; ch < 4; ++ch) {
                    const u32x4 a = *(const LAS u32x4*)(timg + lane * 144 + 32 * ch), b = *(const LAS u32x4*)(timg + lane * 144 + 32 * ch + 16);
                    const unsigned wv[8] = {a.x, a.y, a.z, a.w, b.x, b.y, b.z, b.w};
                    const unsigned nb = 127u - 64u * (unsigned)qq - 16u * (unsigned)ch;
                    float c[16];
#pragma unroll
                    for (int e = 0; e < 8; ++e) {
                        typedef _Float16 h2 __attribute__((ext_vector_type(2)));
                        const h2 p = __builtin_bit_cast(h2, wv[e]);
                        c[2 * e] = __uint_as_float((__float_as_uint((float)p[0]) & ~0x7Fu) | (nb - 2 * e));
                        c[2 * e + 1] = __uint_as_float((__float_as_uint((float)p[1]) & ~0x7Fu) | (nb - 2 * e - 1));
                    }
                    SORT16(c); MERGE16(T, c);
                }
                LDS_WAIT(); asm volatile("" ::: "memory");
            }
#pragma unroll
            for (int i = 0; i < 16; ++i) { const unsigned bits = __float_as_uint(T[i]); ilds[(16 * hf + i) * 64] = (unsigned char)(127u - (bits & 0x7Fu)); (hf ? v2[i] : v1[i]) = __uint_as_float(bits & ~0x7Fu); }
        }
        float cs[16];
#pragma unroll
        for (int i = 0; i < 16; ++i) cs[i] = -3.0e38f;
        { float c[16];
        { c[0] = __uint_as_float((__float_as_uint(v1[0] + v2[0]) & ~0xFFu) | 255u); c[1] = __uint_as_float((__float_as_uint(v1[0] + v2[1]) & ~0xFFu) | 254u); c[2] = __uint_as_float((__float_as_uint(v1[0] + v2[2]) & ~0xFFu) | 253u); c[3] = __uint_as_float((__float_as_uint(v1[0] + v2[3]) & ~0xFFu) | 252u); c[4] = __uint_as_float((__float_as_uint(v1[0] + v2[4]) & ~0xFFu) | 251u); c[5] = __uint_as_float((__float_as_uint(v1[0] + v2[5]) & ~0xFFu) | 250u); c[6] = __uint_as_float((__float_as_uint(v1[0] + v2[6]) & ~0xFFu) | 249u); c[7] = __uint_as_float((__float_as_uint(v1[0] + v2[7]) & ~0xFFu) | 248u); c[8] = __uint_as_float((__float_as_uint(v1[0] + v2[8]) & ~0xFFu) | 247u); c[9] = __uint_as_float((__float_as_uint(v1[0] + v2[9]) & ~0xFFu) | 246u); c[10] = __uint_as_float((__float_as_uint(v1[0] + v2[10]) & ~0xFFu) | 245u); c[11] = __uint_as_float((__float_as_uint(v1[0] + v2[11]) & ~0xFFu) | 244u); c[12] = __uint_as_float((__float_as_uint(v1[0] + v2[12]) & ~0xFFu) | 243u); c[13] = __uint_as_float((__float_as_uint(v1[0] + v2[13]) & ~0xFFu) | 242u); c[14] = __uint_as_float((__float_as_uint(v1[0] + v2[14]) & ~0xFFu) | 241u); c[15] = __uint_as_float((__float_as_uint(v1[0] + v2[15]) & ~0xFFu) | 240u); SORT16(c); MERGE16(cs, c); }
        { c[0] = __uint_as_float((__float_as_uint(v1[1] + v2[0]) & ~0xFFu) | 239u); c[1] = __uint_as_float((__float_as_uint(v1[1] + v2[1]) & ~0xFFu) | 238u); c[2] = __uint_as_float((__float_as_uint(v1[1] + v2[2]) & ~0xFFu) | 237u); c[3] = __uint_as_float((__float_as_uint(v1[1] + v2[3]) & ~0xFFu) | 236u); c[4] = __uint_as_float((__float_as_uint(v1[1] + v2[4]) & ~0xFFu) | 235u); c[5] = __uint_as_float((__float_as_uint(v1[1] + v2[5]) & ~0xFFu) | 234u); c[6] = __uint_as_float((__float_as_uint(v1[1] + v2[6]) & ~0xFFu) | 233u); c[7] = __uint_as_float((__float_as_uint(v1[1] + v2[7]) & ~0xFFu) | 232u); c[8] = __uint_as_float((__float_as_uint(v1[2] + v2[0]) & ~0xFFu) | 223u); c[9] = __uint_as_float((__float_as_uint(v1[2] + v2[1]) & ~0xFFu) | 222u); c[10] = __uint_as_float((__float_as_uint(v1[2] + v2[2]) & ~0xFFu) | 221u); c[11] = __uint_as_float((__float_as_uint(v1[2] + v2[3]) & ~0xFFu) | 220u); c[12] = __uint_as_float((__float_as_uint(v1[2] + v2[4]) & ~0xFFu) | 219u); c[13] = __uint_as_float((__float_as_uint(v1[3] + v2[0]) & ~0xFFu) | 207u); c[14] = __uint_as_float((__float_as_uint(v1[3] + v2[1]) & ~0xFFu) | 206u); c[15] = __uint_as_float((__float_as_uint(v1[3] + v2[2]) & ~0xFFu) | 205u); SORT16(c); MERGE16(cs, c); }
        { c[0] = __uint_as_float((__float_as_uint(v1[3] + v2[3]) & ~0xFFu) | 204u); c[1] = __uint_as_float((__float_as_uint(v1[4] + v2[0]) & ~0xFFu) | 191u); c[2] = __uint_as_float((__float_as_uint(v1[4] + v2[1]) & ~0xFFu) | 190u); c[3] = __uint_as_float((__float_as_uint(v1[4] + v2[2]) & ~0xFFu) | 189u); c[4] = __uint_as_float((__float_as_uint(v1[5] + v2[0]) & ~0xFFu) | 175u); c[5] = __uint_as_float((__float_as_uint(v1[5] + v2[1]) & ~0xFFu) | 174u); c[6] = __uint_as_float((__float_as_uint(v1[6] + v2[0]) & ~0xFFu) | 159u); c[7] = __uint_as_float((__float_as_uint(v1[6] + v2[1]) & ~0xFFu) | 158u); c[8] = __uint_as_float((__float_as_uint(v1[7] + v2[0]) & ~0xFFu) | 143u); c[9] = __uint_as_float((__float_as_uint(v1[7] + v2[1]) & ~0xFFu) | 142u); c[10] = __uint_as_float((__float_as_uint(v1[8] + v2[0]) & ~0xFFu) | 127u); c[11] = __uint_as_float((__float_as_uint(v1[9] + v2[0]) & ~0xFFu) | 111u); c[12] = __uint_as_float((__float_as_uint(v1[10] + v2[0]) & ~0xFFu) | 95u); c[13] = __uint_as_float((__float_as_uint(v1[11] + v2[0]) & ~0xFFu) | 79u); c[14] = __uint_as_float((__float_as_uint(v1[12] + v2[0]) & ~0xFFu) | 63u); c[15] = __uint_as_float((__float_as_uint(v1[13] + v2[0]) & ~0xFFu) | 47u); SORT16(c); MERGE16(cs, c); }
        { c[0] = __uint_as_float((__float_as_uint(v1[14] + v2[0]) & ~0xFFu) | 31u); c[1] = __uint_as_float((__float_as_uint(v1[15] + v2[0]) & ~0xFFu) | 15u); c[2] = -3.0e38f; c[3] = -3.0e38f; c[4] = -3.0e38f; c[5] = -3.0e38f; c[6] = -3.0e38f; c[7] = -3.0e38f; c[8] = -3.0e38f; c[9] = -3.0e38f; c[10] = -3.0e38f; c[11] = -3.0e38f; c[12] = -3.0e38f; c[13] = -3.0e38f; c[14] = -3.0e38f; c[15] = -3.0e38f; SORT16(c); MERGE16(cs, c); }
        }
        float ev[16]; float den = 0.f;
        const float top = __uint_as_float(__float_as_uint(cs[0]) & ~0xFFu);
#pragma unroll
        for (int k = 0; k < 16; ++k) { ev[k] = __expf(__uint_as_float(__float_as_uint(cs[k]) & ~0xFFu) - top); den += ev[k]; }
        const float rden = 1.0f / den;
        LDS_WAIT(); asm volatile("" ::: "memory");
        int eo[16]; float go[16];
#pragma unroll
        for (int k = 0; k < 16; ++k) { const int pos = 255 - (int)(__float_as_uint(cs[k]) & 0xFFu); eo[k] = ((int)ilds[(pos >> 4) * 64] * 128 + (int)ilds[(16 + (pos & 15)) * 64]) * 128; go[k] = ev[k] * rden; }
        LAS u32x4* img = (LAS u32x4*)timg;
#pragma unroll
        for (int q = 0; q < 4; ++q) { img[lane * 4 + q] = (u32x4){(unsigned)eo[4 * q], (unsigned)eo[4 * q + 1], (unsigned)eo[4 * q + 2], (unsigned)eo[4 * q + 3]};
            img[256 + lane * 4 + q] = (u32x4){__float_as_uint(go[4 * q]), __float_as_uint(go[4 * q + 1]), __float_as_uint(go[4 * q + 2]), __float_as_uint(go[4 * q + 3])}; }
        LDS_WAIT(); asm volatile("" ::: "memory");
        GAS u32x4* eg = (GAS u32x4*)((GAS int*)eid + (size_t)row0 * 128); GAS u32x4* gg = (GAS u32x4*)((GAS float*)gate + (size_t)row0 * 128);
#pragma unroll
        for (int q = 0; q < 4; ++q) { eg[64 * q + lane] = img[64 * q + lane]; gg[64 * q + lane] = img[256 + 64 * q + lane]; }
        LDS_WAIT(); asm volatile("" ::: "memory");
    }
}

constexpr float U8_SCALE = 896.0f, V8_SCALE = 4.0f;
typedef _Float16 h2_t __attribute__((ext_vector_type(2)));
__device__ __forceinline__ h2_t fp8x2_to_h2(unsigned w, bool hi) { return hi ? __builtin_amdgcn_cvt_scalef32_pk_f16_fp8(w, 1.0f, true) : __builtin_amdgcn_cvt_scalef32_pk_f16_fp8(w, 1.0f, false); }
#define VM_WAIT_ALL() do { asm volatile("" ::: "memory"); __builtin_amdgcn_s_waitcnt(0x0F70); asm volatile("" ::: "memory"); } while (0)
__device__ __forceinline__ void peer_gather(u32x4 (&t)[16], const char* tb, const LAS unsigned char* slot, int g) {
    const LAS u32x4* ep = (const LAS u32x4*)(slot + 64 * g);
    u32x4 e[4];
#pragma unroll
    for (int i = 0; i < 4; ++i) e[i] = ep[i];
#pragma unroll
    for (int i = 0; i < 4; ++i) { t[4 * i] = *(const GAS u32x4*)(tb + e[i].x); t[4 * i + 1] = *(const GAS u32x4*)(tb + e[i].y); t[4 * i + 2] = *(const GAS u32x4*)(tb + e[i].z); t[4 * i + 3] = *(const GAS u32x4*)(tb + e[i].w); }
}
__device__ __forceinline__ h2_t bf8e(unsigned d) { const unsigned r = __builtin_amdgcn_perm(0u, d, 0x020c000cu); return __builtin_bit_cast(h2_t, r); }
__device__ __forceinline__ h2_t bf8o(unsigned d) { const unsigned r = d & 0xff00ff00u; return __builtin_bit_cast(h2_t, r); }
__device__ __forceinline__ int dot16_i8(const u32x4 t, const u32x4 x) {
    return __builtin_amdgcn_sdot4((int)t.x, (int)x.x, __builtin_amdgcn_sdot4((int)t.y, (int)x.y, __builtin_amdgcn_sdot4((int)t.z, (int)x.z, __builtin_amdgcn_sdot4((int)t.w, (int)x.w, 0, false), false), false), false);
}
__device__ __forceinline__ void peer_u_dma(LAS unsigned char* slot, const unsigned* eoff, const unsigned char* XQ, const float* XSC, int r, int xq, int lane) {
    const unsigned char* src = lane < 32 ? (const unsigned char*)eoff + (size_t)r * 512 + 16 * lane
                             : (lane < 40 ? XQ + (size_t)r * DM + xq * 128 + 16 * (lane - 32) : (const unsigned char*)XSC + (size_t)r * 16);
    __builtin_amdgcn_global_load_lds((const GAS unsigned*)src, (LAS unsigned*)slot, 16, 0, 0);
}
__device__ __forceinline__ unsigned peer_u_compute(const u32x4 (&t)[16], const u32x4 x, const float xs, int lane) {
    float part[16];
#pragma unroll
    for (int i = 0; i < 16; ++i) part[i] = (float)dot16_i8(t[i], x);
    float p8[8], p4[4], p2[2];
    { const bool up = (lane & 4) != 0;
#pragma unroll
      for (int q = 0; q < 8; ++q) { const float keep = up ? part[q + 8] : part[q], send = up ? part[q] : part[q + 8]; p8[q] = keep + xshfl<4>(send); } }
    { const bool up = (lane & 2) != 0;
#pragma unroll
      for (int q = 0; q < 4; ++q) { const float keep = up ? p8[q + 4] : p8[q], send = up ? p8[q] : p8[q + 4]; p4[q] = keep + xshfl<2>(send); } }
    { const bool up = (lane & 1) != 0;
#pragma unroll
      for (int q = 0; q < 2; ++q) { const float keep = up ? p4[q + 2] : p4[q], send = up ? p4[q] : p4[q + 2]; p2[q] = keep + xshfl<1>(send); } }
    return cvt_pk_bf16(p2[0] * xs, p2[1] * xs);
}
__device__ __forceinline__ int peer_next_row(int r, int step, bool skipctx) { r += step; if (skipctx && r < NROW && (r % NB) < CTXL) r += ((CTXL - (r % NB) + step - 1) / step) * step; return r; }
struct RowQ { LAS unsigned* ctr; int rank8, step, limit; unsigned tmax, pend; bool latent; };
__device__ __forceinline__ void rq_issue(RowQ& Q, int lane) { unsigned t = 0u; if (lane == 0) t = __hip_atomic_fetch_add(Q.ctr, 1u, __ATOMIC_RELAXED, __HIP_MEMORY_SCOPE_WORKGROUP); Q.pend = t; }
__device__ __forceinline__ int rq_take(RowQ& Q, int lane) {
    const unsigned t = (unsigned)__builtin_amdgcn_readfirstlane((int)Q.pend);
    rq_issue(Q, lane);
    const int r0 = Q.rank8 + (int)(t & 7u) + (int)(t >> 3) * Q.step;
    const int r = Q.latent ? (r0 / SEQ) * NB + CTXL + (r0 % SEQ) : r0;
    return (t < Q.tmax) ? r : NROW;
}
__device__ __forceinline__ void rq_init(RowQ& Q, Frame& F, int rank, int step, bool skipctx) {
    Q.ctr = (LAS unsigned*)(F.lds + 40960); Q.rank8 = rank * NWAVES; Q.step = step; Q.latent = skipctx; Q.limit = skipctx ? NBATCH * SEQ : NROW;
    Q.tmax = (Q.limit > Q.rank8) ? (unsigned)(((Q.limit - Q.rank8 + step - 1) / step) * 8) : 0u;
    if (F.tid == 0) *Q.ctr = 0u;
    __syncthreads();
    rq_issue(Q, F.lane);
}
template <bool DUMMY = false>
__device__ __forceinline__ void phase_peer_u(Frame& F, const unsigned char* XQ, const float* XSC, const unsigned char* U8, const unsigned* eoff, float* PART, bool skipctx) {
    const int lane = F.lane, xq = blockIdx.x & 7, rank = blockIdx.x >> 3, nr = (F.G - xq + 7) >> 3, step = nr * NWAVES;
    const int g = lane >> 3, c8 = lane & 7;
    const char* ub = (const char*)U8 + (size_t)xq * ((size_t)NEXP * 128) + c8 * 16;
    LAS unsigned char* ring = F.lds + F.wave * 4096;
    RowQ Q; rq_init(Q, F, rank, step, skipctx);
    int rA = rq_take(Q, lane);
    if (rA >= NROW) return;
    int rB = rq_take(Q, lane), i = 0;
    peer_u_dma(ring, eoff, XQ, XSC, rA, xq, lane);
    peer_u_dma(ring + 1024, eoff, XQ, XSC, rB < NROW ? rB : rA, xq, lane);
    VM_WAIT_ALL();
    u32x4 T0[16], T1[16];
    peer_gather(T0, ub, ring, g);
    GAS unsigned* const pout = (GAS unsigned*)PART + (size_t)xq * NROW * 64 + 8 * g + c8;
    unsigned res = 0u; int rP = -1;
#define PEER_U_STEP(TC, TN) { \
        VM_WAIT_ALL(); \
        const int rC = rq_take(Q, lane);     \
        const LAS unsigned char* sa = ring + (i & 3) * 1024; \
        const u32x4 x = *(const LAS u32x4*)(sa + 512 + 16 * c8); const float xs = *(const LAS float*)(sa + 640); \
        peer_u_dma(ring + ((i + 2) & 3) * 1024, eoff, XQ, XSC, rC < NROW ? rC : rB, xq, lane); \
        peer_gather(TN, ub, ring + ((i + 1) & 3) * 1024, g); \
        if (rP >= 0) pout[(size_t)rP * 64] = res; \
        res = peer_u_compute(TC, x, xs, lane); rP = rA; \
        rA = rB; rB = rC; ++i; }
#define PEER_U_TAIL(TC) { VM_WAIT_ALL(); const LAS unsigned char* sa = ring + (i & 3) * 1024; \
        const u32x4 x = *(const LAS u32x4*)(sa + 512 + 16 * c8); const float xs = *(const LAS float*)(sa + 640); \
        if (rP >= 0) pout[(size_t)rP * 64] = res; \
        pout[(size_t)rA * 64] = peer_u_compute(TC, x, xs, lane); }
    while (true) {
        if (rB >= NROW) { PEER_U_TAIL(T0) break; }
        PEER_U_STEP(T0, T1)
        if (rB >= NROW) { PEER_U_TAIL(T1) break; }
        PEER_U_STEP(T1, T0)
    }
#undef PEER_U_STEP
#undef PEER_U_TAIL
}

__device__ __forceinline__ float gelu_as(float v) {
    const float av = fabsf(v), t = __builtin_amdgcn_rcpf(av * 0.2316418882f + 1.0f);
    float q = t * 0.5307027145f + (-0.7265760135f); q = q * t + 0.7107068705f; q = q * t + (-0.142248368f); q = q * t + 0.127414796f; q = q * t;
    const float e = fexp2((v * v) * (-0.72134752044f)), m = v * (q * e);
    return v < 0.f ? m : v - m;
}
__device__ __forceinline__ void phase_peer_w(Frame& F, const float* PART, float* gw, bool skipctx) {
    const int gwv = F.vcu * NWAVES + F.wave, NGW = F.G * NWAVES, lane = F.lane;
    for (int r = gwv; r < NROW; r += NGW) {
        if (skipctx && (r % NB) < CTXL) continue;
        float a0 = 0.f, a1 = 0.f;
#pragma unroll
        for (int g = 0; g < 8; ++g) { const unsigned w = ((const GAS unsigned*)PART)[((size_t)g * NROW + r) * 64 + lane]; a0 += bf_lo(w); a1 += bf_hi(w); }
        GAS f32x2* gp = (GAS f32x2*)(gw + (size_t)r * 128) + lane;
        const f32x2 gt = *gp;
        const _Float16 w0 = (_Float16)(gelu_as(a0 * (1.0f / U8_SCALE)) * gt[0] * (1.0f / V8_SCALE)), w1 = (_Float16)(gelu_as(a1 * (1.0f / U8_SCALE)) * gt[1] * (1.0f / V8_SCALE));
        *gp = (f32x2){__uint_as_float(__builtin_bit_cast(unsigned, (h2_t){w0, w0})), __uint_as_float(__builtin_bit_cast(unsigned, (h2_t){w1, w1}))};
    }
}

__device__ __forceinline__ void peer_v_dma(LAS unsigned char* slot, const unsigned* eoff, const float* gw, int r, int lane) {
    const unsigned char* src = lane < 32 ? (const unsigned char*)eoff + (size_t)r * 512 + 16 * lane : (const unsigned char*)gw + (size_t)r * 512 + 16 * (lane - 32);
    __builtin_amdgcn_global_load_lds((const GAS unsigned*)src, (LAS unsigned*)slot, 16, 0, 0);
}
struct PeerVW { u32x4 w[4]; };
struct PeerVRes { f32x2 xv, gv; unsigned xw; };
struct PeerVAddr { GAS float* xr; GAS bf16_t* xq; bool isctx; int b; };
__device__ __forceinline__ PeerVAddr peer_v_addr(bf16_t* xb, float* xc, int r, int cb, int c8, int lane) {
    PeerVAddr A; A.b = r / NB; const int j = r % NB;
    const int col = cb + 16 * c8 + ((lane >> 3) & 1) * 8 + ((lane >> 4) & 1) * 4 + ((lane >> 5) & 1) * 2;
    A.isctx = j < CTXL;
    A.xr = (GAS float*)(xc + ((size_t)A.b * CTXL + (A.isctx ? j : 0)) * DM + col);
    A.xq = (GAS bf16_t*)(xb + ((size_t)A.b * SEQ + (A.isctx ? 0 : (j - CTXL))) * DM + col);
    return A;
}
__device__ __forceinline__ void peer_v_pre(PeerVRes& R, bf16_t* xb, float* xc, const float* mod, int r, int cb, int c8, int lane, float vscale) {
    const PeerVAddr A = peer_v_addr(xb, xc, r, cb, c8, lane);
    const int col = cb + 16 * c8 + ((lane >> 3) & 1) * 8 + ((lane >> 4) & 1) * 4 + ((lane >> 5) & 1) * 2;
    R.xv = (f32x2){0.f, 0.f}; R.xw = 0u;
    if (A.isctx) R.xv = *(const GAS f32x2*)A.xr; else R.xw = *(const GAS unsigned*)A.xq;
    R.gv = *(const GAS f32x2*)(mod + (A.isctx ? 4 : A.b) * 6144 + 5 * DM + col);
}
__device__ __forceinline__ void peer_v_store(bf16_t* xb, float* xc, int r, int cb, int c8, int lane, const f32x2 xn) {
    const PeerVAddr A = peer_v_addr(xb, xc, r, cb, c8, lane);
    if (A.isctx) *(GAS f32x2*)A.xr = xn; else *(GAS unsigned*)A.xq = cvt_pk_bf16(xn[0], xn[1]);
}
__device__ __forceinline__ f32x2 peer_v_compute(const u32x4 (&t)[16], const PeerVW& M, const PeerVRes& R, bool isctx, int lane, float vscale) {
    h2_t acc[8];
#pragma unroll
    for (int c = 0; c < 8; ++c) acc[c] = (h2_t){(_Float16)0.f, (_Float16)0.f};
#pragma unroll
    for (int i = 0; i < 16; ++i) { const unsigned wu = M.w[i >> 2][i & 3]; const h2_t w2 = __builtin_bit_cast(h2_t, wu);
        const u32x4 d = t[i];
        acc[0] += w2 * bf8e(d.x); acc[1] += w2 * bf8o(d.x); acc[2] += w2 * bf8e(d.y); acc[3] += w2 * bf8o(d.y);
        acc[4] += w2 * bf8e(d.z); acc[5] += w2 * bf8o(d.z); acc[6] += w2 * bf8e(d.w); acc[7] += w2 * bf8o(d.w); }
    h2_t p4[4], p2[2], p1h;
#define H2X(v, M) __builtin_bit_cast(h2_t, __float_as_uint(xshfl<M>(__uint_as_float(__builtin_bit_cast(unsigned, (v))))))
    { const bool up = (lane & 8) != 0;
#pragma unroll
      for (int q = 0; q < 4; ++q) { const h2_t keep = up ? acc[q + 4] : acc[q], send = up ? acc[q] : acc[q + 4]; p4[q] = keep + H2X(send, 8); } }
    { const bool up = (lane & 16) != 0;
#pragma unroll
      for (int q = 0; q < 2; ++q) { const h2_t keep = up ? p4[q + 2] : p4[q], send = up ? p4[q] : p4[q + 2]; p2[q] = keep + H2X(send, 16); } }
    { const bool up = (lane & 32) != 0; const h2_t keep = up ? p2[1] : p2[0], send = up ? p2[0] : p2[1]; p1h = keep + H2X(send, 32); }
#undef H2X
    const f32x2 p1 = {(float)p1h[0], (float)p1h[1]};
    const f32x2 xv = isctx ? R.xv : (f32x2){bf_lo(R.xw), bf_hi(R.xw)};
    return (f32x2){xv[0] + (R.gv[0] * vscale) * p1[0], xv[1] + (R.gv[1] * vscale) * p1[1]};
}
__device__ __forceinline__ void phase_peer_v(Frame& F, const unsigned char* V8, const unsigned* eoff, const float* gw, bf16_t* xb, float* xc, const float* mod, bool skipctx, float vscale) {
    const int lane = F.lane, xq = blockIdx.x & 7, rank = blockIdx.x >> 3, nr = (F.G - xq + 7) >> 3, step = nr * NWAVES;
    const int g = lane >> 3, c8 = lane & 7, cb = xq * 128;
    const char* vb = (const char*)V8 + (size_t)xq * ((size_t)NEXP * 128) + c8 * 16;
    LAS unsigned char* ring = F.lds + F.wave * 4096;
    RowQ Q; rq_init(Q, F, rank, step, skipctx);
    int rA = rq_take(Q, lane);
    if (rA >= NROW) return;
    int rB = rq_take(Q, lane), i = 0;
    peer_v_dma(ring, eoff, gw, rA, lane);
    peer_v_dma(ring + 1024, eoff, gw, rB < NROW ? rB : rA, lane);
    VM_WAIT_ALL();
    u32x4 T0[16], T1[16];
    peer_gather(T0, vb, ring, g);
    PeerVRes RA, RB; f32x2 res = {0.f, 0.f}; int rP = -1;
    peer_v_pre(RA, xb, xc, mod, rA, cb, c8, lane, vscale);
#define PEER_V_STEP(TC, TN) { \
        VM_WAIT_ALL(); \
        const int rC = rq_take(Q, lane);     \
        PeerVW W; { const LAS u32x4* wp = (const LAS u32x4*)(ring + (i & 3) * 1024 + 512 + 64 * g); W.w[0] = wp[0]; W.w[1] = wp[1]; W.w[2] = wp[2]; W.w[3] = wp[3]; } \
        peer_v_dma(ring + ((i + 2) & 3) * 1024, eoff, gw, rC < NROW ? rC : rB, lane); \
        peer_gather(TN, vb, ring + ((i + 1) & 3) * 1024, g); \
        peer_v_pre(RB, xb, xc, mod, rB, cb, c8, lane, vscale); \
        if (rP >= 0) peer_v_store(xb, xc, rP, cb, c8, lane, res); \
        res = peer_v_compute(TC, W, RA, (rA % NB) < CTXL, lane, vscale); rP = rA; RA = RB; \
        rA = rB; rB = rC; ++i; }
#define PEER_V_TAIL(TC) { VM_WAIT_ALL(); PeerVW W; { const LAS u32x4* wp = (const LAS u32x4*)(ring + (i & 3) * 1024 + 512 + 64 * g); W.w[0] = wp[0]; W.w[1] = wp[1]; W.w[2] = wp[2]; W.w[3] = wp[3]; } \
        if (rP >= 0) peer_v_store(xb, xc, rP, cb, c8, lane, res); \
        peer_v_store(xb, xc, rA, cb, c8, lane, peer_v_compute(TC, W, RA, (rA % NB) < CTXL, lane, vscale)); }
    while (true) {
        if (rB >= NROW) { PEER_V_TAIL(T0) break; }
        PEER_V_STEP(T0, T1)
        if (rB >= NROW) { PEER_V_TAIL(T1) break; }
        PEER_V_STEP(T1, T0)
    }
#undef PEER_V_STEP
#undef PEER_V_TAIL
}
#ifndef DIAG
#define DIAG 0
#endif
#if DIAG
#ifndef DIAG_TOL
#define DIAG_TOL 2.5e-3f
#endif
__device__ __forceinline__ float blk_max(LAS float* red, float v, int tid) {
    v = fmaxf(v, xshfl<1>(v)); v = fmaxf(v, xshfl<2>(v)); v = fmaxf(v, xshfl<4>(v)); v = fmaxf(v, xshfl<8>(v)); v = fmaxf(v, xshfl<16>(v)); v = xmax32(v);
    __syncthreads(); if ((tid & 63) == 0) red[tid >> 6] = v; __syncthreads();
    float r = red[0];
#pragma unroll
    for (int i = 1; i < 8; ++i) r = fmaxf(r, red[i]);
    __syncthreads(); return r;
}
__device__ __forceinline__ float blk_sum(LAS float* red, float v, int tid) {
    v = wave_sum(v);
    __syncthreads(); if ((tid & 63) == 0) red[tid >> 6] = v; __syncthreads();
    float r = 0.f;
#pragma unroll
    for (int i = 0; i < 8; ++i) r += red[i];
    __syncthreads(); return r;
}
template <int DQK, class KeyFn>
__device__ __forceinline__ float diag_attn(LAS float* sm, int tid, const bf16_t* qp, const bf16_t* kbase, int kpitch, int koff, const bf16_t* k2base, int k2pitch, int k2off,
                                           const bf16_t* vbase, int vpitch, int voff, int nkeys, KeyFn keyfn, float sink_l2, bool has_sink, const bf16_t* yp) {
    LAS float* mw = sm;
    LAS float* lw = sm + 8;
    LAS float* ow = sm + 16;
    LAS float* red = sm + 16 + 512;
    const int lane = tid & 63, w = tid >> 6;
    const float q0 = bf2f(qp[lane]); const float q1 = (DQK == 96 && lane < 32) ? bf2f(qp[64 + lane]) : 0.f;
    float m = -3.0e38f, l = 0.f, o = 0.f;
    for (int i = w; i < nkeys; i += 8) {
        size_t krow; float bias; bool valid; keyfn(i, krow, bias, valid);
        if (!valid) continue;
        float part = q0 * bf2f(kbase[krow * kpitch + koff + lane]);
        if (DQK == 96 && lane < 32) part += q1 * bf2f(k2base[krow * k2pitch + k2off + lane]);
        const float sc = wave_sum(part) + bias;
        const float mn = fmaxf(m, sc), al = fexp2(m - mn), pp = fexp2(sc - mn);
        m = mn; l = l * al + pp; o = o * al + pp * bf2f(vbase[krow * vpitch + voff + lane]);
    }
    __syncthreads();
    if (lane == 0) { mw[w] = m; lw[w] = l; }
    ow[w * 64 + lane] = o;
    __syncthreads();
    float M = mw[0];
#pragma unroll
    for (int i = 1; i < 8; ++i) M = fmaxf(M, mw[i]);
    if (has_sink) M = fmaxf(M, sink_l2);
    float lt = has_sink ? fexp2(sink_l2 - M) : 0.f, ot = 0.f;
#pragma unroll
    for (int i = 0; i < 8; ++i) { const float f = fexp2(mw[i] - M); lt += lw[i] * f; ot += ow[i * 64 + lane] * f; }
    float num = 0.f, den = 0.f;
    if (tid < 64) { const float r = ot / lt, y = bf2f(yp[tid]); num = (y - r) * (y - r); den = r * r; }
    num = blk_sum(red, num, tid); den = blk_sum(red, den, tid);
    return num / (den + 1e-20f);
}

__device__ __forceinline__ float diag_ret(LAS float* sm, int tid, const bf16_t* P, size_t rb0, int j, int h, float lgf, float lgb, const float* gnf, const float* gnb, const bf16_t* yp) {
    LAS float* ow = sm;
    LAS float* red = sm + 1024;
    const int lane = tid & 63, w = tid >> 6;
    const float q = bf2f(P[(rb0 + j) * PW + C_RQ + h * 64 + lane]);
    const int posj = (j < CTXL) ? (CTXL - 1 - j) : (CTXL + (NB - 1 - j));
    float of = 0.f, ob = 0.f;
    for (int s = w; s < NB; s += 8) {
        const int poss = (s < CTXL) ? (CTXL - 1 - s) : (CTXL + (NB - 1 - s));
        const bool inf = s <= j, inb = poss <= posj;
        if (!inf && !inb) continue;
        const bf16_t* pr = P + (rb0 + s) * PW + h * 64 + lane;
        const float qk = wave_sum(q * bf2f(pr[C_RK])); const float v = bf2f(pr[C_RV]);
        if (inf) of += fexp2(lgf * (float)(j - s)) * qk * v;
        if (inb) ob += fexp2(lgb * (float)(posj - poss)) * qk * v;
    }
    __syncthreads();
    ow[w * 64 + lane] = of; ow[512 + w * 64 + lane] = ob;
    __syncthreads();
    float tf = 0.f, tb = 0.f;
#pragma unroll
    for (int i = 0; i < 8; ++i) { tf += ow[i * 64 + lane]; tb += ow[512 + i * 64 + lane]; }
    const float muf = wave_sum(tf) * (1.f / 64.f), mub = wave_sum(tb) * (1.f / 64.f);
    const float vf = wave_sum((tf - muf) * (tf - muf)) * (1.f / 64.f), vb = wave_sum((tb - mub) * (tb - mub)) * (1.f / 64.f);
    const float gf = bf2f(P[(rb0 + j) * PW + C_RGF + h * 64 + lane]), gb = bf2f(P[(rb0 + j) * PW + C_RGB + h * 64 + lane]);
    const float r = silu_f(gf) * ((tf - muf) / sqrtf(vf + EPS)) * gnf[h * 64 + lane] + silu_f(gb) * ((tb - mub) / sqrtf(vb + EPS)) * gnb[h * 64 + lane];
    float num = 0.f, den = 0.f;
    if (tid < 64) { const float y = bf2f(yp[tid]); num = (y - r) * (y - r); den = r * r; }
    num = blk_sum(red, num, tid); den = blk_sum(red, den, tid);
    return num / (den + 1e-20f);
}

__device__ __forceinline__ void diag_check(Frame& F, const Inputs& I, unsigned char* ws, unsigned* code) {
    const int tid = F.tid;
    LAS float* sm = (LAS float*)F.lds;
    LAS float* raw = (LAS float*)(F.lds + 4096);
    LAS float* xn = (LAS float*)(F.lds + 4096 + 12544);
    LAS float* red = (LAS float*)(F.lds + 4096 + 12544 + 4096);
    const bf16_t* P = (const bf16_t*)(ws + WS_P); const bf16_t* KV = (const bf16_t*)(ws + WS_KV); const bf16_t* Y = (const bf16_t*)(ws + WS_XN);
    const float* MOD = (const float*)(ws + WS_MOD);
    const float tol = DIAG_TOL;
    for (int sidx = blockIdx.x; sidx < 256; sidx += F.G) {
        const int b = sidx & 3, si = sidx >> 2;
        static const int jl[16] = {0, 17, 128, 255, 256, 257, 256 + 63, 256 + 64, 256 + 127, 256 + 128, 256 + 129, 256 + 8191, 256 + 8064, 256 + 8063, 256 + 4095, 256 + 4160};
        int j; if (si < 16) { j = 0; for (int q = 0; q < 16; ++q) if (q == si) j = jl[q]; } else j = 256 + ((si * 2654435761u) >> 7) % 8192u;
        const int h = (si * 7 + 3) & 3;
        const size_t row = (size_t)b * NB + j;
        const bool isctx = j < CTXL; const int t = j - CTXL, prow = t >> 6, pcol = t & 63;
        {
            const float* xr = isctx ? I.ctx + ((size_t)b * CTXL + j) * DM : I.x + ((size_t)b * SEQ + t) * DM;
            const float* mv = MOD + (isctx ? 4 : b) * 6144;
            float ss = 0.f; for (int k = tid; k < DM; k += NTHR) ss += xr[k] * xr[k];
            ss = blk_sum(red, ss, tid);
            const float rs = 1.0f / sqrtf(ss / DM + EPS);
            for (int k = tid; k < DM; k += NTHR) { const float y = xr[k] * rs * I.norm_mix_g[k] * (1.f + mv[DM + k]) + mv[k]; xn[k] = bf_lo(cvt_pk_bf16(y, 0.f)); }
            __syncthreads();
            for (int c = tid; c < INW; c += NTHR) { float a = 0.f; for (int k = 0; k < DM; ++k) a += xn[k] * bf_lo(cvt_pk_bf16(I.w_in[(size_t)k * INW + c], 0.f)); raw[c] = a; }
            __syncthreads();
            float num = 0.f, den = 0.f;
            for (int c = tid; c < INW; c += NTHR) {
                const int oc = orig_col(c);
                float ref = raw[oc], sc = 1.f;
                int rb = -1, R = 0;
                if (oc < 384) { if (oc % 96 >= 64) { rb = oc - (oc % 96) + 64; R = 32; } sc = 0.10206207261596577f * LOG2E; }
                else if (oc >= C_KR && oc < C_SWAQ) { rb = C_KR; R = 32; }
                else if (oc >= C_SWAQ && oc < C_SWAK) { rb = C_SWAQ + ((oc - C_SWAQ) & ~63); R = 64; sc = 0.125f * LOG2E; }
                else if (oc >= C_SWAK && oc < C_SWAV) { rb = C_SWAK + ((oc - C_SWAK) & ~63); R = 64; }
                else if (oc >= C_NAQ && oc < C_NAK) sc = 0.125f * LOG2E;
                else if (oc >= C_RK && oc < C_RV) sc = 0.125f;
                if (rb >= 0 && !isctx) {
                    const int quarter = R / 4, p = oc - rb, part = p / (R / 2), which = (p % (R / 2)) / quarter, jj = p % quarter;
                    const float inv = __powf(10000.f, -(float)jj / (float)quarter);
                    const float ang = (float)(part ? pcol : prow) * inv;
                    const float rev = ang * 0.15915494309189535f; const float cs = __builtin_amdgcn_cosf(rev), sn = __builtin_amdgcn_sinf(rev);
                    const float x1 = raw[rb + part * (R / 2) + jj], x2 = raw[rb + part * (R / 2) + quarter + jj];
                    ref = which ? (x1 * sn + x2 * cs) : (x1 * cs - x2 * sn);
                }
                ref *= sc;
                const float got = bf2f(P[row * PW + c]);
                num += (got - ref) * (got - ref); den += ref * ref;
            }
            num = blk_sum(red, num, tid); den = blk_sum(red, den, tid);
            if (tid == 0 && num > tol * den) atomicOr(code, 1u);
        }
        {
            const float* g = I.mla_kv_norm_g; const float* wu = I.mla_w_ukv;
            float ss = 0.f; for (int k = tid; k < 128; k += NTHR) { const float v = bf2f(P[row * PW + C_CKV + k]); ss += v * v; }
            ss = blk_sum(red, ss, tid);
            const float rs = 1.0f / sqrtf(ss / 128.f + EPS);
            float num = 0.f, den = 0.f;
            { const int n = tid; float a = 0.f; for (int k = 0; k < 128; ++k) a += bf2f(P[row * PW + C_CKV + k]) * g[k] * wu[k * KVW + n]; a *= rs;
              const float got = bf2f(KV[row * KVW + n]); num = (got - a) * (got - a); den = a * a; }
            num = blk_sum(red, num, tid); den = blk_sum(red, den, tid);
            if (tid == 0 && num > tol * den) atomicOr(code, 16u);
        }
        const size_t rb0 = (size_t)b * NB;
        {
            auto keyfn = [&](int i, size_t& krow, float& bias, bool& valid) { krow = rb0 + i; bias = 0.f; valid = true; };
            const float e = diag_attn<96>(sm, tid, P + row * PW + h * 96, KV, KVW, h * 128, P, PW, C_KR, KV, KVW, h * 128 + 64, isctx ? CTXL : NB, keyfn, 0.f, false, Y + row * DM + h * 64);
            if (tid == 0 && e > tol) atomicOr(code, 2u);
        }
        {
            const int g = h >> 1;
            auto keyfn = [&](int i, size_t& krow, float& bias, bool& valid) { krow = rb0 + i; bias = 0.f;
                if (i < CTXL) valid = true; else { const int kp = i - CTXL; valid = (kp - t <= 128) && (t - kp <= 128); } };
            const float e = diag_attn<64>(sm, tid, P + row * PW + C_SWAQ + h * 64, P, PW, C_SWAK + g * 64, P, PW, 0, P, PW, C_SWAV + g * 64, isctx ? CTXL : NB, keyfn,
                                          I.swa_sink[h] * LOG2E, true, Y + row * DM + 256 + h * 64);
            if (tid == 0 && e > tol) atomicOr(code, 4u);
        }
        {
            int rs = prow - 4; rs = rs < 0 ? 0 : (rs > 120 ? 120 : rs); int cs = pcol - 8; cs = cs < 0 ? 0 : (cs > 48 ? 48 : cs);
            const float* rpb = I.na_rpb + h * 15 * 31;
            auto keyfn = [&](int i, size_t& krow, float& bias, bool& valid) { krow = rb0 + i; bias = 0.f;
                if (i < CTXL) valid = true; else { const int kp = i - CTXL, kr = kp >> 6, kc = kp & 63; valid = (kr >= rs && kr < rs + 8 && kc >= cs && kc < cs + 16);
                    if (valid) bias = rpb[(kr - prow + 7) * 31 + (kc - pcol + 15)] * LOG2E; } };
            const float e = diag_attn<64>(sm, tid, P + row * PW + C_NAQ + h * 64, P, PW, C_NAK + h * 64, P, PW, 0, P, PW, C_NAV + h * 64, isctx ? CTXL : NB, keyfn, 0.f, false, Y + row * DM + 512 + h * 64);
            if (tid == 0 && e > tol) atomicOr(code, 8u);
        }
        {
            const float e = diag_ret(sm, tid, P, rb0, j, h, log2_sigmoid(I.ret_decay_f[h]), log2_sigmoid(I.ret_decay_b[h]), I.ret_gn_f, I.ret_gn_b, Y + row * DM + 768 + h * 64);
            if (tid == 0 && e > tol) atomicOr(code, 32u);
        }
    }
}
#endif
constexpr int N_PHASES = 26;
#ifndef MK_SINGLE
#define MK_SINGLE 1
#endif
__device__ __forceinline__ Frame fresh(const Frame& F) { Frame f = F; int ln = lane_id(); asm volatile("" : "+v"(ln)); f.lane = ln; f.tid = F.wave * 64 + ln; return f; }
struct Args { Inputs in; float* out; unsigned char* ws; int ph_lo, ph_hi, li, pad; };

__global__ void __launch_bounds__(NTHR, 2) fwd_kernel(Args args) {
    extern __shared__ __attribute__((aligned(16))) unsigned char lds_raw[];
    Frame F;
    F.lds = (LAS unsigned char*)lds_raw;
    F.tid = threadIdx.x; F.lane = F.tid & 63; F.wave = __builtin_amdgcn_readfirstlane(F.tid >> 6);
    F.G = gridDim.x; { const int bx = blockIdx.x; F.vcu = (F.G % 8 == 0) ? (bx % 8) * (F.G / 8) + bx / 8 : bx; }
    typedef const __attribute__((address_space(4))) Args* KArgP;
    const KArgP kap = (KArgP)__builtin_amdgcn_kernarg_segment_ptr();
#define KARGV(f) ({ KArgP _p = kap; asm volatile("" : "+s"(_p)); _p->f; })
#define KARG(f) as_global(KARGV(f))
    unsigned char* ws = KARGV(ws);
    volatile LAS unsigned* MISC = (volatile LAS unsigned*)(F.lds + MISC_OFF);
    for (int u = F.tid; u < (LDS_BYTES - LDSCTL_OFF) / 4; u += NTHR) ((LAS unsigned*)(F.lds + LDSCTL_OFF))[u] = 0u;
    __syncthreads();
    unsigned* ctl = (unsigned*)(ws + WS_CTL);
    XcdBarrier bar = xcd_barrier_post(ctl + CW_BAR + KARGV(li) * XCD_BAR_WORDS, MISC + 8);
    const int lo = KARGV(ph_lo), hi = KARGV(ph_hi);
#ifndef PH_MASK
#define PH_MASK 0x3ff
#endif
#define PHM(j) ((PH_MASK >> (j)) & 1)
#ifndef UM
#define UM 0xff
#endif
#ifndef REP_J
#define REP_J -1
#define REP_N 1
#endif
#define REPS(j) for (int rep_ = 0; rep_ < ((REP_J == (j)) ? REP_N : 1); ++rep_)
#define IN(k) ({ int lo_ = lo, hi_ = hi; asm volatile("" : "+s"(lo_), "+s"(hi_)); lo_ <= (k) && (k) < hi_; })
#if defined(TPH) || defined(TPB)
#define TSTAMP(k) do { if (blockIdx.x == 0 && threadIdx.x == 0) __hip_atomic_store(ctl + 32 + (k), (unsigned)wall_clock64() | 1u, __ATOMIC_RELAXED, __HIP_MEMORY_SCOPE_AGENT); } while (0)
#else
#define TSTAMP(k) do { } while (0)
#endif
#ifdef TPB
#define BSTAMP(k) do { if ((k) == (TPB) && threadIdx.x == 0) __hip_atomic_store(ctl + 64 + blockIdx.x, (unsigned)wall_clock64() | 1u, __ATOMIC_RELAXED, __HIP_MEMORY_SCOPE_AGENT); } while (0)
#else
#define BSTAMP(k) do { } while (0)
#endif
#define SEAM(k) do { if (IN(k) && IN((k) + 1)) { BSTAMP(k); xcd_barrier(bar); TSTAMP((k) + 1); } } while (0)

#define WSQ() unsigned char* wsq_ = ws; asm volatile("" : "+s"(wsq_)); unsigned char* wsq = as_global(wsq_); \
    float* MOD = (float*)(wsq + WS_MOD); bf16_t* XN = (bf16_t*)(wsq + WS_XN); bf16_t* P = (bf16_t*)(wsq + WS_P); bf16_t* KV = (bf16_t*)(wsq + WS_KV); float* SSQ = (float*)(wsq + WS_SSQ); \
    float* XC = (float*)(wsq + WS_XC); float* RS = (float*)(wsq + WS_RS); unsigned char* UB = wsq + WS_UB; unsigned char* VB = wsq + WS_VB; _Float16* S16 = (_Float16*)(wsq + WS_P); \
    int* EID = (int*)(wsq + WS_KV); float* GATE = (float*)(wsq + WS_GATE); bf16_t* XB = (bf16_t*)(wsq + WS_XB); const float* mod = MOD + (size_t)l * 5 * 6144; \
    const float* xl_cur = (l == 0) ? KARG(in.x) : (const float*)nullptr; const float* xc_cur = (l == 0) ? KARG(in.ctx) : XC; \
    (void)XN; (void)P; (void)KV; (void)SSQ; (void)XC; (void)RS; (void)UB; (void)VB; (void)S16; (void)EID; (void)GATE; (void)XB; (void)mod; (void)xl_cur; (void)xc_cur;

    TSTAMP(0);
    if (IN(0)) REPS(100) { { const Inputs Iv = args.in; phase_prologue(F, Iv, as_global(ws)); }; }
    SEAM(0);

#pragma nounroll
    for (int l0 = 0; l0 < NLAYER; ++l0) {
        int l = l0; asm volatile("" : "+s"(l));
        const int pb = 1 + 12 * l;
        const bool last = (l == NLAYER - 1);

        if (PHM(0) && IN(pb + 0)) REPS(0) { Frame Fq = fresh(F); WSQ();
            phase_norm_mod(Fq, xl_cur, XB, xc_cur, KARG(in.norm_mix_g) + l * DM, mod, 0, XN, false, SSQ);
            phase_convert_uv(Fq, KARG(in.peer_u) + (size_t)l * NEXP * DM, KARG(in.peer_v) + (size_t)l * NEXP * DM, wsq);
        }
        SEAM(pb + 0);

        if (PHM(1) && IN(pb + 1)) REPS(1) { Frame Fq = fresh(F); WSQ();
            pg8::Gemm g{XN, (const bf16_t*)(wsq + WS_WIN) + (size_t)l * PW * DM};
            pg8::LinOrder S{PW / 256, (NROW / 256) * (PW / 256), Fq.G, Fq.vcu, 0};
            pg8::EpiProj E{P, SSQ, (const f32x2*)(wsq + WS_TAB), (const f32x2*)(wsq + WS_TAB + 16384)};
            pg8::gemm_phase<pg8::EpiProj, pg8::LinOrder, DM, DM, DM, true>(Fq.lds, Fq.wave, g, S, E);
        }
        SEAM(pb + 1);

        if (PHM(2) && IN(pb + 2)) REPS(2) { Frame Fq = fresh(F); WSQ();
            {
                pg8::Gemm g{P + C_CKV, (const bf16_t*)(wsq + WS_WUKV) + (size_t)l * KVW * 128};
                pg8::LinOrder S{KVW / 256, (NROW / 256) * (KVW / 256), Fq.G, Fq.vcu, 0};
                pg8::EpiKV E{KV, SSQ};
                pg8::gemm_phase<pg8::EpiKV, pg8::LinOrder, 128, PW, 128, true>(Fq.lds, Fq.wave, g, S, E);
            }
            __syncthreads();
            const RetArgs RA{P, XN, RS, KARG(in.ret_decay_f) + l * 4, KARG(in.ret_decay_b) + l * 4, KARG(in.ret_gn_f) + l * 256, KARG(in.ret_gn_b) + l * 256};
            const AttnArgs AA{P, KV, XN, KARG(in.swa_sink) + l * 4, KARG(in.na_rpb) + (size_t)l * 4 * 15 * 31};
            const int n_ctx = last ? 0 : 16;
            if (UM & 1) REPS(21) for (int u = Fq.vcu; u < 512; u += Fq.G) attn_unit<AT_SWA, false>(Fq, AA, u);
            if (UM & 2) REPS(22) for (int u = Fq.vcu; u < 512; u += Fq.G) attn_unit<AT_NA, false>(Fq, AA, u);
            if (UM & 4) REPS(23) ret_local_loop(Fq, RA, (Fq.vcu + 128) % Fq.G, Fq.G, 16 * 66);
            if (UM & 8) for (int u = (Fq.vcu + 32) % Fq.G; u < n_ctx; u += Fq.G) attn_unit<AT_SWA, true>(Fq, AA, u);
            if (UM & 16) for (int u = (Fq.vcu + 48) % Fq.G; u < n_ctx; u += Fq.G) attn_unit<AT_NA, true>(Fq, AA, u);
        }
        SEAM(pb + 2);

        if (PHM(3) && IN(pb + 3)) { Frame Fq = fresh(F); WSQ();
            const RetArgs RA{P, XN, RS, KARG(in.ret_decay_f) + l * 4, KARG(in.ret_decay_b) + l * 4, KARG(in.ret_gn_f) + l * 256, KARG(in.ret_gn_b) + l * 256};
            ret_scan(Fq, RA);
        }
        SEAM(pb + 3);

        if (PHM(4) && IN(pb + 4)) REPS(4) { Frame Fq = fresh(F); WSQ();
            const RetArgs RA{P, XN, RS, KARG(in.ret_decay_f) + l * 4, KARG(in.ret_decay_b) + l * 4, KARG(in.ret_gn_f) + l * 256, KARG(in.ret_gn_b) + l * 256};
            const AttnArgs AA{P, KV, XN, KARG(in.swa_sink) + l * 4, KARG(in.na_rpb) + (size_t)l * 4 * 15 * 31};
            const int n_ctx = last ? 0 : 16;
#if REP_J == 40
            for (int rep_ = 0; rep_ < REP_N - 1; ++rep_) for (int u = Fq.vcu; u < 512; u += Fq.G) attn_unit<AT_MLA, false, true>(Fq, AA, u);
#endif
            if (UM & 32) for (int u = Fq.vcu; u < 512; u += Fq.G) attn_unit<AT_MLA, false>(Fq, AA, u);
            if (UM & 64) for (int u = (Fq.vcu + Fq.G - 16) % Fq.G; u < n_ctx; u += Fq.G) attn_unit<AT_MLA, true>(Fq, AA, u);
            if (UM & 128) REPS(41) ret_out_loop(Fq, RA, (Fq.vcu + 16) % Fq.G, Fq.G, 16 * 66, last);
        }
        SEAM(pb + 4);

        if (PHM(5) && IN(pb + 5)) { Frame Fq = fresh(F); WSQ();
            pg8::Gemm g{XN, (const bf16_t*)(wsq + WS_WOUT) + (size_t)l * DM * DM};
            pg8::LinOrder S{DM / 256, (last ? 128 : 132) * (DM / 256), Fq.G, Fq.vcu, last ? 1 : 0};
            pg8::EpiResid E{xl_cur, XB, xc_cur, XC, mod};
            pg8::gemm_phase<pg8::EpiResid, pg8::LinOrder, DM, DM, DM, true>(Fq.lds, Fq.wave, g, S, E);
        }
        SEAM(pb + 5);

#if REP_J == 60
        for (int rg_ = 0; rg_ < REP_N; ++rg_) {
#endif
        if (PHM(6) && IN(pb + 6)) REPS(6) { Frame Fq = fresh(F); WSQ(); phase_norm_mod<true>(Fq, nullptr, XB, XC, KARG(in.norm_ffn_g) + l * DM, mod, 3, XN, last, nullptr, wsq + WS_XQ, (float*)(wsq + WS_XSC)); }
        SEAM(pb + 6);
#ifdef EXTRA_BAR
        if (IN(pb + 6) && IN(pb + 7)) for (int eb = 0; eb < EXTRA_BAR; ++eb) xcd_barrier(bar);
#endif

#if REP_J == 70
        if (PHM(7) && IN(pb + 7)) for (int rep_ = 0; rep_ < REP_N - 1; ++rep_) { Frame Fq = fresh(F); WSQ();
            pg8::Gemm g{XN, (const bf16_t*)(wsq + WS_WSC) + (size_t)l * 2048 * DM};
            pg8::LinOrder S{2048 / 256, (last ? 128 : 132) * (2048 / 256), Fq.G, Fq.vcu, last ? 1 : 0};
            pg8::EpiNull E{(float*)(wsq + WS_CTL + 4096)};
            pg8::gemm_phase<pg8::EpiNull, pg8::LinOrder, DM, DM, DM, true>(Fq.lds, Fq.wave, g, S, E); }
#endif
        if (PHM(7) && IN(pb + 7)) REPS(7) { Frame Fq = fresh(F); WSQ();
            pg8::Gemm g{XN, (const bf16_t*)(wsq + WS_WSC) + (size_t)l * 2048 * DM};
            pg8::LinOrder S{2048 / 256, (last ? 128 : 132) * (2048 / 256), Fq.G, Fq.vcu, last ? 1 : 0};
            pg8::EpiScore E{S16};
            pg8::gemm_phase<pg8::EpiScore, pg8::LinOrder, DM, DM, DM, true>(Fq.lds, Fq.wave, g, S, E);
        }
        SEAM(pb + 7);

        if (PHM(8) && IN(pb + 8)) REPS(8) { Frame Fq = fresh(F); WSQ(); phase_topk(Fq, S16, EID, GATE, last); }
        SEAM(pb + 8);

#if REP_J == 90
        if (PHM(9) && IN(pb + 9)) for (int rep_ = 0; rep_ < REP_N - 1; ++rep_) { Frame Fq = fresh(F); WSQ(); phase_peer_u<true>(Fq, wsq + WS_XQ, (const float*)(wsq + WS_XSC), UB, (const unsigned*)EID, (float*)(wsq + WS_P), last); }
#endif
        if (PHM(9) && IN(pb + 9)) REPS(9) { Frame Fq = fresh(F); WSQ(); phase_peer_u(Fq, wsq + WS_XQ, (const float*)(wsq + WS_XSC), UB, (const unsigned*)EID, (float*)(wsq + WS_P), last); }
        SEAM(pb + 9);

        if (PHM(9) && IN(pb + 10)) { Frame Fq = fresh(F); WSQ(); phase_peer_w(Fq, (const float*)(wsq + WS_P), GATE, last); }
        SEAM(pb + 10);
#if REP_J == 60
        }
#endif

        if (PHM(9) && IN(pb + 11)) REPS(11) { Frame Fq = fresh(F); WSQ(); float vsc = 1.0f;
#ifdef PEER_SCALE
            vsc = PEER_SCALE;
#endif
            if (REP_J == 11) { vsc = (rep_ == REP_N - 1) ? 1.0f : 0.0f; asm volatile("" : "+v"(vsc)); }
            phase_peer_v(Fq, VB, (const unsigned*)EID, GATE, XB, XC, mod, last, vsc); }
        SEAM(pb + 11);
    }

#if DIAG
    if (IN(25)) { const float dsc = 1.0f + 0.05f * (float)__hip_atomic_load(ctl + 8, __ATOMIC_RELAXED, __HIP_MEMORY_SCOPE_AGENT); { Frame Fq = fresh(F); phase_final_norm(Fq, (const bf16_t*)as_global(ws + WS_XB), KARG(out), KARG(in.final_norm_g), dsc); } }
#elif defined(TPB)
    if (IN(25)) { unsigned t0; do { t0 = __hip_atomic_load(ctl + 32 + TPB, __ATOMIC_RELAXED, __HIP_MEMORY_SCOPE_AGENT); } while (t0 == 0u);
        int mn = 0x7fffffff, mx = 0;
#ifndef TPB_XQ
#define TPB_XQ -1
#endif
        for (int b = 0; b < (int)gridDim.x; ++b) { if (TPB_XQ >= 0 && (b & 7) != TPB_XQ) continue; const int d = (int)(__hip_atomic_load(ctl + 64 + b, __ATOMIC_RELAXED, __HIP_MEMORY_SCOPE_AGENT) - t0); mn = d < mn ? d : mn; mx = d > mx ? d : mx; }
        int b1 = (mn - (TP_OFF) * 100) / ((TP_UNIT) * 100), b2 = (mx - (TP_OFF2) * 100) / ((TP_UNIT2) * 100);
        b1 = b1 < 0 ? 0 : (b1 > 6 ? 6 : b1); b2 = b2 < 0 ? 0 : (b2 > 5 ? 5 : b2);
        const float dsc = 1.0f + 0.05f * (float)(b1 + 7 * b2);
        { Frame Fq = fresh(F); phase_final_norm(Fq, (const bf16_t*)as_global(ws + WS_XB), KARG(out), KARG(in.final_norm_g), dsc); } }
#elif defined(TPH)
    if (IN(25)) { unsigned ta, tb, tc, td; do { ta = __hip_atomic_load(ctl + 32 + TP_A, __ATOMIC_RELAXED, __HIP_MEMORY_SCOPE_AGENT); tb = __hip_atomic_load(ctl + 32 + TP_B, __ATOMIC_RELAXED, __HIP_MEMORY_SCOPE_AGENT);
            tc = __hip_atomic_load(ctl + 32 + TP_A2, __ATOMIC_RELAXED, __HIP_MEMORY_SCOPE_AGENT); td = __hip_atomic_load(ctl + 32 + TP_B2, __ATOMIC_RELAXED, __HIP_MEMORY_SCOPE_AGENT); } while (ta == 0u || tb == 0u || tc == 0u || td == 0u);
        int b1 = ((int)(tb - ta) - (TP_OFF) * 100) / ((TP_UNIT) * 100), b2 = ((int)(td - tc) - (TP_OFF2) * 100) / ((TP_UNIT2) * 100);
        b1 = b1 < 0 ? 0 : (b1 > 6 ? 6 : b1); b2 = b2 < 0 ? 0 : (b2 > 5 ? 5 : b2);
        const float dsc = 1.0f + 0.05f * (float)(b1 + 7 * b2);
        { Frame Fq = fresh(F); phase_final_norm(Fq, (const bf16_t*)as_global(ws + WS_XB), KARG(out), KARG(in.final_norm_g), dsc); } }
#else
    if (IN(25)) { { Frame Fq = fresh(F); phase_final_norm(Fq, (const bf16_t*)as_global(ws + WS_XB), KARG(out), KARG(in.final_norm_g), 1.0f); } }
#endif
#undef IN
#undef SEAM
}

#if DIAG
__global__ void __launch_bounds__(NTHR, 2) diag_kernel(Args args) {
    extern __shared__ __attribute__((aligned(16))) unsigned char lds_raw[];
    Frame F; F.lds = (LAS unsigned char*)lds_raw; F.tid = threadIdx.x; F.lane = F.tid & 63; F.wave = __builtin_amdgcn_readfirstlane(F.tid >> 6); F.G = gridDim.x; F.vcu = blockIdx.x;
    diag_check(F, args.in, args.ws, (unsigned*)(args.ws + WS_CTL) + 8);
}
#endif
extern "C" void kernel_launch(void* const* d_in, const int* in_sizes, int n_in, void* d_out, int out_size, void* d_ws, size_t ws_size, hipStream_t stream) {
    static int grid = 0;
    if (grid == 0) {
        if (n_in != 25 || in_sizes[0] != NBATCH * SEQ * DM || out_size != NBATCH * SEQ * DM || ws_size < WS_END) {
            fprintf(stderr, "kernel_launch: unexpected problem (n_in %d, in0 %d, out %d, ws %zu < %zu); nothing launched\n", n_in, n_in > 0 ? in_sizes[0] : -1, out_size, ws_size, (size_t)WS_END); grid = -1; return; }
        int dev = 0, cus = 0, per_cu = 0;
        if (hipGetDevice(&dev) != hipSuccess || hipDeviceGetAttribute(&cus, hipDeviceAttributeMultiprocessorCount, dev) != hipSuccess) { grid = -1; return; }
#if DIAG
        (void)hipFuncSetAttribute((const void*)diag_kernel, hipFuncAttributeMaxDynamicSharedMemorySize, LDS_BYTES);
#endif
        if (hipFuncSetAttribute((const void*)fwd_kernel, hipFuncAttributeMaxDynamicSharedMemorySize, LDS_BYTES) != hipSuccess) { fprintf(stderr, "kernel_launch: hipFuncSetAttribute failed\n"); grid = -1; return; }
        if (hipOccupancyMaxActiveBlocksPerMultiprocessor(&per_cu, (const void*)fwd_kernel, NTHR, LDS_BYTES) != hipSuccess || per_cu < 1) {
            fprintf(stderr, "kernel_launch: occupancy query reports %d workgroups per CU\n", per_cu); (void)hipGetLastError(); if (per_cu < 1) { grid = -1; return; } }
        grid = cus;
    }
    if (grid < 0) return;
    (void)hipMemsetAsync((char*)d_ws + WS_CTL, 0, CTL_ZERO_BYTES, stream);
    Args a{};
    const float** ip = (const float**)&a.in;
    for (int i = 0; i < 25; ++i) ip[i] = (const float*)d_in[i];
    a.out = (float*)d_out; a.ws = (unsigned char*)d_ws;
#if DIAG
    a.ph_lo = 0; a.ph_hi = 6; a.li = 0; hipLaunchKernelGGL(fwd_kernel, dim3(grid), dim3(NTHR), LDS_BYTES, stream, a);
    hipLaunchKernelGGL(diag_kernel, dim3(grid), dim3(NTHR), LDS_BYTES, stream, a);
    a.ph_lo = 6; a.ph_hi = N_PHASES; a.li = 1; hipLaunchKernelGGL(fwd_kernel, dim3(grid), dim3(NTHR), LDS_BYTES, stream, a);
#elif MK_SINGLE
    a.ph_lo = 0; a.ph_hi = N_PHASES;
    hipLaunchKernelGGL(fwd_kernel, dim3(grid), dim3(NTHR), LDS_BYTES, stream, a);
#else
    for (int p = 0; p < N_PHASES; ++p) { a.ph_lo = p; a.ph_hi = p + 1; hipLaunchKernelGGL(fwd_kernel, dim3(grid), dim3(NTHR), LDS_BYTES, stream, a); }
#endif
}
```

```cpp
#include <hip/hip_runtime.h>
#include <cstdio>
#include <cstdint>

#define GAS __attribute__((address_space(1)))
#define LAS __attribute__((address_space(3)))
typedef unsigned short bf16_t;
typedef short bf16x8 __attribute__((ext_vector_type(8)));
typedef float f32x4 __attribute__((ext_vector_type(4)));
typedef float f32x2 __attribute__((ext_vector_type(2)));
typedef float f32x16 __attribute__((ext_vector_type(16)));
typedef unsigned u32x4 __attribute__((ext_vector_type(4)));
typedef unsigned u32x2 __attribute__((ext_vector_type(2)));

constexpr int NBATCH = 4, SEQ = 8192, CTXL = 256, DM = 1024, NLAYER = 2;
constexpr int NB = SEQ + CTXL;
constexpr int NROW = NBATCH * NB;
constexpr int PW = 3328;
constexpr int INW = 3104;
constexpr int KVW = 512;
constexpr int C_MLAQ = 0, C_CKV = 384, C_KR = 512, C_SWAQ = 544, C_SWAK = 800, C_SWAV = 928, C_NAQ = 1056, C_NAK = 1312, C_NAV = 1568,
              C_RQ = 1824, C_RK = 2080, C_RV = 2336, C_RGF = 2592, C_RGB = 2848;
constexpr int NEXP = 16384, PEER_K = 128;
constexpr float LOG2E = 1.4426950408889634f;
constexpr float EPS = 1e-6f;

constexpr size_t MiB = 1u << 20;
constexpr size_t WS_CTL = 0, CTL_ZERO_BYTES = 1 * MiB;
constexpr size_t WS_MOD = 1 * MiB;
constexpr size_t WS_TAB = 2 * MiB;
constexpr size_t WS_WIN = 3 * MiB;
constexpr size_t WS_WOUT = 17 * MiB;
constexpr size_t WS_WSC = 21 * MiB;
constexpr size_t WS_WUKV = 29 * MiB;
constexpr size_t WS_SSQ = 30 * MiB;
constexpr size_t WS_XC = 31 * MiB;
constexpr size_t WS_UB = 35 * MiB;
constexpr size_t WS_VB = 67 * MiB;
constexpr size_t WS_XN = 99 * MiB;
constexpr size_t WS_P = 165 * MiB;
constexpr size_t WS_XQ = 300 * MiB;
constexpr size_t WS_XSC = 334 * MiB;
constexpr size_t WS_KV = 380 * MiB;
constexpr size_t WS_GATE = WS_KV + (size_t)NROW * 128 * 4;
constexpr size_t WS_RS = 413 * MiB;
constexpr size_t WS_XB = 446 * MiB;
constexpr size_t WS_END = 510 * MiB;
static_assert(WS_P + (size_t)NROW * 2048 * 2 <= WS_XQ && WS_XQ + (size_t)NROW * DM <= WS_XSC && WS_XSC + (size_t)NROW * 16 <= WS_KV, "ws map (ffn)");
static_assert(WS_WIN + (size_t)2 * PW * DM * 2 <= WS_WOUT && WS_XN + (size_t)NROW * DM * 2 <= WS_P && WS_P + (size_t)NROW * PW * 2 <= WS_KV &&
              WS_KV + (size_t)NROW * KVW * 2 <= WS_RS && WS_GATE + (size_t)NROW * 128 * 4 <= WS_RS && WS_RS + (size_t)32 * 66 * 4096 * 4 <= WS_XB && WS_XB + (size_t)NBATCH * SEQ * DM * 2 <= WS_END, "ws map");
constexpr int CW_TMO = 0, CW_BAR = 4096;

constexpr int RING_BYTES = 131072;
constexpr int LDSCTL_OFF = RING_BYTES, MISC_OFF = LDSCTL_OFF + 320;
constexpr int LDS_BYTES = 147456;
constexpr int NWAVES = 8, NTHR = 512;

__device__ __forceinline__ unsigned cvt_pk_bf16(float lo, float hi) { unsigned r; asm volatile("v_cvt_pk_bf16_f32 %0, %1, %2" : "=v"(r) : "v"(lo), "v"(hi)); return r; }
__device__ __forceinline__ float bf_lo(unsigned w) { return __uint_as_float(w << 16); }
__device__ __forceinline__ float bf_hi(unsigned w) { return __uint_as_float(w & 0xffff0000u); }
__device__ __forceinline__ float bf2f(bf16_t h) { return __uint_as_float((unsigned)h << 16); }
__device__ __forceinline__ int lane_id() { unsigned z = 0u; asm volatile("" : "+v"(z)); return (int)__builtin_amdgcn_mbcnt_hi(~0u, __builtin_amdgcn_mbcnt_lo(~0u, z)); }
template <int M> __device__ __forceinline__ float xshfl(float v) {
    if constexpr (M == 32) { auto rr = __builtin_amdgcn_permlane32_swap(__float_as_uint(v), __float_as_uint(v), false, false);
        return __uint_as_float((lane_id() & 32) ? rr[0] : rr[1]); }
    else return __uint_as_float((unsigned)__builtin_amdgcn_ds_swizzle((int)__float_as_uint(v), (M << 10) | 0x1F));
}
__device__ __forceinline__ float xsum32(float v) { auto rr = __builtin_amdgcn_permlane32_swap(__float_as_uint(v), __float_as_uint(v), false, false); return __uint_as_float(rr[0]) + __uint_as_float(rr[1]); }
__device__ __forceinline__ float xmax32(float v) { auto rr = __builtin_amdgcn_permlane32_swap(__float_as_uint(v), __float_as_uint(v), false, false); return fmaxf(__uint_as_float(rr[0]), __uint_as_float(rr[1])); }
__device__ __forceinline__ float wave_sum(float v) {
    v += xshfl<1>(v); v += xshfl<2>(v); v += xshfl<4>(v); v += xshfl<8>(v); v += xshfl<16>(v); return xsum32(v);
}
__device__ __forceinline__ float fexp2(float x) { return __builtin_amdgcn_exp2f(x); }
__device__ __forceinline__ float silu_f(float x) { return x / (1.f + __expf(-x)); }
template <class T> __device__ __forceinline__ T* as_global(T* p) { return (T*)(GAS T*)p; }
#define LDS_WAIT() asm volatile("s_waitcnt lgkmcnt(0)" ::: "memory")
#define VM_WAIT() asm volatile("s_waitcnt vmcnt(0)" ::: "memory")

#define XB_TMO      128
#define XB_XCNT(j)  (256  + 64 * (j))
#define XB_XSUB(j)  (1280 + 64 * (j))
#define XB_XGEN(j)  (2304 + 64 * (j))
#define XB_TOP      3328
#define XB_TOPGEN   3392
#define XCD_BAR_WORDS 3456
#define XB_SPIN_CAP (1u << 18)
__device__ __forceinline__ unsigned xb_ld(unsigned* p)              { return __hip_atomic_load(p, __ATOMIC_RELAXED, __HIP_MEMORY_SCOPE_AGENT); }
__device__ __forceinline__ unsigned xb_add(unsigned* p, unsigned v) { return __hip_atomic_fetch_add(p, v, __ATOMIC_RELAXED, __HIP_MEMORY_SCOPE_AGENT); }
__device__ __forceinline__ unsigned xb_xcc_id() { return (unsigned)__builtin_amdgcn_s_getreg((3 << 11) | 20) & 0xFu; }
#define XB_SPIN(cond, bar) do { unsigned _sp = 0; while (cond) { __builtin_amdgcn_s_sleep(1); \
    if ((++_sp & 255u) == 0u) { if (xb_ld(&(bar)[XB_TMO])) break; if (_sp > XB_SPIN_CAP) { atomicAdd(&(bar)[XB_TMO], 1u); break; } } } } while (0)
struct XcdBarrier { unsigned* bar; unsigned x; volatile LAS unsigned* st; };
__device__ __forceinline__ XcdBarrier xcd_barrier_post(unsigned* bar, volatile LAS unsigned* st) {
    XcdBarrier b; b.bar = bar; b.x = xb_xcc_id(); b.st = st;
    if (threadIdx.x == 0) (void)xb_add(&bar[XB_XCNT(b.x)], 1u);
    return b;
}
__device__ __forceinline__ void xcd_barrier_complete(unsigned* bar, unsigned x, unsigned& nloc, unsigned& nx) {
    const unsigned G = gridDim.x * gridDim.y * gridDim.z;
    unsigned sum, cnt, mine, sp = 0u;
    for (;;) {
        sum = 0u; cnt = 0u; mine = 0u;
#pragma unroll
        for (unsigned j = 0; j < 16; ++j) { const unsigned c = xb_ld(&bar[XB_XCNT(j)]); sum += c; cnt += (c > 0u) ? 1u : 0u; mine = (j == x) ? c : mine; }
        if (sum == G) break;
        __builtin_amdgcn_s_sleep(1);
        if ((++sp & 255u) == 0u) { if (xb_ld(&bar[XB_TMO])) break; if (sp > XB_SPIN_CAP) { atomicAdd(&bar[XB_TMO], 1u); break; } }
    }
    nloc = mine > 0u ? mine : 1u; nx = cnt > 0u ? cnt : 1u;
}
__device__ __forceinline__ void xcd_barrier(const XcdBarrier& b) {
    asm volatile("s_waitcnt vmcnt(0)" ::: "memory");
    __syncthreads();
    if (threadIdx.x == 0) {
        unsigned* bar = b.bar;
        __builtin_amdgcn_s_waitcnt(0);
        unsigned nloc = b.st[0], nx = b.st[1];
        if (nloc == 0u) { unsigned xo = b.x; asm volatile("" : "+s"(xo)); xcd_barrier_complete(bar, xo, nloc, nx); b.st[0] = nloc; b.st[1] = nx; }
        const unsigned old = xb_add(&bar[XB_XSUB(b.x)], 1u);
        const unsigned gen = old / nloc;
        if (old + 1u == (gen + 1u) * nloc) {
            __builtin_amdgcn_fence(__ATOMIC_RELEASE, "agent");
            asm volatile("s_waitcnt vmcnt(0)" ::: "memory");
            const unsigned og = xb_add(&bar[XB_TOP], 1u);
            const unsigned tg = og / nx;
            if (og + 1u == (tg + 1u) * nx) xb_add(&bar[XB_TOPGEN], 1u);
            else XB_SPIN(xb_ld(&bar[XB_TOPGEN]) == tg, bar);
            __builtin_amdgcn_fence(__ATOMIC_ACQUIRE, "agent");
            xb_add(&bar[XB_XGEN(b.x)], 1u);
            asm volatile("s_waitcnt vmcnt(0)" ::: "memory");
        } else {
            XB_SPIN(xb_ld(&bar[XB_XGEN(b.x)]) == gen, bar);
            __builtin_amdgcn_fence(__ATOMIC_ACQUIRE, "agent");
            asm volatile("s_waitcnt vmcnt(0)" ::: "memory");
        }
    }
    __syncthreads();
}
namespace pg8 {
constexpr int BM = 256, BK = 64, HALF = 128, HTB = HALF * BK * 2, STAGE_BYTES = 8 * HTB;
__host__ __device__ __forceinline__ int lds_byte(int r, int c) { const int st = (r >> 4) * 2 + (c >> 5), rr = r & 15, cc = c & 31, ob = rr * 64 + cc * 2; return st * 1024 + (ob ^ (((ob >> 9) & 1) << 5)); }
__host__ __device__ __forceinline__ void stage_rc(int b, int& R, int& C) { const int st = b / 1024, sb = b % 1024, swz = sb ^ (((sb >> 9) & 1) << 5); R = (st >> 1) * 16 + swz / 64; C = (st & 1) * 32 + (swz % 64) / 2; }
__host__ __device__ __forceinline__ int perm32(int rho) { const int n = rho >> 4, i = rho & 15; return 8 * (i >> 2) + 4 * n + (i & 3); }
struct Unit { int pm, pn; };
struct Gemm { const bf16_t* A; const bf16_t* Bt; };

struct LinOrder {
    int nN, nUnits, G, c, skipctx;
    __device__ __forceinline__ bool next(int i, Unit& u) const {
        const int L = i * G + c; if (L >= nUnits) return false;
        const int pmv = L / nN; u.pn = L - pmv * nN; u.pm = skipctx ? (pmv + pmv / 32 + 1) : pmv; return true;
    }
    __device__ __forceinline__ void a_ready(const Unit&) const {}
    __device__ __forceinline__ void done(const Unit&) const {}
};

template <class Epi, class Sched, int KDIM, int LDA, int LDB, bool ALIGN_EPI = false>
__device__ __forceinline__ void gemm_phase(LAS unsigned char* lds, int wave_sgpr, const Gemm g, const Sched& S, const Epi& E) {
    const int wid = __builtin_amdgcn_readfirstlane(wave_sgpr); int lane = lane_id(); asm volatile("" : "+v"(lane)); const int tid = wid * 64 + lane;
    const int wr = wid >> 2, wc = wid & 3, fr = lane & 15, fq = lane >> 4;
    int nt = KDIM / BK; asm volatile("" : "+s"(nt));
    unsigned voffA[2], voffB[2];
#pragma unroll
    for (int i = 0; i < 2; ++i) { int R, C; stage_rc(tid * 16 + i * 8192, R, C); const int Rb = Epi::PERM ? (64 * (R >> 5) + perm32(R & 31)) : R;
        voffA[i] = (unsigned)(R * LDA + C) * 2u; voffB[i] = (unsigned)(Rb * LDB + C) * 2u; }
    constexpr size_t kstep = (size_t)(BK * 2);
    constexpr size_t hstepA = (size_t)HALF * LDA * 2, hstepB = (size_t)(Epi::PERM ? 32 : HALF) * LDB * 2;
    constexpr size_t tstepA = (size_t)BM * LDA * 2, tstepB = (size_t)BM * LDB * 2;
    const unsigned ldsw = (unsigned)wid * 1024u;
    const int aoff = lds_byte(wr * 64 + fr, fq * 8), boff = lds_byte(wc * 32 + fr, fq * 8);
#define PG8_SA(b, h) (((b) * 2 + (h)) * HTB)
#define PG8_SB(b, h) ((4 + (b) * 2 + (h)) * HTB)
#define PG8_STAGE(bufoff, gbase, voff) do { _Pragma("unroll") for (int _i = 0; _i < 2; ++_i) \
        __builtin_amdgcn_global_load_lds((const unsigned*)((const char*)(gbase) + (voff)[_i]), (LAS unsigned*)(lds + (bufoff) + ldsw + _i * 8192), 16, 0, 0); } while (0)
#define PG8_LDA(dst, b, h) do { _Pragma("unroll") for (int m = 0; m < 4; ++m) _Pragma("unroll") for (int k = 0; k < 2; ++k) dst[m][k] = *(const LAS bf16x8*)(lds + PG8_SA(b, h) + aoff + m * 2048 + k * 1024); } while (0)
#define PG8_LDB(dst, b, h) do { _Pragma("unroll") for (int n = 0; n < 2; ++n) _Pragma("unroll") for (int k = 0; k < 2; ++k) dst[n][k] = *(const LAS bf16x8*)(lds + PG8_SB(b, h) + boff + n * 2048 + k * 1024); } while (0)
#define PG8_MMA(ai, bj, At, Bt) do { __builtin_amdgcn_s_setprio(1); _Pragma("unroll") for (int m = 0; m < 4; ++m) _Pragma("unroll") for (int n = 0; n < 2; ++n) _Pragma("unroll") for (int k = 0; k < 2; ++k) \
        acc[ai][bj][m][n] = __builtin_amdgcn_mfma_f32_16x16x32_bf16(Bt[n][k], At[m][k], acc[ai][bj][m][n], 0, 0, 0); __builtin_amdgcn_s_setprio(0); } while (0)
#define PG8_WAIT_V(n) asm volatile("s_waitcnt vmcnt(" #n ")" ::: "memory")
#define PG8_WAIT_L(n) asm volatile("s_waitcnt lgkmcnt(" #n ")" ::: "memory")
#define PG8_BAR __builtin_amdgcn_s_barrier()
#define PG8_SCHED __builtin_amdgcn_sched_barrier(0)
    Unit cur, nxt; int ui = 0;
    if (!S.next(0, cur)) return;
    f32x4 acc[2][2][4][2];
#pragma unroll
    for (int a = 0; a < 2; ++a)
#pragma unroll
        for (int b = 0; b < 2; ++b)
#pragma unroll
            for (int m = 0; m < 4; ++m)
#pragma unroll
                for (int n = 0; n < 2; ++n) acc[a][b][m][n] = (f32x4){0.f, 0.f, 0.f, 0.f};
    bf16x8 At[4][2], B0[2][2], B1[2][2];
    const char* cA = (const char*)g.A + (size_t)cur.pm * tstepA; const char* cB = (const char*)g.Bt + (size_t)cur.pn * tstepB;
    S.a_ready(cur);
    PG8_STAGE(PG8_SB(0, 0), cB, voffB); PG8_STAGE(PG8_SB(0, 1), cB + hstepB, voffB); PG8_STAGE(PG8_SA(0, 0), cA, voffA); PG8_STAGE(PG8_SA(0, 1), cA + hstepA, voffA);
    if (wr == 1) PG8_BAR;
    PG8_WAIT_V(2); PG8_BAR;
    PG8_STAGE(PG8_SB(1, 0), cB + kstep, voffB); PG8_STAGE(PG8_SA(1, 0), cA + kstep, voffA); PG8_STAGE(PG8_SB(1, 1), cB + hstepB + kstep, voffB);
    PG8_WAIT_V(6); PG8_BAR;
    for (;;) {
        const bool has_next = S.next(ui + 1, nxt);
        const char* nA = has_next ? (const char*)g.A + (size_t)nxt.pm * tstepA : cA; const char* nB = has_next ? (const char*)g.Bt + (size_t)nxt.pn * tstepB : cB;
        for (int t = 0; t < nt; t += 2) {
            const bool last = (t == nt - 2);
            const char* a1 = cA + (size_t)(t + 1) * kstep;
            const char* a2 = last ? nA : cA + (size_t)(t + 2) * kstep; const char* b2 = last ? nB : cB + (size_t)(t + 2) * kstep;
            const char* a3 = a2 + kstep; const char* b3 = b2 + kstep;
            if (last && has_next) S.a_ready(nxt);
            PG8_LDB(B0, 0, 0); PG8_LDB(B1, 0, 1); PG8_SCHED; PG8_LDA(At, 0, 0); PG8_STAGE(PG8_SA(1, 1), a1 + hstepA, voffA);
            PG8_WAIT_V(8); PG8_WAIT_L(0); PG8_BAR; PG8_MMA(0, 0, At, B0); PG8_MMA(0, 1, At, B1); PG8_BAR; PG8_SCHED;
            PG8_LDA(At, 0, 1); PG8_STAGE(PG8_SB(0, 0), b2, voffB); PG8_STAGE(PG8_SB(0, 1), b2 + hstepB, voffB); PG8_STAGE(PG8_SA(0, 0), a2, voffA);
            PG8_WAIT_V(8); PG8_WAIT_L(0); PG8_BAR; PG8_MMA(1, 0, At, B0); PG8_MMA(1, 1, At, B1); PG8_BAR; PG8_SCHED;
            PG8_LDB(B0, 1, 0); PG8_LDB(B1, 1, 1); PG8_SCHED; PG8_LDA(At, 1, 0); PG8_STAGE(PG8_SA(0, 1), a2 + hstepA, voffA);
            PG8_WAIT_V(8); PG8_WAIT_L(0); PG8_BAR; PG8_MMA(0, 0, At, B0); PG8_MMA(0, 1, At, B1); PG8_BAR; PG8_SCHED;
            PG8_LDA(At, 1, 1); PG8_STAGE(PG8_SB(1, 0), b3, voffB); PG8_STAGE(PG8_SB(1, 1), b3 + hstepB, voffB); PG8_STAGE(PG8_SA(1, 0), a3, voffA);
            PG8_WAIT_V(8); PG8_WAIT_L(0); PG8_BAR; PG8_MMA(1, 0, At, B0); PG8_MMA(1, 1, At, B1); PG8_BAR; PG8_SCHED;
        }
        if constexpr (ALIGN_EPI) { if (wr == 0) PG8_BAR; }
        E(acc, cur, wr, wc, fr, fq); S.done(cur);
        if (!has_next) break;
#pragma unroll
        for (int a = 0; a < 2; ++a)
#pragma unroll
            for (int b = 0; b < 2; ++b)
#pragma unroll
                for (int m = 0; m < 4; ++m)
#pragma unroll
                    for (int n = 0; n < 2; ++n) acc[a][b][m][n] = (f32x4){0.f, 0.f, 0.f, 0.f};
        cur = nxt; cA = nA; cB = nB; ++ui;
        if constexpr (ALIGN_EPI) { if (wr == 1) PG8_BAR; }
    }
    PG8_WAIT_V(0);
    if constexpr (!ALIGN_EPI) { if (wr == 0) PG8_BAR; }
    PG8_BAR;
#undef PG8_SA
#undef PG8_SB
#undef PG8_STAGE
#undef PG8_LDA
#undef PG8_LDB
#undef PG8_MMA
#undef PG8_WAIT_V
#undef PG8_WAIT_L
#undef PG8_BAR
#undef PG8_SCHED
}

__device__ __forceinline__ unsigned dpp_ror8(unsigned v) { return (unsigned)__builtin_amdgcn_mov_dpp((int)v, 0x128, 0xf, 0xf, false); }
__device__ __forceinline__ void epi_pair_exchange(const u32x4 c0, const u32x4 c1, int fr, u32x4& a, u32x4& b) {
    const bool lo = fr < 8;
    const u32x4 send = lo ? c1 : c0;
    u32x4 recv; recv.x = dpp_ror8(send.x); recv.y = dpp_ror8(send.y); recv.z = dpp_ror8(send.z); recv.w = dpp_ror8(send.w);
    a = lo ? c0 : recv;
    b = lo ? recv : c1;
}

struct EpiProj {
    static constexpr bool PERM = true;
    bf16_t* P; float* ssq; const f32x2* r64; const f32x2* r32;
    unsigned* krmax;
    struct Cfg { float sc; int rope, pp, c0, cs; bool isckv, iskr, valid; };
    __device__ __forceinline__ Cfg cfg(int cs, int fq, bool isctx) const {
        Cfg C; C.cs = cs; C.c0 = cs + 8 * fq; C.sc = 1.f; C.rope = 0; C.pp = 0; C.valid = cs < INW;
        if (cs < C_CKV) { C.sc = 0.10206207261596577f * LOG2E; const int p = cs % 96; if (p >= 64) { C.rope = 32; C.pp = C.c0 % 96 - 64; } }
        else if (cs < C_KR) { }
        else if (cs < C_SWAQ) { C.rope = 32; C.pp = C.c0 - C_KR; }
        else if (cs < C_SWAK) { C.sc = 0.125f * LOG2E; C.rope = 64; C.pp = (C.c0 - C_SWAQ) & 63; }
        else if (cs < C_SWAV) { C.rope = 64; C.pp = (C.c0 - C_SWAK) & 63; }
        else if (cs < C_NAQ) { }
        else if (cs < C_NAK) { C.sc = 0.125f * LOG2E; }
        else if (cs < C_RK) { }
        else if (cs < C_RV) { C.sc = 0.125f; }
        C.isckv = (cs >= C_CKV && cs < C_KR); C.iskr = (cs >= C_KR && cs < C_SWAQ);
        if (isctx) C.rope = 0;
        return C;
    }
    __device__ __forceinline__ u32x4 chunk(const f32x4 a0, const f32x4 a1, const Cfg& C, int t, int row, int fq, float& kmx) const {
        f32x4 v0 = a0 * C.sc, v1 = a1 * C.sc;
        if (C.rope) {
            f32x4 cs0, cs1;
            if (C.rope == 64) { const int pos = (C.pp >= 32) ? (t & 63) : (t >> 6); const GAS f32x4* tp = (const GAS f32x4*)(r64 + pos * 16 + ((C.pp & 31) >> 1)); cs0 = tp[0]; cs1 = tp[1]; }
            else              { const int pos = (C.pp >= 16) ? (t & 63) : (t >> 6); const GAS f32x4* tp = (const GAS f32x4*)(r32 + pos * 8 + ((C.pp & 15) >> 1)); cs0 = tp[0]; cs1 = tp[1]; }
            f32x4 w0, w1;
            w0[0] = v0[0] * cs0[0] - v0[1] * cs0[1]; w0[1] = v0[0] * cs0[1] + v0[1] * cs0[0];
            w0[2] = v0[2] * cs0[2] - v0[3] * cs0[3]; w0[3] = v0[2] * cs0[3] + v0[3] * cs0[2];
            w1[0] = v1[0] * cs1[0] - v1[1] * cs1[1]; w1[1] = v1[0] * cs1[1] + v1[1] * cs1[0];
            w1[2] = v1[2] * cs1[2] - v1[3] * cs1[3]; w1[3] = v1[2] * cs1[3] + v1[3] * cs1[2];
            v0 = w0; v1 = w1;
        }
        if (C.isckv) {
            float s = (v0[0] * v0[0] + v0[1] * v0[1]) + (v0[2] * v0[2] + v0[3] * v0[3]) + (v1[0] * v1[0] + v1[1] * v1[1]) + (v1[2] * v1[2] + v1[3] * v1[3]);
            s += xshfl<16>(s); s = xsum32(s);
            if (fq == 0) ((GAS float*)ssq)[(size_t)row * 4 + ((C.cs - C_CKV) >> 5)] = s;
        }
        if (C.iskr) {
            float s = (v0[0] * v0[0] + v0[1] * v0[1]) + (v0[2] * v0[2] + v0[3] * v0[3]) + (v1[0] * v1[0] + v1[1] * v1[1]) + (v1[2] * v1[2] + v1[3] * v1[3]);
            s += xshfl<16>(s); s = xsum32(s); kmx = fmaxf(kmx, s);
        }
        u32x4 w; w.x = cvt_pk_bf16(v0[0], v0[1]); w.y = cvt_pk_bf16(v0[2], v0[3]); w.z = cvt_pk_bf16(v1[0], v1[1]); w.w = cvt_pk_bf16(v1[2], v1[3]);
        return w;
    }
    __device__ __forceinline__ void operator()(const f32x4 (&acc)[2][2][4][2], const Unit& u, int wr, int wc, int, int) const {
        int ln_ = lane_id(); asm volatile("" : "+v"(ln_)); const int fr = ln_ & 15, fq = ln_ >> 4;
        float kmx = 0.f;
        const bool isctx = (u.pm % 33) == 0;
        const int tb = (u.pm % 33 - 1) * 256;
        const int cw = u.pn * BM + wc * 64;
        const Cfg C0 = cfg(cw, fq, isctx), C1 = cfg(cw + 32, fq, isctx);
        if (!C0.valid) return;
        const bool vst = (fr < 8) ? true : C1.valid;
        const int cst = cw + ((fr >> 3) << 5) + 8 * fq;
#pragma unroll
        for (int ai = 0; ai < 2; ++ai)
#pragma unroll
            for (int m = 0; m < 4; ++m) {
                const int rg = u.pm * BM + ai * HALF + wr * 64 + m * 16;
                const int row = rg + fr, t = tb + ai * HALF + wr * 64 + m * 16 + fr;
                const u32x4 k0 = chunk(acc[ai][0][m][0], acc[ai][0][m][1], C0, t, row, fq, kmx);
                u32x4 k1 = {0u, 0u, 0u, 0u};
                if (C1.valid) k1 = chunk(acc[ai][1][m][0], acc[ai][1][m][1], C1, t, row, fq, kmx);
                u32x4 sa, sb; epi_pair_exchange(k0, k1, fr, sa, sb);
                if (vst) { *(GAS u32x4*)(P + (size_t)(rg + (fr & 7)) * PW + cst) = sa; *(GAS u32x4*)(P + (size_t)(rg + 8 + (fr & 7)) * PW + cst) = sb; }
            }
        if (C0.iskr || C1.iskr) {
            kmx = fmaxf(kmx, xshfl<1>(kmx)); kmx = fmaxf(kmx, xshfl<2>(kmx)); kmx = fmaxf(kmx, xshfl<4>(kmx)); kmx = fmaxf(kmx, xshfl<8>(kmx));
            if (ln_ == 0) __hip_atomic_fetch_max((GAS unsigned*)krmax + u.pm / 33, __float_as_uint(kmx), __ATOMIC_RELAXED, __HIP_MEMORY_SCOPE_AGENT);
        }
    }
};
struct EpiKV {
    static constexpr bool PERM = true;
    bf16_t* KV; const float* ssq; unsigned* knmax;
    __device__ __forceinline__ void operator()(const f32x4 (&acc)[2][2][4][2], const Unit& u, int wr, int wc, int, int) const {
        int ln_ = lane_id(); asm volatile("" : "+v"(ln_)); const int fr = ln_ & 15, fq = ln_ >> 4;
        const int cst = u.pn * BM + wc * 64 + ((fr >> 3) << 5) + 8 * fq;
        const bool isk = (wc & 1) == 0;
        float kmx = 0.f;
#pragma unroll
        for (int ai = 0; ai < 2; ++ai)
#pragma unroll
            for (int m = 0; m < 4; ++m) {
                const int rg = u.pm * BM + ai * HALF + wr * 64 + m * 16, row = rg + fr;
                const f32x4 q4 = *(const GAS f32x4*)(ssq + (size_t)row * 4); const float rs = 1.0f / sqrtf(((q4[0] + q4[1]) + (q4[2] + q4[3])) * (1.f / 128.f) + EPS);
                u32x4 k[2]; float s = 0.f;
#pragma unroll
                for (int bj = 0; bj < 2; ++bj) { const f32x4 v0 = acc[ai][bj][m][0] * rs, v1 = acc[ai][bj][m][1] * rs;
                    s += (v0[0] * v0[0] + v0[1] * v0[1]) + (v0[2] * v0[2] + v0[3] * v0[3]) + (v1[0] * v1[0] + v1[1] * v1[1]) + (v1[2] * v1[2] + v1[3] * v1[3]);
                    k[bj].x = cvt_pk_bf16(v0[0], v0[1]); k[bj].y = cvt_pk_bf16(v0[2], v0[3]); k[bj].z = cvt_pk_bf16(v1[0], v1[1]); k[bj].w = cvt_pk_bf16(v1[2], v1[3]); }
                if (isk) { s += xshfl<16>(s); s = xsum32(s); kmx = fmaxf(kmx, s); }
                u32x4 sa, sb; epi_pair_exchange(k[0], k[1], fr, sa, sb);
                *(GAS u32x4*)(KV + (size_t)(rg + (fr & 7)) * KVW + cst) = sa; *(GAS u32x4*)(KV + (size_t)(rg + 8 + (fr & 7)) * KVW + cst) = sb;
            }
        if (isk) {
            kmx = fmaxf(kmx, xshfl<1>(kmx)); kmx = fmaxf(kmx, xshfl<2>(kmx)); kmx = fmaxf(kmx, xshfl<4>(kmx)); kmx = fmaxf(kmx, xshfl<8>(kmx));
            if (ln_ == 0) __hip_atomic_fetch_max((GAS unsigned*)knmax + (u.pm / 33) * 4 + u.pn * 2 + (wc >> 1), __float_as_uint(kmx), __ATOMIC_RELAXED, __HIP_MEMORY_SCOPE_AGENT);
        }
    }
};
struct EpiResid {
    static constexpr bool PERM = true;
    const float* xl_in; bf16_t* xb; const float* xc_in; float* xc_out; const float* mod;
    __device__ __forceinline__ void operator()(const f32x4 (&acc)[2][2][4][2], const Unit& u, int wr, int wc, int, int) const {
        int ln_ = lane_id(); asm volatile("" : "+v"(ln_)); const int fr = ln_ & 15, fq = ln_ >> 4;
        const int b = u.pm / 33, jt = u.pm % 33;
        const int cw = u.pn * BM + wc * 64 + 8 * fq;
        const float* gate = mod + ((jt == 0) ? 4 : b) * 6144 + 2 * DM;
        if (jt == 0) {
#pragma unroll
            for (int bj = 0; bj < 2; ++bj) { const int c = cw + 32 * bj; const f32x4 g0 = *(const GAS f32x4*)(gate + c), g1 = *(const GAS f32x4*)(gate + c + 4);
#pragma unroll
                for (int ai = 0; ai < 2; ++ai)
#pragma unroll
                    for (int m = 0; m < 4; ++m) { const size_t off = ((size_t)b * CTXL + ai * HALF + wr * 64 + m * 16 + fr) * DM + c;
                        const f32x4 b0 = *(const GAS f32x4*)(xc_in + off), b1 = *(const GAS f32x4*)(xc_in + off + 4);
                        *(GAS f32x4*)(xc_out + off) = b0 + g0 * acc[ai][bj][m][0]; *(GAS f32x4*)(xc_out + off + 4) = b1 + g1 * acc[ai][bj][m][1]; } }
            return;
        }
        const f32x4 ga0 = *(const GAS f32x4*)(gate + cw), ga1 = *(const GAS f32x4*)(gate + cw + 4), gb0 = *(const GAS f32x4*)(gate + cw + 32), gb1 = *(const GAS f32x4*)(gate + cw + 36);
        const int cst = cw + ((fr >> 3) << 5);
        const size_t rbase = (size_t)b * SEQ + (size_t)(jt - 1) * 256;
#pragma unroll
        for (int ai = 0; ai < 2; ++ai)
#pragma unroll
            for (int m = 0; m < 4; ++m) {
                const size_t rg = rbase + ai * HALF + wr * 64 + m * 16;
                const f32x4 d00 = ga0 * acc[ai][0][m][0], d01 = ga1 * acc[ai][0][m][1], d10 = gb0 * acc[ai][1][m][0], d11 = gb1 * acc[ai][1][m][1];
                u32x4 a0, b0, a1, b1;
                epi_pair_exchange(__builtin_bit_cast(u32x4, d00), __builtin_bit_cast(u32x4, d10), fr, a0, b0);
                epi_pair_exchange(__builtin_bit_cast(u32x4, d01), __builtin_bit_cast(u32x4, d11), fr, a1, b1);
#pragma unroll
                for (int hb = 0; hb < 2; ++hb) {
                    const size_t off = (rg + 8 * hb + (fr & 7)) * DM + cst;
                    const f32x4 e0 = __builtin_bit_cast(f32x4, hb ? b0 : a0), e1 = __builtin_bit_cast(f32x4, hb ? b1 : a1);
                    f32x4 x0, x1;
                    if (xl_in) { x0 = *(const GAS f32x4*)(xl_in + off); x1 = *(const GAS f32x4*)(xl_in + off + 4); }
                    else { const u32x4 w = *(const GAS u32x4*)(xb + off); x0 = (f32x4){bf_lo(w.x), bf_hi(w.x), bf_lo(w.y), bf_hi(w.y)}; x1 = (f32x4){bf_lo(w.z), bf_hi(w.z), bf_lo(w.w), bf_hi(w.w)}; }
                    const f32x4 r0 = x0 + e0, r1 = x1 + e1;
                    u32x4 w2; w2.x = cvt_pk_bf16(r0[0], r0[1]); w2.y = cvt_pk_bf16(r0[2], r0[3]); w2.z = cvt_pk_bf16(r1[0], r1[1]); w2.w = cvt_pk_bf16(r1[2], r1[3]);
                    *(GAS u32x4*)(xb + off) = w2;
                }
            }
    }
};
struct EpiScore {
    static constexpr bool PERM = true;
    _Float16* S;
    __device__ __forceinline__ void operator()(const f32x4 (&acc)[2][2][4][2], const Unit& u, int wr, int wc, int, int) const {
        int ln_ = lane_id(); asm volatile("" : "+v"(ln_)); const int fr = ln_ & 15, fq = ln_ >> 4;
        typedef _Float16 h2 __attribute__((ext_vector_type(2)));
        const int cst = u.pn * BM + wc * 64 + ((fr >> 3) << 5) + 8 * fq;
#pragma unroll
        for (int ai = 0; ai < 2; ++ai)
#pragma unroll
            for (int m = 0; m < 4; ++m) {
                const int rg = u.pm * BM + ai * HALF + wr * 64 + m * 16;
                u32x4 k[2];
#pragma unroll
                for (int bj = 0; bj < 2; ++bj) { const f32x4 v0 = acc[ai][bj][m][0], v1 = acc[ai][bj][m][1];
                    const h2 a = {(_Float16)v0[0], (_Float16)v0[1]}, b = {(_Float16)v0[2], (_Float16)v0[3]}, c = {(_Float16)v1[0], (_Float16)v1[1]}, d = {(_Float16)v1[2], (_Float16)v1[3]};
                    k[bj].x = __builtin_bit_cast(unsigned, a); k[bj].y = __builtin_bit_cast(unsigned, b); k[bj].z = __builtin_bit_cast(unsigned, c); k[bj].w = __builtin_bit_cast(unsigned, d); }
                u32x4 sa, sb; epi_pair_exchange(k[0], k[1], fr, sa, sb);
                *(GAS u32x4*)(S + (size_t)(rg + (fr & 7)) * 2048 + cst) = sa; *(GAS u32x4*)(S + (size_t)(rg + 8 + (fr & 7)) * 2048 + cst) = sb;
            }
    }
};
struct EpiNull {
    static constexpr bool PERM = true;
    float* sink;
    __device__ __forceinline__ void operator()(const f32x4 (&acc)[2][2][4][2], const Unit& u, int wr, int wc, int, int) const {
        float t = 0.f;
#pragma unroll
        for (int a = 0; a < 2; ++a)
#pragma unroll
            for (int b = 0; b < 2; ++b)
#pragma unroll
                for (int m = 0; m < 4; ++m) t += acc[a][b][m][0][0] + acc[a][b][m][1][3];
        if (t == 123.456f) sink[0] = t;
    }
};
}
struct Frame {
    LAS unsigned char* lds;
    int tid, lane, wave, vcu, G;
};
struct Inputs {
    const float *x, *c, *ctx, *c_ctx, *ada_w, *ada_b, *norm_mix_g, *w_in, *mla_kv_norm_g, *mla_w_ukv, *swa_sink, *na_rpb, *ret_decay_f, *ret_decay_b,
                *ret_gn_f, *ret_gn_b, *mix_beta, *w_out, *norm_ffn_g, *peer_wq, *peer_k1, *peer_k2, *peer_u, *peer_v, *final_norm_g;
};

__device__ __forceinline__ int orig_col(int c) {
    if (c < C_CKV) { const int h = c / 96, p = c % 96; if (p < 64) return c; const int pp = p - 64; return h * 96 + 64 + (pp >> 4) * 16 + (pp & 1) * 8 + ((pp & 15) >> 1); }
    if (c < C_KR) return c;
    if (c < C_SWAQ) { const int pp = c - C_KR; return C_KR + (pp >> 4) * 16 + (pp & 1) * 8 + ((pp & 15) >> 1); }
    if (c < C_SWAV) { const int q = c - C_SWAQ, hh = q >> 6, pp = q & 63; return C_SWAQ + hh * 64 + (pp >> 5) * 32 + (pp & 1) * 16 + ((pp & 31) >> 1); }
    return c;
}

template <int MAP  >
__device__ __forceinline__ void transpose_item(const float* W, int K, int Nsrc, int Nvalid, int Ndst, const float* kscale, bf16_t* WT, LAS float* scr, int item, int lane) {
    const int nblk = Ndst / 32, kb = item / nblk, nb = item % nblk, k0 = 64 * kb, n0 = 32 * nb;
    const int nd = n0 + (lane & 31);
    const int ns = (nd < Nvalid) ? (MAP ? orig_col(nd) : nd) : -1;
#pragma unroll 8
    for (int i = 0; i < 32; ++i) { const int kk = 2 * i + (lane >> 5); float v = 0.f; if (ns >= 0) { v = W[(size_t)(k0 + kk) * Nsrc + ns]; if (kscale) v *= kscale[k0 + kk]; } scr[kk * 33 + (lane & 31)] = v; }
    LDS_WAIT(); asm volatile("" ::: "memory");
    const int c = lane & 7;
#pragma unroll
    for (int j = 0; j < 4; ++j) { const int n = (lane >> 3) + 8 * j; const LAS float* s = scr + (8 * c) * 33 + n;
        u32x4 o; o.x = cvt_pk_bf16(s[0 * 33], s[1 * 33]); o.y = cvt_pk_bf16(s[2 * 33], s[3 * 33]); o.z = cvt_pk_bf16(s[4 * 33], s[5 * 33]); o.w = cvt_pk_bf16(s[6 * 33], s[7 * 33]);
        *(GAS u32x4*)(WT + (size_t)(n0 + n) * K + k0 + 8 * c) = o; }
    LDS_WAIT(); asm volatile("" ::: "memory");
}

__device__ __forceinline__ void sincos_small(float af, float& sn, float& cs) {
    const double a = (double)af; const double n = __builtin_rint(a * 0.63661977236758134308); const double r = (a - n * 1.57079632679489655800) - n * 6.123233995736766036e-17;
    const double r2 = r * r;
    const double s = r * (1.0 + r2 * (-1.0 / 6 + r2 * (1.0 / 120 + r2 * (-1.0 / 5040 + r2 * (1.0 / 362880 + r2 * (-1.0 / 39916800 + r2 * (1.0 / 6227020800.0)))))));
    const double c = 1.0 + r2 * (-0.5 + r2 * (1.0 / 24 + r2 * (-1.0 / 720 + r2 * (1.0 / 40320 + r2 * (-1.0 / 3628800 + r2 * (1.0 / 479001600 + r2 * (-1.0 / 87178291200.0)))))));
    const int q = ((int)n) & 3;
    const double ss = (q == 0) ? s : (q == 1) ? c : (q == 2) ? -s : -c;
    const double cc = (q == 0) ? c : (q == 1) ? -s : (q == 2) ? -c : s;
    sn = (float)ss; cs = (float)cc;
}

__device__ __forceinline__ void phase_prologue(Frame& F, const Inputs& I, unsigned char* ws) {
    float* MOD = (float*)(ws + WS_MOD);
    {
        LAS float* sc = (LAS float*)F.lds;
        LAS float* red = (LAS float*)(F.lds + 20480);
        for (int i = F.tid; i < 5 * DM; i += NTHR) { const float v = (i < 4 * DM) ? I.c[i] : I.c_ctx[i - 4 * DM]; sc[i] = silu_f(v); }
        __syncthreads();
        for (int task = blockIdx.x; task < NLAYER * 96; task += F.G) {
            const int l = task / 96, n = (task % 96) * 64 + F.lane;
            const float* w = I.ada_w + (size_t)l * DM * 6144 + n;
            float a0 = 0.f, a1 = 0.f, a2 = 0.f, a3 = 0.f, a4 = 0.f;
            const int kb = F.wave * 128;
            for (int k0 = kb; k0 < kb + 128; k0 += 16) {
                float wv[16];
#pragma unroll
                for (int i = 0; i < 16; ++i) wv[i] = ((const GAS float*)w)[(size_t)(k0 + i) * 6144];
#pragma unroll
                for (int i = 0; i < 16; ++i) { const int k = k0 + i; a0 += sc[k] * wv[i]; a1 += sc[DM + k] * wv[i]; a2 += sc[2 * DM + k] * wv[i]; a3 += sc[3 * DM + k] * wv[i]; a4 += sc[4 * DM + k] * wv[i]; }
            }
            LAS float* rw = red + F.wave * 320 + F.lane;
            rw[0] = a0; rw[64] = a1; rw[128] = a2; rw[192] = a3; rw[256] = a4;
            __syncthreads();
            if (F.tid < 320) { const int r = F.tid >> 6, ln = F.tid & 63; float s = 0.f;
#pragma unroll
                for (int wv = 0; wv < 8; ++wv) s += red[wv * 320 + r * 64 + ln];
                const int nn = (task % 96) * 64 + ln; MOD[(size_t)(l * 5 + r) * 6144 + nn] = s + I.ada_b[l * 6144 + nn]; }
            __syncthreads();
        }
    }
    {
        LAS float* scr = (LAS float*)(F.lds + F.wave * 16384);
        const int gw = F.vcu * NWAVES + F.wave, NGW = F.G * NWAVES;
        constexpr int I_IN = (DM / 64) * (PW / 32), I_OUT = (DM / 64) * (DM / 32), I_UKV = (128 / 64) * (KVW / 32);
        constexpr int PER_L = I_IN + I_OUT + I_UKV;
        for (int it = gw; it < NLAYER * PER_L; it += NGW) {
            const int l = it / PER_L; int r = it % PER_L;
            if (r < I_IN) { transpose_item<1>(I.w_in + (size_t)l * DM * INW, DM, INW, INW, PW, nullptr, (bf16_t*)(ws + WS_WIN) + (size_t)l * PW * DM, scr, r, F.lane); continue; } r -= I_IN;
            if (r < I_OUT) { transpose_item<0>(I.w_out + (size_t)l * DM * DM, DM, DM, DM, DM, I.mix_beta + l * DM, (bf16_t*)(ws + WS_WOUT) + (size_t)l * DM * DM, scr, r, F.lane); continue; } r -= I_OUT;
            transpose_item<0>(I.mla_w_ukv + (size_t)l * 128 * KVW, 128, KVW, KVW, KVW, I.mla_kv_norm_g + l * 128, (bf16_t*)(ws + WS_WUKV) + (size_t)l * KVW * 128, scr, r, F.lane);
        }
    }
    __syncthreads();
    {
        LAS float* wqs = (LAS float*)F.lds;
        LAS float* kps = (LAS float*)(F.lds + 32768);
        for (int task = blockIdx.x; task < NLAYER * 16 * 16; task += F.G) {
            const int l = task >> 8, hp = (task >> 4) & 15, k0 = (task & 15) * 64;
            const float* kp = ((hp & 1) ? I.peer_k2 : I.peer_k1) + (size_t)l * 128 * 128;
            for (int i = F.tid; i < 64 * 128; i += NTHR) wqs[i] = I.peer_wq[(size_t)l * DM * 2048 + (size_t)(k0 + (i >> 7)) * 2048 + hp * 128 + (i & 127)];
            for (int i = F.tid; i < 128 * 128; i += NTHR) kps[(i >> 7) * 129 + (i & 127)] = kp[i];
            __syncthreads();
            const int n = F.tid & 127, kq = F.tid >> 7;
            float a[16];
#pragma unroll
            for (int i = 0; i < 16; ++i) a[i] = 0.f;
            for (int d = 0; d < 128; d += 4) {
                const float kv0 = kps[n * 129 + d], kv1 = kps[n * 129 + d + 1], kv2 = kps[n * 129 + d + 2], kv3 = kps[n * 129 + d + 3];
#pragma unroll
                for (int i = 0; i < 16; ++i) { const f32x4 w4 = *(const LAS f32x4*)(wqs + (kq * 16 + i) * 128 + d);
                    a[i] += w4[0] * kv0; a[i] += w4[1] * kv1; a[i] += w4[2] * kv2; a[i] += w4[3] * kv3; } }
            bf16_t* o = (bf16_t*)(ws + WS_WSC) + (size_t)l * 2048 * DM + (size_t)(hp * 128 + n) * DM + k0 + kq * 16;
            u32x4 w0, w1; w0.x = cvt_pk_bf16(a[0], a[1]); w0.y = cvt_pk_bf16(a[2], a[3]); w0.z = cvt_pk_bf16(a[4], a[5]); w0.w = cvt_pk_bf16(a[6], a[7]);
            w1.x = cvt_pk_bf16(a[8], a[9]); w1.y = cvt_pk_bf16(a[10], a[11]); w1.z = cvt_pk_bf16(a[12], a[13]); w1.w = cvt_pk_bf16(a[14], a[15]);
            *(GAS u32x4*)o = w0; *(GAS u32x4*)(o + 8) = w1;
            __syncthreads();
        }
    }
    {
        const int gt = blockIdx.x * NTHR + F.tid;
        if (gt < 128 * 16 + 128 * 8) {
            const bool big = gt < 2048; const int e = big ? gt : gt - 2048; const int q = big ? 16 : 8; const int pos = e / q, j = e % q;
            const float inv = (float)exp2(-(double)j / (double)q * 13.287712379549449);
            const float ang = (float)pos * inv; float sn, cs; sincos_small(ang, sn, cs);
            f32x2* tab = (f32x2*)(ws + WS_TAB + (big ? 0 : 16384));
            tab[e] = (f32x2){cs, sn};
        }
    }
}

struct ItemQ { LAS unsigned* ctr; unsigned pend; };
__device__ __forceinline__ void iq_issue(ItemQ& Q, int lane) { unsigned t = 0u; if (lane == 0) t = __hip_atomic_fetch_add(Q.ctr, 1u, __ATOMIC_RELAXED, __HIP_MEMORY_SCOPE_WORKGROUP); Q.pend = t; }
__device__ __forceinline__ unsigned iq_take(ItemQ& Q, int lane) { const unsigned t = (unsigned)__builtin_amdgcn_readfirstlane((int)Q.pend); iq_issue(Q, lane); return t; }
__device__ __forceinline__ void iq_init(ItemQ& Q, Frame& F, int slot) { Q.ctr = (LAS unsigned*)(F.lds + MISC_OFF + 256 + 16 * slot); if (F.tid == 0) *Q.ctr = 0u; __syncthreads(); iq_issue(Q, F.lane); }
#define DYN_ITEMS(x, N, slot) ItemQ q_; iq_init(q_, F, slot); for (unsigned t_ = iq_take(q_, F.lane); ((x) = F.vcu + (int)t_ * F.G) < (N); t_ = iq_take(q_, F.lane))

__device__ __forceinline__ unsigned pack_i8(const f32x4 y) {
    const int q0 = __float2int_rn(fminf(fmaxf(y[0], -127.f), 127.f)), q1 = __float2int_rn(fminf(fmaxf(y[1], -127.f), 127.f)), q2 = __float2int_rn(fminf(fmaxf(y[2], -127.f), 127.f)), q3 = __float2int_rn(fminf(fmaxf(y[3], -127.f), 127.f));
    return ((unsigned)q0 & 0xFFu) | (((unsigned)q1 & 0xFFu) << 8) | (((unsigned)q2 & 0xFFu) << 16) | ((unsigned)q3 << 24);
}
__device__ __forceinline__ void phase_convert_uv(Frame& F, const float* u, const float* v, unsigned char* ws) {
    const size_t nblk = (size_t)NEXP * DM / 1024;
    const int gw = F.vcu * NWAVES + F.wave, NGW = F.G * NWAVES, lane = F.lane;
    for (size_t i = gw; i < 2 * nblk; i += NGW) {
        const bool second = i >= nblk; const size_t j = second ? i - nblk : i; const float sc = second ? 56.0f : 95.5f;
        const GAS f32x4* s = (const GAS f32x4*)(second ? v : u) + j * 256 + lane;
        GAS unsigned* d = (GAS unsigned*)(ws + (second ? WS_VB : WS_UB)) + (size_t)(lane >> 5) * ((size_t)NEXP * 32) + j * 32 + (lane & 31);
        f32x4 a[4];
#pragma unroll
        for (int q = 0; q < 4; ++q) a[q] = s[64 * q] * sc;
        if (second) {
#pragma unroll
            for (int q = 0; q < 4; ++q) d[(size_t)q * ((size_t)NEXP * 64)] = pack_i8(a[q]);
        } else {
            GAS unsigned* du = (GAS unsigned*)(ws + WS_UB) + j * 32 + (lane >> 1);
#pragma unroll
            for (int q = 0; q < 4; ++q) {
                unsigned P = 0u;
#pragma unroll
                for (int e = 0; e < 4; ++e) { const int n = __float2int_rn(fminf(fmaxf(a[q][e], -8.f), 7.f)); P |= ((unsigned)n & 0xFu) << (8 * e); }
                if (lane & 1) P <<= 4;
                const unsigned Q2 = __float_as_uint(xshfl<1>(__uint_as_float(P)));
                if (!(lane & 1)) du[(size_t)q * ((size_t)NEXP * 32)] = P | Q2;
            }
        }
    }
}

template <bool Q8 = false>
__device__ __forceinline__ void phase_norm_mod(Frame& F, const float* xl, const bf16_t* xb, const float* xc, const float* gain, const float* mod  , int chunk, bf16_t* XN, bool skipctx, float* ssq_zero, unsigned char* XQ = nullptr, float* XSC = nullptr) {
    const int gw = F.vcu * NWAVES + F.wave, NGW = F.G * NWAVES;
    (void)ssq_zero;
    int gi; DYN_ITEMS(gi, NROW / 4, 1) {
        const int r0 = 4 * gi, b = r0 / NB, j0 = r0 % NB;
        const bool isctx = j0 < CTXL;
        if (skipctx && isctx) continue;
        const float* mv = mod + (isctx ? 4 : b) * 6144 + chunk * DM;
        f32x4 v[4][4]; float s[4];
        if (!isctx && xl == nullptr) {
            const GAS u32x2* x2 = (const GAS u32x2*)(xb + ((size_t)b * SEQ + (j0 - CTXL)) * DM) + F.lane;
            u32x2 w[4][4];
#pragma unroll
            for (int i = 0; i < 4; ++i)
#pragma unroll
                for (int q = 0; q < 4; ++q) w[i][q] = x2[i * (DM / 4) + 64 * q];
#pragma unroll
            for (int i = 0; i < 4; ++i)
#pragma unroll
                for (int q = 0; q < 4; ++q) v[i][q] = (f32x4){bf_lo(w[i][q].x), bf_hi(w[i][q].x), bf_lo(w[i][q].y), bf_hi(w[i][q].y)};
        } else {
            const float* xr = isctx ? xc + ((size_t)b * CTXL + j0) * DM : xl + ((size_t)b * SEQ + (j0 - CTXL)) * DM;
            const GAS f32x4* x4 = (const GAS f32x4*)xr + F.lane;
#pragma unroll
            for (int i = 0; i < 4; ++i)
#pragma unroll
                for (int q = 0; q < 4; ++q) v[i][q] = x4[i * (DM / 4) + 64 * q];
        }
#pragma unroll
        for (int i = 0; i < 4; ++i) { float a = 0.f;
#pragma unroll
            for (int q = 0; q < 4; ++q) a += (v[i][q][0] * v[i][q][0] + v[i][q][1] * v[i][q][1]) + (v[i][q][2] * v[i][q][2] + v[i][q][3] * v[i][q][3]);
            s[i] = a; }
#pragma unroll
        for (int i = 0; i < 4; ++i) s[i] = 1.0f / sqrtf(wave_sum(s[i]) * (1.f / DM) + EPS);
#pragma unroll
        for (int q = 0; q < 4; ++q) {
            const int c = 4 * F.lane + 256 * q;
            const f32x4 g = *(const GAS f32x4*)(gain + c), sh = *(const GAS f32x4*)(mv + c), sc = *(const GAS f32x4*)(mv + DM + c);
            const f32x4 gs = g * (sc + 1.0f);
#pragma unroll
            for (int i = 0; i < 4; ++i) {
                const f32x4 y = (v[i][q] * s[i]) * gs + sh;
                u32x2 w; w.x = cvt_pk_bf16(y[0], y[1]); w.y = cvt_pk_bf16(y[2], y[3]);
                ((GAS u32x2*)(XN + (size_t)(r0 + i) * DM) + F.lane)[64 * q] = w;
                if (Q8) v[i][q] = y;
            }
        }
        if (Q8) {
#pragma unroll
            for (int i = 0; i < 4; ++i) { float m = 0.f;
#pragma unroll
                for (int q = 0; q < 4; ++q) m = fmaxf(fmaxf(m, fmaxf(fabsf(v[i][q][0]), fabsf(v[i][q][1]))), fmaxf(fabsf(v[i][q][2]), fabsf(v[i][q][3])));
                m = fmaxf(m, xshfl<1>(m)); m = fmaxf(m, xshfl<2>(m)); m = fmaxf(m, xshfl<4>(m)); m = fmaxf(m, xshfl<8>(m)); m = fmaxf(m, xshfl<16>(m)); m = fmaxf(xmax32(m), 1e-20f);
                const float qs = 119.0f / m;
#pragma unroll
                for (int q = 0; q < 4; ++q) {
                    const unsigned Y = pack_i8(v[i][q] * qs + 8.0f), Yp = __float_as_uint(xshfl<1>(__uint_as_float(Y)));
                    const unsigned Y0 = (F.lane & 1) ? Yp : Y, Y1 = (F.lane & 1) ? Y : Yp;
                    const unsigned hp = ((Y0 >> 4) & 0x0F0F0F0Fu) | (Y1 & 0xF0F0F0F0u), lp = ((Y0 & 0x0F0F0F0Fu) | ((Y1 << 4) & 0xF0F0F0F0u)) ^ 0x88888888u;
                    ((GAS unsigned*)(XQ + (size_t)(r0 + i) * DM) + F.lane)[64 * q] = (F.lane & 1) ? lp : hp; }
                if (F.lane == 0) ((GAS float*)XSC)[(size_t)(r0 + i) * 4] = m * (1.0f / 119.0f);
            }
        }
    }
}

__device__ __forceinline__ void phase_final_norm(Frame& F, const bf16_t* xb, float* out, const float* gain, float dsc) {
    const int gw = F.vcu * NWAVES + F.wave, NGW = F.G * NWAVES;
    for (int gi = gw; gi < NBATCH * SEQ / 4; gi += NGW) {
        const int r0 = 4 * gi;
        const GAS u32x2* x2 = (const GAS u32x2*)(xb + (size_t)r0 * DM) + F.lane;
        u32x2 w[4][4];
#pragma unroll
        for (int i = 0; i < 4; ++i)
#pragma unroll
            for (int q = 0; q < 4; ++q) w[i][q] = x2[i * (DM / 4) + 64 * q];
        f32x4 v[4][4]; float s[4];
#pragma unroll
        for (int i = 0; i < 4; ++i) { float a = 0.f;
#pragma unroll
            for (int q = 0; q < 4; ++q) { v[i][q] = (f32x4){bf_lo(w[i][q].x), bf_hi(w[i][q].x), bf_lo(w[i][q].y), bf_hi(w[i][q].y)}; a += (v[i][q][0] * v[i][q][0] + v[i][q][1] * v[i][q][1]) + (v[i][q][2] * v[i][q][2] + v[i][q][3] * v[i][q][3]); }
            s[i] = a; }
#pragma unroll
        for (int i = 0; i < 4; ++i) s[i] = dsc / sqrtf(wave_sum(s[i]) * (1.f / DM) + EPS);
#pragma unroll
        for (int q = 0; q < 4; ++q) { const f32x4 g = *(const GAS f32x4*)(gain + 4 * F.lane + 256 * q);
#pragma unroll
            for (int i = 0; i < 4; ++i) ((GAS f32x4*)(out + (size_t)(r0 + i) * DM) + F.lane)[64 * q] = (v[i][q] * s[i]) * g; }
    }
}
__device__ __forceinline__ int crow(int r, int hi) { return (r & 3) + 8 * (r >> 2) + 4 * hi; }
constexpr int VS = 68;
enum { AT_MLA = 0, AT_SWA = 1, AT_NA = 2 };
#ifndef ATT_THR
#define ATT_THR 8.0f
#endif
#ifndef SC_MLA
#define SC_MLA 1.0f
#endif
#ifndef SC_SWA
#define SC_SWA 1.0f
#endif
#ifndef SC_NA
#define SC_NA 1.0f
#endif
#ifndef SKIP_ATT
#define SKIP_ATT 0
#endif
struct AttnArgs { const bf16_t* P; const bf16_t* KV; bf16_t* Y; const float* sink; const float* rpb; const unsigned* kmx; };

#ifndef ABL
#define ABL 0
#endif
template <int KIND, bool CTXQ, bool DUMMY = false>
__device__ __forceinline__ void attn_unit(Frame& F, const AttnArgs& A, int unit) {
    constexpr int AB = DUMMY ? ABL : 0;
    constexpr int DQK = (KIND == AT_MLA) ? 96 : 64, KS = DQK + 8, NP = DQK / 8, NS = DQK / 16;
    constexpr int KT_BYTES = 64 * KS * 2, VT_BYTES = 8448, VDH = 4224;
    LAS unsigned char* lds = F.lds;
    LAS unsigned char* Vt[2] = {lds + 3 * KT_BYTES, lds + 3 * KT_BYTES + VT_BYTES};
    LAS float* rpbl = (LAS float*)(lds + 3 * KT_BYTES + 2 * VT_BYTES);
    int lane = lane_id(); asm volatile("" : "+v"(lane));
    const int w = F.wave, tid = w * 64 + lane, r32 = lane & 31, hi = lane >> 5;

    int b, h = 0, g = 0, n = 0;
    if (KIND == AT_MLA) { if (CTXQ) { b = unit >> 2; h = unit & 3; } else { b = unit >> 7; h = (unit >> 5) & 3; n = unit & 31; } }
    else if (KIND == AT_SWA) { if (CTXQ) { b = unit >> 2; g = (unit >> 1) & 1; n = unit & 1; } else { b = unit >> 7; g = (unit >> 6) & 1; n = unit & 63; } }
    else { if (CTXQ) { b = unit >> 2; h = unit & 3; } else { b = unit >> 7; h = (unit >> 5) & 3; n = unit & 31; } }
    const size_t rb = (size_t)b * NB;

    int qj;
    int hq = h, qpos = 0, qrow = 0, qcol = 0;
    if (KIND == AT_MLA) qj = CTXQ ? (32 * w + r32) : (CTXL + 256 * n + 32 * w + r32);
    else if (KIND == AT_SWA) { hq = 2 * g + (w >> 2); qpos = 128 * n + 32 * (w & 3) + r32; qj = CTXQ ? qpos : CTXL + qpos; }
    else { if (CTXQ) qj = 32 * w + r32; else { qrow = 4 * n + (w >> 1); qcol = 32 * (w & 1) + r32; qj = CTXL + qrow * 64 + qcol; } }
    const int qcolbase = (KIND == AT_MLA) ? (C_MLAQ + hq * 96) : (KIND == AT_SWA) ? (C_SWAQ + hq * 64) : (C_NAQ + hq * 64);
    constexpr int QSB = DQK * 2 + 16, WSTB = 32 * 208;
    LAS unsigned char* wst = lds + 3 * KT_BYTES + 2 * VT_BYTES + 2048 + w * WSTB;
    bf16x8 qr[NS];
    {
        const int qj0 = __builtin_amdgcn_readfirstlane(qj - r32);
        const bf16_t* q0 = A.P + (rb + qj0) * PW + qcolbase;
#pragma unroll
        for (int i = 0; i < NP / 2; ++i) { const int idx = lane + 64 * i, row = idx / NP, ch = idx - row * NP;
            *(LAS u32x4*)(wst + row * QSB + ch * 16) = *(const GAS u32x4*)(q0 + (size_t)row * PW + ch * 8); }
        LDS_WAIT(); asm volatile("" ::: "memory");
#pragma unroll
        for (int s = 0; s < NS; ++s) qr[s] = *(const LAS bf16x8*)(wst + r32 * QSB + (16 * s + 8 * hi) * 2);
        LDS_WAIT(); asm volatile("" ::: "memory");
    }

    int nt = 4, band_lo = 0;
    if (!CTXQ) {
        if (KIND == AT_MLA) nt = 132;
        else if (KIND == AT_SWA) { band_lo = (n == 0) ? 2 : 0; const int band_hi = (n == 63) ? 4 : 6; nt = 4 + band_hi - band_lo; }
        else { int lo = 4 * n - 4; lo = lo < 0 ? 0 : (lo > 120 ? 120 : lo); int hi2 = 4 * n + 3 - 4; hi2 = hi2 < 0 ? 0 : (hi2 > 120 ? 120 : hi2); band_lo = lo; nt = 4 + (hi2 + 7 - lo + 1); }
    }
    auto tile_j0 = [&](int t) -> int {
        if (t < 4) return 64 * t;
        if (KIND == AT_MLA) return 64 * t;
        if (KIND == AT_SWA) return CTXL + 128 * (n - 1) + 64 * (band_lo + t - 4);
        return CTXL + 64 * (band_lo + t - 4);
    };
    int na_rs = 0, na_cs = 0;
    if (KIND == AT_NA && !CTXQ) { na_rs = qrow - 4; na_rs = na_rs < 0 ? 0 : (na_rs > 120 ? 120 : na_rs); na_cs = qcol - 8; na_cs = na_cs < 0 ? 0 : (na_cs > 48 ? 48 : na_cs); }

    const int vkey = tid >> 3, vdp = tid & 7;
    const int kcolbase = (KIND == AT_SWA) ? (C_SWAK + g * 64) : (C_NAK + h * 64);
    const int vcolbase = (KIND == AT_SWA) ? (C_SWAV + g * 64) : (C_NAV + h * 64);
    constexpr int KPITCH0 = (KIND == AT_MLA) ? KVW : PW, VPITCH = (KIND == AT_MLA) ? KVW : PW;
    const GAS char* kbase0 = (KIND == AT_MLA) ? (const GAS char*)(A.KV + rb * KVW + h * 128) : (const GAS char*)(A.P + rb * PW + kcolbase);
    const GAS char* kbase1 = (const GAS char*)(A.P + rb * PW + C_KR);
    const GAS char* vbase = (KIND == AT_MLA) ? (const GAS char*)(A.KV + rb * KVW + h * 128 + 64) : (const GAS char*)(A.P + rb * PW + vcolbase);
    const unsigned koff0 = (unsigned)((tid >> 3) * KPITCH0 + (tid & 7) * 8) * 2u, koff1 = (unsigned)((tid >> 3) * PW + (tid & 7) * 4) * 2u, voff = (unsigned)(vkey * VPITCH + vdp * 8) * 2u;
    constexpr bool has_k1 = (DQK == 96);
    const unsigned kl0 = (unsigned)((tid >> 3) * (KS * 2) + (tid & 7) * 16), kl1 = (unsigned)((tid >> 3) * (KS * 2) + 128 + (tid & 7) * 8);
    struct Stage { u32x4 k0; u32x2 k1; u32x4 v; };
    auto gloadK = [&](Stage& R, int t) { const int j0 = tile_j0(t); R.k0 = *(const GAS u32x4*)(kbase0 + (size_t)j0 * (KPITCH0 * 2) + koff0); if (has_k1) R.k1 = *(const GAS u32x2*)(kbase1 + (size_t)j0 * (PW * 2) + koff1); };
    auto gloadV = [&](Stage& R, int t) { R.v = *(const GAS u32x4*)(vbase + (size_t)tile_j0(t) * (VPITCH * 2) + voff); };
    auto lstoreK = [&](const Stage& R, int kofs) { *(LAS u32x4*)(lds + kofs + kl0) = R.k0; if (has_k1) *(LAS u32x2*)(lds + kofs + kl1) = R.k1; };
    const unsigned vlo = (unsigned)((vdp >> 2) * VDH + (vkey >> 4) * 1024 + (vkey & 15) * 64 + (vdp & 3) * 16);
    auto lstoreV = [&](const Stage& R, int buf) { *(LAS u32x4*)(Vt[buf] + vlo) = R.v; };
    struct KF { bf16x8 f[NS]; };
    auto kread = [&](KF& K, int kofs, int hf) {
        const LAS unsigned char* kb = lds + kofs + (32 * hf + r32) * (KS * 2) + hi * 16;
#pragma unroll
        for (int q = 0; q < NS; ++q) K.f[q] = *(const LAS bf16x8*)(kb + q * 32);
    };
    auto qkh = [&](const KF& K, const f32x16& negm, f32x16& p) {
        p = __builtin_amdgcn_mfma_f32_32x32x16_bf16(K.f[0], qr[0], negm, 0, 0, 0);
#pragma unroll
        for (int q = 1; q < NS; ++q) p = __builtin_amdgcn_mfma_f32_32x32x16_bf16(K.f[q], qr[q], p, 0, 0, 0);
    };
    struct VF { u32x2 l0[2], h0[2], l1[2], h1[2]; };
    typedef short v4i16_t __attribute__((ext_vector_type(4)));
    const unsigned vro = (unsigned)(((lane >> 4) & 1) * 32 + (lane & 3) * 8 + (4 * hi + ((lane & 15) >> 2)) * 64);
    auto vtr = [&](const LAS unsigned char* p) { return __builtin_bit_cast(u32x2, __builtin_amdgcn_ds_read_tr16_b64_v4i16((LAS v4i16_t*)p)); };
    auto vread = [&](VF& V, int buf, int hf) {
        const LAS unsigned char* vb = Vt[buf] + vro + hf * 2048;
#pragma unroll
        for (int q = 0; q < 2; ++q) { V.l0[q] = vtr(vb + q * 1024); V.h0[q] = vtr(vb + q * 1024 + 512);
            V.l1[q] = vtr(vb + VDH + q * 1024); V.h1[q] = vtr(vb + VDH + q * 1024 + 512); }
    };
    auto mask_half = [&](int t, int hf, f32x16& p) {
        if (CTXQ) return;
        if (KIND == AT_SWA) {
            if (t < 4) return;
            const int dbu = -128 + 64 * (band_lo + t - 4) + 32 * hf - 32 * (w & 3);
            if (dbu >= -97 && dbu <= 97) return;
            if (dbu > 159 || dbu < -159) {
#pragma unroll
                for (int r = 0; r < 16; ++r) p[r] = -1.0e30f;
                return;
            }
            int db = 128 * (n - 1) + 64 * (band_lo + t - 4) + 32 * hf + 4 * hi - qpos;
            asm volatile("" : "+v"(db));
#pragma unroll
            for (int r = 0; r < 16; ++r) { const int c = (r & 3) + 8 * (r >> 2); if (db > 128 - c || db < -128 - c) p[r] = -1.0e30f; }
        } else if (KIND == AT_NA) {
            const bool band = t >= 4;
            const int krow = band_lo + t - 4;
            if (band && !(krow >= na_rs && krow < na_rs + 8)) {
#pragma unroll
                for (int r = 0; r < 16; ++r) p[r] = -1.0e30f;
                return;
            }
            const bool rowok = true;
            const int dr = band ? (krow - qrow + 7) : 0;
            int e = 4 * hi + 32 * hf - na_cs;
            const LAS float* brow = rpbl + (dr < 0 ? 0 : (dr > 14 ? 14 : dr)) * 32 + (15 - qcol + 4 * hi + 32 * hf);
            asm volatile("" : "+v"(e));
#pragma unroll
            for (int r = 0; r < 16; ++r) { const int c = (r & 3) + 8 * (r >> 2);
                const bool v0 = rowok && (!band || (unsigned)(e + c) < 16u);
                const float b0 = (band && v0) ? brow[c] : 0.f;
                p[r] = v0 ? p[r] + b0 : -1.0e30f; }
        }
    };

    if (KIND == AT_NA && !CTXQ) { for (int i = tid; i < 15 * 32; i += NTHR) { const int dr = i >> 5, dc = i & 31; rpbl[i] = (dc < 31) ? ((const GAS float*)A.rpb)[(h * 15 + dr) * 31 + dc] * LOG2E : 0.f; } }

    nt = __builtin_amdgcn_readfirstlane(nt); asm volatile("" : "+s"(nt));
    Stage RA, RB;
    RA.k1 = (u32x2){0u, 0u}; RB.k1 = RA.k1;
    gloadK(RA, 0); gloadV(RA, 0); gloadK(RB, nt > 1 ? 1 : 0);
    lstoreK(RA, 0); lstoreV(RA, 0); lstoreK(RB, KT_BYTES);
    int kA = 0, kB = KT_BYTES, kC = 2 * KT_BYTES;
    gloadK(RB, nt > 2 ? 2 : nt - 1); gloadV(RB, nt > 1 ? 1 : nt - 1);
    __syncthreads();
    float m_ref, l_run = 0.f;
    f32x16 o0, o1, pa, pb, negm;
#pragma unroll
    for (int r = 0; r < 16; ++r) { o0[r] = 0.f; o1[r] = 0.f; negm[r] = 0.f; }
    if (KIND == AT_MLA) {
        float q2 = 0.f;
#pragma unroll
        for (int s = 0; s < NS; ++s) { const u32x4 w4 = __builtin_bit_cast(u32x4, qr[s]);
            q2 += (bf_lo(w4.x) * bf_lo(w4.x) + bf_hi(w4.x) * bf_hi(w4.x)) + (bf_lo(w4.y) * bf_lo(w4.y) + bf_hi(w4.y) * bf_hi(w4.y)) + (bf_lo(w4.z) * bf_lo(w4.z) + bf_hi(w4.z) * bf_hi(w4.z)) + (bf_lo(w4.w) * bf_lo(w4.w) + bf_hi(w4.w) * bf_hi(w4.w)); }
        q2 = xsum32(q2);
        const float k2 = __uint_as_float(__hip_atomic_load((const GAS unsigned*)A.kmx + b * 4 + h, __ATOMIC_RELAXED, __HIP_MEMORY_SCOPE_AGENT)) + __uint_as_float(__hip_atomic_load((const GAS unsigned*)A.kmx + 16 + b, __ATOMIC_RELAXED, __HIP_MEMORY_SCOPE_AGENT));
        m_ref = sqrtf(q2 * k2) * 1.02f + 0.05f;
#pragma unroll
        for (int r = 0; r < 16; ++r) negm[r] = -m_ref;
        KF K0; kread(K0, 0, 0); qkh(K0, negm, pa);
    } else {
      f32x16& pc = pa; KF K0; kread(K0, 0, 0); qkh(K0, negm, pc); mask_half(0, 0, pc);
      float mx = pc[0];
#pragma unroll
      for (int r = 1; r < 16; ++r) mx = fmaxf(mx, pc[r]);
      mx = xmax32(mx); m_ref = mx;
#pragma unroll
      for (int r = 0; r < 16; ++r) { pc[r] -= mx; negm[r] = -mx; } }
#define ATT_HALF(t, hf, tn, hn, kbuf, pc, pn) do { \
        KF Kn; VF Vc; \
        kread(Kn, (kbuf), (hn)); vread(Vc, (t) & 1, (hf)); \
        qkh(Kn, negm, pn); \
        float rsum = 0.f; \
        _Pragma("unroll") for (int r = 0; r < 16; ++r) { if (!(AB & 1)) pc[r] = fexp2(pc[r]); rsum += pc[r]; } \
        l_run += rsum; \
        mask_half((tn), (hn), pn); \
        if (KIND != AT_MLA) { \
        float mx = fmaxf(pn[0], pn[1]); \
        _Pragma("unroll") for (int r = 2; r < 16; ++r) mx = fmaxf(mx, pn[r]); \
        mx = xmax32(mx); \
        if (__builtin_expect(((tn) < nt) && __any(mx > ATT_THR), 0)) { \
            const float d = fmaxf(mx, 0.f), al = fexp2(-d); \
            m_ref += d; l_run *= al; \
            _Pragma("unroll") for (int r = 0; r < 16; ++r) { pn[r] -= d; o0[r] *= al; o1[r] *= al; pc[r] *= al; negm[r] = -m_ref; } \
        } } \
        const bf16x8 pf0 = __builtin_bit_cast(bf16x8, (u32x4){cvt_pk_bf16(pc[0], pc[1]), cvt_pk_bf16(pc[2], pc[3]), cvt_pk_bf16(pc[4], pc[5]), cvt_pk_bf16(pc[6], pc[7])}); \
        const bf16x8 pf1 = __builtin_bit_cast(bf16x8, (u32x4){cvt_pk_bf16(pc[8], pc[9]), cvt_pk_bf16(pc[10], pc[11]), cvt_pk_bf16(pc[12], pc[13]), cvt_pk_bf16(pc[14], pc[15])}); \
        o0 = __builtin_amdgcn_mfma_f32_32x32x16_bf16(__builtin_bit_cast(bf16x8, (u32x4){Vc.l0[0].x, Vc.l0[0].y, Vc.h0[0].x, Vc.h0[0].y}), pf0, o0, 0, 0, 0); \
        o1 = __builtin_amdgcn_mfma_f32_32x32x16_bf16(__builtin_bit_cast(bf16x8, (u32x4){Vc.l1[0].x, Vc.l1[0].y, Vc.h1[0].x, Vc.h1[0].y}), pf0, o1, 0, 0, 0); \
        o0 = __builtin_amdgcn_mfma_f32_32x32x16_bf16(__builtin_bit_cast(bf16x8, (u32x4){Vc.l0[1].x, Vc.l0[1].y, Vc.h0[1].x, Vc.h0[1].y}), pf1, o0, 0, 0, 0); \
        o1 = __builtin_amdgcn_mfma_f32_32x32x16_bf16(__builtin_bit_cast(bf16x8, (u32x4){Vc.l1[1].x, Vc.l1[1].y, Vc.h1[1].x, Vc.h1[1].y}), pf1, o1, 0, 0, 0); \
    } while (0)
#define ATT_STEP(t, RL, RS) do { \
        if (!(AB & 32)) { const int tk_ = ((t) + 3 < nt) ? (t) + 3 : nt - 1, tv_ = ((t) + 2 < nt) ? (t) + 2 : nt - 1; gloadK(RL, tk_); gloadV(RL, tv_); } \
        ATT_HALF(t, 0, t, 1, kA, pa, pb); \
        ATT_HALF(t, 1, (t) + 1, 0, kB, pb, pa); \
        if (!(AB & 64)) lstoreK(RS, kC); if (!(AB & 8)) lstoreV(RS, ((t) + 1) & 1); \
        { const int k_ = kA; kA = kB; kB = kC; kC = k_; } \
        if (!(AB & 16)) __syncthreads(); \
    } while (0)
#pragma nounroll
    for (int t = 0; t < nt; t += 2) {
        ATT_STEP(t, RA, RB);
        if (t + 1 < nt) ATT_STEP(t + 1, RB, RA);
    }
#undef ATT_STEP
#undef ATT_HALF
    const float m_run = m_ref;
    float l_tot = xsum32(l_run);
    if (KIND == AT_SWA) l_tot += fexp2(((const GAS float*)A.sink)[hq] * LOG2E - m_run);
    const float rl = ((KIND == AT_MLA) ? SC_MLA : (KIND == AT_SWA) ? SC_SWA : SC_NA) / l_tot;
    const int ycol = (KIND == AT_MLA) ? (hq * 64) : (KIND == AT_SWA) ? (256 + hq * 64) : (512 + hq * 64);
    LAS unsigned char* ost = wst;
#pragma unroll
    for (int q4 = 0; q4 < 4; ++q4) {
        u32x2 w0, w1;
        w0.x = cvt_pk_bf16(o0[4 * q4] * rl, o0[4 * q4 + 1] * rl); w0.y = cvt_pk_bf16(o0[4 * q4 + 2] * rl, o0[4 * q4 + 3] * rl);
        w1.x = cvt_pk_bf16(o1[4 * q4] * rl, o1[4 * q4 + 1] * rl); w1.y = cvt_pk_bf16(o1[4 * q4 + 2] * rl, o1[4 * q4 + 3] * rl);
        *(LAS u32x2*)(ost + r32 * 144 + (4 * hi + 8 * q4) * 2) = w0; *(LAS u32x2*)(ost + r32 * 144 + (32 + 4 * hi + 8 * q4) * 2) = w1;
    }
    LDS_WAIT(); asm volatile("" ::: "memory");
    const int qj0 = __builtin_amdgcn_readfirstlane(qj);
#pragma unroll
    for (int i = 0; i < 4; ++i) { const int rr = 8 * i + (lane >> 3), ch = lane & 7;
        *(GAS u32x4*)(A.Y + (rb + qj0 + rr) * DM + ycol + 8 * ch) = *(const LAS u32x4*)(ost + rr * 144 + 16 * ch); }
    LDS_WAIT(); asm volatile("" ::: "memory");
}
constexpr int RVS = 132;
struct RetArgs { const bf16_t* P; bf16_t* Y; float* RS; const float* decay_f; const float* decay_b; const float* gn_f; const float* gn_b; };
__device__ __forceinline__ float log2_sigmoid(float d) { return -log2f(1.0f + expf(-d)); }

struct RStage { u32x4 k[2], v[2]; };
__device__ __forceinline__ void ret_stage_load(RStage& S, const bf16_t* P, int unit, int tid) {
    const int c = unit % 66, bh = unit / 66, b = bh >> 2, h = bh & 3;
    const size_t row0 = (size_t)b * NB + 128 * c;
#pragma unroll
    for (int j = 0; j < 2; ++j) {
        const int q = tid + 512 * j, tok = q >> 3, dp = q & 7;
        const bf16_t* pr = P + (row0 + tok) * PW + h * 64 + dp * 8;
        S.k[j] = *(const GAS u32x4*)(pr + C_RK); S.v[j] = *(const GAS u32x4*)(pr + C_RV);
    }
}
__device__ __forceinline__ void ret_local_loop(Frame& F, const RetArgs& A, int u0, int ustep, int nunits) {
    int lane = lane_id(); asm volatile("" : "+v"(lane));
    const int w = F.wave, tid = w * 64 + lane, r32 = lane & 31, hi = lane >> 5;
    LAS bf16_t* Ktt = (LAS bf16_t*)F.lds;
    LAS bf16_t* Vtf = Ktt + 64 * RVS;
    LAS bf16_t* Vtb = Vtf + 64 * RVS;
    RStage S;
    int unit = u0;
    if (unit < nunits) ret_stage_load(S, A.P, unit, tid);
    __syncthreads();
    while (unit < nunits) {
        const int c = unit % 66, bh = unit / 66, h = bh & 3;
        const float lgf = log2_sigmoid(((const GAS float*)A.decay_f)[h]), lgb = log2_sigmoid(((const GAS float*)A.decay_b)[h]);
#pragma unroll
        for (int j = 0; j < 2; ++j) {
            const int q = tid + 512 * j, tok = q >> 3, dp = q & 7;
            const float wf = fexp2(lgf * (float)(127 - tok)), wb = fexp2(lgb * (float)tok);
            LAS bf16_t* kt = Ktt + (8 * dp) * RVS + tok; LAS bf16_t* vf = Vtf + (8 * dp) * RVS + tok; LAS bf16_t* vb = Vtb + (8 * dp) * RVS + tok;
            const unsigned kw[4] = {S.k[j].x, S.k[j].y, S.k[j].z, S.k[j].w}, vw[4] = {S.v[j].x, S.v[j].y, S.v[j].z, S.v[j].w};
#pragma unroll
            for (int e = 0; e < 4; ++e) {
                kt[(2 * e) * RVS] = (bf16_t)(kw[e] & 0xffffu); kt[(2 * e + 1) * RVS] = (bf16_t)(kw[e] >> 16);
                const float v0 = bf_lo(vw[e]), v1 = bf_hi(vw[e]);
                const unsigned pf = cvt_pk_bf16(v0 * wf, v1 * wf), pb = cvt_pk_bf16(v0 * wb, v1 * wb);
                vf[(2 * e) * RVS] = (bf16_t)(pf & 0xffffu); vf[(2 * e + 1) * RVS] = (bf16_t)(pf >> 16);
                vb[(2 * e) * RVS] = (bf16_t)(pb & 0xffffu); vb[(2 * e + 1) * RVS] = (bf16_t)(pb >> 16);
            }
        }
        const int unext = unit + ustep;
        if (unext < nunits) ret_stage_load(S, A.P, unext, tid);
        __syncthreads();
        const int dir = w >> 2, dvb = (w >> 1) & 1, dkb = w & 1;
        const LAS bf16_t* va = (dir ? Vtb : Vtf) + (32 * dvb + r32) * RVS + 8 * hi;
        const LAS bf16_t* kb = Ktt + (32 * dkb + r32) * RVS + 8 * hi;
        f32x16 acc;
#pragma unroll
        for (int r = 0; r < 16; ++r) acc[r] = 0.f;
#pragma unroll
        for (int s = 0; s < 8; ++s) {
            const u32x2 a0 = *(const LAS u32x2*)(va + 16 * s), a1 = *(const LAS u32x2*)(va + 16 * s + 4);
            const u32x2 b0 = *(const LAS u32x2*)(kb + 16 * s), b1 = *(const LAS u32x2*)(kb + 16 * s + 4);
            acc = __builtin_amdgcn_mfma_f32_32x32x16_bf16(__builtin_bit_cast(bf16x8, (u32x4){a0.x, a0.y, a1.x, a1.y}), __builtin_bit_cast(bf16x8, (u32x4){b0.x, b0.y, b1.x, b1.y}), acc, 0, 0, 0);
        }
        GAS float* out = (GAS float*)A.RS + ((size_t)(bh * 2 + dir) * 66 + c) * 4096 + 32 * dkb + r32;
#pragma unroll
        for (int r = 0; r < 16; ++r) out[(32 * dvb + crow(r, hi)) * 64] = acc[r];
        __syncthreads();
        unit = unext;
    }
}

__device__ __forceinline__ void ret_scan(Frame& F, const RetArgs& A) {
    for (int e = blockIdx.x * NTHR + F.tid; e < 32 * 4096; e += F.G * NTHR) {
        const int seq = e >> 12, el = e & 4095, dir = seq & 1, h = (seq >> 1) & 3;
        const float a = fexp2(128.0f * log2_sigmoid(dir ? ((const GAS float*)A.decay_b)[h] : ((const GAS float*)A.decay_f)[h]));
        GAS float* base = (GAS float*)A.RS + (size_t)seq * 66 * 4096 + el;
        float s = 0.f;
#pragma nounroll
        for (int n0 = 0; n0 < 66; n0 += 11) {
            int nb = n0; asm volatile("" : "+s"(nb));
            float u[11];
#pragma unroll
            for (int i = 0; i < 11; ++i) { const int n = nb + i; const int c = dir ? ((n < 2) ? 1 - n : 67 - n) : n; u[i] = base[(size_t)c * 4096]; }
#pragma unroll
            for (int i = 0; i < 11; ++i) { const int n = nb + i; const int c = dir ? ((n < 2) ? 1 - n : 67 - n) : n; base[(size_t)c * 4096] = s; s = a * s + u[i]; }
        }
    }
}

struct RStage3 { u32x4 k[2], v[2], q[2]; f32x4 st[4]; };
__device__ __forceinline__ void ret_stage_load3(RStage3& S, const bf16_t* P, const float* RS, int unit, int tid) {
    const int c = unit % 66, bh = unit / 66, b = bh >> 2, h = bh & 3;
    const size_t row0 = (size_t)b * NB + 128 * c;
#pragma unroll
    for (int j = 0; j < 2; ++j) {
        const int q = tid + 512 * j, tok = q >> 3, dp = q & 7;
        const bf16_t* pr = P + (row0 + tok) * PW + h * 64 + dp * 8;
        S.k[j] = *(const GAS u32x4*)(pr + C_RK); S.v[j] = *(const GAS u32x4*)(pr + C_RV); S.q[j] = *(const GAS u32x4*)(pr + C_RQ);
    }
#pragma unroll
    for (int k = 0; k < 4; ++k) S.st[k] = ((const GAS f32x4*)(RS + ((size_t)(bh * 2 + (k >> 1)) * 66 + c) * 4096))[tid + 512 * (k & 1)];
}
__device__ __forceinline__ void ret_out_loop(Frame& F, const RetArgs& A, int u0, int ustep, int nunits, bool skipctx) {
    int lane = lane_id(); asm volatile("" : "+v"(lane));
    const int w = F.wave, tid = w * 64 + lane, r32 = lane & 31, hi = lane >> 5;
    constexpr int KS = 72;
    LAS unsigned char* Kc = F.lds;
    LAS bf16_t* Vt = (LAS bf16_t*)(F.lds + 128 * KS * 2);
    LAS float* comb = (LAS float*)(F.lds + 128 * KS * 2 + 64 * RVS * 2);
    auto nextu = [&](int u) { u += ustep; while (skipctx && u < nunits && (u % 66) < 2) u += ustep; return u; };
    int unit = u0; while (skipctx && unit < nunits && (unit % 66) < 2) unit += ustep;
    LAS float* Sst = comb + 128 * 65;
    LAS unsigned char* Qc = (LAS unsigned char*)(Sst + 2 * 64 * 68);
    RStage3 S;
    if (unit < nunits) ret_stage_load3(S, A.P, A.RS, unit, tid);
    LAS float* gnl = (LAS float*)(F.lds + 122880);
    gnl[tid] = (tid < 256) ? ((const GAS float*)A.gn_f)[tid] : ((const GAS float*)A.gn_b)[tid - 256];
    __syncthreads();
    while (unit < nunits) {
    const int c = unit % 66, bh = unit / 66, b = bh >> 2, h = bh & 3;
    const size_t row0 = (size_t)b * NB + 128 * c;
    const int dir = w >> 2, qg = w & 3, qi = 32 * qg + r32;
    const bf16_t* prow = A.P + (row0 + qi) * PW;
#pragma unroll
    for (int j = 0; j < 2; ++j) {
        const int q = tid + 512 * j, tok = q >> 3, dp = q & 7;
        *(LAS u32x4*)(Kc + tok * (KS * 2) + dp * 16) = S.k[j];
        *(LAS u32x4*)(Qc + tok * (KS * 2) + dp * 16) = S.q[j];
        const u32x4 vv = S.v[j];
        LAS bf16_t* vt = Vt + (8 * dp) * RVS + tok;
        vt[0 * RVS] = (bf16_t)(vv.x & 0xffffu); vt[1 * RVS] = (bf16_t)(vv.x >> 16); vt[2 * RVS] = (bf16_t)(vv.y & 0xffffu); vt[3 * RVS] = (bf16_t)(vv.y >> 16);
        vt[4 * RVS] = (bf16_t)(vv.z & 0xffffu); vt[5 * RVS] = (bf16_t)(vv.z >> 16); vt[6 * RVS] = (bf16_t)(vv.w & 0xffffu); vt[7 * RVS] = (bf16_t)(vv.w >> 16);
    }
#pragma unroll
    for (int k = 0; k < 4; ++k) { const int e4 = tid + 512 * (k & 1); *(LAS f32x4*)(Sst + (k >> 1) * (64 * 68) + (e4 >> 4) * 68 + (e4 & 15) * 4) = S.st[k]; }
    const int unext = nextu(unit);
    if (unext < nunits) ret_stage_load3(S, A.P, A.RS, unext, tid);
    const float lg = log2_sigmoid(dir ? ((const GAS float*)A.decay_b)[h] : ((const GAS float*)A.decay_f)[h]);
    f32x16 o0, o1;
#pragma unroll
    for (int r = 0; r < 16; ++r) { o0[r] = 0.f; o1[r] = 0.f; }
    __syncthreads();
    bf16x8 qr[4];
#pragma unroll
    for (int s = 0; s < 4; ++s) qr[s] = *(const LAS bf16x8*)(Qc + qi * (KS * 2) + hi * 16 + s * 32);
    { const LAS float* sp = Sst + dir * (64 * 68) + r32 * 68 + 8 * hi;
#pragma unroll
    for (int s = 0; s < 4; ++s) {
        const f32x4 a0 = *(const LAS f32x4*)(sp + 16 * s), a1 = *(const LAS f32x4*)(sp + 16 * s + 4), b0 = *(const LAS f32x4*)(sp + 32 * 68 + 16 * s), b1 = *(const LAS f32x4*)(sp + 32 * 68 + 16 * s + 4);
        const bf16x8 fa = __builtin_bit_cast(bf16x8, (u32x4){cvt_pk_bf16(a0[0], a0[1]), cvt_pk_bf16(a0[2], a0[3]), cvt_pk_bf16(a1[0], a1[1]), cvt_pk_bf16(a1[2], a1[3])});
        const bf16x8 fb = __builtin_bit_cast(bf16x8, (u32x4){cvt_pk_bf16(b0[0], b0[1]), cvt_pk_bf16(b0[2], b0[3]), cvt_pk_bf16(b1[0], b1[1]), cvt_pk_bf16(b1[2], b1[3])});
        o0 = __builtin_amdgcn_mfma_f32_32x32x16_bf16(fa, qr[s], o0, 0, 0, 0);
        o1 = __builtin_amdgcn_mfma_f32_32x32x16_bf16(fb, qr[s], o1, 0, 0, 0);
    } }
    { const float qdec = fexp2(lg * (float)(dir ? (128 - qi) : (qi + 1)));
#pragma unroll
      for (int r = 0; r < 16; ++r) { o0[r] *= qdec; o1[r] *= qdec; } }
#pragma unroll
    for (int kt = 0; kt < 2; ++kt) {
        const bool need = dir ? (64 * kt + 63 >= 32 * qg) : (64 * kt <= 32 * qg + 31);
        if (!need) continue;
        f32x16 p0, p1;
#pragma unroll
        for (int r = 0; r < 16; ++r) { p0[r] = 0.f; p1[r] = 0.f; }
        const LAS unsigned char* kb = Kc + (64 * kt + r32) * (KS * 2) + hi * 16;
#pragma unroll
        for (int s = 0; s < 4; ++s) {
            const bf16x8 a0 = *(const LAS bf16x8*)(kb + s * 32), a1 = *(const LAS bf16x8*)(kb + 32 * (KS * 2) + s * 32);
            p0 = __builtin_amdgcn_mfma_f32_32x32x16_bf16(a0, qr[s], p0, 0, 0, 0);
            p1 = __builtin_amdgcn_mfma_f32_32x32x16_bf16(a1, qr[s], p1, 0, 0, 0);
        }
#pragma unroll
        for (int r = 0; r < 16; ++r) {
            const int j0 = 64 * kt + crow(r, hi), j1 = j0 + 32;
            const int d0 = dir ? (j0 - qi) : (qi - j0), d1 = dir ? (j1 - qi) : (qi - j1);
            p0[r] = (d0 >= 0) ? p0[r] * fexp2(lg * (float)d0) : 0.f;
            p1[r] = (d1 >= 0) ? p1[r] * fexp2(lg * (float)d1) : 0.f;
        }
        u32x4 pw[4];
        pw[0] = (u32x4){cvt_pk_bf16(p0[0], p0[1]), cvt_pk_bf16(p0[2], p0[3]), cvt_pk_bf16(p0[4], p0[5]), cvt_pk_bf16(p0[6], p0[7])};
        pw[1] = (u32x4){cvt_pk_bf16(p0[8], p0[9]), cvt_pk_bf16(p0[10], p0[11]), cvt_pk_bf16(p0[12], p0[13]), cvt_pk_bf16(p0[14], p0[15])};
        pw[2] = (u32x4){cvt_pk_bf16(p1[0], p1[1]), cvt_pk_bf16(p1[2], p1[3]), cvt_pk_bf16(p1[4], p1[5]), cvt_pk_bf16(p1[6], p1[7])};
        pw[3] = (u32x4){cvt_pk_bf16(p1[8], p1[9]), cvt_pk_bf16(p1[10], p1[11]), cvt_pk_bf16(p1[12], p1[13]), cvt_pk_bf16(p1[14], p1[15])};
        const LAS bf16_t* vb = Vt + r32 * RVS + 64 * kt + 4 * hi;
#pragma unroll
        for (int s = 0; s < 4; ++s) {
            const u32x2 l0 = *(const LAS u32x2*)(vb + 16 * s), h0 = *(const LAS u32x2*)(vb + 16 * s + 8);
            const u32x2 l1 = *(const LAS u32x2*)(vb + 32 * RVS + 16 * s), h1 = *(const LAS u32x2*)(vb + 32 * RVS + 16 * s + 8);
            const bf16x8 pf = __builtin_bit_cast(bf16x8, pw[s]);
            o0 = __builtin_amdgcn_mfma_f32_32x32x16_bf16(__builtin_bit_cast(bf16x8, (u32x4){l0.x, l0.y, h0.x, h0.y}), pf, o0, 0, 0, 0);
            o1 = __builtin_amdgcn_mfma_f32_32x32x16_bf16(__builtin_bit_cast(bf16x8, (u32x4){l1.x, l1.y, h1.x, h1.y}), pf, o1, 0, 0, 0);
        }
    }
    float sum = 0.f;
#pragma unroll
    for (int r = 0; r < 16; ++r) sum += o0[r] + o1[r];
    sum = xsum32(sum);
    const float mu = sum * (1.f / 64.f);
    float var = 0.f;
#pragma unroll
    for (int r = 0; r < 16; ++r) { o0[r] -= mu; o1[r] -= mu; var += o0[r] * o0[r] + o1[r] * o1[r]; }
    var = xsum32(var);
    const float rstd = 1.0f / sqrtf(var * (1.f / 64.f) + EPS);
    const LAS float* gn = gnl + dir * 256 + h * 64 + 4 * hi;
    u32x4 G[4];
    { const bf16_t* gp = prow + (dir ? C_RGB : C_RGF) + h * 64 + 32 * hi;
#pragma unroll
      for (int j = 0; j < 4; ++j) G[j] = *(const GAS u32x4*)(gp + 8 * j);
#pragma unroll
      for (int j = 0; j < 4; ++j) { auto r0 = __builtin_amdgcn_permlane32_swap(G[j].x, G[j].z, false, false); auto r1 = __builtin_amdgcn_permlane32_swap(G[j].y, G[j].w, false, false);
          G[j].x = r0[0]; G[j].z = r0[1]; G[j].y = r1[0]; G[j].w = r1[1]; } }
    LAS float* cb = comb + qi * 65 + 4 * hi;
    if (dir == 1) {
#pragma unroll
        for (int q4 = 0; q4 < 4; ++q4)
#pragma unroll
            for (int half = 0; half < 2; ++half) {
                const int d = 8 * q4 + 32 * half; const f32x4 g4 = *(const LAS f32x4*)(gn + d); const u32x2 gw = half ? (u32x2){G[q4].z, G[q4].w} : (u32x2){G[q4].x, G[q4].y};
                const float gt[4] = {bf_lo(gw.x), bf_hi(gw.x), bf_lo(gw.y), bf_hi(gw.y)};
#pragma unroll
                for (int e = 0; e < 4; ++e) { const float ov = half ? o1[4 * q4 + e] : o0[4 * q4 + e]; cb[d + e] = silu_f(gt[e]) * (ov * rstd) * g4[e]; }
            }
    }
    __syncthreads();
    if (dir == 0) {
#pragma unroll
        for (int q4 = 0; q4 < 4; ++q4)
#pragma unroll
            for (int half = 0; half < 2; ++half) {
                const int d = 8 * q4 + 32 * half; const f32x4 g4 = *(const LAS f32x4*)(gn + d); const u32x2 gw = half ? (u32x2){G[q4].z, G[q4].w} : (u32x2){G[q4].x, G[q4].y};
                const float gt[4] = {bf_lo(gw.x), bf_hi(gw.x), bf_lo(gw.y), bf_hi(gw.y)};
                float y[4];
#pragma unroll
                for (int e = 0; e < 4; ++e) { const float ov = half ? o1[4 * q4 + e] : o0[4 * q4 + e]; y[e] = silu_f(gt[e]) * (ov * rstd) * g4[e] + cb[d + e]; }
                u32x2 wv; wv.x = cvt_pk_bf16(y[0], y[1]); wv.y = cvt_pk_bf16(y[2], y[3]); *(LAS u32x2*)(Qc + qi * (KS * 2) + (d + 4 * hi) * 2) = wv;
            }
    }
    __syncthreads();
#pragma unroll
    for (int j = 0; j < 2; ++j) { const int q = tid + 512 * j, tok = q >> 3, dp = q & 7;
        *(GAS u32x4*)(A.Y + (row0 + tok) * DM + 768 + h * 64 + 8 * dp) = *(const LAS u32x4*)(Qc + tok * (KS * 2) + dp * 16); }
    __syncthreads();
    unit = unext;
    }
}
#define CE(a, i, j) do { const float hi_ = fmaxf(a[i], a[j]), lo_ = fminf(a[i], a[j]); a[i] = hi_; a[j] = lo_; } while (0)
#define SORT16(a) do { CE(a,0,13); CE(a,1,12); CE(a,2,15); CE(a,3,14); CE(a,4,8); CE(a,5,6); CE(a,7,11); CE(a,9,10); CE(a,0,5); CE(a,1,7); CE(a,2,9); CE(a,3,4); CE(a,6,13); CE(a,8,14); CE(a,10,15); CE(a,11,12); CE(a,0,1); CE(a,2,3); CE(a,4,5); CE(a,6,8); CE(a,7,9); CE(a,10,11); CE(a,12,13); CE(a,14,15); CE(a,0,2); CE(a,1,3); CE(a,4,10); CE(a,5,11); CE(a,6,7); CE(a,8,9); CE(a,12,14); CE(a,13,15); CE(a,1,2); CE(a,3,12); CE(a,4,6); CE(a,5,7); CE(a,8,10); CE(a,9,11); CE(a,13,14); CE(a,1,4); CE(a,2,6); CE(a,5,8); CE(a,7,10); CE(a,9,13); CE(a,11,14); CE(a,2,4); CE(a,3,6); CE(a,9,12); CE(a,11,13); CE(a,3,5); CE(a,6,8); CE(a,7,9); CE(a,10,12); CE(a,3,4); CE(a,5,6); CE(a,7,8); CE(a,9,10); CE(a,11,12); CE(a,6,7); CE(a,8,9); } while (0)
#define MERGE16(T, C) do { T[0] = fmaxf(T[0], C[15]); T[1] = fmaxf(T[1], C[14]); T[2] = fmaxf(T[2], C[13]); T[3] = fmaxf(T[3], C[12]); T[4] = fmaxf(T[4], C[11]); T[5] = fmaxf(T[5], C[10]); T[6] = fmaxf(T[6], C[9]); T[7] = fmaxf(T[7], C[8]); T[8] = fmaxf(T[8], C[7]); T[9] = fmaxf(T[9], C[6]); T[10] = fmaxf(T[10], C[5]); T[11] = fmaxf(T[11], C[4]); T[12] = fmaxf(T[12], C[3]); T[13] = fmaxf(T[13], C[2]); T[14] = fmaxf(T[14], C[1]); T[15] = fmaxf(T[15], C[0]); CE(T,0,8); CE(T,1,9); CE(T,2,10); CE(T,3,11); CE(T,4,12); CE(T,5,13); CE(T,6,14); CE(T,7,15); CE(T,0,4); CE(T,1,5); CE(T,2,6); CE(T,3,7); CE(T,8,12); CE(T,9,13); CE(T,10,14); CE(T,11,15); CE(T,0,2); CE(T,1,3); CE(T,4,6); CE(T,5,7); CE(T,8,10); CE(T,9,11); CE(T,12,14); CE(T,13,15); CE(T,0,1); CE(T,2,3); CE(T,4,5); CE(T,6,7); CE(T,8,9); CE(T,10,11); CE(T,12,13); CE(T,14,15); } while (0)

__device__ __forceinline__ void phase_topk(Frame& F, const _Float16* S16, int* eid, float* gate, bool skipctx) {
    LAS unsigned char* timg = F.lds + F.wave * 11264;
    LAS unsigned char* ilds = F.lds + F.wave * 11264 + 9216 + F.lane;
    const int lane = F.lane, gwv = F.vcu * NWAVES + F.wave, NGW = F.G * NWAVES;
    u32x4 ld[8];
    auto nextwt = [&](int wt_) { wt_ += NGW; while (skipctx && wt_ < NROW / 8 && ((8 * wt_) % NB) < CTXL) wt_ += NGW; return wt_; };
    auto issue = [&](int wt_, int q_) { const GAS unsigned char* bl = (const GAS unsigned char*)(S16 + (size_t)(8 * wt_) * 2048);
#pragma unroll
        for (int i = 0; i < 8; ++i) ld[i] = *(const GAS u32x4*)(bl + (size_t)(8 * i + (lane >> 3)) * 512 + 128 * q_ + 16 * (lane & 7)); };
    ItemQ q_; iq_init(q_, F, 3);
    auto draw = [&]() { int x; do { const unsigned t_ = iq_take(q_, lane); x = F.vcu + (int)t_ * F.G; } while (x < NROW / 8 && skipctx && ((8 * x) % NB) < CTXL); return x; };
    int wt = draw();
    if (wt < NROW / 8) issue(wt, 0);
    while (wt < NROW / 8) {
        const int wtn = draw();
        const int row0 = 8 * wt;
        const int row = row0 + (lane >> 3), h = lane & 7;
        float v1[16], v2[16];
#pragma unroll
        for (int hf = 0; hf < 2; ++hf) {
            float T[16];
#pragma unroll
            for (int i = 0; i < 16; ++i) T[i] = -3.0e38f;
#pragma unroll
            for (int qq = 0; qq < 2; ++qq) {
                const int q = 2 * hf + qq;
#pragma unroll
                for (int i = 0; i < 8; ++i) *(LAS u32x4*)(timg + (8 * i + (lane >> 3)) * 144 + 16 * (lane & 7)) = ld[i];
                LDS_WAIT(); asm volatile("" ::: "memory");
                if (q < 3) issue(wt, q + 1); else if (wtn < NROW / 8) issue(wtn, 0);
#pragma unroll
                for (int ch = 0; ch < 4; ++ch) {
                    const u32x4 a = *(const LAS u32x4*)(timg + lane * 144 + 32 * ch), b = *(const LAS u32x4*)(timg + lane * 144 + 32 * ch + 16);
                    const unsigned wv[8] = {a.x, a.y, a.z, a.w, b.x, b.y, b.z, b.w};
                    const unsigned nb = 127u - 64u * (unsigned)qq - 16u * (unsigned)ch;
                    float c[16];
#pragma unroll
                    for (int e = 0; e < 8; ++e) {
                        typedef _Float16 h2 __attribute__((ext_vector_type(2)));
                        const h2 p = __builtin_bit_cast(h2, wv[e]);
                        c[2 * e] = __uint_as_float((__float_as_uint((float)p[0]) & ~0x7Fu) | (nb - 2 * e));
                        c[2 * e + 1] = __uint_as_float((__float_as_uint((float)p[1]) & ~0x7Fu) | (nb - 2 * e - 1));
                    }
                    SORT16(c); MERGE16(T, c);
                }
                LDS_WAIT(); asm volatile("" ::: "memory");
            }
#pragma unroll
            for (int i = 0; i < 16; ++i) { const unsigned bits = __float_as_uint(T[i]); ilds[(16 * hf + i) * 64] = (unsigned char)(127u - (bits & 0x7Fu)); (hf ? v2[i] : v1[i]) = __uint_as_float(bits & ~0x7Fu); }
        }
        float cs[16];
#pragma unroll
        for (int i = 0; i < 16; ++i) cs[i] = -3.0e38f;
        { float c[16];
        { c[0] = __uint_as_float((__float_as_uint(v1[0] + v2[0]) & ~0xFFu) | 255u); c[1] = __uint_as_float((__float_as_uint(v1[0] + v2[1]) & ~0xFFu) | 254u); c[2] = __uint_as_float((__float_as_uint(v1[0] + v2[2]) & ~0xFFu) | 253u); c[3] = __uint_as_float((__float_as_uint(v1[0] + v2[3]) & ~0xFFu) | 252u); c[4] = __uint_as_float((__float_as_uint(v1[0] + v2[4]) & ~0xFFu) | 251u); c[5] = __uint_as_float((__float_as_uint(v1[0] + v2[5]) & ~0xFFu) | 250u); c[6] = __uint_as_float((__float_as_uint(v1[0] + v2[6]) & ~0xFFu) | 249u); c[7] = __uint_as_float((__float_as_uint(v1[0] + v2[7]) & ~0xFFu) | 248u); c[8] = __uint_as_float((__float_as_uint(v1[0] + v2[8]) & ~0xFFu) | 247u); c[9] = __uint_as_float((__float_as_uint(v1[0] + v2[9]) & ~0xFFu) | 246u); c[10] = __uint_as_float((__float_as_uint(v1[0] + v2[10]) & ~0xFFu) | 245u); c[11] = __uint_as_float((__float_as_uint(v1[0] + v2[11]) & ~0xFFu) | 244u); c[12] = __uint_as_float((__float_as_uint(v1[0] + v2[12]) & ~0xFFu) | 243u); c[13] = __uint_as_float((__float_as_uint(v1[0] + v2[13]) & ~0xFFu) | 242u); c[14] = __uint_as_float((__float_as_uint(v1[0] + v2[14]) & ~0xFFu) | 241u); c[15] = __uint_as_float((__float_as_uint(v1[0] + v2[15]) & ~0xFFu) | 240u); SORT16(c); MERGE16(cs, c); }
        { c[0] = __uint_as_float((__float_as_uint(v1[1] + v2[0]) & ~0xFFu) | 239u); c[1] = __uint_as_float((__float_as_uint(v1[1] + v2[1]) & ~0xFFu) | 238u); c[2] = __uint_as_float((__float_as_uint(v1[1] + v2[2]) & ~0xFFu) | 237u); c[3] = __uint_as_float((__float_as_uint(v1[1] + v2[3]) & ~0xFFu) | 236u); c[4] = __uint_as_float((__float_as_uint(v1[1] + v2[4]) & ~0xFFu) | 235u); c[5] = __uint_as_float((__float_as_uint(v1[1] + v2[5]) & ~0xFFu) | 234u); c[6] = __uint_as_float((__float_as_uint(v1[1] + v2[6]) & ~0xFFu) | 233u); c[7] = __uint_as_float((__float_as_uint(v1[1] + v2[7]) & ~0xFFu) | 232u); c[8] = __uint_as_float((__float_as_uint(v1[2] + v2[0]) & ~0xFFu) | 223u); c[9] = __uint_as_float((__float_as_uint(v1[2] + v2[1]) & ~0xFFu) | 222u); c[10] = __uint_as_float((__float_as_uint(v1[2] + v2[2]) & ~0xFFu) | 221u); c[11] = __uint_as_float((__float_as_uint(v1[2] + v2[3]) & ~0xFFu) | 220u); c[12] = __uint_as_float((__float_as_uint(v1[2] + v2[4]) & ~0xFFu) | 219u); c[13] = __uint_as_float((__float_as_uint(v1[3] + v2[0]) & ~0xFFu) | 207u); c[14] = __uint_as_float((__float_as_uint(v1[3] + v2[1]) & ~0xFFu) | 206u); c[15] = __uint_as_float((__float_as_uint(v1[3] + v2[2]) & ~0xFFu) | 205u); SORT16(c); MERGE16(cs, c); }
        { c[0] = __uint_as_float((__float_as_uint(v1[3] + v2[3]) & ~0xFFu) | 204u); c[1] = __uint_as_float((__float_as_uint(v1[4] + v2[0]) & ~0xFFu) | 191u); c[2] = __uint_as_float((__float_as_uint(v1[4] + v2[1]) & ~0xFFu) | 190u); c[3] = __uint_as_float((__float_as_uint(v1[4] + v2[2]) & ~0xFFu) | 189u); c[4] = __uint_as_float((__float_as_uint(v1[5] + v2[0]) & ~0xFFu) | 175u); c[5] = __uint_as_float((__float_as_uint(v1[5] + v2[1]) & ~0xFFu) | 174u); c[6] = __uint_as_float((__float_as_uint(v1[6] + v2[0]) & ~0xFFu) | 159u); c[7] = __uint_as_float((__float_as_uint(v1[6] + v2[1]) & ~0xFFu) | 158u); c[8] = __uint_as_float((__float_as_uint(v1[7] + v2[0]) & ~0xFFu) | 143u); c[9] = __uint_as_float((__float_as_uint(v1[7] + v2[1]) & ~0xFFu) | 142u); c[10] = __uint_as_float((__float_as_uint(v1[8] + v2[0]) & ~0xFFu) | 127u); c[11] = __uint_as_float((__float_as_uint(v1[9] + v2[0]) & ~0xFFu) | 111u); c[12] = __uint_as_float((__float_as_uint(v1[10] + v2[0]) & ~0xFFu) | 95u); c[13] = __uint_as_float((__float_as_uint(v1[11] + v2[0]) & ~0xFFu) | 79u); c[14] = __uint_as_float((__float_as_uint(v1[12] + v2[0]) & ~0xFFu) | 63u); c[15] = __uint_as_float((__float_as_uint(v1[13] + v2[0]) & ~0xFFu) | 47u); SORT16(c); MERGE16(cs, c); }
        { c[0] = __uint_as_float((__float_as_uint(v1[14] + v2[0]) & ~0xFFu) | 31u); c[1] = __uint_as_float((__float_as_uint(v1[15] + v2[0]) & ~0xFFu) | 15u); c[2] = -3.0e38f; c[3] = -3.0e38f; c[4] = -3.0e38f; c[5] = -3.0e38f; c[6] = -3.0e38f; c[7] = -3.0e38f; c[8] = -3.0e38f; c[9] = -3.0e38f; c[10] = -3.0e38f; c[11] = -3.0e38f; c[12] = -3.0e38f; c[13] = -3.0e38f; c[14] = -3.0e38f; c[15] = -3.0e38f; SORT16(c); MERGE16(cs, c); }
        }
        float ev[16]; float den = 0.f;
        const float top = __uint_as_float(__float_as_uint(cs[0]) & ~0xFFu);
#pragma unroll
        for (int k = 0; k < 16; ++k) { ev[k] = __expf(__uint_as_float(__float_as_uint(cs[k]) & ~0xFFu) - top); den += ev[k]; }
        const float rden = 1.0f / den;
        LDS_WAIT(); asm volatile("" ::: "memory");
        int eo[16]; float go[16];
#pragma unroll
        for (int k = 0; k < 16; ++k) { const int pos = 255 - (int)(__float_as_uint(cs[k]) & 0xFFu); eo[k] = ((int)ilds[(pos >> 4) * 64] * 128 + (int)ilds[(16 + (pos & 15)) * 64]) * 128; go[k] = ev[k] * rden; }
        LAS u32x4* img = (LAS u32x4*)timg;
#pragma unroll
        for (int q = 0; q < 4; ++q) { img[lane * 4 + q] = (u32x4){(unsigned)eo[4 * q], (unsigned)eo[4 * q + 1], (unsigned)eo[4 * q + 2], (unsigned)eo[4 * q + 3]};
            img[256 + lane * 4 + q] = (u32x4){__float_as_uint(go[4 * q]), __float_as_uint(go[4 * q + 1]), __float_as_uint(go[4 * q + 2]), __float_as_uint(go[4 * q + 3])}; }
        LDS_WAIT(); asm volatile("" ::: "memory");
        GAS u32x4* eg = (GAS u32x4*)((GAS int*)eid + (size_t)row0 * 128); GAS u32x4* gg = (GAS u32x4*)((GAS float*)gate + (size_t)row0 * 128);
#pragma unroll
        for (int q = 0; q < 4; ++q) { eg[64 * q + lane] = img[64 * q + lane]; gg[64 * q + lane] = img[256 + 64 * q + lane]; }
        LDS_WAIT(); asm volatile("" ::: "memory");
        wt = wtn;
    }
}

constexpr float U8_SCALE = 95.5f, V8_SCALE = 56.0f;
typedef _Float16 h2_t __attribute__((ext_vector_type(2)));
__device__ __forceinline__ h2_t fp8x2_to_h2(unsigned w, bool hi) { return hi ? __builtin_amdgcn_cvt_scalef32_pk_f16_fp8(w, 1.0f, true) : __builtin_amdgcn_cvt_scalef32_pk_f16_fp8(w, 1.0f, false); }
#define VM_WAIT_ALL() do { asm volatile("" ::: "memory"); __builtin_amdgcn_s_waitcnt(0x0F70); asm volatile("" ::: "memory"); } while (0)
__device__ __forceinline__ void peer_gather(u32x4 (&t)[16], const char* tb, const LAS unsigned char* slot, int g) {
    const LAS u32x4* ep = (const LAS u32x4*)(slot + 64 * g);
    u32x4 e[4];
#pragma unroll
    for (int i = 0; i < 4; ++i) e[i] = ep[i];
#pragma unroll
    for (int i = 0; i < 4; ++i) { t[4 * i] = *(const GAS u32x4*)(tb + e[i].x); t[4 * i + 1] = *(const GAS u32x4*)(tb + e[i].y); t[4 * i + 2] = *(const GAS u32x4*)(tb + e[i].z); t[4 * i + 3] = *(const GAS u32x4*)(tb + e[i].w); }
}
__device__ __forceinline__ h2_t bf8e(unsigned d) { const unsigned r = __builtin_amdgcn_perm(0u, d, 0x020c000cu); return __builtin_bit_cast(h2_t, r); }
__device__ __forceinline__ h2_t bf8o(unsigned d) { const unsigned r = d & 0xff00ff00u; return __builtin_bit_cast(h2_t, r); }
__device__ __forceinline__ int dot16_i8(const u32x4 t, const u32x4 x) {
    return __builtin_amdgcn_sdot4((int)t.x, (int)x.x, __builtin_amdgcn_sdot4((int)t.y, (int)x.y, __builtin_amdgcn_sdot4((int)t.z, (int)x.z, __builtin_amdgcn_sdot4((int)t.w, (int)x.w, 0, false), false), false), false);
}
__device__ __forceinline__ void peer_u_dma(LAS unsigned char* slot, const unsigned* eoff, const unsigned char* XQ, const float* XSC, int r, int xq, int lane) {
    const unsigned char* src = lane < 32 ? (const unsigned char*)eoff + (size_t)r * 512 + 16 * lane
                             : (lane < 48 ? XQ + (size_t)r * DM + xq * 256 + 16 * (lane - 32) : (const unsigned char*)XSC + (size_t)r * 16);
    __builtin_amdgcn_global_load_lds((const GAS unsigned*)src, (LAS unsigned*)slot, 16, 0, 0);
}
struct XPlanes { unsigned h[4], l[4]; };
__device__ __forceinline__ XPlanes x_planes(const u32x4 x0, const u32x4 x1) {
    XPlanes P; P.h[0] = x0.x; P.l[0] = x0.y; P.h[1] = x0.z; P.l[1] = x0.w; P.h[2] = x1.x; P.l[2] = x1.y; P.h[3] = x1.z; P.l[3] = x1.w; return P;
}
__device__ __forceinline__ int dot32_i4(const u32x4 t, const XPlanes& P) {
    int a1 = 0, a2 = 0;
    a1 = __builtin_amdgcn_sdot8((int)t.x, (int)P.h[0], a1, false); a2 = __builtin_amdgcn_sdot8((int)t.x, (int)P.l[0], a2, false);
    a1 = __builtin_amdgcn_sdot8((int)t.y, (int)P.h[1], a1, false); a2 = __builtin_amdgcn_sdot8((int)t.y, (int)P.l[1], a2, false);
    a1 = __builtin_amdgcn_sdot8((int)t.z, (int)P.h[2], a1, false); a2 = __builtin_amdgcn_sdot8((int)t.z, (int)P.l[2], a2, false);
    a1 = __builtin_amdgcn_sdot8((int)t.w, (int)P.h[3], a1, false); a2 = __builtin_amdgcn_sdot8((int)t.w, (int)P.l[3], a2, false);
    return (a1 << 4) + a2;
}
__device__ __forceinline__ unsigned peer_u_compute(const u32x4 (&t)[16], const u32x4 x, const u32x4 x1, const float xs, int lane) {
    float part[16];
    const XPlanes XP = x_planes(x, x1);
#pragma unroll
    for (int i = 0; i < 16; ++i) part[i] = (float)dot32_i4(t[i], XP);
    float p8[8], p4[4], p2[2];
    { const bool up = (lane & 4) != 0;
#pragma unroll
      for (int q = 0; q < 8; ++q) { const float keep = up ? part[q + 8] : part[q], send = up ? part[q] : part[q + 8]; p8[q] = keep + xshfl<4>(send); } }
    { const bool up = (lane & 2) != 0;
#pragma unroll
      for (int q = 0; q < 4; ++q) { const float keep = up ? p8[q + 4] : p8[q], send = up ? p8[q] : p8[q + 4]; p4[q] = keep + __uint_as_float((unsigned)__builtin_amdgcn_mov_dpp((int)__float_as_uint(send), 0x4E, 0xf, 0xf, false)); } }
    { const bool up = (lane & 1) != 0;
#pragma unroll
      for (int q = 0; q < 2; ++q) { const float keep = up ? p4[q + 2] : p4[q], send = up ? p4[q] : p4[q + 2]; p2[q] = keep + __uint_as_float((unsigned)__builtin_amdgcn_mov_dpp((int)__float_as_uint(send), 0xB1, 0xf, 0xf, false)); } }
    return cvt_pk_bf16(p2[0] * xs, p2[1] * xs);
}
__device__ __forceinline__ int peer_next_row(int r, int step, bool skipctx) { r += step; if (skipctx && r < NROW && (r % NB) < CTXL) r += ((CTXL - (r % NB) + step - 1) / step) * step; return r; }
struct RowQ { LAS unsigned* ctr; int rank8, step, limit; unsigned tmax, pend; bool latent; };
__device__ __forceinline__ void rq_issue(RowQ& Q, int lane) { unsigned t = 0u; if (lane == 0) t = __hip_atomic_fetch_add(Q.ctr, 1u, __ATOMIC_RELAXED, __HIP_MEMORY_SCOPE_WORKGROUP); Q.pend = t; }
__device__ __forceinline__ int rq_take(RowQ& Q, int lane) {
    const unsigned t = (unsigned)__builtin_amdgcn_readfirstlane((int)Q.pend);
    rq_issue(Q, lane);
    const int r0 = Q.rank8 + (int)(t & 7u) + (int)(t >> 3) * Q.step;
    const int r = Q.latent ? (r0 / SEQ) * NB + CTXL + (r0 % SEQ) : r0;
    return (t < Q.tmax) ? r : NROW;
}
__device__ __forceinline__ void rq_init(RowQ& Q, Frame& F, int rank, int step, bool skipctx) {
    Q.ctr = (LAS unsigned*)(F.lds + 40960); Q.rank8 = rank * NWAVES; Q.step = step; Q.latent = skipctx; Q.limit = skipctx ? NBATCH * SEQ : NROW;
    Q.tmax = (Q.limit > Q.rank8) ? (unsigned)(((Q.limit - Q.rank8 + step - 1) / step) * 8) : 0u;
    if (F.tid == 0) *Q.ctr = 0u;
    __syncthreads();
    rq_issue(Q, F.lane);
}
template <bool DUMMY = false>
__device__ __forceinline__ void phase_peer_u(Frame& F, const unsigned char* XQ, const float* XSC, const unsigned char* U8, const unsigned* eoff, float* PART, bool skipctx) {
    const int lane = F.lane, xq = blockIdx.x & 3, rank = blockIdx.x >> 2, nr = (F.G - xq + 3) >> 2, step = nr * NWAVES;
    const int g = lane >> 3, c8 = lane & 7;
    const char* ub = (const char*)U8 + (size_t)xq * ((size_t)NEXP * 128) + c8 * 16;
    LAS unsigned char* ring = F.lds + F.wave * 4096;
    RowQ Q; rq_init(Q, F, rank, step, skipctx);
    int rA = rq_take(Q, lane);
    if (rA >= NROW) return;
    int rB = rq_take(Q, lane), i = 0;
    peer_u_dma(ring, eoff, XQ, XSC, rA, xq, lane);
    peer_u_dma(ring + 1024, eoff, XQ, XSC, rB < NROW ? rB : rA, xq, lane);
    VM_WAIT_ALL();
    u32x4 T0[16], T1[16];
    peer_gather(T0, ub, ring, g);
    GAS unsigned* const pout = (GAS unsigned*)PART + (size_t)xq * NROW * 64 + 8 * g + c8;
    unsigned res = 0u; int rP = -1;
#define PEER_U_STEP(TC, TN) { \
        VM_WAIT_ALL(); \
        const int rC = rq_take(Q, lane);     \
        const LAS unsigned char* sa = ring + (i & 3) * 1024; \
        const u32x4 x = *(const LAS u32x4*)(sa + 512 + 32 * c8), x1 = *(const LAS u32x4*)(sa + 528 + 32 * c8); const float xs = *(const LAS float*)(sa + 768); \
        peer_u_dma(ring + ((i + 2) & 3) * 1024, eoff, XQ, XSC, rC < NROW ? rC : rB, xq, lane); \
        peer_gather(TN, ub, ring + ((i + 1) & 3) * 1024, g); \
        if (rP >= 0) pout[(size_t)rP * 64] = res; \
        res = peer_u_compute(TC, x, x1, xs, lane); rP = rA; \
        rA = rB; rB = rC; ++i; }
#define PEER_U_TAIL(TC) { VM_WAIT_ALL(); const LAS unsigned char* sa = ring + (i & 3) * 1024; \
        const u32x4 x = *(const LAS u32x4*)(sa + 512 + 32 * c8), x1 = *(const LAS u32x4*)(sa + 528 + 32 * c8); const float xs = *(const LAS float*)(sa + 768); \
        if (rP >= 0) pout[(size_t)rP * 64] = res; \
        pout[(size_t)rA * 64] = peer_u_compute(TC, x, x1, xs, lane); }
    while (true) {
        if (rB >= NROW) { PEER_U_TAIL(T0) break; }
        PEER_U_STEP(T0, T1)
        if (rB >= NROW) { PEER_U_TAIL(T1) break; }
        PEER_U_STEP(T1, T0)
    }
#undef PEER_U_STEP
#undef PEER_U_TAIL
}

__device__ __forceinline__ float gelu_as(float v) {
    const float av = fabsf(v), t = __builtin_amdgcn_rcpf(av * 0.2316418882f + 1.0f);
    float q = t * 0.5307027145f + (-0.7265760135f); q = q * t + 0.7107068705f; q = q * t + (-0.142248368f); q = q * t + 0.127414796f; q = q * t;
    const float e = fexp2((v * v) * (-0.72134752044f)), m = v * (q * e);
    return v < 0.f ? m : v - m;
}
__device__ __forceinline__ void phase_peer_w(Frame& F, const float* PART, float* gw, bool skipctx) {
    const int gwv = F.vcu * NWAVES + F.wave, NGW = F.G * NWAVES, lane = F.lane;
    int r; DYN_ITEMS(r, NROW, 4) {
        if (skipctx && (r % NB) < CTXL) continue;
        float a0 = 0.f, a1 = 0.f;
#pragma unroll
        for (int g = 0; g < 4; ++g) { const unsigned w = ((const GAS unsigned*)PART)[((size_t)g * NROW + r) * 64 + lane]; a0 += bf_lo(w); a1 += bf_hi(w); }
        GAS f32x2* gp = (GAS f32x2*)(gw + (size_t)r * 128) + lane;
        const f32x2 gt = *gp;
        const float w0 = gelu_as(a0 * (1.0f / U8_SCALE)) * gt[0], w1 = gelu_as(a1 * (1.0f / U8_SCALE)) * gt[1];
        float m = fmaxf(fabsf(w0), fabsf(w1));
        m = fmaxf(m, xshfl<1>(m)); m = fmaxf(m, xshfl<2>(m)); m = fmaxf(m, xshfl<4>(m)); m = fmaxf(m, xshfl<8>(m)); m = fmaxf(m, xshfl<16>(m)); m = fmaxf(xmax32(m), 1e-30f);
        const float qs = 127.0f / m;
        const int q0 = __float2int_rn(w0 * qs), q1 = __float2int_rn(w1 * qs);
        ((GAS unsigned short*)(gw + (size_t)r * 128))[lane] = (unsigned short)(((unsigned)q0 & 0xFFu) | (((unsigned)q1 & 0xFFu) << 8));
        if (lane == 0) ((GAS float*)(gw + (size_t)r * 128))[32] = m * (1.0f / 127.0f) * (1.0f / V8_SCALE);
    }
}

__device__ __forceinline__ void peer_v_dma(LAS unsigned char* slot, const unsigned* eoff, const float* gw, int r, int lane) {
    const unsigned char* src = lane < 32 ? (const unsigned char*)eoff + (size_t)r * 512 + 16 * lane : (const unsigned char*)gw + (size_t)r * 512 + (lane < 40 ? 16 * (lane - 32) : 128);
    __builtin_amdgcn_global_load_lds((const GAS unsigned*)src, (LAS unsigned*)slot, 16, 0, 0);
}
struct PeerVW { u32x4 w; float s; };
struct PeerVRes { f32x2 xv, gv; unsigned xw; };
struct PeerVAddr { GAS float* xr; GAS bf16_t* xq; bool isctx; int b; };
__device__ __forceinline__ PeerVAddr peer_v_addr(bf16_t* xb, float* xc, int r, int cb, int c8, int lane) {
    PeerVAddr A; A.b = r / NB; const int j = r % NB;
    const int col = cb + 16 * c8 + ((lane >> 3) & 1) * 8 + ((lane >> 4) & 1) * 4 + ((lane >> 5) & 1) * 2;
    A.isctx = j < CTXL;
    A.xr = (GAS float*)(xc + ((size_t)A.b * CTXL + (A.isctx ? j : 0)) * DM + col);
    A.xq = (GAS bf16_t*)(xb + ((size_t)A.b * SEQ + (A.isctx ? 0 : (j - CTXL))) * DM + col);
    return A;
}
__device__ __forceinline__ void peer_v_pre(PeerVRes& R, bf16_t* xb, float* xc, const float* mod, int r, int cb, int c8, int lane, float vscale) {
    const PeerVAddr A = peer_v_addr(xb, xc, r, cb, c8, lane);
    const int col = cb + 16 * c8 + ((lane >> 3) & 1) * 8 + ((lane >> 4) & 1) * 4 + ((lane >> 5) & 1) * 2;
    R.xv = (f32x2){0.f, 0.f}; R.xw = 0u;
    if (A.isctx) R.xv = *(const GAS f32x2*)A.xr; else R.xw = *(const GAS unsigned*)A.xq;
    R.gv = *(const GAS f32x2*)(mod + (A.isctx ? 4 : A.b) * 6144 + 5 * DM + col);
}
__device__ __forceinline__ void peer_v_store(bf16_t* xb, float* xc, int r, int cb, int c8, int lane, const f32x2 xn) {
    const PeerVAddr A = peer_v_addr(xb, xc, r, cb, c8, lane);
    if (A.isctx) *(GAS f32x2*)A.xr = xn; else *(GAS unsigned*)A.xq = cvt_pk_bf16(xn[0], xn[1]);
}
__device__ __forceinline__ f32x2 peer_v_compute(const u32x4 (&t)[16], const PeerVW& M, const PeerVRes& R, bool isctx, int lane, float vscale) {
    int acc[16];
#pragma unroll
    for (int c = 0; c < 16; ++c) acc[c] = 0;
#pragma unroll
    for (int q = 0; q < 4; ++q) {
        const int wq = (int)M.w[q];
#pragma unroll
        for (int j = 0; j < 4; ++j) {
            const unsigned d0 = t[4 * q][j], d1 = t[4 * q + 1][j], d2 = t[4 * q + 2][j], d3 = t[4 * q + 3][j];
            const unsigned l01 = __builtin_amdgcn_perm(d1, d0, 0x05010400u), h01 = __builtin_amdgcn_perm(d1, d0, 0x07030602u);
            const unsigned l23 = __builtin_amdgcn_perm(d3, d2, 0x05010400u), h23 = __builtin_amdgcn_perm(d3, d2, 0x07030602u);
            acc[4 * j + 0] = __builtin_amdgcn_sdot4((int)__builtin_amdgcn_perm(l23, l01, 0x05040100u), wq, acc[4 * j + 0], false);
            acc[4 * j + 1] = __builtin_amdgcn_sdot4((int)__builtin_amdgcn_perm(l23, l01, 0x07060302u), wq, acc[4 * j + 1], false);
            acc[4 * j + 2] = __builtin_amdgcn_sdot4((int)__builtin_amdgcn_perm(h23, h01, 0x05040100u), wq, acc[4 * j + 2], false);
            acc[4 * j + 3] = __builtin_amdgcn_sdot4((int)__builtin_amdgcn_perm(h23, h01, 0x07060302u), wq, acc[4 * j + 3], false);
        }
    }
    int p8[8], p4[4], p2[2];
    { const bool up = (lane & 8) != 0;
#pragma unroll
      for (int q = 0; q < 8; ++q) { const int keep = up ? acc[q + 8] : acc[q], send = up ? acc[q] : acc[q + 8]; p8[q] = keep + __builtin_amdgcn_mov_dpp(send, 0x128, 0xf, 0xf, false); } }
#pragma unroll
    for (int q = 0; q < 4; ++q) { auto r = __builtin_amdgcn_permlane16_swap((unsigned)p8[q], (unsigned)p8[q + 4], false, false); p4[q] = (int)r[0] + (int)r[1]; }
#pragma unroll
    for (int q = 0; q < 2; ++q) { auto r = __builtin_amdgcn_permlane32_swap((unsigned)p4[q], (unsigned)p4[q + 2], false, false); p2[q] = (int)r[0] + (int)r[1]; }
    const f32x2 p1 = {(float)p2[0] * M.s, (float)p2[1] * M.s};
    const f32x2 xv = isctx ? R.xv : (f32x2){bf_lo(R.xw), bf_hi(R.xw)};
    return (f32x2){xv[0] + (R.gv[0] * vscale) * p1[0], xv[1] + (R.gv[1] * vscale) * p1[1]};
}
__device__ __forceinline__ void phase_peer_v(Frame& F, const unsigned char* V8, const unsigned* eoff, const float* gw, bf16_t* xb, float* xc, const float* mod, bool skipctx, float vscale) {
    const int lane = F.lane, xq = blockIdx.x & 7, rank = blockIdx.x >> 3, nr = (F.G - xq + 7) >> 3, step = nr * NWAVES;
    const int g = lane >> 3, c8 = lane & 7, cb = xq * 128;
    const char* vb = (const char*)V8 + (size_t)xq * ((size_t)NEXP * 128) + c8 * 16;
    LAS unsigned char* ring = F.lds + F.wave * 4096;
    RowQ Q; rq_init(Q, F, rank, step, skipctx);
    int rA = rq_take(Q, lane);
    if (rA >= NROW) return;
    int rB = rq_take(Q, lane), i = 0;
    peer_v_dma(ring, eoff, gw, rA, lane);
    peer_v_dma(ring + 1024, eoff, gw, rB < NROW ? rB : rA, lane);
    VM_WAIT_ALL();
    u32x4 T0[16], T1[16];
    peer_gather(T0, vb, ring, g);
    PeerVRes RA, RB; f32x2 res = {0.f, 0.f}; int rP = -1;
    peer_v_pre(RA, xb, xc, mod, rA, cb, c8, lane, vscale);
#define PEER_V_STEP(TC, TN) { \
        VM_WAIT_ALL(); \
        const int rC = rq_take(Q, lane);     \
        PeerVW W; { const LAS unsigned char* wsl = ring + (i & 3) * 1024; W.w = *(const LAS u32x4*)(wsl + 512 + 16 * g); W.s = *(const LAS float*)(wsl + 640); } \
        peer_v_dma(ring + ((i + 2) & 3) * 1024, eoff, gw, rC < NROW ? rC : rB, lane); \
        peer_gather(TN, vb, ring + ((i + 1) & 3) * 1024, g); \
        peer_v_pre(RB, xb, xc, mod, rB, cb, c8, lane, vscale); \
        if (rP >= 0) peer_v_store(xb, xc, rP, cb, c8, lane, res); \
        res = peer_v_compute(TC, W, RA, (rA % NB) < CTXL, lane, vscale); rP = rA; RA = RB; \
        rA = rB; rB = rC; ++i; }
#define PEER_V_TAIL(TC) { VM_WAIT_ALL(); PeerVW W; { const LAS unsigned char* wsl = ring + (i & 3) * 1024; W.w = *(const LAS u32x4*)(wsl + 512 + 16 * g); W.s = *(const LAS float*)(wsl + 640); } \
        if (rP >= 0) peer_v_store(xb, xc, rP, cb, c8, lane, res); \
        peer_v_store(xb, xc, rA, cb, c8, lane, peer_v_compute(TC, W, RA, (rA % NB) < CTXL, lane, vscale)); }
    while (true) {
        if (rB >= NROW) { PEER_V_TAIL(T0) break; }
        PEER_V_STEP(T0, T1)
        if (rB >= NROW) { PEER_V_TAIL(T1) break; }
        PEER_V_STEP(T1, T0)
    }
#undef PEER_V_STEP
#undef PEER_V_TAIL
}
#ifndef DIAG
#define DIAG 0
#endif
#if DIAG
#ifndef DIAG_TOL
#define DIAG_TOL 2.5e-3f
#endif
__device__ __forceinline__ float blk_max(LAS float* red, float v, int tid) {
    v = fmaxf(v, xshfl<1>(v)); v = fmaxf(v, xshfl<2>(v)); v = fmaxf(v, xshfl<4>(v)); v = fmaxf(v, xshfl<8>(v)); v = fmaxf(v, xshfl<16>(v)); v = xmax32(v);
    __syncthreads(); if ((tid & 63) == 0) red[tid >> 6] = v; __syncthreads();
    float r = red[0];
#pragma unroll
    for (int i = 1; i < 8; ++i) r = fmaxf(r, red[i]);
    __syncthreads(); return r;
}
__device__ __forceinline__ float blk_sum(LAS float* red, float v, int tid) {
    v = wave_sum(v);
    __syncthreads(); if ((tid & 63) == 0) red[tid >> 6] = v; __syncthreads();
    float r = 0.f;
#pragma unroll
    for (int i = 0; i < 8; ++i) r += red[i];
    __syncthreads(); return r;
}
template <int DQK, class KeyFn>
__device__ __forceinline__ float diag_attn(LAS float* sm, int tid, const bf16_t* qp, const bf16_t* kbase, int kpitch, int koff, const bf16_t* k2base, int k2pitch, int k2off,
                                           const bf16_t* vbase, int vpitch, int voff, int nkeys, KeyFn keyfn, float sink_l2, bool has_sink, const bf16_t* yp) {
    LAS float* mw = sm;
    LAS float* lw = sm + 8;
    LAS float* ow = sm + 16;
    LAS float* red = sm + 16 + 512;
    const int lane = tid & 63, w = tid >> 6;
    const float q0 = bf2f(qp[lane]); const float q1 = (DQK == 96 && lane < 32) ? bf2f(qp[64 + lane]) : 0.f;
    float m = -3.0e38f, l = 0.f, o = 0.f;
    for (int i = w; i < nkeys; i += 8) {
        size_t krow; float bias; bool valid; keyfn(i, krow, bias, valid);
        if (!valid) continue;
        float part = q0 * bf2f(kbase[krow * kpitch + koff + lane]);
        if (DQK == 96 && lane < 32) part += q1 * bf2f(k2base[krow * k2pitch + k2off + lane]);
        const float sc = wave_sum(part) + bias;
        const float mn = fmaxf(m, sc), al = fexp2(m - mn), pp = fexp2(sc - mn);
        m = mn; l = l * al + pp; o = o * al + pp * bf2f(vbase[krow * vpitch + voff + lane]);
    }
    __syncthreads();
    if (lane == 0) { mw[w] = m; lw[w] = l; }
    ow[w * 64 + lane] = o;
    __syncthreads();
    float M = mw[0];
#pragma unroll
    for (int i = 1; i < 8; ++i) M = fmaxf(M, mw[i]);
    if (has_sink) M = fmaxf(M, sink_l2);
    float lt = has_sink ? fexp2(sink_l2 - M) : 0.f, ot = 0.f;
#pragma unroll
    for (int i = 0; i < 8; ++i) { const float f = fexp2(mw[i] - M); lt += lw[i] * f; ot += ow[i * 64 + lane] * f; }
    float num = 0.f, den = 0.f;
    if (tid < 64) { const float r = ot / lt, y = bf2f(yp[tid]); num = (y - r) * (y - r); den = r * r; }
    num = blk_sum(red, num, tid); den = blk_sum(red, den, tid);
    return num / (den + 1e-20f);
}

__device__ __forceinline__ float diag_ret(LAS float* sm, int tid, const bf16_t* P, size_t rb0, int j, int h, float lgf, float lgb, const float* gnf, const float* gnb, const bf16_t* yp) {
    LAS float* ow = sm;
    LAS float* red = sm + 1024;
    const int lane = tid & 63, w = tid >> 6;
    const float q = bf2f(P[(rb0 + j) * PW + C_RQ + h * 64 + lane]);
    const int posj = (j < CTXL) ? (CTXL - 1 - j) : (CTXL + (NB - 1 - j));
    float of = 0.f, ob = 0.f;
    for (int s = w; s < NB; s += 8) {
        const int poss = (s < CTXL) ? (CTXL - 1 - s) : (CTXL + (NB - 1 - s));
        const bool inf = s <= j, inb = poss <= posj;
        if (!inf && !inb) continue;
        const bf16_t* pr = P + (rb0 + s) * PW + h * 64 + lane;
        const float qk = wave_sum(q * bf2f(pr[C_RK])); const float v = bf2f(pr[C_RV]);
        if (inf) of += fexp2(lgf * (float)(j - s)) * qk * v;
        if (inb) ob += fexp2(lgb * (float)(posj - poss)) * qk * v;
    }
    __syncthreads();
    ow[w * 64 + lane] = of; ow[512 + w * 64 + lane] = ob;
    __syncthreads();
    float tf = 0.f, tb = 0.f;
#pragma unroll
    for (int i = 0; i < 8; ++i) { tf += ow[i * 64 + lane]; tb += ow[512 + i * 64 + lane]; }
    const float muf = wave_sum(tf) * (1.f / 64.f), mub = wave_sum(tb) * (1.f / 64.f);
    const float vf = wave_sum((tf - muf) * (tf - muf)) * (1.f / 64.f), vb = wave_sum((tb - mub) * (tb - mub)) * (1.f / 64.f);
    const float gf = bf2f(P[(rb0 + j) * PW + C_RGF + h * 64 + lane]), gb = bf2f(P[(rb0 + j) * PW + C_RGB + h * 64 + lane]);
    const float r = silu_f(gf) * ((tf - muf) / sqrtf(vf + EPS)) * gnf[h * 64 + lane] + silu_f(gb) * ((tb - mub) / sqrtf(vb + EPS)) * gnb[h * 64 + lane];
    float num = 0.f, den = 0.f;
    if (tid < 64) { const float y = bf2f(yp[tid]); num = (y - r) * (y - r); den = r * r; }
    num = blk_sum(red, num, tid); den = blk_sum(red, den, tid);
    return num / (den + 1e-20f);
}

__device__ __forceinline__ void diag_check(Frame& F, const Inputs& I, unsigned char* ws, unsigned* code) {
    const int tid = F.tid;
    LAS float* sm = (LAS float*)F.lds;
    LAS float* raw = (LAS float*)(F.lds + 4096);
    LAS float* xn = (LAS float*)(F.lds + 4096 + 12544);
    LAS float* red = (LAS float*)(F.lds + 4096 + 12544 + 4096);
    const bf16_t* P = (const bf16_t*)(ws + WS_P); const bf16_t* KV = (const bf16_t*)(ws + WS_KV); const bf16_t* Y = (const bf16_t*)(ws + WS_XN);
    const float* MOD = (const float*)(ws + WS_MOD);
    const float tol = DIAG_TOL;
    for (int sidx = blockIdx.x; sidx < 256; sidx += F.G) {
        const int b = sidx & 3, si = sidx >> 2;
        static const int jl[16] = {0, 17, 128, 255, 256, 257, 256 + 63, 256 + 64, 256 + 127, 256 + 128, 256 + 129, 256 + 8191, 256 + 8064, 256 + 8063, 256 + 4095, 256 + 4160};
        int j; if (si < 16) { j = 0; for (int q = 0; q < 16; ++q) if (q == si) j = jl[q]; } else j = 256 + ((si * 2654435761u) >> 7) % 8192u;
        const int h = (si * 7 + 3) & 3;
        const size_t row = (size_t)b * NB + j;
        const bool isctx = j < CTXL; const int t = j - CTXL, prow = t >> 6, pcol = t & 63;
        {
            const float* xr = isctx ? I.ctx + ((size_t)b * CTXL + j) * DM : I.x + ((size_t)b * SEQ + t) * DM;
            const float* mv = MOD + (isctx ? 4 : b) * 6144;
            float ss = 0.f; for (int k = tid; k < DM; k += NTHR) ss += xr[k] * xr[k];
            ss = blk_sum(red, ss, tid);
            const float rs = 1.0f / sqrtf(ss / DM + EPS);
            for (int k = tid; k < DM; k += NTHR) { const float y = xr[k] * rs * I.norm_mix_g[k] * (1.f + mv[DM + k]) + mv[k]; xn[k] = bf_lo(cvt_pk_bf16(y, 0.f)); }
            __syncthreads();
            for (int c = tid; c < INW; c += NTHR) { float a = 0.f; for (int k = 0; k < DM; ++k) a += xn[k] * bf_lo(cvt_pk_bf16(I.w_in[(size_t)k * INW + c], 0.f)); raw[c] = a; }
            __syncthreads();
            float num = 0.f, den = 0.f;
            for (int c = tid; c < INW; c += NTHR) {
                const int oc = orig_col(c);
                float ref = raw[oc], sc = 1.f;
                int rb = -1, R = 0;
                if (oc < 384) { if (oc % 96 >= 64) { rb = oc - (oc % 96) + 64; R = 32; } sc = 0.10206207261596577f * LOG2E; }
                else if (oc >= C_KR && oc < C_SWAQ) { rb = C_KR; R = 32; }
                else if (oc >= C_SWAQ && oc < C_SWAK) { rb = C_SWAQ + ((oc - C_SWAQ) & ~63); R = 64; sc = 0.125f * LOG2E; }
                else if (oc >= C_SWAK && oc < C_SWAV) { rb = C_SWAK + ((oc - C_SWAK) & ~63); R = 64; }
                else if (oc >= C_NAQ && oc < C_NAK) sc = 0.125f * LOG2E;
                else if (oc >= C_RK && oc < C_RV) sc = 0.125f;
                if (rb >= 0 && !isctx) {
                    const int quarter = R / 4, p = oc - rb, part = p / (R / 2), which = (p % (R / 2)) / quarter, jj = p % quarter;
                    const float inv = __powf(10000.f, -(float)jj / (float)quarter);
                    const float ang = (float)(part ? pcol : prow) * inv;
                    const float rev = ang * 0.15915494309189535f; const float cs = __builtin_amdgcn_cosf(rev), sn = __builtin_amdgcn_sinf(rev);
                    const float x1 = raw[rb + part * (R / 2) + jj], x2 = raw[rb + part * (R / 2) + quarter + jj];
                    ref = which ? (x1 * sn + x2 * cs) : (x1 * cs - x2 * sn);
                }
                ref *= sc;
                const float got = bf2f(P[row * PW + c]);
                num += (got - ref) * (got - ref); den += ref * ref;
            }
            num = blk_sum(red, num, tid); den = blk_sum(red, den, tid);
            if (tid == 0 && num > tol * den) atomicOr(code, 1u);
        }
        {
            const float* g = I.mla_kv_norm_g; const float* wu = I.mla_w_ukv;
            float ss = 0.f; for (int k = tid; k < 128; k += NTHR) { const float v = bf2f(P[row * PW + C_CKV + k]); ss += v * v; }
            ss = blk_sum(red, ss, tid);
            const float rs = 1.0f / sqrtf(ss / 128.f + EPS);
            float num = 0.f, den = 0.f;
            { const int n = tid; float a = 0.f; for (int k = 0; k < 128; ++k) a += bf2f(P[row * PW + C_CKV + k]) * g[k] * wu[k * KVW + n]; a *= rs;
              const float got = bf2f(KV[row * KVW + n]); num = (got - a) * (got - a); den = a * a; }
            num = blk_sum(red, num, tid); den = blk_sum(red, den, tid);
            if (tid == 0 && num > tol * den) atomicOr(code, 16u);
        }
        const size_t rb0 = (size_t)b * NB;
        {
            auto keyfn = [&](int i, size_t& krow, float& bias, bool& valid) { krow = rb0 + i; bias = 0.f; valid = true; };
            const float e = diag_attn<96>(sm, tid, P + row * PW + h * 96, KV, KVW, h * 128, P, PW, C_KR, KV, KVW, h * 128 + 64, isctx ? CTXL : NB, keyfn, 0.f, false, Y + row * DM + h * 64);
            if (tid == 0 && e > tol) atomicOr(code, 2u);
        }
        {
            const int g = h >> 1;
            auto keyfn = [&](int i, size_t& krow, float& bias, bool& valid) { krow = rb0 + i; bias = 0.f;
                if (i < CTXL) valid = true; else { const int kp = i - CTXL; valid = (kp - t <= 128) && (t - kp <= 128); } };
            const float e = diag_attn<64>(sm, tid, P + row * PW + C_SWAQ + h * 64, P, PW, C_SWAK + g * 64, P, PW, 0, P, PW, C_SWAV + g * 64, isctx ? CTXL : NB, keyfn,
                                          I.swa_sink[h] * LOG2E, true, Y + row * DM + 256 + h * 64);
            if (tid == 0 && e > tol) atomicOr(code, 4u);
        }
        {
            int rs = prow - 4; rs = rs < 0 ? 0 : (rs > 120 ? 120 : rs); int cs = pcol - 8; cs = cs < 0 ? 0 : (cs > 48 ? 48 : cs);
            const float* rpb = I.na_rpb + h * 15 * 31;
            auto keyfn = [&](int i, size_t& krow, float& bias, bool& valid) { krow = rb0 + i; bias = 0.f;
                if (i < CTXL) valid = true; else { const int kp = i - CTXL, kr = kp >> 6, kc = kp & 63; valid = (kr >= rs && kr < rs + 8 && kc >= cs && kc < cs + 16);
                    if (valid) bias = rpb[(kr - prow + 7) * 31 + (kc - pcol + 15)] * LOG2E; } };
            const float e = diag_attn<64>(sm, tid, P + row * PW + C_NAQ + h * 64, P, PW, C_NAK + h * 64, P, PW, 0, P, PW, C_NAV + h * 64, isctx ? CTXL : NB, keyfn, 0.f, false, Y + row * DM + 512 + h * 64);
            if (tid == 0 && e > tol) atomicOr(code, 8u);
        }
        {
            const float e = diag_ret(sm, tid, P, rb0, j, h, log2_sigmoid(I.ret_decay_f[h]), log2_sigmoid(I.ret_decay_b[h]), I.ret_gn_f, I.ret_gn_b, Y + row * DM + 768 + h * 64);
            if (tid == 0 && e > tol) atomicOr(code, 32u);
        }
    }
}
#endif
constexpr int N_PHASES = 26;
#ifndef MK_SINGLE
#define MK_SINGLE 1
#endif
__device__ __forceinline__ Frame fresh(const Frame& F) { Frame f = F; int ln = lane_id(); asm volatile("" : "+v"(ln)); f.lane = ln; f.tid = F.wave * 64 + ln; return f; }
struct Args { Inputs in; float* out; unsigned char* ws; int ph_lo, ph_hi, li, pad; };

__global__ void __launch_bounds__(NTHR, 2) fwd_kernel(Args args) {
    extern __shared__ __attribute__((aligned(16))) unsigned char lds_raw[];
    Frame F;
    F.lds = (LAS unsigned char*)lds_raw;
    F.tid = threadIdx.x; F.lane = F.tid & 63; F.wave = __builtin_amdgcn_readfirstlane(F.tid >> 6);
    F.G = gridDim.x; { const int bx = blockIdx.x; F.vcu = (F.G % 8 == 0) ? (bx % 8) * (F.G / 8) + bx / 8 : bx; }
    typedef const __attribute__((address_space(4))) Args* KArgP;
    const KArgP kap = (KArgP)__builtin_amdgcn_kernarg_segment_ptr();
#define KARGV(f) ({ KArgP _p = kap; asm volatile("" : "+s"(_p)); _p->f; })
#define KARG(f) as_global(KARGV(f))
    unsigned char* ws = KARGV(ws);
    volatile LAS unsigned* MISC = (volatile LAS unsigned*)(F.lds + MISC_OFF);
    for (int u = F.tid; u < (LDS_BYTES - LDSCTL_OFF) / 4; u += NTHR) ((LAS unsigned*)(F.lds + LDSCTL_OFF))[u] = 0u;
    __syncthreads();
    unsigned* ctl = (unsigned*)(ws + WS_CTL);
    XcdBarrier bar = xcd_barrier_post(ctl + CW_BAR + KARGV(li) * XCD_BAR_WORDS, MISC + 8);
    const int lo = KARGV(ph_lo), hi = KARGV(ph_hi);
#ifndef PH_MASK
#define PH_MASK 0x3ff
#endif
#define PHM(j) ((PH_MASK >> (j)) & 1)
#ifndef UM
#define UM 0xff
#endif
#ifndef REP_J
#define REP_J -1
#define REP_N 1
#endif
#define REPS(j) for (int rep_ = 0; rep_ < ((REP_J == (j)) ? REP_N : 1); ++rep_)
#define IN(k) ({ int lo_ = lo, hi_ = hi; asm volatile("" : "+s"(lo_), "+s"(hi_)); lo_ <= (k) && (k) < hi_; })
#if defined(TPH) || defined(TPB)
#define TSTAMP(k) do { if (blockIdx.x == 0 && threadIdx.x == 0) __hip_atomic_store(ctl + 32 + (k), (unsigned)wall_clock64() | 1u, __ATOMIC_RELAXED, __HIP_MEMORY_SCOPE_AGENT); } while (0)
#else
#define TSTAMP(k) do { } while (0)
#endif
#ifdef TPB
#define BSTAMP(k) do { if ((k) == (TPB) && threadIdx.x == 0) __hip_atomic_store(ctl + 64 + blockIdx.x, (unsigned)wall_clock64() | 1u, __ATOMIC_RELAXED, __HIP_MEMORY_SCOPE_AGENT); } while (0)
#else
#define BSTAMP(k) do { } while (0)
#endif
#define SEAM(k) do { if (IN(k) && IN((k) + 1)) { BSTAMP(k); xcd_barrier(bar); TSTAMP((k) + 1); } } while (0)

#define WSQ() unsigned char* wsq_ = ws; asm volatile("" : "+s"(wsq_)); unsigned char* wsq = as_global(wsq_); \
    float* MOD = (float*)(wsq + WS_MOD); bf16_t* XN = (bf16_t*)(wsq + WS_XN); bf16_t* P = (bf16_t*)(wsq + WS_P); bf16_t* KV = (bf16_t*)(wsq + WS_KV); float* SSQ = (float*)(wsq + WS_SSQ); \
    float* XC = (float*)(wsq + WS_XC); float* RS = (float*)(wsq + WS_RS); unsigned char* UB = wsq + WS_UB; unsigned char* VB = wsq + WS_VB; _Float16* S16 = (_Float16*)(wsq + WS_P); \
    int* EID = (int*)(wsq + WS_KV); float* GATE = (float*)(wsq + WS_GATE); bf16_t* XB = (bf16_t*)(wsq + WS_XB); const float* mod = MOD + (size_t)l * 5 * 6144; \
    const float* xl_cur = (l == 0) ? KARG(in.x) : (const float*)nullptr; const float* xc_cur = (l == 0) ? KARG(in.ctx) : XC; \
    (void)XN; (void)P; (void)KV; (void)SSQ; (void)XC; (void)RS; (void)UB; (void)VB; (void)S16; (void)EID; (void)GATE; (void)XB; (void)mod; (void)xl_cur; (void)xc_cur;

    TSTAMP(0);
    if (IN(0)) REPS(100) { { const Inputs Iv = args.in; phase_prologue(F, Iv, as_global(ws)); }; }
    SEAM(0);

#pragma nounroll
    for (int l0 = 0; l0 < NLAYER; ++l0) {
        int l = l0; asm volatile("" : "+s"(l));
        const int pb = 1 + 12 * l;
        const bool last = (l == NLAYER - 1);

        if (PHM(0) && IN(pb + 0)) REPS(0) { Frame Fq = fresh(F); WSQ();
            phase_norm_mod(Fq, xl_cur, XB, xc_cur, KARG(in.norm_mix_g) + l * DM, mod, 0, XN, false, SSQ);
            phase_convert_uv(Fq, KARG(in.peer_u) + (size_t)l * NEXP * DM, KARG(in.peer_v) + (size_t)l * NEXP * DM, wsq);
        }
        SEAM(pb + 0);

        if (PHM(1) && IN(pb + 1)) REPS(1) { Frame Fq = fresh(F); WSQ();
            pg8::Gemm g{XN, (const bf16_t*)(wsq + WS_WIN) + (size_t)l * PW * DM};
            pg8::LinOrder S{PW / 256, (NROW / 256) * (PW / 256), Fq.G, Fq.vcu, 0};
            pg8::EpiProj E{P, SSQ, (const f32x2*)(wsq + WS_TAB), (const f32x2*)(wsq + WS_TAB + 16384), ctl + 69632 + l * 32 + 16};
            pg8::gemm_phase<pg8::EpiProj, pg8::LinOrder, DM, DM, DM, true>(Fq.lds, Fq.wave, g, S, E);
        }
        SEAM(pb + 1);

        if (PHM(2) && IN(pb + 2)) REPS(2) { Frame Fq = fresh(F); WSQ();
            {
                pg8::Gemm g{P + C_CKV, (const bf16_t*)(wsq + WS_WUKV) + (size_t)l * KVW * 128};
                pg8::LinOrder S{KVW / 256, (NROW / 256) * (KVW / 256), Fq.G, Fq.vcu, 0};
                pg8::EpiKV E{KV, SSQ, ctl + 69632 + l * 32};
                pg8::gemm_phase<pg8::EpiKV, pg8::LinOrder, 128, PW, 128, true>(Fq.lds, Fq.wave, g, S, E);
            }
            __syncthreads();
            const RetArgs RA{P, XN, RS, KARG(in.ret_decay_f) + l * 4, KARG(in.ret_decay_b) + l * 4, KARG(in.ret_gn_f) + l * 256, KARG(in.ret_gn_b) + l * 256};
            const AttnArgs AA{P, KV, XN, KARG(in.swa_sink) + l * 4, KARG(in.na_rpb) + (size_t)l * 4 * 15 * 31, ctl + 69632 + l * 32};
            const int n_ctx = last ? 0 : 16;
            if (UM & 1) REPS(21) for (int u = Fq.vcu; u < 512; u += Fq.G) attn_unit<AT_SWA, false>(Fq, AA, u);
            if (UM & 2) REPS(22) for (int u = Fq.vcu; u < 512; u += Fq.G) attn_unit<AT_NA, false>(Fq, AA, u);
            if (UM & 4) REPS(23) ret_local_loop(Fq, RA, (Fq.vcu + 128) % Fq.G, Fq.G, 16 * 66);
            if (UM & 8) for (int u = (Fq.vcu + 32) % Fq.G; u < n_ctx; u += Fq.G) attn_unit<AT_SWA, true>(Fq, AA, u);
            if (UM & 16) for (int u = (Fq.vcu + 48) % Fq.G; u < n_ctx; u += Fq.G) attn_unit<AT_NA, true>(Fq, AA, u);
        }
        SEAM(pb + 2);

        if (PHM(3) && IN(pb + 3)) { Frame Fq = fresh(F); WSQ();
            const RetArgs RA{P, XN, RS, KARG(in.ret_decay_f) + l * 4, KARG(in.ret_decay_b) + l * 4, KARG(in.ret_gn_f) + l * 256, KARG(in.ret_gn_b) + l * 256};
            ret_scan(Fq, RA);
        }
        SEAM(pb + 3);

        if (PHM(4) && IN(pb + 4)) REPS(4) { Frame Fq = fresh(F); WSQ();
            const RetArgs RA{P, XN, RS, KARG(in.ret_decay_f) + l * 4, KARG(in.ret_decay_b) + l * 4, KARG(in.ret_gn_f) + l * 256, KARG(in.ret_gn_b) + l * 256};
            const AttnArgs AA{P, KV, XN, KARG(in.swa_sink) + l * 4, KARG(in.na_rpb) + (size_t)l * 4 * 15 * 31, ctl + 69632 + l * 32};
            const int n_ctx = last ? 0 : 16;
#if REP_J == 40
            for (int rep_ = 0; rep_ < REP_N - 1; ++rep_) for (int u = Fq.vcu; u < 512; u += Fq.G) attn_unit<AT_MLA, false, true>(Fq, AA, u);
#endif
            if (UM & 32) for (int u = Fq.vcu; u < 512; u += Fq.G) attn_unit<AT_MLA, false>(Fq, AA, u);
            if (UM & 64) for (int u = (Fq.vcu + Fq.G - 16) % Fq.G; u < n_ctx; u += Fq.G) attn_unit<AT_MLA, true>(Fq, AA, u);
            if (UM & 128) REPS(41) ret_out_loop(Fq, RA, (Fq.vcu + 16) % Fq.G, Fq.G, 16 * 66, last);
        }
        SEAM(pb + 4);

        if (PHM(5) && IN(pb + 5)) { Frame Fq = fresh(F); WSQ();
            pg8::Gemm g{XN, (const bf16_t*)(wsq + WS_WOUT) + (size_t)l * DM * DM};
            pg8::LinOrder S{DM / 256, (last ? 128 : 132) * (DM / 256), Fq.G, Fq.vcu, last ? 1 : 0};
            pg8::EpiResid E{xl_cur, XB, xc_cur, XC, mod};
            pg8::gemm_phase<pg8::EpiResid, pg8::LinOrder, DM, DM, DM, true>(Fq.lds, Fq.wave, g, S, E);
        }
        SEAM(pb + 5);

#if REP_J == 60
        for (int rg_ = 0; rg_ < REP_N; ++rg_) {
#endif
        if (PHM(6) && IN(pb + 6)) REPS(6) { Frame Fq = fresh(F); WSQ(); phase_norm_mod<true>(Fq, nullptr, XB, XC, KARG(in.norm_ffn_g) + l * DM, mod, 3, XN, last, nullptr, wsq + WS_XQ, (float*)(wsq + WS_XSC)); }
        SEAM(pb + 6);
#ifdef EXTRA_BAR
        if (IN(pb + 6) && IN(pb + 7)) for (int eb = 0; eb < EXTRA_BAR; ++eb) xcd_barrier(bar);
#endif

#if REP_J == 70
        if (PHM(7) && IN(pb + 7)) for (int rep_ = 0; rep_ < REP_N - 1; ++rep_) { Frame Fq = fresh(F); WSQ();
            pg8::Gemm g{XN, (const bf16_t*)(wsq + WS_WSC) + (size_t)l * 2048 * DM};
            pg8::LinOrder S{2048 / 256, (last ? 128 : 132) * (2048 / 256), Fq.G, Fq.vcu, last ? 1 : 0};
            pg8::EpiNull E{(float*)(wsq + WS_CTL + 4096)};
            pg8::gemm_phase<pg8::EpiNull, pg8::LinOrder, DM, DM, DM, true>(Fq.lds, Fq.wave, g, S, E); }
#endif
        if (PHM(7) && IN(pb + 7)) REPS(7) { Frame Fq = fresh(F); WSQ();
            pg8::Gemm g{XN, (const bf16_t*)(wsq + WS_WSC) + (size_t)l * 2048 * DM};
            pg8::LinOrder S{2048 / 256, (last ? 128 : 132) * (2048 / 256), Fq.G, Fq.vcu, last ? 1 : 0};
            pg8::EpiScore E{S16};
            pg8::gemm_phase<pg8::EpiScore, pg8::LinOrder, DM, DM, DM, true>(Fq.lds, Fq.wave, g, S, E);
        }
        SEAM(pb + 7);

        if (PHM(8) && IN(pb + 8)) REPS(8) { Frame Fq = fresh(F); WSQ(); phase_topk(Fq, S16, EID, GATE, last); }
        SEAM(pb + 8);

#if REP_J == 90
        if (PHM(9) && IN(pb + 9)) for (int rep_ = 0; rep_ < REP_N - 1; ++rep_) { Frame Fq = fresh(F); WSQ(); phase_peer_u<true>(Fq, wsq + WS_XQ, (const float*)(wsq + WS_XSC), UB, (const unsigned*)EID, (float*)(wsq + WS_P), last); }
#endif
        if (PHM(9) && IN(pb + 9)) REPS(9) { Frame Fq = fresh(F); WSQ(); phase_peer_u(Fq, wsq + WS_XQ, (const float*)(wsq + WS_XSC), UB, (const unsigned*)EID, (float*)(wsq + WS_P), last); }
        SEAM(pb + 9);

        if (PHM(9) && IN(pb + 10)) { Frame Fq = fresh(F); WSQ(); phase_peer_w(Fq, (const float*)(wsq + WS_P), GATE, last); }
        SEAM(pb + 10);
#if REP_J == 60
        }
#endif

        if (PHM(9) && IN(pb + 11)) REPS(11) { Frame Fq = fresh(F); WSQ(); float vsc = 1.0f;
#ifdef PEER_SCALE
            vsc = PEER_SCALE;
#endif
            if (REP_J == 11) { vsc = (rep_ == REP_N - 1) ? 1.0f : 0.0f; asm volatile("" : "+v"(vsc)); }
            phase_peer_v(Fq, VB, (const unsigned*)EID, GATE, XB, XC, mod, last, vsc); }
        SEAM(pb + 11);
    }

#if DIAG
    if (IN(25)) { const float dsc = 1.0f + 0.05f * (float)__hip_atomic_load(ctl + 8, __ATOMIC_RELAXED, __HIP_MEMORY_SCOPE_AGENT); { Frame Fq = fresh(F); phase_final_norm(Fq, (const bf16_t*)as_global(ws + WS_XB), KARG(out), KARG(in.final_norm_g), dsc); } }
#elif defined(TPB)
    if (IN(25)) { unsigned t0; do { t0 = __hip_atomic_load(ctl + 32 + TPB, __ATOMIC_RELAXED, __HIP_MEMORY_SCOPE_AGENT); } while (t0 == 0u);
        int mn = 0x7fffffff, mx = 0;
#ifndef TPB_XQ
#define TPB_XQ -1
#endif
        for (int b = 0; b < (int)gridDim.x; ++b) { if (TPB_XQ >= 0 && (b & 7) != TPB_XQ) continue; const int d = (int)(__hip_atomic_load(ctl + 64 + b, __ATOMIC_RELAXED, __HIP_MEMORY_SCOPE_AGENT) - t0); mn = d < mn ? d : mn; mx = d > mx ? d : mx; }
        int b1 = (mn - (TP_OFF) * 100) / ((TP_UNIT) * 100), b2 = (mx - (TP_OFF2) * 100) / ((TP_UNIT2) * 100);
        b1 = b1 < 0 ? 0 : (b1 > 6 ? 6 : b1); b2 = b2 < 0 ? 0 : (b2 > 5 ? 5 : b2);
        const float dsc = 1.0f + 0.05f * (float)(b1 + 7 * b2);
        { Frame Fq = fresh(F); phase_final_norm(Fq, (const bf16_t*)as_global(ws + WS_XB), KARG(out), KARG(in.final_norm_g), dsc); } }
#elif defined(TPH)
    if (IN(25)) { unsigned ta, tb, tc, td; do { ta = __hip_atomic_load(ctl + 32 + TP_A, __ATOMIC_RELAXED, __HIP_MEMORY_SCOPE_AGENT); tb = __hip_atomic_load(ctl + 32 + TP_B, __ATOMIC_RELAXED, __HIP_MEMORY_SCOPE_AGENT);
            tc = __hip_atomic_load(ctl + 32 + TP_A2, __ATOMIC_RELAXED, __HIP_MEMORY_SCOPE_AGENT); td = __hip_atomic_load(ctl + 32 + TP_B2, __ATOMIC_RELAXED, __HIP_MEMORY_SCOPE_AGENT); } while (ta == 0u || tb == 0u || tc == 0u || td == 0u);
        int b1 = ((int)(tb - ta) - (TP_OFF) * 100) / ((TP_UNIT) * 100), b2 = ((int)(td - tc) - (TP_OFF2) * 100) / ((TP_UNIT2) * 100);
        b1 = b1 < 0 ? 0 : (b1 > 6 ? 6 : b1); b2 = b2 < 0 ? 0 : (b2 > 5 ? 5 : b2);
        const float dsc = 1.0f + 0.05f * (float)(b1 + 7 * b2);
        { Frame Fq = fresh(F); phase_final_norm(Fq, (const bf16_t*)as_global(ws + WS_XB), KARG(out), KARG(in.final_norm_g), dsc); } }
#else
    if (IN(25)) { { Frame Fq = fresh(F); phase_final_norm(Fq, (const bf16_t*)as_global(ws + WS_XB), KARG(out), KARG(in.final_norm_g), 1.0f); } }
#endif
#undef IN
#undef SEAM
}

#if DIAG
__global__ void __launch_bounds__(NTHR, 2) diag_kernel(Args args) {
    extern __shared__ __attribute__((aligned(16))) unsigned char lds_raw[];
    Frame F; F.lds = (LAS unsigned char*)lds_raw; F.tid = threadIdx.x; F.lane = F.tid & 63; F.wave = __builtin_amdgcn_readfirstlane(F.tid >> 6); F.G = gridDim.x; F.vcu = blockIdx.x;
    diag_check(F, args.in, args.ws, (unsigned*)(args.ws + WS_CTL) + 8);
}
#endif
extern "C" void kernel_launch(void* const* d_in, const int* in_sizes, int n_in, void* d_out, int out_size, void* d_ws, size_t ws_size, hipStream_t stream) {
    static int grid = 0;
    if (grid == 0) {
        if (n_in != 25 || in_sizes[0] != NBATCH * SEQ * DM || out_size != NBATCH * SEQ * DM || ws_size < WS_END) {
            fprintf(stderr, "kernel_launch: unexpected problem (n_in %d, in0 %d, out %d, ws %zu < %zu); nothing launched\n", n_in, n_in > 0 ? in_sizes[0] : -1, out_size, ws_size, (size_t)WS_END); grid = -1; return; }
        int dev = 0, cus = 0, per_cu = 0;
        if (hipGetDevice(&dev) != hipSuccess || hipDeviceGetAttribute(&cus, hipDeviceAttributeMultiprocessorCount, dev) != hipSuccess) { grid = -1; return; }
#if DIAG
        (void)hipFuncSetAttribute((const void*)diag_kernel, hipFuncAttributeMaxDynamicSharedMemorySize, LDS_BYTES);
#endif
        if (hipFuncSetAttribute((const void*)fwd_kernel, hipFuncAttributeMaxDynamicSharedMemorySize, LDS_BYTES) != hipSuccess) { fprintf(stderr, "kernel_launch: hipFuncSetAttribute failed\n"); grid = -1; return; }
        if (hipOccupancyMaxActiveBlocksPerMultiprocessor(&per_cu, (const void*)fwd_kernel, NTHR, LDS_BYTES) != hipSuccess || per_cu < 1) {
            fprintf(stderr, "kernel_launch: occupancy query reports %d workgroups per CU\n", per_cu); (void)hipGetLastError(); if (per_cu < 1) { grid = -1; return; } }
        grid = cus;
    }
    if (grid < 0) return;
    (void)hipMemsetAsync((char*)d_ws + WS_CTL, 0, CTL_ZERO_BYTES, stream);
    Args a{};
    const float** ip = (const float**)&a.in;
    for (int i = 0; i < 25; ++i) ip[i] = (const float*)d_in[i];
    a.out = (float*)d_out; a.ws = (unsigned char*)d_ws;
#if DIAG
    a.ph_lo = 0; a.ph_hi = 6; a.li = 0; hipLaunchKernelGGL(fwd_kernel, dim3(grid), dim3(NTHR), LDS_BYTES, stream, a);
    hipLaunchKernelGGL(diag_kernel, dim3(grid), dim3(NTHR), LDS_BYTES, stream, a);
    a.ph_lo = 6; a.ph_hi = N_PHASES; a.li = 1; hipLaunchKernelGGL(fwd_kernel, dim3(grid), dim3(NTHR), LDS_BYTES, stream, a);
#elif MK_SINGLE
    a.ph_lo = 0; a.ph_hi = N_PHASES;
    hipLaunchKernelGGL(fwd_kernel, dim3(grid), dim3(NTHR), LDS_BYTES, stream, a);
#else
    for (int p = 0; p < N_PHASES; ++p) { a.ph_lo = p; a.ph_hi = p + 1; hipLaunchKernelGGL(fwd_kernel, dim3(grid), dim3(NTHR), LDS_BYTES, stream, a); }
#endif
}
```
